# Optimizing an MI355X kernel written in HIP

```python
import math
import jax
import jax.numpy as jnp
from jax import lax
import numpy as np

D_MODEL = 1024
BATCH = 1
SEQ = 16384
DEPTH = 2
DEC_BATCH = 4
DEC_SEQ = 4096
PAST_LEN = 128

HY_WIDTH = D_MODEL // 2
HY_ORDER = 2
SHORT_CONV = 3
FILTER_EMB = 33
FILTER_HIDDEN = 64
DECAY_TARGET = 0.01
FAST_DECAY_PCT = 0.3
SLOW_DECAY_PCT = 1.5
HEAD_DIM = 64
N_HEADS = 8
N_KV_HEADS = 2
ATT_WIDTH = N_HEADS * HEAD_DIM
KV_WIDTH = N_KV_HEADS * HEAD_DIM
WINDOW = 128
BLOCK = 128
ROPE_THETA = 10000.0
N_BRANCH = 2
IN_WIDTH = 3 * HY_WIDTH + ATT_WIDTH + 2 * KV_WIDTH + N_BRANCH * D_MODEL
N_EXPERTS = 16
CAPACITY_FACTOR = 2
D_FF = 2816
EPS = 1e-6

kernel_name = 'hyena_swa_ec_moe_adaln_encoder'


def rms_norm(x, g):
    xf = x.astype(jnp.float32)
    y = xf * lax.rsqrt(jnp.mean(xf * xf, axis=-1, keepdims=True) + EPS)
    return (y * g.astype(jnp.float32)).astype(x.dtype)


def short_conv(u, w, b):
    up = jnp.pad(u, ((0, 0), (1, 1), (0, 0)))
    return up[:, :-2] * w[0] + up[:, 1:-1] * w[1] + up[:, 2:] * w[2] + b


def hyena_filters(L, p):
    t = jnp.linspace(0.0, 1.0, L, dtype=jnp.float32)[:, None]
    bands = (FILTER_EMB - 1) // 2
    f = jnp.linspace(1e-4, bands - 1, bands, dtype=jnp.float32)[None, :]
    w = (2.0 * math.pi / L) * jnp.arange(L, dtype=jnp.float32)[:, None]
    z = jnp.concatenate([t, jnp.cos(f * w), -jnp.sin(f * w)], axis=-1)
    fr = p['flt_freq'].astype(jnp.float32)
    h = jnp.sin(fr * (z @ p['flt_w1'].astype(jnp.float32) + p['flt_b1'].astype(jnp.float32)))
    h = jnp.sin(fr * (h @ p['flt_w2'].astype(jnp.float32) + p['flt_b2'].astype(jnp.float32)))
    h = jnp.sin(fr * (h @ p['flt_w3'].astype(jnp.float32) + p['flt_b3'].astype(jnp.float32)))
    h = (h @ p['flt_w_out'].astype(jnp.float32)).reshape(L, 2, HY_ORDER, HY_WIDTH)
    max_decay = math.log(DECAY_TARGET) / FAST_DECAY_PCT
    min_decay = math.log(DECAY_TARGET) / SLOW_DECAY_PCT
    deltas = jnp.abs(jnp.linspace(min_decay, max_decay, HY_WIDTH, dtype=jnp.float32))
    h = h * jnp.exp(-t * deltas)[:, None, None, :]
    fwd, bwd = h[:, 0], h[:, 1]
    k = jnp.concatenate([fwd, jnp.zeros((1, HY_ORDER, HY_WIDTH), jnp.float32), bwd[:0:-1]], axis=0)
    k = k * lax.rsqrt(jnp.sum(k * k, axis=0, keepdims=True) + EPS)
    return jnp.fft.rfft(k, n=2 * L, axis=0)


def long_conv(u, kf):
    L = u.shape[1]
    uf = jnp.fft.rfft(u.astype(jnp.float32), n=2 * L, axis=1)
    y = jnp.fft.irfft(uf * kf[None], n=2 * L, axis=1)[:, :L]
    return y.astype(u.dtype)


def rope_tables(L):
    inv = 1.0 / (ROPE_THETA ** (jnp.arange(0, HEAD_DIM, 2, dtype=jnp.float32) / HEAD_DIM))
    ang = jnp.arange(L, dtype=jnp.float32)[:, None] * inv[None, :]
    return jnp.cos(ang), jnp.sin(ang)


def apply_rope(x, cos, sin):
    half = HEAD_DIM // 2
    xf = x.astype(jnp.float32)
    x1, x2 = xf[..., :half], xf[..., half:]
    c = cos[None, :, None, :]
    s = sin[None, :, None, :]
    return jnp.concatenate([x1 * c - x2 * s, x2 * c + x1 * s], axis=-1).astype(x.dtype)


def band_attention(q, k, v, sink):
    B, L = q.shape[0], q.shape[1]
    nb = L // BLOCK
    G = N_HEADS // N_KV_HEADS

    def kv_blocks(t):
        tp = jnp.pad(t, ((0, 0), (BLOCK, BLOCK), (0, 0), (0, 0)))
        return jnp.concatenate(
            [tp[:, i * BLOCK:i * BLOCK + L].reshape(B, nb, BLOCK, N_KV_HEADS, HEAD_DIM) for i in range(3)],
            axis=2)

    kb, vb = kv_blocks(k), kv_blocks(v)
    qb = q.reshape(B, nb, BLOCK, N_KV_HEADS, G, HEAD_DIM)
    s = jnp.einsum('bnqkgd,bnskd->bnkgqs', qb, kb, preferred_element_type=jnp.float32) * (HEAD_DIM ** -0.5)
    qpos = jnp.arange(nb)[:, None, None] * BLOCK + jnp.arange(BLOCK)[None, :, None]
    kpos = (jnp.arange(nb)[:, None, None] - 1) * BLOCK + jnp.arange(3 * BLOCK)[None, None, :]
    mask = (jnp.abs(kpos - qpos) <= WINDOW) & (kpos >= 0) & (kpos < L)
    s = jnp.where(mask[None, :, None, None], s, -1e30)
    sink_l = sink.astype(jnp.float32).reshape(N_KV_HEADS, G)[None, None, :, :, None, None]
    m = jnp.maximum(jnp.max(s, axis=-1, keepdims=True), sink_l)
    pr = jnp.exp(s - m)
    denom = jnp.sum(pr, axis=-1, keepdims=True) + jnp.exp(sink_l - m)
    o = jnp.einsum('bnkgqs,bnskd->bnqkgd', (pr / denom).astype(v.dtype), vb)
    return o.reshape(B, L, ATT_WIDTH)


def mixer(h, p):
    B, L, _ = h.shape
    proj = h @ p['w_in']
    s0 = 3 * HY_WIDTH
    s1 = s0 + ATT_WIDTH
    s2 = s1 + KV_WIDTH
    s3 = s2 + KV_WIDTH
    hy, q, k, v, gates = proj[..., :s0], proj[..., s0:s1], proj[..., s1:s2], proj[..., s2:s3], proj[..., s3:]
    hy = short_conv(hy, p['hy_conv_w'], p['hy_conv_b'])
    z = hy[..., :HY_WIDTH]
    gate_list = (hy[..., HY_WIDTH:2 * HY_WIDTH], hy[..., 2 * HY_WIDTH:])
    kf = hyena_filters(L, p)
    for o in range(HY_ORDER):
        z = gate_list[o] * (long_conv(z, kf[:, o]) + p['hy_bias'][o] * z)
    y_hy = z @ p['w_hy_proj']
    cos, sin = rope_tables(L)
    q = apply_rope(rms_norm(q.reshape(B, L, N_HEADS, HEAD_DIM), p['q_norm_g']), cos, sin)
    k = apply_rope(rms_norm(k.reshape(B, L, N_KV_HEADS, HEAD_DIM), p['k_norm_g']), cos, sin)
    v = v.reshape(B, L, N_KV_HEADS, HEAD_DIM)
    y_at = band_attention(q, k, v, p['sink_logit']) @ p['w_at_proj']
    g = jax.nn.sigmoid(gates)
    merged = g[..., :D_MODEL] * y_hy + g[..., D_MODEL:] * y_at
    return merged @ p['w_o']


def expert_choice_moe(h, p):
    B, L, D = h.shape
    T = B * L
    cap = CAPACITY_FACTOR * T // N_EXPERTS
    hf = h.reshape(T, D)
    aff = jax.nn.softmax((hf @ p['router_w']).astype(jnp.float32), axis=-1)
    gate, idx = lax.top_k(aff.T, cap)
    xe = hf[idx]
    hid = jax.nn.silu(jnp.einsum('ecd,edf->ecf', xe, p['exp_w_gate'])) * jnp.einsum('ecd,edf->ecf', xe, p['exp_w_up'])
    ye = jnp.einsum('ecf,efd->ecd', hid, p['exp_w_down'])
    contrib = (gate[..., None].astype(ye.dtype) * ye).reshape(-1, D)
    y = jnp.zeros_like(hf).at[idx.reshape(-1)].add(contrib)
    return y.reshape(B, L, D)


def encoder_layer(x, c, p):
    mod = (jax.nn.silu(c) @ p['ada_w'] + p['ada_b'])[:, None, :]
    sh1, sc1, g1, sh2, sc2, g2 = jnp.split(mod, 6, axis=-1)
    h = rms_norm(x, p['norm1_g']) * (1.0 + sc1) + sh1
    x = x + g1 * mixer(h, p)
    h = rms_norm(x, p['norm2_g']) * (1.0 + sc2) + sh2
    x = x + g2 * expert_choice_moe(h, p)
    return x


def setup_inputs(seed: int = 0) -> dict:
    key = jax.random.key(seed)
    ks = jax.random.split(key, 32)
    f32 = jnp.float32

    def nrm(k, shape, scale):
        return jax.random.normal(k, shape, f32) * scale

    return {
        'x_prompt': nrm(ks[0], (BATCH, SEQ, D_MODEL), 1.0),
        'x_sample': nrm(ks[1], (DEC_BATCH, DEC_SEQ, D_MODEL), 1.0),
        'c_prompt': nrm(ks[2], (BATCH, D_MODEL), 1.0),
        'c_sample': nrm(ks[3], (DEC_BATCH, D_MODEL), 1.0),
        'ada_w': nrm(ks[4], (DEPTH, D_MODEL, 6 * D_MODEL), 0.5 * D_MODEL ** -0.5),
        'ada_b': nrm(ks[5], (DEPTH, 6 * D_MODEL), 0.02),
        'norm1_g': 1.0 + nrm(ks[6], (DEPTH, D_MODEL), 0.02),
        'norm2_g': 1.0 + nrm(ks[7], (DEPTH, D_MODEL), 0.02),
        'w_in': nrm(ks[8], (DEPTH, D_MODEL, IN_WIDTH), D_MODEL ** -0.5),
        'hy_conv_w': nrm(ks[9], (DEPTH, SHORT_CONV, 3 * HY_WIDTH), SHORT_CONV ** -0.5),
        'hy_conv_b': nrm(ks[10], (DEPTH, 3 * HY_WIDTH), 0.02),
        'flt_w1': nrm(ks[11], (DEPTH, FILTER_EMB, FILTER_HIDDEN), FILTER_EMB ** -0.5),
        'flt_b1': nrm(ks[12], (DEPTH, FILTER_HIDDEN), 0.1),
        'flt_w2': nrm(ks[13], (DEPTH, FILTER_HIDDEN, FILTER_HIDDEN), FILTER_HIDDEN ** -0.5),
        'flt_b2': nrm(ks[14], (DEPTH, FILTER_HIDDEN), 0.1),
        'flt_w3': nrm(ks[15], (DEPTH, FILTER_HIDDEN, FILTER_HIDDEN), FILTER_HIDDEN ** -0.5),
        'flt_b3': nrm(ks[16], (DEPTH, FILTER_HIDDEN), 0.1),
        'flt_freq': 1.0 + nrm(ks[17], (DEPTH, FILTER_HIDDEN), 0.02),
        'flt_w_out': nrm(ks[18], (DEPTH, FILTER_HIDDEN, 2 * HY_ORDER * HY_WIDTH), FILTER_HIDDEN ** -0.5),
        'hy_bias': nrm(ks[19], (DEPTH, HY_ORDER, HY_WIDTH), 1.0),
        'q_norm_g': 1.0 + nrm(ks[20], (DEPTH, HEAD_DIM), 0.02),
        'k_norm_g': 1.0 + nrm(ks[21], (DEPTH, HEAD_DIM), 0.02),
        'sink_logit': nrm(ks[22], (DEPTH, N_HEADS), 0.5),
        'w_hy_proj': nrm(ks[23], (DEPTH, HY_WIDTH, D_MODEL), HY_WIDTH ** -0.5),
        'w_at_proj': nrm(ks[24], (DEPTH, ATT_WIDTH, D_MODEL), ATT_WIDTH ** -0.5),
        'w_o': nrm(ks[25], (DEPTH, D_MODEL, D_MODEL), D_MODEL ** -0.5),
        'router_w': nrm(ks[26], (DEPTH, D_MODEL, N_EXPERTS), D_MODEL ** -0.5),
        'exp_w_gate': nrm(ks[27], (DEPTH, N_EXPERTS, D_MODEL, D_FF), D_MODEL ** -0.5),
        'exp_w_up': nrm(ks[28], (DEPTH, N_EXPERTS, D_MODEL, D_FF), D_MODEL ** -0.5),
        'exp_w_down': nrm(ks[29], (DEPTH, N_EXPERTS, D_FF, D_MODEL), D_FF ** -0.5),
    }


def reference(x_prompt, x_sample, c_prompt, c_sample, ada_w, ada_b, norm1_g, norm2_g, w_in, hy_conv_w, hy_conv_b,
              flt_w1, flt_b1, flt_w2, flt_b2, flt_w3, flt_b3, flt_freq, flt_w_out, hy_bias, q_norm_g, k_norm_g,
              sink_logit, w_hy_proj, w_at_proj, w_o, router_w, exp_w_gate, exp_w_up, exp_w_down):
    y_prompt = x_prompt
    y_sample = x_sample
    for l in range(DEPTH):
        p = dict(ada_w=ada_w[l], ada_b=ada_b[l], norm1_g=norm1_g[l], norm2_g=norm2_g[l], w_in=w_in[l],
                 hy_conv_w=hy_conv_w[l], hy_conv_b=hy_conv_b[l], flt_w1=flt_w1[l], flt_b1=flt_b1[l],
                 flt_w2=flt_w2[l], flt_b2=flt_b2[l], flt_w3=flt_w3[l], flt_b3=flt_b3[l], flt_freq=flt_freq[l],
                 flt_w_out=flt_w_out[l], hy_bias=hy_bias[l], q_norm_g=q_norm_g[l], k_norm_g=k_norm_g[l],
                 sink_logit=sink_logit[l], w_hy_proj=w_hy_proj[l], w_at_proj=w_at_proj[l], w_o=w_o[l],
                 router_w=router_w[l], exp_w_gate=exp_w_gate[l], exp_w_up=exp_w_up[l], exp_w_down=exp_w_down[l])
        y_prompt = encoder_layer(y_prompt, c_prompt, p)
        y_sample = encoder_layer(y_sample, c_sample, p)
    return (y_prompt, y_sample)
```

```cpp
#include <hip/hip_runtime.h>
#include <cstdio>
#include <cstdint>
#define MK_PER_PHASE 0
#ifndef MK_NOPK
#define MK_NOPK 0
#endif
#if defined(__HIP_DEVICE_COMPILE__) && MK_NOPK
#pragma clang attribute push(__attribute__((target("no-packed-fp32-ops"))), apply_to = function)
#endif
namespace pg8 {
#define PG8_LAS __attribute__((address_space(3)))
typedef unsigned short bf16_t;
typedef short bf16x8 __attribute__((ext_vector_type(8)));
typedef float f32x4 __attribute__((ext_vector_type(4)));
typedef unsigned u32x4 __attribute__((ext_vector_type(4)));
constexpr int BM = 256, BK = 64, HALF = 128, HTB = HALF * BK * 2  , STAGE_BYTES = 8 * HTB, NXCD = 8, WGM = 8;

__host__ __device__ __forceinline__ int lds_byte(int r, int c) { const int st = (r >> 4) * 2 + (c >> 5), rr = r & 15, cc = c & 31, ob = rr * 64 + cc * 2; return st * 1024 + (ob ^ (((ob >> 9) & 1) << 5)); }
__host__ __device__ __forceinline__ void stage_rc(int b, int& R, int& C) { const int st = b / 1024, sb = b % 1024, swz = sb ^ (((sb >> 9) & 1) << 5); R = (st >> 1) * 16 + swz / 64; C = (st & 1) * 32 + (swz % 64) / 2; }
__host__ __device__ __forceinline__ int perm32(int rho) { const int n = rho >> 4, i = rho & 15; return 8 * (i >> 2) + 4 * n + (i & 3); }

struct Unit { int pm, pn; };
struct Gemm { const bf16_t* A; const bf16_t* Bt; int M, N, K; int tpg, ng; size_t gstride; };

struct StaticOrder {
    int nM, nN, nwg, G, c;
    __host__ __device__ void init(int M, int N, int G_, int c_) { nM = M / BM; nN = N / BM; nwg = nM * nN; G = G_; c = c_; }
    __host__ __device__ bool next(int i, Unit& u) const {
        const long L = (long)i * G + c; if (L >= nwg) return false;
        int wgid = (int)L; { const int q = nwg / NXCD, r = nwg % NXCD, xcd = wgid % NXCD, off = wgid / NXCD; wgid = (xcd < r ? xcd * (q + 1) : r * (q + 1) + (xcd - r) * q) + off; }
        const int nig = WGM * nN, gid = wgid / nig, fm = gid * WGM, gsz = (nM - fm) < WGM ? (nM - fm) : WGM;
        u.pm = fm + ((wgid % nig) % gsz); u.pn = (wgid % nig) / gsz; return true;
    }
    __device__ __forceinline__ void a_ready(const Unit&) const {}
    __device__ __forceinline__ void done(const Unit&) const {}
};

__device__ __forceinline__ unsigned cvt_pk_bf16(float lo, float hi) { unsigned r; asm volatile("v_cvt_pk_bf16_f32 %0, %1, %2" : "=v"(r) : "v"(lo), "v"(hi)); return r; }
typedef float f32x2 __attribute__((ext_vector_type(2)));
__device__ __forceinline__ f32x2 gelu_pk(f32x2 v) {
    const f32x2 av = __builtin_elementwise_abs(v), d = av * 0.2316418882f + 1.0f;
    f32x2 t; t.x = __builtin_amdgcn_rcpf(d.x); t.y = __builtin_amdgcn_rcpf(d.y);
    f32x2 q = t * 0.5307027145f + (-0.7265760135f); q = q * t + 0.7107068705f; q = q * t + (-0.142248368f); q = q * t + 0.127414796f; q = q * t;
    const f32x2 s = (v * v) * (-0.72134752044f);
    f32x2 e; e.x = __builtin_amdgcn_exp2f(s.x); e.y = __builtin_amdgcn_exp2f(s.y);
    const f32x2 m = v * (q * e), r = v - m;
    f32x2 o; o.x = v.x < 0.f ? m.x : r.x; o.y = v.y < 0.f ? m.y : r.y; return o;
}

template <int ACT  > struct EpiBf16 {
    static constexpr bool PERM = true, AFTER_DRAIN = false; static constexpr int MID_T = 0; static_assert(ACT == 0 || ACT == 1, "EpiBf16: ACT is 0 (none) or 1 (gelu_pk)");
    bf16_t* O; int ldc; const float* bias; int split_cols; size_t split_stride; float scale0;
    __device__ __forceinline__ void operator()(const f32x4 (&acc)[2][2][4][2], const Unit& u, int wr, int wc, int fr, int fq) const {
        const int row0 = u.pm * BM + wr * 64 + fr; int colt = u.pn * BM; bf16_t* base = O;
        float sc = 1.f; if (split_cols) { const int t = colt / split_cols; base += (size_t)t * split_stride; colt -= t * split_cols; if (t == 0) sc = scale0; }
        const int col0 = colt + wc * 32 + 8 * fq, bcol0 = u.pn * BM + wc * 32 + 8 * fq;
        f32x4 bv[2][2];
#pragma unroll
        for (int bj = 0; bj < 2; ++bj)
#pragma unroll
            for (int n = 0; n < 2; ++n) bv[bj][n] = bias ? *(const f32x4*)(bias + bcol0 + bj * HALF + 4 * n) : (f32x4){0.f, 0.f, 0.f, 0.f};
#pragma unroll
        for (int ai = 0; ai < 2; ++ai)
#pragma unroll
            for (int m = 0; m < 4; ++m) { bf16_t* rowp = base + (size_t)(row0 + ai * HALF + m * 16) * ldc + col0;
#pragma unroll
                for (int bj = 0; bj < 2; ++bj) { f32x4 v0 = acc[ai][bj][m][0] + bv[bj][0], v1 = acc[ai][bj][m][1] + bv[bj][1];
                    if (ACT == 1) { f32x2 a = gelu_pk((f32x2){v0[0], v0[1]}), b = gelu_pk((f32x2){v0[2], v0[3]}), c = gelu_pk((f32x2){v1[0], v1[1]}), d = gelu_pk((f32x2){v1[2], v1[3]});
                        v0 = (f32x4){a.x, a.y, b.x, b.y}; v1 = (f32x4){c.x, c.y, d.x, d.y}; }
                    v0 = v0 * sc; v1 = v1 * sc; u32x4 w; w.x = cvt_pk_bf16(v0[0], v0[1]); w.y = cvt_pk_bf16(v0[2], v0[3]); w.z = cvt_pk_bf16(v1[0], v1[1]); w.w = cvt_pk_bf16(v1[2], v1[3]);
                    *(u32x4*)(rowp + bj * HALF) = w; } }
    }
};

struct EpiF32 {
    static constexpr bool PERM = false, AFTER_DRAIN = false; static constexpr int MID_T = 0;
    float* C; int ldc;
    __device__ __forceinline__ void operator()(const f32x4 (&acc)[2][2][4][2], const Unit& u, int wr, int wc, int fr, int fq) const {
        const int row0 = u.pm * BM + wr * 64 + fr, col0 = u.pn * BM + wc * 32 + 4 * fq;
#pragma unroll
        for (int ai = 0; ai < 2; ++ai)
#pragma unroll
            for (int m = 0; m < 4; ++m) { float* rowp = C + (size_t)(row0 + ai * HALF + m * 16) * ldc + col0;
#pragma unroll
                for (int bj = 0; bj < 2; ++bj)
#pragma unroll
                    for (int n = 0; n < 2; ++n) *(f32x4*)(rowp + bj * HALF + n * 16) = acc[ai][bj][m][n]; }
    }
};
struct EpiSwiGLU {
    static constexpr bool PERM = true, AFTER_DRAIN = false; static constexpr int MID_T = 0;
    bf16_t* O; int ldc;
    __device__ __forceinline__ static float silu(float x) { return x * __builtin_amdgcn_rcpf(1.0f + __builtin_amdgcn_exp2f(-1.4426950408889634f * x)); }
    __device__ __forceinline__ void operator()(const f32x4 (&acc)[2][2][4][2], const Unit& u, int wr, int wc, int fr, int fq) const {
        const int row0 = u.pm * BM + wr * 64 + fr, col0 = u.pn * HALF + wc * 32 + 8 * fq;
#pragma unroll
        for (int ai = 0; ai < 2; ++ai)
#pragma unroll
            for (int m = 0; m < 4; ++m) { bf16_t* rowp = O + (size_t)(row0 + ai * HALF + m * 16) * ldc + col0;
                const f32x4 g0 = acc[ai][0][m][0], g1 = acc[ai][0][m][1], u0 = acc[ai][1][m][0], u1 = acc[ai][1][m][1];
                u32x4 w; w.x = cvt_pk_bf16(silu(g0[0]) * u0[0], silu(g0[1]) * u0[1]); w.y = cvt_pk_bf16(silu(g0[2]) * u0[2], silu(g0[3]) * u0[3]);
                w.z = cvt_pk_bf16(silu(g1[0]) * u1[0], silu(g1[1]) * u1[1]); w.w = cvt_pk_bf16(silu(g1[2]) * u1[2], silu(g1[3]) * u1[3]);
                *(u32x4*)rowp = w; }
    }
};
struct EpiProj {
    static constexpr bool PERM = true, AFTER_DRAIN = false; static constexpr int MID_T = 0;
    bf16_t* O; int ldc; float* HT; int ldt; int NT;
    __device__ __forceinline__ void operator()(const f32x4 (&acc)[2][2][4][2], const Unit& u, int wr, int wc, int fr, int fq) const {
        const int row0 = u.pm * BM + wr * 64 + fr, col0 = u.pn * BM + wc * 32 + 8 * fq;
        if (u.pn < NT) {
#pragma unroll
            for (int ai = 0; ai < 2; ++ai)
#pragma unroll
                for (int m = 0; m < 4; ++m) { float* cp = HT + (size_t)col0 * ldt + (row0 + ai * HALF + m * 16);
#pragma unroll
                    for (int bj = 0; bj < 2; ++bj)
#pragma unroll
                        for (int n = 0; n < 2; ++n)
#pragma unroll
                            for (int e = 0; e < 4; ++e) cp[(size_t)(bj * HALF + 4 * n + e) * ldt] = acc[ai][bj][m][n][e]; }
        } else {
#pragma unroll
            for (int ai = 0; ai < 2; ++ai)
#pragma unroll
                for (int m = 0; m < 4; ++m) { bf16_t* rowp = O + (size_t)(row0 + ai * HALF + m * 16) * ldc + col0;
#pragma unroll
                    for (int bj = 0; bj < 2; ++bj) { const f32x4 v0 = acc[ai][bj][m][0], v1 = acc[ai][bj][m][1];
                        u32x4 w; w.x = cvt_pk_bf16(v0[0], v0[1]); w.y = cvt_pk_bf16(v0[2], v0[3]); w.z = cvt_pk_bf16(v1[0], v1[1]); w.w = cvt_pk_bf16(v1[2], v1[3]);
                        *(u32x4*)(rowp + bj * HALF) = w; } }
        }
    }
};
struct EpiGate {
    static constexpr bool PERM = true, AFTER_DRAIN = false; static constexpr int MID_T = 0;
    bf16_t* O; int ldc; const bf16_t* G; int ldg; int first;
    __device__ __forceinline__ static float sig(float x) { return __builtin_amdgcn_rcpf(1.0f + __builtin_amdgcn_exp2f(-1.4426950408889634f * x)); }
    __device__ __forceinline__ static float lo(unsigned w) { return __builtin_bit_cast(float, w << 16); }
    __device__ __forceinline__ static float hi(unsigned w) { return __builtin_bit_cast(float, w & 0xffff0000u); }
    __device__ __forceinline__ void operator()(const f32x4 (&acc)[2][2][4][2], const Unit& u, int wr, int wc, int fr, int fq) const {
        const int row0 = u.pm * BM + wr * 64 + fr, col0 = u.pn * BM + wc * 32 + 8 * fq;
#pragma unroll
        for (int ai = 0; ai < 2; ++ai)
#pragma unroll
            for (int m = 0; m < 4; ++m) { const size_t row = (size_t)(row0 + ai * HALF + m * 16);
#pragma unroll
                for (int bj = 0; bj < 2; ++bj) { const f32x4 v0 = acc[ai][bj][m][0], v1 = acc[ai][bj][m][1];
                    const u32x4 g = *(const u32x4*)(G + row * ldg + col0 + bj * HALF);
                    float o[8] = {sig(lo(g.x)) * v0[0], sig(hi(g.x)) * v0[1], sig(lo(g.y)) * v0[2], sig(hi(g.y)) * v0[3], sig(lo(g.z)) * v1[0], sig(hi(g.z)) * v1[1], sig(lo(g.w)) * v1[2], sig(hi(g.w)) * v1[3]};
                    u32x4* op = (u32x4*)(O + row * ldc + col0 + bj * HALF);
                    if (!first) { const u32x4 p = *op; o[0] += lo(p.x); o[1] += hi(p.x); o[2] += lo(p.y); o[3] += hi(p.y); o[4] += lo(p.z); o[5] += hi(p.z); o[6] += lo(p.w); o[7] += hi(p.w); }
                    u32x4 w; w.x = cvt_pk_bf16(o[0], o[1]); w.y = cvt_pk_bf16(o[2], o[3]); w.z = cvt_pk_bf16(o[4], o[5]); w.w = cvt_pk_bf16(o[6], o[7]);
                    *op = w; } }
    }
};
struct EpiResid {
    static constexpr bool PERM = false, AFTER_DRAIN = false; static constexpr int MID_T = 0;
    const float* xa; const float* xb; float* out; const float* gbase; int row_split, sub_rows, gstride, ldc;
    __device__ __forceinline__ void operator()(const f32x4 (&acc)[2][2][4][2], const Unit& u, int wr, int wc, int fr, int fq) const {
        const int row0 = u.pm * BM + wr * 64 + fr, col0 = u.pn * BM + wc * 32 + 4 * fq;
#pragma unroll
        for (int ai = 0; ai < 2; ++ai)
#pragma unroll
            for (int m = 0; m < 4; ++m) { const int row = row0 + ai * HALF + m * 16;
                const float* xr = (row < row_split ? xa + (size_t)row * ldc : xb + (size_t)(row - row_split) * ldc) + col0;
                const float* gr = gbase + (size_t)(row < row_split ? 0 : 1 + (row - row_split) / sub_rows) * gstride + col0;
                float* orow = out + (size_t)row * ldc + col0;
                f32x4 xv[2][2], gv[2][2];
#pragma unroll
                for (int bj = 0; bj < 2; ++bj)
#pragma unroll
                    for (int n = 0; n < 2; ++n) { xv[bj][n] = *(const f32x4*)(xr + bj * HALF + n * 16); gv[bj][n] = *(const f32x4*)(gr + bj * HALF + n * 16); }
#pragma unroll
                for (int bj = 0; bj < 2; ++bj)
#pragma unroll
                    for (int n = 0; n < 2; ++n) *(f32x4*)(orow + bj * HALF + n * 16) = xv[bj][n] + gv[bj][n] * acc[ai][bj][m][n]; }
    }
};
struct EpiGate2 {
    static constexpr bool PERM = true, AFTER_DRAIN = false; static constexpr int MID_T = 8;
    bf16_t* O; int ldc; const bf16_t* G1; const bf16_t* G2; int ldg;
    __device__ __forceinline__ static float en(float x) { return __builtin_amdgcn_exp2f(-1.4426950408889634f * x); }
    __device__ __forceinline__ static float lo(unsigned w) { return __builtin_bit_cast(float, w << 16); }
    __device__ __forceinline__ static float hi(unsigned w) { return __builtin_bit_cast(float, w & 0xffff0000u); }
    __device__ __forceinline__ static f32x4 rho4(unsigned a0, unsigned a1, unsigned b0, unsigned b1) {
        f32x4 r; r[0] = (1.f + en(lo(b0))) * __builtin_amdgcn_rcpf(1.f + en(lo(a0))); r[1] = (1.f + en(hi(b0))) * __builtin_amdgcn_rcpf(1.f + en(hi(a0)));
        r[2] = (1.f + en(lo(b1))) * __builtin_amdgcn_rcpf(1.f + en(lo(a1))); r[3] = (1.f + en(hi(b1))) * __builtin_amdgcn_rcpf(1.f + en(hi(a1))); return r; }
    __device__ __forceinline__ void mid(f32x4 (&acc)[2][2][4][2], const Unit& u, int wr, int wc, int fr_, int fq_) const {
        int fr = fr_, fq = fq_; asm volatile("" : "+v"(fr), "+v"(fq));
        const int row0 = u.pm * BM + wr * 64 + fr, col0 = u.pn * BM + wc * 32 + 8 * fq;
#pragma unroll
        for (int ai = 0; ai < 2; ++ai)
#pragma unroll
            for (int mh = 0; mh < 4; mh += 2) {
                u32x4 a[2][2], b[2][2];
#pragma unroll
                for (int mm = 0; mm < 2; ++mm) { const size_t row = (size_t)(row0 + ai * HALF + (mh + mm) * 16);
#pragma unroll
                    for (int bj = 0; bj < 2; ++bj) { a[mm][bj] = *(const u32x4*)(G1 + row * ldg + col0 + bj * HALF); b[mm][bj] = *(const u32x4*)(G2 + row * ldg + col0 + bj * HALF); } }
                asm volatile("" ::: "memory");
#pragma unroll
                for (int mm = 0; mm < 2; ++mm)
#pragma unroll
                    for (int bj = 0; bj < 2; ++bj) { const int m = mh + mm;
                        acc[ai][bj][m][0] = acc[ai][bj][m][0] * rho4(a[mm][bj].x, a[mm][bj].y, b[mm][bj].x, b[mm][bj].y);
                        acc[ai][bj][m][1] = acc[ai][bj][m][1] * rho4(a[mm][bj].z, a[mm][bj].w, b[mm][bj].z, b[mm][bj].w); }
                asm volatile("" ::: "memory");
            }
    }
    __device__ __forceinline__ void operator()(const f32x4 (&acc)[2][2][4][2], const Unit& u, int wr, int wc, int fr, int fq) const {
        const int row0 = u.pm * BM + wr * 64 + fr, col0 = u.pn * BM + wc * 32 + 8 * fq;
#pragma unroll
        for (int ai = 0; ai < 2; ++ai)
#pragma unroll
            for (int m = 0; m < 4; ++m) { const size_t row = (size_t)(row0 + ai * HALF + m * 16);
#pragma unroll
                for (int bj = 0; bj < 2; ++bj) { const f32x4 v0 = acc[ai][bj][m][0], v1 = acc[ai][bj][m][1];
                    const u32x4 b = *(const u32x4*)(G2 + row * ldg + col0 + bj * HALF);
                    u32x4 w;
                    w.x = cvt_pk_bf16(v0[0] * __builtin_amdgcn_rcpf(1.f + en(lo(b.x))), v0[1] * __builtin_amdgcn_rcpf(1.f + en(hi(b.x))));
                    w.y = cvt_pk_bf16(v0[2] * __builtin_amdgcn_rcpf(1.f + en(lo(b.y))), v0[3] * __builtin_amdgcn_rcpf(1.f + en(hi(b.y))));
                    w.z = cvt_pk_bf16(v1[0] * __builtin_amdgcn_rcpf(1.f + en(lo(b.z))), v1[1] * __builtin_amdgcn_rcpf(1.f + en(hi(b.z))));
                    w.w = cvt_pk_bf16(v1[2] * __builtin_amdgcn_rcpf(1.f + en(lo(b.w))), v1[3] * __builtin_amdgcn_rcpf(1.f + en(hi(b.w))));
                    *(u32x4*)(O + row * ldc + col0 + bj * HALF) = w; } }
    }
};
struct EpiColMajor {
    static constexpr bool PERM = false, AFTER_DRAIN = false; static constexpr int MID_T = 0;
    float* HT; int ldt;
    __device__ __forceinline__ void operator()(const f32x4 (&acc)[2][2][4][2], const Unit& u, int wr, int wc, int fr, int fq) const {
        const int row0 = u.pm * BM + wr * 64 + 4 * fq, col0 = u.pn * BM + wc * 32 + fr;
#pragma unroll
        for (int bj = 0; bj < 2; ++bj)
#pragma unroll
            for (int n = 0; n < 2; ++n) { float* cp = HT + (size_t)(col0 + bj * HALF + 16 * n) * ldt + row0;
#pragma unroll
                for (int ai = 0; ai < 2; ++ai)
#pragma unroll
                    for (int m = 0; m < 4; ++m) *(f32x4*)(cp + ai * HALF + 16 * m) = acc[ai][bj][m][n]; }
    }
};
__device__ __forceinline__ float clamp448(float x) { return __builtin_fminf(__builtin_fmaxf(x, -448.f), 448.f); }
__device__ __forceinline__ unsigned pack4_fp8(float a, float b, float c, float d) { int w = __builtin_amdgcn_cvt_pk_fp8_f32(clamp448(a), clamp448(b), 0, false); w = __builtin_amdgcn_cvt_pk_fp8_f32(clamp448(c), clamp448(d), w, true); return (unsigned)w; }
struct EpiSwiGLU8 {
    static constexpr bool PERM = true, AFTER_DRAIN = false; static constexpr int MID_T = 0;
    unsigned char* O; int ldc; float sin, sout;
    __device__ __forceinline__ static float silu(float x) { return x * __builtin_amdgcn_rcpf(1.0f + __builtin_amdgcn_exp2f(-1.4426950408889634f * x)); }
    __device__ __forceinline__ void operator()(const f32x4 (&acc)[2][2][4][2], const Unit& u, int wr, int wc, int fr, int fq) const {
        const int row0 = u.pm * BM + wr * 64 + fr, col0 = u.pn * HALF + wc * 32 + 8 * fq;
#pragma unroll
        for (int ai = 0; ai < 2; ++ai)
#pragma unroll
            for (int m = 0; m < 4; ++m) { unsigned char* rowp = O + (size_t)(row0 + ai * HALF + m * 16) * ldc + col0;
                const f32x4 g0 = acc[ai][0][m][0] * sin, g1 = acc[ai][0][m][1] * sin, u0 = acc[ai][1][m][0] * (sin * sout), u1 = acc[ai][1][m][1] * (sin * sout);
                typedef unsigned u32x2 __attribute__((ext_vector_type(2)));
                u32x2 w; w.x = pack4_fp8(silu(g0[0]) * u0[0], silu(g0[1]) * u0[1], silu(g0[2]) * u0[2], silu(g0[3]) * u0[3]); w.y = pack4_fp8(silu(g1[0]) * u1[0], silu(g1[1]) * u1[1], silu(g1[2]) * u1[2], silu(g1[3]) * u1[3]);
                *(u32x2*)rowp = w; asm volatile("" ::: "memory"); }
    }
};
struct EpiBf16S {
    static constexpr bool PERM = true, AFTER_DRAIN = false; static constexpr int MID_T = 0;
    bf16_t* O; int ldc; float s;
    __device__ __forceinline__ void operator()(const f32x4 (&acc)[2][2][4][2], const Unit& u, int wr, int wc, int fr, int fq) const {
        const int row0 = u.pm * BM + wr * 64 + fr, col0 = u.pn * BM + wc * 32 + 8 * fq;
#pragma unroll
        for (int ai = 0; ai < 2; ++ai)
#pragma unroll
            for (int m = 0; m < 4; ++m) { bf16_t* rowp = O + (size_t)(row0 + ai * HALF + m * 16) * ldc + col0;
#pragma unroll
                for (int bj = 0; bj < 2; ++bj) { const f32x4 v0 = acc[ai][bj][m][0] * s, v1 = acc[ai][bj][m][1] * s;
                    u32x4 w; w.x = cvt_pk_bf16(v0[0], v0[1]); w.y = cvt_pk_bf16(v0[2], v0[3]); w.z = cvt_pk_bf16(v1[0], v1[1]); w.w = cvt_pk_bf16(v1[2], v1[3]);
                    *(u32x4*)(rowp + bj * HALF) = w; } }
    }
};
#define PG8_FP4_PACK8(w, x0, x1, x2, x3, x4, x5, x6, x7) do { (w) = 0u; (w) = __builtin_amdgcn_cvt_scalef32_pk_fp4_f32((w), (x0), (x1), 1.0f, 0); (w) = __builtin_amdgcn_cvt_scalef32_pk_fp4_f32((w), (x2), (x3), 1.0f, 1); \
        (w) = __builtin_amdgcn_cvt_scalef32_pk_fp4_f32((w), (x4), (x5), 1.0f, 2); (w) = __builtin_amdgcn_cvt_scalef32_pk_fp4_f32((w), (x6), (x7), 1.0f, 3); } while (0)
__device__ __forceinline__ float clamp6(float x) { return x; }
struct EpiSwiGLU4 {
    static constexpr bool PERM = true, AFTER_DRAIN = false; static constexpr int MID_T = 0;
    unsigned char* O; int ldc; float sin, sout;
    __device__ __forceinline__ static float silu(float x) { return x * __builtin_amdgcn_rcpf(1.0f + __builtin_amdgcn_exp2f(-1.4426950408889634f * x)); }
    __device__ __forceinline__ void operator()(const f32x4 (&acc)[2][2][4][2], const Unit& u, int wr, int wc, int fr, int fq) const {
        const int row0 = u.pm * BM + wr * 64 + fr, col0 = u.pn * HALF + wc * 32 + 8 * fq;
#pragma unroll
        for (int ai = 0; ai < 2; ++ai)
#pragma unroll
            for (int m = 0; m < 4; ++m) { unsigned char* rowp = O + (size_t)(row0 + ai * HALF + m * 16) * ldc + (col0 >> 1);
                const f32x4 g0 = acc[ai][0][m][0] * sin, g1 = acc[ai][0][m][1] * sin, u0 = acc[ai][1][m][0] * (sin * sout), u1 = acc[ai][1][m][1] * (sin * sout);
                unsigned w; PG8_FP4_PACK8(w, clamp6(silu(g0[0]) * u0[0]), clamp6(silu(g0[1]) * u0[1]), clamp6(silu(g0[2]) * u0[2]), clamp6(silu(g0[3]) * u0[3]), clamp6(silu(g1[0]) * u1[0]), clamp6(silu(g1[1]) * u1[1]), clamp6(silu(g1[2]) * u1[2]), clamp6(silu(g1[3]) * u1[3]));
                *(unsigned*)rowp = w; asm volatile("" ::: "memory"); }
    }
};

template <class Epi, class Sched, bool ALIGN_EPI = false, bool SP2 = false, bool SWAP = false>
__device__ __forceinline__ void gemm_phase(PG8_LAS unsigned char* lds, const Gemm g, const Sched& S, const Epi& E) {
    int tid_ = threadIdx.x; asm volatile("" : "+v"(tid_));
    const int tid = tid_, wid = __builtin_amdgcn_readfirstlane(tid >> 6), lane = tid & 63, wr = wid >> 2, wc = wid & 3, fr = lane & 15, fq = lane >> 4;
    const int K = g.K, nt = K / BK;
    unsigned voffA[2], voffB[2];
#pragma unroll
    for (int i = 0; i < 2; ++i) { int R, C; stage_rc(tid * 16 + i * 8192, R, C); const int Rb = Epi::PERM ? ((R & ~31) + perm32(R & 31)) : R;
        voffA[i] = (unsigned)(R * K + C) * 2u; voffB[i] = (unsigned)(Rb * K + C) * 2u; }
    const size_t kstep = (size_t)(BK * 2);
    const size_t hstep = (size_t)HALF * K * 2;
    const size_t tstep = 2 * hstep;
    const unsigned ldsw = (unsigned)wid * 1024u;
    const int aoff = lds_byte(wr * 64 + fr, fq * 8), boff = lds_byte(wc * 32 + fr, fq * 8);
#define PG8_SA(b, h) (((b) * 2 + (h)) * HTB)
#define PG8_SB(b, h) ((4 + (b) * 2 + (h)) * HTB)
#define PG8_STAGE(bufoff, gbase, voff) do { _Pragma("unroll") for (int _i = 0; _i < 2; ++_i) \
        __builtin_amdgcn_global_load_lds((const unsigned*)((const char*)(gbase) + (voff)[_i]), (PG8_LAS unsigned*)(lds + (bufoff) + ldsw + _i * 8192), 16, 0, 0); } while (0)
#define PG8_LDA(dst, b, h) do { _Pragma("unroll") for (int m = 0; m < 4; ++m) _Pragma("unroll") for (int k = 0; k < 2; ++k) dst[m][k] = *(const PG8_LAS bf16x8*)(lds + PG8_SA(b, h) + aoff + m * 2048 + k * 1024); } while (0)
#define PG8_LDB(dst, b, h) do { _Pragma("unroll") for (int n = 0; n < 2; ++n) _Pragma("unroll") for (int k = 0; k < 2; ++k) dst[n][k] = *(const PG8_LAS bf16x8*)(lds + PG8_SB(b, h) + boff + n * 2048 + k * 1024); } while (0)
#define PG8_MMA(ai, bj, At, Bt) do { __builtin_amdgcn_s_setprio(1); _Pragma("unroll") for (int m = 0; m < 4; ++m) _Pragma("unroll") for (int n = 0; n < 2; ++n) _Pragma("unroll") for (int k = 0; k < 2; ++k) \
        acc[ai][bj][m][n] = SWAP ? __builtin_amdgcn_mfma_f32_16x16x32_bf16(At[m][k], Bt[n][k], acc[ai][bj][m][n], 0, 0, 0) : __builtin_amdgcn_mfma_f32_16x16x32_bf16(Bt[n][k], At[m][k], acc[ai][bj][m][n], 0, 0, 0); __builtin_amdgcn_s_setprio(0); } while (0)
#define PG8_WAIT_V(n) asm volatile("s_waitcnt vmcnt(" #n ")" ::: "memory")
#define PG8_WAIT_L(n) asm volatile("s_waitcnt lgkmcnt(" #n ")" ::: "memory")
#define PG8_BAR __builtin_amdgcn_s_barrier()
#define PG8_SCHED __builtin_amdgcn_sched_barrier(0)
    Unit cur, nxt; int ui = 0;
    if (!S.next(0, cur)) return;
    f32x4 acc[2][2][4][2];
#pragma unroll
    for (int a = 0; a < 2; ++a)
#pragma unroll
        for (int b = 0; b < 2; ++b)
#pragma unroll
            for (int m = 0; m < 4; ++m)
#pragma unroll
                for (int n = 0; n < 2; ++n) acc[a][b][m][n] = (f32x4){0.f, 0.f, 0.f, 0.f};
    bf16x8 At[4][2], B0[2][2], B1[2][2];
    const char* cA = (const char*)g.A + (size_t)cur.pm * tstep; const char* cB = (const char*)g.Bt + (size_t)((cur.pm / g.tpg) % g.ng) * g.gstride + (size_t)cur.pn * tstep;
    S.a_ready(cur);
    if constexpr (SP2) {
        PG8_STAGE(PG8_SB(0, 0), cB, voffB); PG8_STAGE(PG8_SB(0, 1), cB + hstep, voffB); PG8_STAGE(PG8_SA(0, 0), cA, voffA); PG8_STAGE(PG8_SA(0, 1), cA + hstep, voffA);
        if (wr == 1) PG8_BAR;
        PG8_WAIT_V(2); PG8_BAR;
        PG8_STAGE(PG8_SB(1, 0), cB + kstep, voffB); PG8_STAGE(PG8_SA(1, 0), cA + kstep, voffA); PG8_STAGE(PG8_SB(1, 1), cB + hstep + kstep, voffB);
        PG8_WAIT_V(6); PG8_BAR;
    } else {
        PG8_STAGE(PG8_SB(0, 0), cB, voffB); PG8_STAGE(PG8_SA(0, 0), cA, voffA); PG8_STAGE(PG8_SB(0, 1), cB + hstep, voffB); PG8_STAGE(PG8_SA(0, 1), cA + hstep, voffA);
        if (wr == 1) PG8_BAR;
        PG8_WAIT_V(4); PG8_BAR;
        PG8_STAGE(PG8_SB(1, 0), cB + kstep, voffB); PG8_STAGE(PG8_SA(1, 0), cA + kstep, voffA); PG8_STAGE(PG8_SB(1, 1), cB + hstep + kstep, voffB);
        PG8_WAIT_V(6); PG8_BAR;
    }
    for (;;) {
        const bool has_next = S.next(ui + 1, nxt);
        const char* nA = has_next ? (const char*)g.A + (size_t)nxt.pm * tstep : cA; const char* nB = has_next ? (const char*)g.Bt + (size_t)((nxt.pm / g.tpg) % g.ng) * g.gstride + (size_t)nxt.pn * tstep : cB;
        for (int t = 0; t < nt; t += 2) {
            if constexpr (Epi::MID_T > 0) { if (t == Epi::MID_T) E.mid(acc, cur, wr, wc, fr, fq); }
            const bool last = (t == nt - 2);
            const char* a1 = cA + (size_t)(t + 1) * kstep;
            const char* a2 = last ? nA : cA + (size_t)(t + 2) * kstep; const char* b2 = last ? nB : cB + (size_t)(t + 2) * kstep;
            const char* a3 = a2 + kstep; const char* b3 = b2 + kstep;
            if (last && has_next) S.a_ready(nxt);
            if constexpr (SP2) {
            PG8_LDB(B0, 0, 0); PG8_LDB(B1, 0, 1); PG8_SCHED; PG8_LDA(At, 0, 0); PG8_STAGE(PG8_SA(1, 1), a1 + hstep, voffA);
            PG8_WAIT_V(8); PG8_WAIT_L(0); PG8_BAR; PG8_MMA(0, 0, At, B0); PG8_MMA(0, 1, At, B1); PG8_BAR; PG8_SCHED;
            PG8_LDA(At, 0, 1); PG8_STAGE(PG8_SB(0, 0), b2, voffB); PG8_STAGE(PG8_SB(0, 1), b2 + hstep, voffB); PG8_STAGE(PG8_SA(0, 0), a2, voffA);
            PG8_WAIT_V(8); PG8_WAIT_L(0); PG8_BAR; PG8_MMA(1, 0, At, B0); PG8_MMA(1, 1, At, B1); PG8_BAR; PG8_SCHED;
            PG8_LDB(B0, 1, 0); PG8_LDB(B1, 1, 1); PG8_SCHED; PG8_LDA(At, 1, 0); PG8_STAGE(PG8_SA(0, 1), a2 + hstep, voffA);
            PG8_WAIT_V(8); PG8_WAIT_L(0); PG8_BAR; PG8_MMA(0, 0, At, B0); PG8_MMA(0, 1, At, B1); PG8_BAR; PG8_SCHED;
            PG8_LDA(At, 1, 1); PG8_STAGE(PG8_SB(1, 0), b3, voffB); PG8_STAGE(PG8_SB(1, 1), b3 + hstep, voffB); PG8_STAGE(PG8_SA(1, 0), a3, voffA);
            PG8_WAIT_V(8); PG8_WAIT_L(0); PG8_BAR; PG8_MMA(1, 0, At, B0); PG8_MMA(1, 1, At, B1); PG8_BAR; PG8_SCHED;
            } else {
            PG8_LDB(B0, 0, 0); PG8_SCHED; PG8_LDA(At, 0, 0); PG8_STAGE(PG8_SA(1, 1), a1 + hstep, voffA);
            PG8_WAIT_L(8); PG8_BAR; PG8_WAIT_L(0); PG8_MMA(0, 0, At, B0); PG8_BAR; PG8_SCHED;
            PG8_LDB(B1, 0, 1); PG8_STAGE(PG8_SB(0, 0), b2, voffB);
            PG8_BAR; PG8_WAIT_L(0); PG8_MMA(0, 1, At, B1); PG8_BAR;
            PG8_LDA(At, 0, 1); PG8_STAGE(PG8_SA(0, 0), a2, voffA);
            PG8_BAR; PG8_WAIT_L(0); PG8_MMA(1, 0, At, B0); PG8_BAR; PG8_SCHED;
            PG8_STAGE(PG8_SB(0, 1), b2 + hstep, voffB);
            PG8_WAIT_V(6); PG8_BAR; PG8_MMA(1, 1, At, B1); PG8_BAR;
            PG8_LDB(B0, 1, 0); PG8_SCHED; PG8_LDA(At, 1, 0); PG8_STAGE(PG8_SA(0, 1), a2 + hstep, voffA);
            PG8_WAIT_L(8); PG8_BAR; PG8_WAIT_L(0); PG8_MMA(0, 0, At, B0); PG8_BAR; PG8_SCHED;
            PG8_LDB(B1, 1, 1); PG8_STAGE(PG8_SB(1, 0), b3, voffB);
            PG8_BAR; PG8_WAIT_L(0); PG8_MMA(0, 1, At, B1); PG8_BAR;
            PG8_LDA(At, 1, 1); PG8_STAGE(PG8_SA(1, 0), a3, voffA);
            PG8_BAR; PG8_WAIT_L(0); PG8_MMA(1, 0, At, B0); PG8_BAR; PG8_SCHED;
            PG8_STAGE(PG8_SB(1, 1), b3 + hstep, voffB);
            PG8_WAIT_V(6); PG8_BAR; PG8_MMA(1, 1, At, B1); PG8_BAR;
            }
        }
        if constexpr (ALIGN_EPI) { if (wr == 0) PG8_BAR; }
        if constexpr (!Epi::AFTER_DRAIN) { E(acc, cur, wr, wc, fr, fq); S.done(cur); }
        if (!has_next) break;
#pragma unroll
        for (int a = 0; a < 2; ++a)
#pragma unroll
            for (int b = 0; b < 2; ++b)
#pragma unroll
                for (int m = 0; m < 4; ++m)
#pragma unroll
                    for (int n = 0; n < 2; ++n) acc[a][b][m][n] = (f32x4){0.f, 0.f, 0.f, 0.f};
        cur = nxt; cA = nA; cB = nB; ++ui;
        if constexpr (ALIGN_EPI) { if (wr == 1) PG8_BAR; }
    }
    PG8_WAIT_V(0);
    if constexpr (!ALIGN_EPI) { if (wr == 0) PG8_BAR; }
    PG8_BAR;
    if constexpr (Epi::AFTER_DRAIN) { E.fused(acc, cur, wr, wc, fr, fq, lds, wid, lane); S.done(cur); }
#undef PG8_SA
#undef PG8_SB
#undef PG8_STAGE
#undef PG8_LDA
#undef PG8_LDB
#undef PG8_MMA
#undef PG8_WAIT_V
#undef PG8_WAIT_L
#undef PG8_BAR
#undef PG8_SCHED
}
typedef int v8i_t __attribute__((ext_vector_type(8)));
__host__ __device__ __forceinline__ int lds_byte8(int r, int c16) { return (r >> 4) * 2048 + c16 * 256 + (r & 15) * 16; }
__host__ __device__ __forceinline__ void stage_rc8(int b, int& R, int& C) { R = (b / 2048) * 16 + (b % 256) / 16; C = ((b % 2048) / 256) * 8; }
__device__ __forceinline__ v8i_t ld_frag8(const PG8_LAS unsigned char* p) { const u32x4 a = *(const PG8_LAS u32x4*)p, b = *(const PG8_LAS u32x4*)(p + 256);
    v8i_t r; r[0] = (int)a.x; r[1] = (int)a.y; r[2] = (int)a.z; r[3] = (int)a.w; r[4] = (int)b.x; r[5] = (int)b.y; r[6] = (int)b.z; r[7] = (int)b.w; return r; }
template <class Epi, class Sched, bool ALIGN_EPI = false, bool SP2 = false>
__device__ __forceinline__ void gemm_phase8(PG8_LAS unsigned char* lds, const Gemm g, const Sched& S, const Epi& E) {
    int tid_ = threadIdx.x; asm volatile("" : "+v"(tid_));
    const int tid = tid_, wid = __builtin_amdgcn_readfirstlane(tid >> 6), lane = tid & 63, wr = wid >> 2, wc = wid & 3, fr = lane & 15, fq = lane >> 4;
    const int K = g.K, nt = K / BK;
    unsigned voffA[2], voffB[2];
#pragma unroll
    for (int i = 0; i < 2; ++i) { int R, C; stage_rc8(tid * 16 + i * 8192, R, C); const int Rb = Epi::PERM ? ((R & ~31) + perm32(R & 31)) : R;
        voffA[i] = (unsigned)(R * K + C) * 2u; voffB[i] = (unsigned)(Rb * K + C) * 2u; }
    const size_t kstep = (size_t)(BK * 2);
    const size_t hstep = (size_t)HALF * K * 2;
    const size_t tstep = 2 * hstep;
    const unsigned ldsw = (unsigned)wid * 1024u;
    const int aoff = lds_byte8(wr * 64 + fr, 2 * fq), boff = lds_byte8(wc * 32 + fr, 2 * fq);
#define PG8_SA(b, h) (((b) * 2 + (h)) * HTB)
#define PG8_SB(b, h) ((4 + (b) * 2 + (h)) * HTB)
#define PG8_STAGE(bufoff, gbase, voff) do { _Pragma("unroll") for (int _i = 0; _i < 2; ++_i) \
        __builtin_amdgcn_global_load_lds((const unsigned*)((const char*)(gbase) + (voff)[_i]), (PG8_LAS unsigned*)(lds + (bufoff) + ldsw + _i * 8192), 16, 0, 0); } while (0)
#define PG8_LDA(dst, b, h) do { _Pragma("unroll") for (int m = 0; m < 4; ++m) dst[m] = ld_frag8(lds + PG8_SA(b, h) + aoff + m * 2048); } while (0)
#define PG8_LDB(dst, b, h) do { _Pragma("unroll") for (int n = 0; n < 2; ++n) dst[n] = ld_frag8(lds + PG8_SB(b, h) + boff + n * 2048); } while (0)
#define PG8_MMA(ai, bj, At, Bt) do { __builtin_amdgcn_s_setprio(1); _Pragma("unroll") for (int m = 0; m < 4; ++m) _Pragma("unroll") for (int n = 0; n < 2; ++n) \
        asm volatile("v_mfma_scale_f32_16x16x128_f8f6f4 %0, %1, %2, %0, %3, %3 op_sel_hi:[0,0,0]" : "+v"(acc[ai][bj][m][n]) : "v"(Bt[n]), "v"(At[m]), "v"(one_scale)); __builtin_amdgcn_s_setprio(0); } while (0)
#define PG8_WAIT_V(n) asm volatile("s_waitcnt vmcnt(" #n ")" ::: "memory")
#define PG8_WAIT_L(n) asm volatile("s_waitcnt lgkmcnt(" #n ")" ::: "memory")
#define PG8_BAR __builtin_amdgcn_s_barrier()
#define PG8_SCHED __builtin_amdgcn_sched_barrier(0)
    Unit cur, nxt; int ui = 0;
    if (!S.next(0, cur)) return;
    f32x4 acc[2][2][4][2];
#pragma unroll
    for (int a = 0; a < 2; ++a)
#pragma unroll
        for (int b = 0; b < 2; ++b)
#pragma unroll
            for (int m = 0; m < 4; ++m)
#pragma unroll
                for (int n = 0; n < 2; ++n) acc[a][b][m][n] = (f32x4){0.f, 0.f, 0.f, 0.f};
    v8i_t At[4], B0[2], B1[2]; int one_scale = 0x7F7F7F7F; asm volatile("" : "+v"(one_scale));

    const char* cA = (const char*)g.A + (size_t)cur.pm * tstep; const char* cB = (const char*)g.Bt + (size_t)((cur.pm / g.tpg) % g.ng) * g.gstride + (size_t)cur.pn * tstep;
    S.a_ready(cur);
    if constexpr (SP2) {
        PG8_STAGE(PG8_SB(0, 0), cB, voffB); PG8_STAGE(PG8_SB(0, 1), cB + hstep, voffB); PG8_STAGE(PG8_SA(0, 0), cA, voffA); PG8_STAGE(PG8_SA(0, 1), cA + hstep, voffA);
        if (wr == 1) PG8_BAR;
        PG8_WAIT_V(2); PG8_BAR;
        PG8_STAGE(PG8_SB(1, 0), cB + kstep, voffB); PG8_STAGE(PG8_SA(1, 0), cA + kstep, voffA); PG8_STAGE(PG8_SB(1, 1), cB + hstep + kstep, voffB);
        PG8_WAIT_V(6); PG8_BAR;
    } else {
        PG8_STAGE(PG8_SB(0, 0), cB, voffB); PG8_STAGE(PG8_SA(0, 0), cA, voffA); PG8_STAGE(PG8_SB(0, 1), cB + hstep, voffB); PG8_STAGE(PG8_SA(0, 1), cA + hstep, voffA);
        if (wr == 1) PG8_BAR;
        PG8_WAIT_V(4); PG8_BAR;
        PG8_STAGE(PG8_SB(1, 0), cB + kstep, voffB); PG8_STAGE(PG8_SA(1, 0), cA + kstep, voffA); PG8_STAGE(PG8_SB(1, 1), cB + hstep + kstep, voffB);
        PG8_WAIT_V(6); PG8_BAR;
    }
    for (;;) {
        const bool has_next = S.next(ui + 1, nxt);
        const char* nA = has_next ? (const char*)g.A + (size_t)nxt.pm * tstep : cA; const char* nB = has_next ? (const char*)g.Bt + (size_t)((nxt.pm / g.tpg) % g.ng) * g.gstride + (size_t)nxt.pn * tstep : cB;
#pragma unroll 1
        for (int t = 0; t < nt; t += 2) {
            if constexpr (Epi::MID_T > 0) { if (t == Epi::MID_T) E.mid(acc, cur, wr, wc, fr, fq); }
            const bool last = (t == nt - 2);
            const char* a1 = cA + (size_t)(t + 1) * kstep;
            const char* a2 = last ? nA : cA + (size_t)(t + 2) * kstep; const char* b2 = last ? nB : cB + (size_t)(t + 2) * kstep;
            const char* a3 = a2 + kstep; const char* b3 = b2 + kstep;
            if (last && has_next) S.a_ready(nxt);
            if constexpr (SP2) {
            PG8_LDB(B0, 0, 0); PG8_LDB(B1, 0, 1); PG8_SCHED; PG8_LDA(At, 0, 0); PG8_STAGE(PG8_SA(1, 1), a1 + hstep, voffA);
            PG8_WAIT_V(8); PG8_WAIT_L(0); PG8_BAR; PG8_MMA(0, 0, At, B0); PG8_MMA(0, 1, At, B1); PG8_BAR; PG8_SCHED;
            PG8_LDA(At, 0, 1); PG8_STAGE(PG8_SB(0, 0), b2, voffB); PG8_STAGE(PG8_SB(0, 1), b2 + hstep, voffB); PG8_STAGE(PG8_SA(0, 0), a2, voffA);
            PG8_WAIT_V(8); PG8_WAIT_L(0); PG8_BAR; PG8_MMA(1, 0, At, B0); PG8_MMA(1, 1, At, B1); PG8_BAR; PG8_SCHED;
            PG8_LDB(B0, 1, 0); PG8_LDB(B1, 1, 1); PG8_SCHED; PG8_LDA(At, 1, 0); PG8_STAGE(PG8_SA(0, 1), a2 + hstep, voffA);
            PG8_WAIT_V(8); PG8_WAIT_L(0); PG8_BAR; PG8_MMA(0, 0, At, B0); PG8_MMA(0, 1, At, B1); PG8_BAR; PG8_SCHED;
            PG8_LDA(At, 1, 1); PG8_STAGE(PG8_SB(1, 0), b3, voffB); PG8_STAGE(PG8_SB(1, 1), b3 + hstep, voffB); PG8_STAGE(PG8_SA(1, 0), a3, voffA);
            PG8_WAIT_V(8); PG8_WAIT_L(0); PG8_BAR; PG8_MMA(1, 0, At, B0); PG8_MMA(1, 1, At, B1); PG8_BAR; PG8_SCHED;
            } else {
            PG8_LDB(B0, 0, 0); PG8_SCHED; PG8_LDA(At, 0, 0); PG8_STAGE(PG8_SA(1, 1), a1 + hstep, voffA);
            PG8_WAIT_L(8); PG8_BAR; PG8_WAIT_L(0); PG8_MMA(0, 0, At, B0); PG8_BAR; PG8_SCHED;
            PG8_LDB(B1, 0, 1); PG8_STAGE(PG8_SB(0, 0), b2, voffB);
            PG8_BAR; PG8_WAIT_L(0); PG8_MMA(0, 1, At, B1); PG8_BAR;
            PG8_LDA(At, 0, 1); PG8_STAGE(PG8_SA(0, 0), a2, voffA);
            PG8_BAR; PG8_WAIT_L(0); PG8_MMA(1, 0, At, B0); PG8_BAR; PG8_SCHED;
            PG8_STAGE(PG8_SB(0, 1), b2 + hstep, voffB);
            PG8_WAIT_V(6); PG8_BAR; PG8_MMA(1, 1, At, B1); PG8_BAR;
            PG8_LDB(B0, 1, 0); PG8_SCHED; PG8_LDA(At, 1, 0); PG8_STAGE(PG8_SA(0, 1), a2 + hstep, voffA);
            PG8_WAIT_L(8); PG8_BAR; PG8_WAIT_L(0); PG8_MMA(0, 0, At, B0); PG8_BAR; PG8_SCHED;
            PG8_LDB(B1, 1, 1); PG8_STAGE(PG8_SB(1, 0), b3, voffB);
            PG8_BAR; PG8_WAIT_L(0); PG8_MMA(0, 1, At, B1); PG8_BAR;
            PG8_LDA(At, 1, 1); PG8_STAGE(PG8_SA(1, 0), a3, voffA);
            PG8_BAR; PG8_WAIT_L(0); PG8_MMA(1, 0, At, B0); PG8_BAR; PG8_SCHED;
            PG8_STAGE(PG8_SB(1, 1), b3 + hstep, voffB);
            PG8_WAIT_V(6); PG8_BAR; PG8_MMA(1, 1, At, B1); PG8_BAR;
            }
        }
        if constexpr (ALIGN_EPI) { if (wr == 0) PG8_BAR; }
        asm volatile("s_nop 15\n\ts_nop 15" ::: "memory");
        if constexpr (!Epi::AFTER_DRAIN) { E(acc, cur, wr, wc, fr, fq); S.done(cur); }
        if (!has_next) break;
#pragma unroll
        for (int a = 0; a < 2; ++a)
#pragma unroll
            for (int b = 0; b < 2; ++b)
#pragma unroll
                for (int m = 0; m < 4; ++m)
#pragma unroll
                    for (int n = 0; n < 2; ++n) acc[a][b][m][n] = (f32x4){0.f, 0.f, 0.f, 0.f};
        cur = nxt; cA = nA; cB = nB; ++ui;
        if constexpr (ALIGN_EPI) { if (wr == 1) PG8_BAR; }
    }
    PG8_WAIT_V(0);
    if constexpr (!ALIGN_EPI) { if (wr == 0) PG8_BAR; }
    PG8_BAR;
    if constexpr (Epi::AFTER_DRAIN) { E.fused(acc, cur, wr, wc, fr, fq, lds, wid, lane); S.done(cur); }
#undef PG8_SA
#undef PG8_SB
#undef PG8_STAGE
#undef PG8_LDA
#undef PG8_LDB
#undef PG8_MMA
#undef PG8_WAIT_V
#undef PG8_WAIT_L
#undef PG8_BAR
#undef PG8_SCHED
}
#ifndef PG8_PRIO_MMA
#define PG8_PRIO_MMA 1
#endif
typedef int v4i_t __attribute__((ext_vector_type(4)));
__host__ __device__ __forceinline__ int lds_byte4(int r, int c16) { return r * 128 + ((c16 ^ ((r >> 1) & 7)) << 4); }
__host__ __device__ __forceinline__ void stage_rc4(int b, int& R, int& C) { R = b / 128; C = ((((b % 128) / 16) ^ ((R >> 1) & 7))) * 8; }
template <class Epi, class Sched, bool ALIGN_EPI = false, bool SP2 = false, int VAR = 0  >
__device__ __forceinline__ void gemm_phase4(PG8_LAS unsigned char* lds, const Gemm g, const Sched& S, const Epi& E) {
    int tid_ = threadIdx.x; asm volatile("" : "+v"(tid_));
    const int tid = tid_, wid = __builtin_amdgcn_readfirstlane(tid >> 6), lane = tid & 63, wr = wid >> 2, wc = wid & 3, fr = lane & 15, fq = lane >> 4;
    const int K = g.K, nt = K / BK;
    unsigned voffA[2], voffB[2];
#pragma unroll
    for (int i = 0; i < 2; ++i) { int R, C; stage_rc4(tid * 16 + i * 8192, R, C); const int Rb = Epi::PERM ? ((R & ~31) + perm32(R & 31)) : R;
        voffA[i] = (unsigned)(R * K + C) * 2u; voffB[i] = (unsigned)(Rb * K + C) * 2u; }
    const size_t kstep = (size_t)(BK * 2);
    const size_t hstep = (size_t)HALF * K * 2;
    const size_t tstep = 2 * hstep;
    const unsigned ldsw = (unsigned)wid * 1024u;
    const int aoff[2] = {lds_byte4(wr * 64 + fr, fq), lds_byte4(wr * 64 + fr, 4 + fq)}, boff[2] = {lds_byte4(wc * 32 + fr, fq), lds_byte4(wc * 32 + fr, 4 + fq)};
#define PG8_SA(b, h) (((b) * 2 + (h)) * HTB)
#define PG8_SB(b, h) ((4 + (b) * 2 + (h)) * HTB)
#define PG8_STAGE(bufoff, gbase, voff) do { if constexpr ((VAR & 4) == 0) _Pragma("unroll") for (int _i = 0; _i < 2; ++_i) \
        __builtin_amdgcn_global_load_lds((const unsigned*)((const char*)(gbase) + (voff)[_i]), (PG8_LAS unsigned*)(lds + (bufoff) + ldsw + _i * 8192), 16, 0, 0); } while (0)
#define PG8_LDA(dst, b, h) do { if constexpr ((VAR & 2) == 0) _Pragma("unroll") for (int m = 0; m < 4; ++m) _Pragma("unroll") for (int k = 0; k < 2; ++k) dst[m][k] = *(const PG8_LAS v4i_t*)(lds + PG8_SA(b, h) + aoff[k] + m * 2048); } while (0)
#define PG8_LDB(dst, b, h) do { if constexpr ((VAR & 2) == 0) _Pragma("unroll") for (int n = 0; n < 2; ++n) _Pragma("unroll") for (int k = 0; k < 2; ++k) dst[n][k] = *(const PG8_LAS v4i_t*)(lds + PG8_SB(b, h) + boff[k] + n * 2048); } while (0)
#define PG8_MMA(ai, bj, At, Bt) do { __builtin_amdgcn_s_setprio(PG8_PRIO_MMA); if constexpr ((VAR & 1) == 0) _Pragma("unroll") for (int k = 0; k < 2; ++k) _Pragma("unroll") for (int m = 0; m < 4; ++m) _Pragma("unroll") for (int n = 0; n < 2; ++n)   \
        asm volatile("v_mfma_scale_f32_16x16x128_f8f6f4 %0, %1, %2, %0, %3, %3 op_sel_hi:[0,0,0] cbsz:4 blgp:4" : "+v"(acc[ai][bj][m][n]) : "v"(Bt[n][k]), "v"(At[m][k]), "v"(one_scale)); __builtin_amdgcn_s_setprio(1 - PG8_PRIO_MMA); } while (0)
#define PG8_WAIT_V(n) asm volatile("s_waitcnt vmcnt(" #n ")" ::: "memory")
#define PG8_WAIT_L(n) asm volatile("s_waitcnt lgkmcnt(" #n ")" ::: "memory")
#define PG8_BAR __builtin_amdgcn_s_barrier()
#define PG8_SCHED __builtin_amdgcn_sched_barrier(0)
    Unit cur, nxt; int ui = 0;
    if (!S.next(0, cur)) return;
    f32x4 acc[2][2][4][2];
#pragma unroll
    for (int a = 0; a < 2; ++a)
#pragma unroll
        for (int b = 0; b < 2; ++b)
#pragma unroll
            for (int m = 0; m < 4; ++m)
#pragma unroll
                for (int n = 0; n < 2; ++n) acc[a][b][m][n] = (f32x4){0.f, 0.f, 0.f, 0.f};
    v4i_t At[4][2] = {}, B0[2][2] = {}, B1[2][2] = {}; if constexpr (VAR != 0) { _Pragma("unroll") for (int m = 0; m < 4; ++m) _Pragma("unroll") for (int k = 0; k < 2; ++k) asm volatile("" : "+v"(At[m][k])); _Pragma("unroll") for (int n = 0; n < 2; ++n) _Pragma("unroll") for (int k = 0; k < 2; ++k) asm volatile("" : "+v"(B0[n][k]), "+v"(B1[n][k])); }
    int one_scale = 0x7F7F7F7F; asm volatile("" : "+v"(one_scale));

    const char* cA = (const char*)g.A + (size_t)cur.pm * tstep; const char* cB = (const char*)g.Bt + (size_t)((cur.pm / g.tpg) % g.ng) * g.gstride + (size_t)cur.pn * tstep;
    S.a_ready(cur);
    if constexpr (SP2) {
        PG8_STAGE(PG8_SB(0, 0), cB, voffB); PG8_STAGE(PG8_SB(0, 1), cB + hstep, voffB); PG8_STAGE(PG8_SA(0, 0), cA, voffA); PG8_STAGE(PG8_SA(0, 1), cA + hstep, voffA);
        if (wr == 1) PG8_BAR;
        PG8_WAIT_V(2); PG8_BAR;
        PG8_STAGE(PG8_SB(1, 0), cB + kstep, voffB); PG8_STAGE(PG8_SA(1, 0), cA + kstep, voffA); PG8_STAGE(PG8_SB(1, 1), cB + hstep + kstep, voffB);
        PG8_WAIT_V(6); PG8_BAR;
    } else {
        PG8_STAGE(PG8_SB(0, 0), cB, voffB); PG8_STAGE(PG8_SA(0, 0), cA, voffA); PG8_STAGE(PG8_SB(0, 1), cB + hstep, voffB); PG8_STAGE(PG8_SA(0, 1), cA + hstep, voffA);
        if (wr == 1) PG8_BAR;
        PG8_WAIT_V(4); PG8_BAR;
        PG8_STAGE(PG8_SB(1, 0), cB + kstep, voffB); PG8_STAGE(PG8_SA(1, 0), cA + kstep, voffA); PG8_STAGE(PG8_SB(1, 1), cB + hstep + kstep, voffB);
        PG8_WAIT_V(6); PG8_BAR;
    }
    for (;;) {
        const bool has_next = S.next(ui + 1, nxt);
        const char* nA = has_next ? (const char*)g.A + (size_t)nxt.pm * tstep : cA; const char* nB = has_next ? (const char*)g.Bt + (size_t)((nxt.pm / g.tpg) % g.ng) * g.gstride + (size_t)nxt.pn * tstep : cB;
#pragma unroll 1
        for (int t = 0; t < nt; t += 2) {
            if constexpr (Epi::MID_T > 0) { if (t == Epi::MID_T) E.mid(acc, cur, wr, wc, fr, fq); }
            const bool last = (t == nt - 2);
            const char* a1 = cA + (size_t)(t + 1) * kstep;
            const char* a2 = last ? nA : cA + (size_t)(t + 2) * kstep; const char* b2 = last ? nB : cB + (size_t)(t + 2) * kstep;
            const char* a3 = a2 + kstep; const char* b3 = b2 + kstep;
            if (last && has_next) S.a_ready(nxt);
            if constexpr (SP2) {
            PG8_LDB(B0, 0, 0); PG8_LDB(B1, 0, 1); PG8_SCHED; PG8_LDA(At, 0, 0); PG8_STAGE(PG8_SA(1, 1), a1 + hstep, voffA);
            PG8_WAIT_V(8); PG8_WAIT_L(0); PG8_BAR; PG8_MMA(0, 0, At, B0); PG8_MMA(0, 1, At, B1); PG8_BAR; PG8_SCHED;
            PG8_LDA(At, 0, 1); PG8_STAGE(PG8_SB(0, 0), b2, voffB); PG8_STAGE(PG8_SB(0, 1), b2 + hstep, voffB); PG8_STAGE(PG8_SA(0, 0), a2, voffA);
            PG8_WAIT_V(8); PG8_WAIT_L(0); PG8_BAR; PG8_MMA(1, 0, At, B0); PG8_MMA(1, 1, At, B1); PG8_BAR; PG8_SCHED;
            PG8_LDB(B0, 1, 0); PG8_LDB(B1, 1, 1); PG8_SCHED; PG8_LDA(At, 1, 0); PG8_STAGE(PG8_SA(0, 1), a2 + hstep, voffA);
            PG8_WAIT_V(8); PG8_WAIT_L(0); PG8_BAR; PG8_MMA(0, 0, At, B0); PG8_MMA(0, 1, At, B1); PG8_BAR; PG8_SCHED;
            PG8_LDA(At, 1, 1); PG8_STAGE(PG8_SB(1, 0), b3, voffB); PG8_STAGE(PG8_SB(1, 1), b3 + hstep, voffB); PG8_STAGE(PG8_SA(1, 0), a3, voffA);
            PG8_WAIT_V(8); PG8_WAIT_L(0); PG8_BAR; PG8_MMA(1, 0, At, B0); PG8_MMA(1, 1, At, B1); PG8_BAR; PG8_SCHED;
            } else {
            PG8_LDB(B0, 0, 0); PG8_SCHED; PG8_LDA(At, 0, 0); PG8_STAGE(PG8_SA(1, 1), a1 + hstep, voffA);
            PG8_WAIT_L(8); PG8_BAR; PG8_WAIT_L(0); PG8_MMA(0, 0, At, B0); PG8_BAR; PG8_SCHED;
            PG8_LDB(B1, 0, 1); PG8_STAGE(PG8_SB(0, 0), b2, voffB);
            PG8_BAR; PG8_WAIT_L(0); PG8_MMA(0, 1, At, B1); PG8_BAR;
            PG8_LDA(At, 0, 1); PG8_STAGE(PG8_SA(0, 0), a2, voffA);
            PG8_BAR; PG8_WAIT_L(0); PG8_MMA(1, 0, At, B0); PG8_BAR; PG8_SCHED;
            PG8_STAGE(PG8_SB(0, 1), b2 + hstep, voffB);
            PG8_WAIT_V(6); PG8_BAR; PG8_MMA(1, 1, At, B1); PG8_BAR;
            PG8_LDB(B0, 1, 0); PG8_SCHED; PG8_LDA(At, 1, 0); PG8_STAGE(PG8_SA(0, 1), a2 + hstep, voffA);
            PG8_WAIT_L(8); PG8_BAR; PG8_WAIT_L(0); PG8_MMA(0, 0, At, B0); PG8_BAR; PG8_SCHED;
            PG8_LDB(B1, 1, 1); PG8_STAGE(PG8_SB(1, 0), b3, voffB);
            PG8_BAR; PG8_WAIT_L(0); PG8_MMA(0, 1, At, B1); PG8_BAR;
            PG8_LDA(At, 1, 1); PG8_STAGE(PG8_SA(1, 0), a3, voffA);
            PG8_BAR; PG8_WAIT_L(0); PG8_MMA(1, 0, At, B0); PG8_BAR; PG8_SCHED;
            PG8_STAGE(PG8_SB(1, 1), b3 + hstep, voffB);
            PG8_WAIT_V(6); PG8_BAR; PG8_MMA(1, 1, At, B1); PG8_BAR;
            }
        }
        if constexpr (ALIGN_EPI) { if (wr == 0) PG8_BAR; }
        asm volatile("s_nop 15\n\ts_nop 15" ::: "memory");
        if constexpr (!Epi::AFTER_DRAIN && (VAR & 8) == 0) { E(acc, cur, wr, wc, fr, fq); S.done(cur); }
        if (!has_next) break;
#pragma unroll
        for (int a = 0; a < 2; ++a)
#pragma unroll
            for (int b = 0; b < 2; ++b)
#pragma unroll
                for (int m = 0; m < 4; ++m)
#pragma unroll
                    for (int n = 0; n < 2; ++n) acc[a][b][m][n] = (f32x4){0.f, 0.f, 0.f, 0.f};
        cur = nxt; cA = nA; cB = nB; ++ui;
        if constexpr (ALIGN_EPI) { if (wr == 1) PG8_BAR; }
    }
    PG8_WAIT_V(0);
    if constexpr (!ALIGN_EPI) { if (wr == 0) PG8_BAR; }
    PG8_BAR;
    if constexpr (Epi::AFTER_DRAIN) { E.fused(acc, cur, wr, wc, fr, fq, lds, wid, lane); S.done(cur); }
#undef PG8_SA
#undef PG8_SB
#undef PG8_STAGE
#undef PG8_LDA
#undef PG8_LDB
#undef PG8_MMA
#undef PG8_WAIT_V
#undef PG8_WAIT_L
#undef PG8_BAR
#undef PG8_SCHED
}
}
constexpr int NWAVES = 8;
#ifndef MK_ATTN_SIMPLE
#define MK_ATTN_SIMPLE 0
#endif
#ifndef MK_TOPK_RANK
#define MK_TOPK_RANK 0
#endif
#ifndef MK_PER_PHASE
#define MK_PER_PHASE 0
#endif

constexpr int D = 1024, TP = 16384, TS = 4096, NSB = 4, T = TP + NSB * TS;
constexpr int DEPTH = 2, NMOD = 5;
constexpr int HYW = 512, NHY = 3 * HYW, ATW = 512, KVW = 128, INW = 4352;
constexpr int COL_Q = 1536, COL_K = 2048, COL_V = 2176, COL_G = 2304;
constexpr int NH = 8, NKV = 2, HD = 64, WIN = 128;
constexpr int NE = 16, CAP = 2048, FF = 2816, NGRP = 2, TG = 16384;
constexpr int NSLOT = NGRP * NE * CAP;
constexpr float EPS = 1e-6f;
constexpr int FH = 64, FEMB = 33, FOUT = 2048;
constexpr int TPAD = T + 64;
constexpr int KB_UP = D / 2, KB_DN = 1536;
constexpr int KFS_P = 16392, KFS_S = 4104;

constexpr size_t MiB = 1u << 20;
constexpr size_t WS_CTL = 0, CTL_ZERO_BYTES = 1 * MiB;
constexpr size_t WS_MOD = 1 * MiB;
constexpr size_t WS_PSUM = 2 * MiB;
constexpr size_t WS_AFFT = 7 * MiB;
constexpr size_t WS_SLOT = 9 * MiB;
constexpr size_t WS_IDX = 11 * MiB;
constexpr size_t WS_GATEV = 11 * MiB + 512 * 1024;
constexpr size_t WS_ROPE = 12 * MiB;
constexpr size_t WS_WIN = 16 * MiB;
constexpr size_t WS_WHY = 33 * MiB;
constexpr size_t WS_WAT = 35 * MiB;
constexpr size_t WS_WO = 37 * MiB;
constexpr size_t WS_AFFTOK = 41 * MiB;
constexpr size_t WS_WOUT = 43 * MiB;
constexpr size_t WS_WGU = 48 * MiB;
constexpr size_t WS_WD = 224 * MiB;
constexpr size_t WS_H = 312 * MiB;
constexpr size_t WS_R1 = 376 * MiB;
constexpr size_t WS_HRAW_P = WS_R1, WS_HRAW_S = WS_R1 + 128 * MiB;
constexpr size_t WS_Z2T = WS_R1, WS_Z2AT = WS_R1 + 65 * MiB;
constexpr int ZAP = 2 * HYW;
constexpr size_t WS_KF_P = 536 * MiB, WS_KF_S = 665 * MiB;
constexpr size_t WS_YHY = 536 * MiB, WS_YAT = 600 * MiB;
constexpr size_t WS_HYT = 698 * MiB;
constexpr size_t WS_MERGED = 698 * MiB, WS_MIX = 762 * MiB;
constexpr size_t WS_PROJ = 891 * MiB;
constexpr size_t WS_QN = 1162 * MiB, WS_KN = 1194 * MiB;
constexpr size_t WS_XE = 376 * MiB, WS_HID = 504 * MiB, WS_YE = 856 * MiB;
constexpr size_t WS_END = 1202 * MiB;
static_assert(WS_KF_P + (size_t)1024 * KFS_P * 8 <= WS_KF_S && WS_KF_S + (size_t)1024 * KFS_S * 8 <= WS_HYT && WS_HYT + (size_t)NHY * TPAD * 4 <= WS_PROJ && WS_PROJ + (size_t)T * INW * 2 <= WS_END && WS_Z2T + (size_t)HYW * TPAD * 4 <= WS_Z2AT && WS_Z2AT + (size_t)T * ZAP * 2 <= WS_R1 + 160 * MiB, "ws map");
static_assert(WS_HID + (size_t)NSLOT * FF * 2 <= WS_YE && WS_YE + (size_t)NSLOT * D * 2 <= WS_END && WS_WGU + (size_t)NE * 2 * FF * D * 2 <= WS_WD && WS_WD + (size_t)NE * D * FF * 2 <= WS_H, "ws map 2");
constexpr int CW_BAR = 4096;

constexpr int RING_OFF = 0, RING_BYTES = 139264;
constexpr int LDSCTL_OFF = RING_BYTES, MISC_OFF = LDSCTL_OFF + 320;
constexpr int SCR_OFF = RING_BYTES + 1024;
constexpr int LDS_BYTES = 151552;
static_assert(MISC_OFF + 128 <= SCR_OFF && SCR_OFF + 8192 <= LDS_BYTES, "LDS map");

#define GAS __attribute__((address_space(1)))
#define LAS __attribute__((address_space(3)))
typedef unsigned short bf16;
typedef unsigned v4u __attribute__((ext_vector_type(4)));
typedef unsigned v2u __attribute__((ext_vector_type(2)));
typedef float f32x4 __attribute__((ext_vector_type(4)));
typedef float f32x2 __attribute__((ext_vector_type(2)));
typedef float f32x16 __attribute__((ext_vector_type(16)));
typedef short bf16x8 __attribute__((ext_vector_type(8)));
typedef GAS unsigned gu32;
#define RLX_AGENT __ATOMIC_RELAXED, __HIP_MEMORY_SCOPE_AGENT
#define LDS_WAIT() asm volatile("s_waitcnt lgkmcnt(0)" ::: "memory")
#define VM_WAIT() asm volatile("s_waitcnt vmcnt(0)" ::: "memory")
__device__ __forceinline__ unsigned f2bf(float f) { unsigned u = __builtin_bit_cast(unsigned, f); return (u + 0x7fffu + ((u >> 16) & 1u)) >> 16; }
__device__ __forceinline__ unsigned pk2(float lo, float hi) { return f2bf(lo) | (f2bf(hi) << 16); }
__device__ __forceinline__ float bf2f(unsigned b) { return __builtin_bit_cast(float, b << 16); }
__device__ __forceinline__ float bflo(unsigned w) { return __builtin_bit_cast(float, w << 16); }
__device__ __forceinline__ float bfhi(unsigned w) { return __builtin_bit_cast(float, w & 0xffff0000u); }
__device__ __forceinline__ float wave_sum(float v) {
#pragma unroll
    for (int o = 1; o < 64; o <<= 1) v += __shfl_xor(v, o);
    return v;
}
__device__ __forceinline__ float wave_max(float v) {
#pragma unroll
    for (int o = 1; o < 64; o <<= 1) v = fmaxf(v, __shfl_xor(v, o));
    return v;
}
__device__ __forceinline__ float rdlane(float v, int l) { return __builtin_bit_cast(float, __builtin_amdgcn_readlane(__builtin_bit_cast(int, v), l)); }
__device__ __forceinline__ float sin_rev(float x) { return __builtin_amdgcn_sinf(x); }
__device__ __forceinline__ float cos_rev(float x) { return __builtin_amdgcn_cosf(x); }
__device__ __forceinline__ float fast_exp(float x) { return __builtin_amdgcn_exp2f(1.4426950408889634f * x); }
__device__ __forceinline__ float sigmoidf(float x) { return __builtin_amdgcn_rcpf(1.0f + fast_exp(-x)); }
__device__ __forceinline__ float siluf(float x) { return x * sigmoidf(x); }
__device__ __forceinline__ float siluf_acc(float x) { return x / (1.0f + expf(-x)); }

#define XB_TMO      128
#define XB_XCNT(j)  (256  + 64 * (j))
#define XB_XSUB(j)  (1280 + 64 * (j))
#define XB_XGEN(j)  (2304 + 64 * (j))
#define XB_TOP      3328
#define XB_TOPGEN   3392
#define XCD_BAR_WORDS 3456
#define XB_SPIN_CAP (1u << 22)

__device__ __forceinline__ unsigned xb_ld(unsigned* p)              { return __hip_atomic_load(p, __ATOMIC_RELAXED, __HIP_MEMORY_SCOPE_AGENT); }
__device__ __forceinline__ unsigned xb_add(unsigned* p, unsigned v) { return __hip_atomic_fetch_add(p, v, __ATOMIC_RELAXED, __HIP_MEMORY_SCOPE_AGENT); }
__device__ __forceinline__ unsigned xb_xcc_id() { return (unsigned)__builtin_amdgcn_s_getreg((3 << 11) | 20) & 0xFu; }
#define XB_SPIN(cond, bar) do { unsigned _sp = 0; while (cond) { __builtin_amdgcn_s_sleep(1); \
    if ((++_sp & 255u) == 0u) { if (xb_ld(&(bar)[XB_TMO])) break; if (_sp > XB_SPIN_CAP) { atomicAdd(&(bar)[XB_TMO], 1u); break; } } } } while (0)

struct XcdBarrier {
    unsigned* bar; unsigned x;
    volatile LAS unsigned* st;
};

__device__ __forceinline__ XcdBarrier xcd_barrier_post(unsigned* bar, volatile LAS unsigned* st) {
    XcdBarrier b; b.bar = bar; b.x = xb_xcc_id(); b.st = st;
    if (threadIdx.x == 0) (void)xb_add(&bar[XB_XCNT(b.x)], 1u);
    return b;
}
__device__ __forceinline__ void xcd_barrier_complete(unsigned* bar, unsigned x, unsigned& nloc, unsigned& nx) {
    const unsigned G = gridDim.x * gridDim.y * gridDim.z;
    unsigned sum, cnt, mine, sp = 0u;
    for (;;) {
        sum = 0u; cnt = 0u; mine = 0u;
#pragma unroll
        for (unsigned j = 0; j < 16; ++j) { const unsigned c = xb_ld(&bar[XB_XCNT(j)]); sum += c; cnt += (c > 0u) ? 1u : 0u; mine = (j == x) ? c : mine; }
        if (sum == G) break;
        __builtin_amdgcn_s_sleep(1);
        if ((++sp & 255u) == 0u) { if (xb_ld(&bar[XB_TMO])) break; if (sp > XB_SPIN_CAP) { atomicAdd(&bar[XB_TMO], 1u); break; } }
    }
    nloc = mine > 0u ? mine : 1u; nx = cnt > 0u ? cnt : 1u;
}

__device__ __forceinline__ void xcd_barrier(const XcdBarrier& b) {
    asm volatile("s_waitcnt vmcnt(0)" ::: "memory");
    __syncthreads();
    if (threadIdx.x == 0) {
        unsigned* bar = b.bar;
        __builtin_amdgcn_s_waitcnt(0);
        unsigned nloc = b.st[0], nx = b.st[1];
        if (nloc == 0u) { xcd_barrier_complete(bar, b.x, nloc, nx); b.st[0] = nloc; b.st[1] = nx; }
        const unsigned old = xb_add(&bar[XB_XSUB(b.x)], 1u);
        const unsigned gen = old / nloc;
        if (old + 1u == (gen + 1u) * nloc) {
            __builtin_amdgcn_fence(__ATOMIC_RELEASE, "agent");
            asm volatile("s_waitcnt vmcnt(0)" ::: "memory");
            const unsigned og = xb_add(&bar[XB_TOP], 1u);
            const unsigned tg = og / nx;
            if (og + 1u == (tg + 1u) * nx) xb_add(&bar[XB_TOPGEN], 1u);
            else XB_SPIN(xb_ld(&bar[XB_TOPGEN]) == tg, bar);
            __builtin_amdgcn_fence(__ATOMIC_ACQUIRE, "agent");
            xb_add(&bar[XB_XGEN(b.x)], 1u);
            asm volatile("s_waitcnt vmcnt(0)" ::: "memory");
        } else {
            XB_SPIN(xb_ld(&bar[XB_XGEN(b.x)]) == gen, bar);
            __builtin_amdgcn_fence(__ATOMIC_ACQUIRE, "agent");
            asm volatile("s_waitcnt vmcnt(0)" ::: "memory");
        }
    }
    __syncthreads();
}


#define FFT_DEV __device__ __forceinline__
#define FFT_LDS LAS
__device__ __forceinline__ int fft_tid_() { int t = threadIdx.x; asm volatile("" : "+v"(t)); return t; }
#define FFT_TID fft_tid_()
#define FFT_NTHR (NWAVES * 64)
#define FFT_SYNC() __syncthreads()
__device__ __forceinline__ float fft_sin_rev(float x) { return __builtin_amdgcn_sinf(x); }
__device__ __forceinline__ float fft_cos_rev(float x) { return __builtin_amdgcn_cosf(x); }
__device__ __forceinline__ unsigned fft_brev(unsigned x) { return __builtin_bitreverse32(x); }
typedef float c32 __attribute__((ext_vector_type(2)));
#define FFT_PIDX(i) ((i) + (((i) >> 6) << 2))
FFT_DEV c32 c_mk(float a, float b) { c32 r; r.x = a; r.y = b; return r; }
FFT_DEV c32 c_add(c32 a, c32 b) { return a + b; }
FFT_DEV c32 c_sub(c32 a, c32 b) { return a - b; }
FFT_DEV c32 c_mul(c32 a, c32 b) { return b * a.x + c_mk(-b.y, b.x) * a.y; }
FFT_DEV c32 c_mulc(c32 a, c32 b) { return a * b.x + c_mk(a.y, -a.x) * b.y; }
FFT_DEV c32 c_conj(c32 a) { return c_mk(a.x, -a.y); }
FFT_DEV c32 c_scale(c32 a, float s) { return a * s; }
FFT_DEV c32 c_twid(float rev) { return c_mk(fft_cos_rev(rev), -fft_sin_rev(rev)); }
FFT_DEV c32 c_root16(int j) {
    const float C1 = 0.92387953251128674f, S1 = 0.38268343236508977f, H = 0.70710678118654752f;
    switch (j) { case 0: return c_mk(1.f, 0.f); case 1: return c_mk(C1, -S1); case 2: return c_mk(H, -H); case 3: return c_mk(S1, -C1);
                 case 4: return c_mk(0.f, -1.f); case 5: return c_mk(-S1, -C1); case 6: return c_mk(-H, -H); default: return c_mk(-C1, -S1); }
}
template <int LOGM, int NST, bool INV, int NB, int PRUNE> FFT_DEV void fft_pass(FFT_LDS c32* buf0, int s) {
    constexpr int M = 1 << LOGM, R = 1 << NST, G = M / R, PADM = FFT_PIDX(M);
    const int lq = LOGM - s - NST, q = 1 << lq;
    for (int gi = FFT_TID; gi < NB * G; gi += FFT_NTHR) {
        const int g = gi & (G - 1); FFT_LDS c32* buf = buf0 + (gi / G) * PADM;
        const int r = g & (q - 1), i0 = ((g >> lq) << (lq + NST)) + r;
        const int pb = FFT_PIDX(i0);
        c32 x[R];
#pragma unroll
        for (int j = 0; j < R; ++j) x[j] = (PRUNE == 1 && j >= R / 2) ? c_mk(0.f, 0.f) : buf[pb + FFT_PIDX(j * q)];
        c32 Ts[NST];
        Ts[0] = c_twid((float)(r << s) * (1.0f / M));
#pragma unroll
        for (int t = 1; t < NST; ++t) Ts[t] = c_mul(Ts[t - 1], Ts[t - 1]);
#pragma unroll
        for (int tt = 0; tt < NST; ++tt) {
            const int t = INV ? NST - 1 - tt : tt, h = R >> (t + 1);
            c32 Pq[R / 2], Qq[R / 2];
#pragma unroll
            for (int jj = 0; jj < h; ++jj) {
                c32 tw;
                if (jj < (h + 1) / 2) tw = jj == 0 ? Ts[t] : c_mul(Ts[t], c_root16(jj * (8 / h)));
                else { const c32 b = INV ? c_mk(Pq[jj - h / 2].x, -Pq[jj - h / 2].y) : Pq[jj - h / 2]; tw = c_mk(b.y, -b.x); }
                if (!INV) { Pq[jj] = tw; Qq[jj] = c_mk(-tw.y, tw.x); } else { Pq[jj] = c_mk(tw.x, -tw.y); Qq[jj] = c_mk(tw.y, tw.x); }
            }
#pragma unroll
            for (int j = 0; j < R / 2; ++j) { const int jj = j % h, b = (j / h) * 2 * h + jj;
                if (!INV) {
                    if (PRUNE == 1 && t == 0) { const c32 a = x[b]; x[b + h] = Pq[jj] * a.x + Qq[jj] * a.y; }
                    else { const c32 a = x[b], c = x[b + h], d = a - c; x[b] = a + c; x[b + h] = Pq[jj] * d.x + Qq[jj] * d.y; }
                } else {
                    const c32 a = x[b], cr = x[b + h], c = Pq[jj] * cr.x + Qq[jj] * cr.y; x[b] = a + c;
                    if (!(PRUNE == 2 && t == 0)) x[b + h] = a - c;
                }
            }
        }
#pragma unroll
        for (int j = 0; j < R; ++j) if (!(PRUNE == 2 && j >= R / 2)) buf[pb + FFT_PIDX(j * q)] = x[j];
    }
}
template <int LOGM, int NB, bool ZP> FFT_DEV void fft_fwd(FFT_LDS c32* buf) {
    static_assert(LOGM % 4 == 0 || LOGM % 4 == 2, "radix-16 passes + one radix-4 pass");
    FFT_SYNC(); fft_pass<LOGM, 4, false, NB, ZP ? 1 : 0>(buf, 0);
    int s = 4;
#pragma unroll
    for (int p = 1; p < LOGM / 4; ++p) { FFT_SYNC(); fft_pass<LOGM, 4, false, NB, 0>(buf, s); s += 4; }
    if (LOGM % 4 == 2) { FFT_SYNC(); fft_pass<LOGM, 2, false, NB, 0>(buf, s); }
    FFT_SYNC();
}
template <int LOGM, int NB, bool HO> FFT_DEV void fft_inv(FFT_LDS c32* buf) {
    int s = LOGM;
    if (LOGM % 4 == 2) { s -= 2; FFT_SYNC(); fft_pass<LOGM, 2, true, NB, 0>(buf, s); }
#pragma unroll
    for (int p = 1; p < LOGM / 4; ++p) { s -= 4; FFT_SYNC(); fft_pass<LOGM, 4, true, NB, 0>(buf, s); }
    FFT_SYNC(); fft_pass<LOGM, 4, true, NB, HO ? 2 : 0>(buf, 0);
    FFT_SYNC();
}
template <int LOGM> FFT_DEV void filt_untangle(FFT_LDS const c32* buf, c32* KfP, float scale) {
    constexpr int M = 1 << LOGM;
    for (int t = FFT_TID; t <= M / 2; t += FFT_NTHR) {
        if (t == 0) { const c32 Z0 = buf[FFT_PIDX(0)]; KfP[0] = c_mk((Z0.x + Z0.y) * scale, 0.f); KfP[M] = c_mk((Z0.x - Z0.y) * scale, 0.f); }
        else {
            const int p1 = t == M / 2 ? 1 : 2 * t, kk = (int)(fft_brev((unsigned)p1) >> (32 - LOGM)), p2 = (int)(fft_brev((unsigned)(M - kk)) >> (32 - LOGM));
            const c32 A = buf[FFT_PIDX(p1)], B = buf[FFT_PIDX(p2)];
            const c32 E = c_mk(0.5f * (A.x + B.x), 0.5f * (A.y - B.y)), O = c_mk(0.5f * (A.y + B.y), -0.5f * (A.x - B.x));
            const c32 wk = c_twid((float)kk * (0.5f / M)), Tt = c_mul(wk, O);
            KfP[p1] = c_scale(c_add(E, Tt), scale); KfP[p2] = c_scale(c_conj(c_sub(E, Tt)), scale);
        }
    }
}
template <int LOGM, int NB, int CH> FFT_DEV void pw_fetch(const c32* __restrict__ KfP, c32 (&K1)[CH], c32 (&K2)[CH], int i0) {
    constexpr int M = 1 << LOGM;
#pragma unroll
    for (int j = 0; j < CH; ++j) { const int t = (i0 + j * FFT_NTHR) & (M / 2 - 1), p1 = 2 * t, kk = (int)(fft_brev((unsigned)p1) >> (32 - LOGM)), p2 = t == 0 ? M : (int)(fft_brev((unsigned)(M - kk)) >> (32 - LOGM));
        K1[j] = KfP[p1]; K2[j] = KfP[p2]; }
}
template <int LOGM, int NB, int CH> FFT_DEV void conv_pointwise(FFT_LDS c32* buf0, const c32* __restrict__ KfP, float invM, c32 (&K1)[CH], c32 (&K2)[CH]) {
    constexpr int M = 1 << LOGM, PADM = FFT_PIDX(M), NP = NB * (M / 2);
    for (int i0 = FFT_TID; i0 < NP; i0 += CH * FFT_NTHR) {
        c32 N1[CH], N2[CH];
        const bool more = i0 + CH * FFT_NTHR < NP;
        if (more) pw_fetch<LOGM, NB, CH>(KfP, N1, N2, i0 + CH * FFT_NTHR);
#pragma unroll
        for (int j = 0; j < CH; ++j) { const int i = i0 + j * FFT_NTHR, t = i & (M / 2 - 1), p1 = 2 * t, kk = (int)(fft_brev((unsigned)p1) >> (32 - LOGM)); FFT_LDS c32* buf = buf0 + (i / (M / 2)) * PADM;
            if (t == 0) { const c32 Z0 = buf[FFT_PIDX(0)]; const float Y0 = (Z0.x + Z0.y) * K1[j].x * invM, YM = (Z0.x - Z0.y) * K2[j].x * invM; buf[FFT_PIDX(0)] = c_mk(0.5f * (Y0 + YM), 0.5f * (Y0 - YM)); }
            else {
                const int p2 = (int)(fft_brev((unsigned)(M - kk)) >> (32 - LOGM));
                const c32 A = buf[FFT_PIDX(p1)], B = buf[FFT_PIDX(p2)];
                const c32 E = c_mk(0.5f * (A.x + B.x), 0.5f * (A.y - B.y)), O = c_mk(0.5f * (A.y + B.y), -0.5f * (A.x - B.x));
                const c32 wk = c_twid((float)kk * (0.5f / M)), Tt = c_mul(wk, O);
                const c32 Yk = c_scale(c_mul(c_add(E, Tt), K1[j]), invM), Ymk = c_scale(c_mul(c_conj(c_sub(E, Tt)), K2[j]), invM);
                const c32 Ep = c_scale(c_add(Yk, c_conj(Ymk)), 0.5f), Op = c_scale(c_mulc(c_sub(Yk, c_conj(Ymk)), wk), 0.5f);
                buf[FFT_PIDX(p1)] = c_mk(Ep.x - Op.y, Ep.y + Op.x); buf[FFT_PIDX(p2)] = c_mk(Ep.x + Op.y, Op.x - Ep.y);
            }
        }
        if (more) {
#pragma unroll
            for (int j = 0; j < CH; ++j) { K1[j] = N1[j]; K2[j] = N2[j]; } }
    }
    for (int sb = FFT_TID; sb < NB; sb += FFT_NTHR) {
        FFT_LDS c32* buf = buf0 + sb * PADM; const c32 Zh = buf[FFT_PIDX(1)], Y = c_scale(c_mul(c_conj(Zh), KfP[1]), invM); buf[FFT_PIDX(1)] = c_conj(Y); }
}
FFT_DEV c32 conv_pair(const float* __restrict__ p, int m, int L, float w0, float w1, float w2, float b) {
    const float a = m > 0 ? p[2 * m - 1] : 0.f, x0 = p[2 * m], x1 = p[2 * m + 1], c = 2 * m + 2 < L ? p[2 * m + 2] : 0.f;
    return c_mk(w0 * a + w1 * x0 + w2 * x1 + b, w0 * x0 + w1 * x1 + w2 * c + b);
}
template <int LOGM, int NB, int CH> FFT_DEV void hyena_unit(FFT_LDS c32* buf, const float* __restrict__ pz, const float* __restrict__ pg0, const float* __restrict__ pg1, const float* cw, const c32* __restrict__ Kf0, const c32* __restrict__ Kf1, float bias0, float bias1, float* __restrict__ zout) {
    constexpr int M = 1 << LOGM, H = M / 2, L = M, PADM = FFT_PIDX(M); const float invM = 1.0f / M;
    for (int i0 = FFT_TID; i0 < NB * H; i0 += CH * FFT_NTHR) {
        c32 z[CH];
#pragma unroll
        for (int j = 0; j < CH; ++j) { const int i = i0 + j * FFT_NTHR, sq = i / H, m = i & (H - 1); z[j] = conv_pair(pz + sq * L, m, L, cw[0], cw[1], cw[2], cw[3]); }
#pragma unroll
        for (int j = 0; j < CH; ++j) { const int i = i0 + j * FFT_NTHR, sq = i / H, m = i & (H - 1); *(c32*)(zout + sq * L + 2 * m) = z[j]; buf[sq * PADM + FFT_PIDX(m)] = z[j]; }
    }
#ifdef PROBE_FFT_EXTRA
    fft_fwd<LOGM, NB, false>(buf); fft_inv<LOGM, NB, false>(buf);
    for (int i = FFT_TID; i < NB * M; i += FFT_NTHR) { const int sq = i / M, m = i & (M - 1); buf[sq * PADM + FFT_PIDX(m)] = buf[sq * PADM + FFT_PIDX(m)] * invM; }
#endif
    c32 KA[CH], KB[CH];
    pw_fetch<LOGM, NB, CH>(Kf0, KA, KB, FFT_TID);
    fft_fwd<LOGM, NB, true>(buf); conv_pointwise<LOGM, NB, CH>(buf, Kf0, invM, KA, KB); fft_inv<LOGM, NB, true>(buf);
    for (int i0 = FFT_TID; i0 < NB * H; i0 += CH * FFT_NTHR) {
        c32 g[CH], u[CH];
#pragma unroll
        for (int j = 0; j < CH; ++j) { const int i = i0 + j * FFT_NTHR, sq = i / H, m = i & (H - 1); g[j] = conv_pair(pg0 + sq * L, m, L, cw[4], cw[5], cw[6], cw[7]); u[j] = *(const c32*)(zout + sq * L + 2 * m); }
#pragma unroll
        for (int j = 0; j < CH; ++j) { const int i = i0 + j * FFT_NTHR, sq = i / H, m = i & (H - 1); const c32 y = buf[sq * PADM + FFT_PIDX(m)]; const c32 v = g[j] * (y + u[j] * bias0);
            *(c32*)(zout + sq * L + 2 * m) = v; buf[sq * PADM + FFT_PIDX(m)] = v; }
    }
    pw_fetch<LOGM, NB, CH>(Kf1, KA, KB, FFT_TID);
    fft_fwd<LOGM, NB, true>(buf); conv_pointwise<LOGM, NB, CH>(buf, Kf1, invM, KA, KB); fft_inv<LOGM, NB, true>(buf);
    for (int i0 = FFT_TID; i0 < NB * H; i0 += CH * FFT_NTHR) {
        c32 g[CH], u[CH];
#pragma unroll
        for (int j = 0; j < CH; ++j) { const int i = i0 + j * FFT_NTHR, sq = i / H, m = i & (H - 1); g[j] = conv_pair(pg1 + sq * L, m, L, cw[8], cw[9], cw[10], cw[11]); u[j] = *(const c32*)(zout + sq * L + 2 * m); }
#pragma unroll
        for (int j = 0; j < CH; ++j) { const int i = i0 + j * FFT_NTHR, sq = i / H, m = i & (H - 1); const c32 y = buf[sq * PADM + FFT_PIDX(m)]; *(c32*)(zout + sq * L + 2 * m) = g[j] * (y + u[j] * bias1); }
    }
    FFT_SYNC();
}
template <int LOGM, int CH> FFT_DEV void filter_unit(FFT_LDS c32* buf, const float* __restrict__ fwd, const float* __restrict__ bwd, int tstride, c32* __restrict__ KfP, float scale) {
    constexpr int M = 1 << LOGM, L = M, H = M / 2;
#define FFT_TIX(t) ((size_t)((t) >> 5) * tstride + ((t) & 31))
    for (int m0 = FFT_TID; m0 < H; m0 += CH * FFT_NTHR) {
        c32 a[CH], b[CH];
#pragma unroll
        for (int j = 0; j < CH; ++j) { const int m = m0 + j * FFT_NTHR; a[j] = *(const c32*)(fwd + FFT_TIX(2 * m));
            b[j] = m == 0 ? c_mk(0.f, bwd[FFT_TIX(L - 1)]) : c_mk(bwd[FFT_TIX(L - 2 * m)], bwd[FFT_TIX(L - 2 * m - 1)]); }
#pragma unroll
        for (int j = 0; j < CH; ++j) { const int m = m0 + j * FFT_NTHR; buf[FFT_PIDX(m)] = a[j]; buf[FFT_PIDX(m + H)] = b[j]; }
    }
#undef FFT_TIX
    fft_fwd<LOGM, 1, false>(buf); filt_untangle<LOGM>(buf, KfP, scale);
    FFT_SYNC();
}

struct Frame {
    LAS unsigned char* lds;
    volatile LAS unsigned* MISC;
    gu32* ctl;
    int tid, lane, wave;
    int vcu, G, bid;
    float* out; unsigned char* ws;
};
struct Args { const float* in[30]; float* out; unsigned char* ws; int ph_lo, ph_hi; };
typedef GAS const float* cfp_t;
typedef __attribute__((address_space(4))) const cfp_t* KargTab;
struct InPtrs { KargTab t; __device__ __forceinline__ const float* operator[](int i) const { return (const float*)t[i]; } };
struct InTab { InPtrs in; };
enum { I_XP = 0, I_XS, I_CP, I_CS, I_ADAW, I_ADAB, I_N1G, I_N2G, I_WIN, I_HCW, I_HCB, I_FW1, I_FB1, I_FW2, I_FB2, I_FW3, I_FB3, I_FFREQ, I_FWOUT, I_HYB, I_QNG, I_KNG, I_SINK, I_WHY, I_WAT, I_WO, I_RW, I_EWG, I_EWU, I_EWD };

__device__ __forceinline__ int mod_row(int r) { return r < TP ? 0 : 1 + ((r - TP) >> 12); }
__device__ __forceinline__ void seq_bounds(int r, int& s0, int& len) { if (r < TP) { s0 = 0; len = TP; } else { s0 = TP + (((r - TP) >> 12) << 12); len = TS; } }
__device__ __forceinline__ const float* x_row(const Frame& F, const InTab& A, int l, int r) { return l == 0 ? (r < TP ? A.in[I_XP] + (size_t)r * D : A.in[I_XS] + (size_t)(r - TP) * D) : F.out + (size_t)r * D; }

__device__ __forceinline__ void transpose_item(const float* W, int N, int K, int k0, int n0, bf16* WT, int dst_row0, LAS float* scr, int lane) {
    float r_[32];
#pragma unroll
    for (int i = 0; i < 32; ++i) r_[i] = W[(size_t)(k0 + 2 * i + (lane >> 5)) * N + n0 + (lane & 31)];
#pragma unroll
    for (int i = 0; i < 32; ++i) scr[(2 * i + (lane >> 5)) * 33 + (lane & 31)] = r_[i];
    LDS_WAIT(); asm volatile("" ::: "memory");
    const int c = lane & 7;
#pragma unroll
    for (int j = 0; j < 4; ++j) { const int n = (lane >> 3) + 8 * j; const LAS float* s = scr + (8 * c) * 33 + n;
        v4u o; o.x = pk2(s[0 * 33], s[1 * 33]); o.y = pk2(s[2 * 33], s[3 * 33]); o.z = pk2(s[4 * 33], s[5 * 33]); o.w = pk2(s[6 * 33], s[7 * 33]);
        *(v4u*)(WT + (size_t)(dst_row0 + n) * K + k0 + 8 * c) = o; }
    LDS_WAIT(); asm volatile("" ::: "memory");
}
__device__ __forceinline__ void convert_small_weights(Frame& F, const InTab& A) {
    LAS float* scr = (LAS float*)(F.lds + RING_OFF + F.wave * 16384);
    const int gw = F.vcu * NWAVES + F.wave, NGW = F.G * NWAVES;
    constexpr int I_IN = (D / 64) * (INW / 32), I_P = (HYW / 64) * (D / 32), I_O = (D / 64) * (D / 32), I_F = FOUT / 32, PER_L = I_IN + 2 * I_P + I_O + I_F;
    for (int it = gw; it < DEPTH * PER_L; it += NGW) {
        const int l = it / PER_L; int r = it % PER_L;
        if (r < I_IN) { const int nb = INW / 32; transpose_item(A.in[I_WIN] + (size_t)l * D * INW, INW, D, 64 * (r / nb), 32 * (r % nb), (bf16*)(F.ws + WS_WIN) + (size_t)l * INW * D, 32 * (r % nb), scr, F.lane); continue; } r -= I_IN;
        if (r < I_P) { const int nb = D / 32; transpose_item(A.in[I_WHY] + (size_t)l * HYW * D, D, 2 * HYW, 64 * (r / nb), 32 * (r % nb), (bf16*)(F.ws + WS_WHY) + (size_t)l * D * 2 * HYW, 32 * (r % nb), scr, F.lane); continue; } r -= I_P;
        if (r < I_P) { const int nb = D / 32; transpose_item(A.in[I_WAT] + (size_t)l * ATW * D, D, 2 * HYW, 64 * (r / nb), 32 * (r % nb), (bf16*)(F.ws + WS_WHY) + (size_t)l * D * 2 * HYW + HYW, 32 * (r % nb), scr, F.lane); continue; } r -= I_P;
        if (r < I_O) { const int nb = D / 32; transpose_item(A.in[I_WO] + (size_t)l * D * D, D, D, 64 * (r / nb), 32 * (r % nb), (bf16*)(F.ws + WS_WO) + (size_t)l * D * D, 32 * (r % nb), scr, F.lane); continue; } r -= I_O;
        transpose_item(A.in[I_FWOUT] + (size_t)l * FH * FOUT, FOUT, FH, 0, 32 * r, (bf16*)(F.ws + WS_WOUT) + (size_t)l * FOUT * FH, 32 * r, scr, F.lane);
    }
}
struct CvItem { const float* src; unsigned char* dst; int N, K; float sc; };
__device__ __forceinline__ CvItem cv_moe_item(const Frame& F, const InTab& A, int l, int it) {
    constexpr int I_G = (D / 64) * (FF / 32), I_D = (FF / 64) * (D / 32), PER_E = 2 * I_G + I_D;
    const int e = it / PER_E; int r = it % PER_E; CvItem c;
    if (r < 2 * I_G) { const int up = r >= I_G; if (up) r -= I_G; const int nb = FF / 32, k0 = 64 * (r / nb), n0 = 32 * (r % nb);
        c.src = A.in[up ? I_EWU : I_EWG] + ((size_t)l * NE + e) * D * FF + (size_t)k0 * FF + n0; c.N = FF; c.K = KB_UP; c.sc = 64.f;
        c.dst = (unsigned char*)(F.ws + WS_WGU) + ((size_t)e * (2 * FF) + (256 * (n0 >> 7) + (up ? 128 : 0) + (n0 & 127))) * KB_UP + (k0 >> 1); }
    else { r -= 2 * I_G; const int nb = D / 32, k0 = 64 * (r / nb), n0 = 32 * (r % nb);
        c.src = A.in[I_EWD] + ((size_t)l * NE + e) * FF * D + (size_t)k0 * D + n0; c.N = D; c.K = KB_DN; c.sc = 128.f;
        c.dst = (unsigned char*)(F.ws + WS_WD) + ((size_t)e * D + n0) * KB_DN + (k0 >> 1); }
    return c;
}
template <int VAR = 0  >
__device__ __forceinline__ void convert_moe_weights(Frame& F, const InTab& A, int l) {
    const int gw = F.vcu * NWAVES + F.wave, NGW = F.G * NWAVES, lane = F.lane, g = lane >> 3, c = lane & 7;
    constexpr int TOTAL = NE * (2 * (D / 64) * (FF / 32) + (FF / 64) * (D / 32));
    for (int i = (F.vcu * NWAVES + F.wave) * 64 + lane; i < NE * D * ((KB_DN - FF / 2) / 16); i += NGW * 64) { const int row = i >> 3, ch = i & 7;
        *(v4u*)((unsigned char*)(F.ws + WS_WD) + (size_t)row * KB_DN + FF / 2 + 16 * ch) = (v4u){0u, 0u, 0u, 0u}; }
    f32x4 ra[8], rb[8]; CvItem cur, nxt;
    if (gw < TOTAL) { cur = cv_moe_item(F, A, l, gw); const float* p = cur.src + (size_t)(8 * g) * cur.N + 4 * c;
#pragma unroll
        for (int i = 0; i < 8; ++i) ra[i] = *(const f32x4*)(p + (size_t)i * cur.N); }
    for (int it = gw; it < TOTAL; it += NGW) {
        const bool more = it + NGW < TOTAL;
        if (more) { nxt = cv_moe_item(F, A, l, it + NGW); const float* p = nxt.src + (size_t)(8 * g) * nxt.N + 4 * c;
#pragma unroll
            for (int i = 0; i < 8; ++i) rb[i] = *(const f32x4*)(p + (size_t)i * nxt.N); }
        const float sc = cur.sc;
#pragma unroll
        for (int j = 0; j < 4; ++j) { unsigned w; PG8_FP4_PACK8(w, ra[0][j] * sc, ra[1][j] * sc, ra[2][j] * sc, ra[3][j] * sc, ra[4][j] * sc, ra[5][j] * sc, ra[6][j] * sc, ra[7][j] * sc);
            if (VAR == 0 || w == 0x12345678u) *(unsigned*)(cur.dst + (size_t)(4 * c + j) * cur.K + 4 * g) = w; }
        if (more) { cur = nxt;
#pragma unroll
            for (int i = 0; i < 8; ++i) ra[i] = rb[i]; }
    }
}
__device__ __forceinline__ void adaln_mod(Frame& F, const InTab& A) {
    LAS float* sc = (LAS float*)(F.lds + RING_OFF);
    LAS float* red = (LAS float*)(F.lds + RING_OFF + 32768);
    for (int i = F.tid; i < NMOD * D; i += NWAVES * 64) { const int b = i / D, k = i % D; const float c = b == 0 ? A.in[I_CP][k] : A.in[I_CS][(b - 1) * D + k]; sc[i] = siluf_acc(c); }
    __syncthreads();
    float* mod = (float*)(F.ws + WS_MOD);
    for (int u = F.vcu; u < DEPTH * 96; u += F.G) {
        const int l = u / 96, n = (u % 96) * 64 + F.lane;
        const float* W = A.in[I_ADAW] + (size_t)l * D * 6 * D + n;
        float a[NMOD] = {0.f, 0.f, 0.f, 0.f, 0.f};
#pragma unroll 4
        for (int k = 128 * F.wave; k < 128 * F.wave + 128; ++k) { const float w = W[(size_t)k * 6 * D];
#pragma unroll
            for (int b = 0; b < NMOD; ++b) a[b] += sc[b * D + k] * w; }
#pragma unroll
        for (int b = 0; b < NMOD; ++b) red[(F.wave * NMOD + b) * 64 + F.lane] = a[b];
        __syncthreads();
        if (F.tid < NMOD * 64) { const int b = F.tid >> 6, ln = F.tid & 63; float s = A.in[I_ADAB][l * 6 * D + (u % 96) * 64 + ln];
#pragma unroll
            for (int w = 0; w < NWAVES; ++w) s += red[(w * NMOD + b) * 64 + ln];
            mod[((size_t)l * NMOD + b) * 6 * D + (u % 96) * 64 + ln] = s; }
        __syncthreads();
    }
}
__device__ __forceinline__ void norm_mod_rows(Frame& F, const InTab& A, int l, const float* g, int sh_off, int sc_off) {
    const int gw = F.vcu * NWAVES + F.wave, NGW = F.G * NWAVES;
    const float* mod = (const float*)(F.ws + WS_MOD) + (size_t)l * NMOD * 6 * D;
    bf16* H = (bf16*)(F.ws + WS_H);
    for (int m = gw; m < T; m += NGW) {
        const f32x4* xr = (const f32x4*)x_row(F, A, l, m) + F.lane;
        f32x4 v[4]; float ss = 0.f;
#pragma unroll
        for (int j = 0; j < 4; ++j) { v[j] = xr[64 * j]; ss += (v[j].x * v[j].x + v[j].y * v[j].y) + (v[j].z * v[j].z + v[j].w * v[j].w); }
        const float rstd = 1.0f / sqrtf(wave_sum(ss) * (1.f / D) + EPS);
        const float* mr = mod + (size_t)mod_row(m) * 6 * D;
        unsigned long long* o8 = (unsigned long long*)(H + (size_t)m * D) + F.lane;
#pragma unroll
        for (int j = 0; j < 4; ++j) { const int c = 4 * F.lane + 256 * j;
            const f32x4 gg = *(const f32x4*)(g + c), sc = *(const f32x4*)(mr + sc_off + c), sh = *(const f32x4*)(mr + sh_off + c);
            const f32x4 o = v[j] * rstd * gg * (sc + 1.0f) + sh;
            o8[64 * j] = (unsigned long long)pk2(o.x, o.y) | ((unsigned long long)pk2(o.z, o.w) << 32); }
    }
}

__device__ __forceinline__ void filter_time_tiles(Frame& F, const InTab& A, int l) {
    LAS bf16* h3s = (LAS bf16*)(F.lds + RING_OFF);
    const float* w1 = A.in[I_FW1] + (size_t)l * FEMB * FH; const float* b1 = A.in[I_FB1] + l * FH;
    const float* w2 = A.in[I_FW2] + (size_t)l * FH * FH;   const float* b2 = A.in[I_FB2] + l * FH;
    const float* w3 = A.in[I_FW3] + (size_t)l * FH * FH;   const float* b3 = A.in[I_FB3] + l * FH;
    const bf16* woT = (const bf16*)(F.ws + WS_WOUT) + (size_t)l * FOUT * FH;
    const float fr = A.in[I_FFREQ][l * FH + F.lane] * 0.15915494309189535f;
    const float bb1 = b1[F.lane], bb2 = b2[F.lane], bb3 = b3[F.lane];
    const int lane = F.lane;
    LAS float* wl1 = (LAS float*)(F.lds + RING_OFF + 16384); LAS float* wl2 = wl1 + FEMB * FH; LAS float* wl3 = wl2 + FH * FH;
    for (int i = F.tid; i < FEMB * FH; i += NWAVES * 64) wl1[i] = w1[i];
    for (int i = F.tid; i < FH * FH; i += NWAVES * 64) { wl2[i] = w2[i]; wl3[i] = w3[i]; }
    __syncthreads();
    for (int tile = F.vcu; tile < 640; tile += F.G) {
        const int set = tile >= 512, tl0 = set ? tile - 512 : tile, L = set ? TS : TP, j0 = 32 * tl0;
        float* hraw = (float*)(F.ws + (set ? WS_HRAW_S : WS_HRAW_P));
        float* psum = (float*)(F.ws + WS_PSUM) + (set ? (size_t)512 * FOUT : 0) + (size_t)tl0 * FOUT;
        const float invL = 1.0f / (float)L, invLm1 = 1.0f / (float)(L - 1);
        {
            float zv[4], h[4], pre[4];
#pragma unroll
            for (int i = 0; i < 4; ++i) { const int j = j0 + F.wave + 8 * i; float z = 0.f;
                if (lane == 0) z = (float)j * invLm1;
                else if (lane <= 32) { const int b = (lane - 1) & 15; const float fb = 1e-4f + (float)b * ((15.0f - 1e-4f) / 15.0f); const float rev = fb * (float)j * invL; z = lane <= 16 ? cos_rev(rev) : -sin_rev(rev); }
                zv[i] = z; pre[i] = bb1; }
#define FT_LAYER(WL, NK, SRC) do { _Pragma("unroll 1") for (int k0 = 0; k0 < (NK); k0 += 16) { float w_[16]; \
                _Pragma("unroll") for (int j = 0; j < 16; ++j) w_[j] = (k0 + j < (NK)) ? (WL)[(k0 + j) * FH + lane] : 0.f; \
                _Pragma("unroll") for (int j = 0; j < 16; ++j) { _Pragma("unroll") for (int i = 0; i < 4; ++i) pre[i] += rdlane(SRC[i], (k0 + j) & 63) * w_[j]; } } } while (0)
            FT_LAYER(wl1, FEMB, zv);
#pragma unroll
            for (int i = 0; i < 4; ++i) { h[i] = sin_rev(fr * pre[i]); pre[i] = bb2; }
            FT_LAYER(wl2, FH, h);
#pragma unroll
            for (int i = 0; i < 4; ++i) { h[i] = sin_rev(fr * pre[i]); pre[i] = bb3; }
            FT_LAYER(wl3, FH, h);
#undef FT_LAYER
#pragma unroll
            for (int i = 0; i < 4; ++i) h3s[(F.wave + 8 * i) * 72 + lane] = (bf16)f2bf(sin_rev(fr * pre[i]));
        }
        __syncthreads();
        {
            const int hi = lane >> 5, lr = lane & 31;
            bf16x8 af[4], bcur[4], bnxt[4];
#pragma unroll
            for (int s = 0; s < 4; ++s) { af[s] = *(const LAS bf16x8*)(h3s + lr * 72 + 16 * s + 8 * hi); bcur[s] = *(const bf16x8*)(woT + (size_t)((F.wave * 8) * 32 + lr) * FH + 16 * s + 8 * hi); }
#pragma unroll 1
            for (int r = 0; r < 8; ++r) {
                const int n = (F.wave * 8 + r) * 32 + lr;
                if (r < 7) {
#pragma unroll
                    for (int s = 0; s < 4; ++s) bnxt[s] = *(const bf16x8*)(woT + (size_t)(n + 32) * FH + 16 * s + 8 * hi); }
                f32x16 acc = {0.f, 0.f, 0.f, 0.f, 0.f, 0.f, 0.f, 0.f, 0.f, 0.f, 0.f, 0.f, 0.f, 0.f, 0.f, 0.f};
#pragma unroll
                for (int s = 0; s < 4; ++s) acc = __builtin_amdgcn_mfma_f32_32x32x16_bf16(af[s], bcur[s], acc, 0, 0, 0);
                const int dir = n >> 10, c = n & 511;
                const float delta = 3.070113457325394f + (float)c * ((15.350567286626971f - 3.070113457325394f) / 511.0f);
                float ssq = 0.f;
#pragma unroll
                for (int g = 0; g < 4; ++g) { f32x4 v;
#pragma unroll
                    for (int e = 0; e < 4; ++e) { const int j = j0 + 8 * g + 4 * hi + e; const float val = acc[4 * g + e] * fast_exp(-(float)j * invLm1 * delta); v[e] = val; if (!(dir == 1 && j == 0)) ssq += val * val; }
                    *(f32x4*)(hraw + ((size_t)tl0 * FOUT + n) * 32 + 8 * g + 4 * hi) = v; }
                ssq += __shfl_xor(ssq, 32);
                if (lane < 32) psum[n] = ssq;
#pragma unroll
                for (int s = 0; s < 4; ++s) bcur[s] = bnxt[s];
            }
        }
        __syncthreads();
    }
}

__device__ __forceinline__ void filter_fft_units(Frame& F) {
    LAS c32* buf = (LAS c32*)(F.lds + RING_OFF);
    LAS float* red = (LAS float*)(F.lds + SCR_OFF);
    const bool deal = F.G == 256, heavy = F.bid < 128;
    for (int k = 0; k < (deal ? 9 : (2048 + F.G - 1) / F.G); ++k) {
        int u;
        if (!deal) { u = F.vcu + k * F.G; if (u >= 2048) break; }
        else if (k < 5) { if (heavy) { if (k >= 3) continue; u = F.bid + 128 * k; } else u = 384 + (F.bid - 128) + 128 * k; }
        else u = 1024 + F.bid + 256 * (k - 5);
        const int set = u >= 1024, oc = u & 1023, ntile = set ? 128 : 512;
        const float* psum = (const float*)(F.ws + WS_PSUM) + (set ? (size_t)512 * FOUT : 0);
        float s = 0.f;
        if (F.tid < ntile) s = psum[(size_t)F.tid * FOUT + oc] + psum[(size_t)F.tid * FOUT + 1024 + oc];
        s = wave_sum(s);
        if (F.lane == 0) red[F.wave] = s;
        __syncthreads();
        float tot = 0.f;
#pragma unroll
        for (int w = 0; w < NWAVES; ++w) tot += red[w];
        const float scale = 1.0f / sqrtf(tot + EPS);
        if (set == 0) { const float* hr = (const float*)(F.ws + WS_HRAW_P); filter_unit<14, 8>(buf, hr + (size_t)oc * 32, hr + (size_t)(1024 + oc) * 32, FOUT * 32, (c32*)(F.ws + WS_KF_P) + (size_t)oc * KFS_P, scale); }
        else          { const float* hr = (const float*)(F.ws + WS_HRAW_S); filter_unit<12, 4>(buf, hr + (size_t)oc * 32, hr + (size_t)(1024 + oc) * 32, FOUT * 32, (c32*)(F.ws + WS_KF_S) + (size_t)oc * KFS_S, scale); }
    }
}
__device__ __forceinline__ void shortconv_transpose(Frame& F, const InTab& A, int l) {
    LAS float* scr = (LAS float*)(F.lds + RING_OFF + F.wave * 16384);
    const int gw = F.vcu * NWAVES + F.wave, NGW = F.G * NWAVES, lane = F.lane;
    const bf16* P = (const bf16*)(F.ws + WS_PROJ); float* HYT = (float*)(F.ws + WS_HYT);
    const float* cw = A.in[I_HCW] + (size_t)l * 3 * NHY; const float* cb = A.in[I_HCB] + (size_t)l * NHY;
    for (int it = gw; it < (T / 64) * (NHY / 32); it += NGW) {
        const int rt = it / (NHY / 32), ct = it % (NHY / 32), r0 = 64 * rt, c0 = 32 * ct;
        int s0, len; seq_bounds(r0, s0, len);
        for (int i = 0; i < 33; ++i) { const int rr = 2 * i + (lane >> 5), r = r0 - 1 + rr;
            float v = 0.f; if (r >= s0 && r < s0 + len) v = bf2f(P[(size_t)r * INW + c0 + (lane & 31)]);
            scr[rr * 33 + (lane & 31)] = v; }
        LDS_WAIT(); asm volatile("" ::: "memory");
        for (int cc = 0; cc < 32; ++cc) { const int c = c0 + cc; const float w0 = cw[c], w1 = cw[NHY + c], w2 = cw[2 * NHY + c], b = cb[c];
            const float v = w0 * scr[lane * 33 + cc] + w1 * scr[(lane + 1) * 33 + cc] + w2 * scr[(lane + 2) * 33 + cc] + b;
            HYT[(size_t)c * T + r0 + lane] = v; }
        LDS_WAIT(); asm volatile("" ::: "memory");
    }
}
__device__ const double ROPE_INV_REV[32] = {0.15915494309189535, 0.11934937021124886, 0.08949940160889101, 0.06711508300522726, 0.050329212104487035, 0.03774158471741977, 0.0283021958306234, 0.02122365276477766,
    0.015915494309189534, 0.011934937021124886, 0.008949940160889102, 0.006711508300522725, 0.005032921210448704, 0.003774158471741977, 0.00283021958306234, 0.0021223652764777662,
    0.0015915494309189536, 0.0011934937021124885, 0.0008949940160889102, 0.0006711508300522726, 0.0005032921210448703, 0.00037741584717419774, 0.00028302195830623395, 0.0002122365276477766,
    0.00015915494309189535, 0.00011934937021124886, 8.949940160889102e-05, 6.711508300522725e-05, 5.0329212104487035e-05, 3.774158471741978e-05, 2.8302195830623396e-05, 2.122365276477766e-05};
__device__ __forceinline__ void qk_norm_rope(Frame& F, const InTab& A, int l) {
    const int gw = F.vcu * NWAVES + F.wave, NGW = F.G * NWAVES, lane = F.lane;
    const bf16* P = (const bf16*)(F.ws + WS_PROJ); bf16* QN = (bf16*)(F.ws + WS_QN); bf16* KN = (bf16*)(F.ws + WS_KN);
    const float gq = A.in[I_QNG][l * HD + lane], gk = A.in[I_KNG][l * HD + lane];
    const double invr = ROPE_INV_REV[lane & 31];
    for (int m = gw; m < T; m += NGW) {
        int s0, len; seq_bounds(m, s0, len);
        double rv = (double)(m - s0) * invr; rv -= floor(rv);
        const float rf = (float)rv, cs = cos_rev(rf), sn = sin_rev(rf);
        for (int h = 0; h < NH + NKV; ++h) {
            const float x = bf2f(P[(size_t)m * INW + COL_Q + h * HD + lane]);
            const float ss = wave_sum(x * x);
            float y = x * (1.0f / sqrtf(ss * (1.f / HD) + EPS)) * (h < NH ? gq : gk);
            const float p = __shfl_xor(y, 32);
            float o = lane < 32 ? y * cs - p * sn : y * cs + p * sn;
            if (h < NH) QN[(size_t)m * ATW + h * HD + lane] = (bf16)f2bf(o * 0.125f); else KN[(size_t)m * KVW + (h - NH) * HD + lane] = (bf16)f2bf(o);
        }
    }
}
__device__ __forceinline__ void hyena_units(Frame& F, const InTab& A, int l) {
    LAS c32* buf = (LAS c32*)(F.lds + RING_OFF);
    LAS float* cws = (LAS float*)(F.lds + SCR_OFF);
    const float* HYT = (const float*)(F.ws + WS_HYT); float* Z2T = (float*)(F.ws + WS_Z2T);
    const float* hb = A.in[I_HYB] + (size_t)l * 2 * HYW;
    const float* cw = A.in[I_HCW] + (size_t)l * 3 * NHY; const float* cb = A.in[I_HCB] + (size_t)l * NHY;
    for (int u = F.vcu; u < 2 * HYW; u += F.G) {
        const int c = u & 511;
        if (F.tid < 12) { const int j = F.tid >> 2, k = F.tid & 3; cws[F.tid] = k < 3 ? cw[k * NHY + j * HYW + c] : cb[j * HYW + c]; }
        __syncthreads();
        float w[12];
#pragma unroll
        for (int i = 0; i < 12; ++i) w[i] = cws[i];
        if (u < HYW) { const size_t o = (size_t)c * TPAD;
            hyena_unit<14, 1, 8>(buf, HYT + o, HYT + (size_t)HYW * TPAD + o, HYT + (size_t)2 * HYW * TPAD + o, w, (const c32*)(F.ws + WS_KF_P) + (size_t)c * KFS_P, (const c32*)(F.ws + WS_KF_P) + (size_t)(512 + c) * KFS_P, hb[c], hb[HYW + c], Z2T + o); }
        else { const size_t o = (size_t)c * TPAD + TP;
            hyena_unit<12, NSB, 8>(buf, HYT + o, HYT + (size_t)HYW * TPAD + o, HYT + (size_t)2 * HYW * TPAD + o, w, (const c32*)(F.ws + WS_KF_S) + (size_t)c * KFS_S, (const c32*)(F.ws + WS_KF_S) + (size_t)(512 + c) * KFS_S, hb[c], hb[HYW + c], Z2T + o); }
    }
}
__device__ __forceinline__ void z2_transpose(Frame& F) {
    LAS float* scr = (LAS float*)(F.lds + RING_OFF + F.wave * 16384);
    const int gw = F.vcu * NWAVES + F.wave, NGW = F.G * NWAVES, lane = F.lane;
    const float* Z2T = (const float*)(F.ws + WS_Z2T); bf16* Z2 = (bf16*)(F.ws + WS_Z2AT);
    for (int it = gw; it < (T / 64) * (HYW / 32); it += NGW) {
        const int rt = it / (HYW / 32), ct = it % (HYW / 32), r0 = 64 * rt, c0 = 32 * ct;
        float r_[32];
#pragma unroll
        for (int cc = 0; cc < 32; ++cc) r_[cc] = Z2T[(size_t)(c0 + cc) * TPAD + r0 + lane];
#pragma unroll
        for (int cc = 0; cc < 32; ++cc) scr[cc * 65 + lane] = r_[cc];
        LDS_WAIT(); asm volatile("" ::: "memory");
        for (int i = 0; i < 32; ++i) { const int rr = 2 * i + (lane >> 5); Z2[(size_t)(r0 + rr) * ZAP + c0 + (lane & 31)] = (bf16)f2bf(scr[(lane & 31) * 65 + rr]); }
        LDS_WAIT(); asm volatile("" ::: "memory");
    }
}
__device__ __forceinline__ void attention_simple(Frame& F, const InTab& A, int l) {
    LAS float* qs = (LAS float*)(F.lds + RING_OFF + F.wave * 4096);
    LAS float* ps = qs + 64;
    const int gw = F.vcu * NWAVES + F.wave, NGW = F.G * NWAVES, lane = F.lane;
    const bf16* P = (const bf16*)(F.ws + WS_PROJ); const bf16* QN = (const bf16*)(F.ws + WS_QN); const bf16* KN = (const bf16*)(F.ws + WS_KN); bf16* AT = (bf16*)(F.ws + WS_Z2AT) + HYW;
    for (int it = gw; it < T * NH; it += NGW) {
        const int m = it >> 3, h = it & 7, kv = h >> 2;
        int s0, len; seq_bounds(m, s0, len);
        const int jlo = max(m - WIN, s0), jhi = min(m + WIN, s0 + len - 1), nk = jhi - jlo + 1;
        qs[lane] = bf2f(QN[(size_t)m * ATW + h * HD + lane]);
        LDS_WAIT(); asm volatile("" ::: "memory");
        const float sink = A.in[I_SINK][l * NH + h];
        float sc[5]; float mx = sink;
#pragma unroll
        for (int r = 0; r < 5; ++r) { const int jj = lane + 64 * r; float s = -1e30f;
            if (jj < nk) { const v4u* kp = (const v4u*)(KN + (size_t)(jlo + jj) * KVW + kv * HD); float a = 0.f;
#pragma unroll
                for (int c = 0; c < 8; ++c) { const v4u w = kp[c]; const LAS float* q = qs + 8 * c;
                    a += q[0] * bflo(w.x) + q[1] * bfhi(w.x) + q[2] * bflo(w.y) + q[3] * bfhi(w.y) + q[4] * bflo(w.z) + q[5] * bfhi(w.z) + q[6] * bflo(w.w) + q[7] * bfhi(w.w); }
                s = a; }
            sc[r] = s; mx = fmaxf(mx, s); }
        mx = wave_max(mx);
        float den = 0.f;
#pragma unroll
        for (int r = 0; r < 5; ++r) { const int jj = lane + 64 * r; const float p = jj < nk ? fast_exp(sc[r] - mx) : 0.f; den += p; ps[jj] = p; }
        den = wave_sum(den) + fast_exp(sink - mx);
        LDS_WAIT(); asm volatile("" ::: "memory");
        float o = 0.f;
        const bf16* vp = P + (size_t)jlo * INW + COL_V + kv * HD + lane;
        for (int j = 0; j < nk; ++j) o += ps[j] * bf2f(vp[(size_t)j * INW]);
        AT[(size_t)m * ZAP + h * HD + lane] = (bf16)f2bf(o / den);
        LDS_WAIT(); asm volatile("" ::: "memory");
    }
}
__device__ __forceinline__ void merge_gates(Frame& F) {
    const bf16* P = (const bf16*)(F.ws + WS_PROJ); const bf16* YH = (const bf16*)(F.ws + WS_YHY); const bf16* YA = (const bf16*)(F.ws + WS_YAT); bf16* MG = (bf16*)(F.ws + WS_MERGED);
    const size_t nthr = (size_t)F.G * NWAVES * 64, t0 = (size_t)F.vcu * NWAVES * 64 + F.tid;
    for (size_t i = t0; i < (size_t)T * D / 8; i += nthr) {
        const size_t m = i >> 7; const int c = (int)(i & 127) * 8;
        const v4u gh = *(const v4u*)(P + m * INW + COL_G + c), ga = *(const v4u*)(P + m * INW + COL_G + D + c), yh = *(const v4u*)(YH + m * D + c), ya = *(const v4u*)(YA + m * D + c);
        v4u o;
#pragma unroll
        for (int k = 0; k < 4; ++k) { const float a = sigmoidf(bflo(gh[k])) * bflo(yh[k]) + sigmoidf(bflo(ga[k])) * bflo(ya[k]), b = sigmoidf(bfhi(gh[k])) * bfhi(yh[k]) + sigmoidf(bfhi(ga[k])) * bfhi(ya[k]); o[k] = pk2(a, b); }
        *(v4u*)(MG + m * D + c) = o;
    }
}
__device__ __forceinline__ void resid_norm_router(Frame& F, const InTab& A, int l) {
    const int gw = F.vcu * NWAVES + F.wave, NGW = F.G * NWAVES, lane = F.lane;
    const float* mod = (const float*)(F.ws + WS_MOD) + (size_t)l * NMOD * 6 * D;
    const float* MIX = (const float*)(F.ws + WS_MIX); bf16* H = (bf16*)(F.ws + WS_H); float* AFFT = (float*)(F.ws + WS_AFFT);
    const float* g2 = A.in[I_N2G] + (size_t)l * D; const float* rw = A.in[I_RW] + (size_t)l * D * NE;
    for (int m = gw; m < T; m += NGW) {
        const f32x4* xr = (const f32x4*)x_row(F, A, l, m) + lane; const f32x4* mx = (const f32x4*)(MIX + (size_t)m * D) + lane;
        const float* mr = mod + (size_t)mod_row(m) * 6 * D;
        f32x4 v[4]; float ss = 0.f;
#pragma unroll
        for (int j = 0; j < 4; ++j) { const int c = 4 * lane + 256 * j; const f32x4 g1 = *(const f32x4*)(mr + 2 * D + c);
            v[j] = xr[64 * j] + g1 * mx[64 * j]; ((f32x4*)(F.out + (size_t)m * D))[lane + 64 * j] = v[j];
            ss += (v[j].x * v[j].x + v[j].y * v[j].y) + (v[j].z * v[j].z + v[j].w * v[j].w); }
        const float rstd = 1.0f / sqrtf(wave_sum(ss) * (1.f / D) + EPS);
        float lg[NE];
#pragma unroll
        for (int e = 0; e < NE; ++e) lg[e] = 0.f;
        unsigned long long* o8 = (unsigned long long*)(H + (size_t)m * D) + lane;
#pragma unroll
        for (int j = 0; j < 4; ++j) { const int c = 4 * lane + 256 * j;
            const f32x4 gg = *(const f32x4*)(g2 + c), sc = *(const f32x4*)(mr + 4 * D + c), sh = *(const f32x4*)(mr + 3 * D + c);
            const f32x4 o = v[j] * rstd * gg * (sc + 1.0f) + sh;
            o8[64 * j] = (unsigned long long)pk2(o.x, o.y) | ((unsigned long long)pk2(o.z, o.w) << 32);
#pragma unroll
            for (int q = 0; q < 4; ++q) { const f32x4* wr = (const f32x4*)(rw + (size_t)(c + q) * NE);
#pragma unroll
                for (int e4 = 0; e4 < 4; ++e4) { const f32x4 w = wr[e4]; lg[4 * e4 + 0] += o[q] * w.x; lg[4 * e4 + 1] += o[q] * w.y; lg[4 * e4 + 2] += o[q] * w.z; lg[4 * e4 + 3] += o[q] * w.w; } } }
        float mxl = -1e30f;
#pragma unroll
        for (int e = 0; e < NE; ++e) { lg[e] = wave_sum(lg[e]); mxl = fmaxf(mxl, lg[e]); }
        float den = 0.f;
#pragma unroll
        for (int e = 0; e < NE; ++e) { lg[e] = expf(lg[e] - mxl); den += lg[e]; }
        const int grp = m >= TG, tg = m - grp * TG;
        float mine = 0.f;
#pragma unroll
        for (int e = 0; e < NE; ++e) mine = lane == e ? lg[e] / den : mine;
        if (lane < NE) AFFT[((size_t)grp * NE + lane) * TG + tg] = mine;
    }
}
__device__ __forceinline__ void topk_rank(Frame& F) {
    const float* AFFT = (const float*)(F.ws + WS_AFFT); int* SLOT = (int*)(F.ws + WS_SLOT); int* IDX = (int*)(F.ws + WS_IDX); float* GV = (float*)(F.ws + WS_GATEV);
    const size_t nthr = (size_t)F.G * NWAVES * 64, t0 = (size_t)F.vcu * NWAVES * 64 + F.tid;
    for (size_t i = t0; i < (size_t)NGRP * NE * TG; i += nthr) {
        const int ge = (int)(i >> 14), t = (int)(i & (TG - 1));
        const float* a = AFFT + (size_t)ge * TG; const float mine = a[t];
        int rank = 0;
        for (int j = 0; j < TG; j += 4) { const f32x4 v = *(const f32x4*)(a + j);
            rank += (v.x > mine || (v.x == mine && j + 0 < t)) ? 1 : 0; rank += (v.y > mine || (v.y == mine && j + 1 < t)) ? 1 : 0;
            rank += (v.z > mine || (v.z == mine && j + 2 < t)) ? 1 : 0; rank += (v.w > mine || (v.w == mine && j + 3 < t)) ? 1 : 0; }
        SLOT[i] = rank < CAP ? rank : -1;
        if (rank < CAP) { IDX[(size_t)ge * CAP + rank] = t; GV[(size_t)ge * CAP + rank] = mine; }
    }
}
__device__ __forceinline__ void gather_rows(Frame& F) {
    const int gw = F.vcu * NWAVES + F.wave, NGW = F.G * NWAVES, lane = F.lane;
    const bf16* __restrict__ H = (const bf16*)(F.ws + WS_H); unsigned char* __restrict__ XE = (unsigned char*)(F.ws + WS_XE); unsigned char* __restrict__ HID = (unsigned char*)(F.ws + WS_HID); const int* __restrict__ IDX = (const int*)(F.ws + WS_IDX);
    for (int sb = gw * 64; sb < NSLOT; sb += NGW * 64) {
        const int grp = sb >> 15, tix = IDX[sb + lane];
#pragma unroll
        for (int j = 0; j < 8; ++j) { const int q = j * 64 + lane; *(v4u*)(HID + (size_t)(sb + (q >> 3)) * KB_DN + FF / 2 + 16 * (q & 7)) = (v4u){0u, 0u, 0u, 0u}; }
        for (int i = 0; i < 64; i += 4) {
            v4u a[4], b[4];
#pragma unroll
            for (int k = 0; k < 4; ++k) { const int t = __builtin_amdgcn_readlane(tix, i + k); const v4u* src = (const v4u*)(H + ((size_t)grp * TG + t) * D); a[k] = src[2 * lane]; b[k] = src[2 * lane + 1]; }
#pragma unroll
            for (int k = 0; k < 4; ++k) { unsigned char* dst = XE + (size_t)(sb + i + k) * KB_UP;
                v2u w;
                PG8_FP4_PACK8(w.x, pg8::clamp6(1.f * bflo(a[k].x)), pg8::clamp6(1.f * bfhi(a[k].x)), pg8::clamp6(1.f * bflo(a[k].y)), pg8::clamp6(1.f * bfhi(a[k].y)), pg8::clamp6(1.f * bflo(a[k].z)), pg8::clamp6(1.f * bfhi(a[k].z)), pg8::clamp6(1.f * bflo(a[k].w)), pg8::clamp6(1.f * bfhi(a[k].w)));
                PG8_FP4_PACK8(w.y, pg8::clamp6(1.f * bflo(b[k].x)), pg8::clamp6(1.f * bfhi(b[k].x)), pg8::clamp6(1.f * bflo(b[k].y)), pg8::clamp6(1.f * bfhi(b[k].y)), pg8::clamp6(1.f * bflo(b[k].z)), pg8::clamp6(1.f * bfhi(b[k].z)), pg8::clamp6(1.f * bflo(b[k].w)), pg8::clamp6(1.f * bfhi(b[k].w)));
                *(v2u*)(dst + 8 * lane) = w; }
        }
    }
}
__device__ __forceinline__ void moe_combine(Frame& F, int l) {
    const int gw = F.vcu * NWAVES + F.wave, NGW = F.G * NWAVES, lane = F.lane;
    const float* mod = (const float*)(F.ws + WS_MOD) + (size_t)l * NMOD * 6 * D;
    const int* SLOT = (const int*)(F.ws + WS_SLOT); const float* GV = (const float*)(F.ws + WS_GATEV); const bf16* YE = (const bf16*)(F.ws + WS_YE);
    for (int m = gw; m < T; m += NGW) {
        const int grp = m >= TG, tg = m - grp * TG;
        const float* mr = mod + (size_t)mod_row(m) * 6 * D;
        f32x4 acc[4];
#pragma unroll
        for (int j = 0; j < 4; ++j) acc[j] = (f32x4){0.f, 0.f, 0.f, 0.f};
        for (int e = 0; e < NE; ++e) {
            const int sl = SLOT[((size_t)grp * NE + e) * TG + tg];
            if (sl >= 0) { const size_t row = ((size_t)grp * NE + e) * CAP + sl; const float gt = GV[row]; const v2u* yr = (const v2u*)(YE + row * D) + lane;
#pragma unroll
                for (int j = 0; j < 4; ++j) { const v2u w = yr[64 * j]; acc[j] += (f32x4){bflo(w.x), bfhi(w.x), bflo(w.y), bfhi(w.y)} * gt; } }
        }
        f32x4* xo = (f32x4*)(F.out + (size_t)m * D) + lane;
#pragma unroll
        for (int j = 0; j < 4; ++j) { const f32x4 g2 = *(const f32x4*)(mr + 5 * D + 4 * lane + 256 * j); xo[64 * j] = xo[64 * j] + g2 * acc[j]; }
    }
}

__device__ __forceinline__ void topk_select(Frame& F) {
    LAS unsigned* keys = (LAS unsigned*)(F.lds + RING_OFF);
    LAS unsigned* hist = (LAS unsigned*)(F.lds + RING_OFF + 65536);
    LAS unsigned* misc = (LAS unsigned*)(F.lds + RING_OFF + 65536 + 8192);
    const float* AFFT = (const float*)(F.ws + WS_AFFT); int* SLOT = (int*)(F.ws + WS_SLOT); int* IDX = (int*)(F.ws + WS_IDX); float* GV = (float*)(F.ws + WS_GATEV);
    const int tid = F.tid, lane = F.lane, wave = F.wave;
    for (int u = F.vcu; u < NGRP * NE; u += F.G) {
        const float* a = AFFT + (size_t)u * TG;
        for (int i = tid; i < TG; i += NWAVES * 64) keys[i] = __builtin_bit_cast(unsigned, a[i]);
        unsigned prefix = 0u, mask = 0u, need = CAP;
        for (int pass = 0; pass < 4; ++pass) {
            const int shift = 24 - 8 * pass;
            for (int i = tid; i < NWAVES * 256; i += NWAVES * 64) hist[i] = 0u;
            __syncthreads();
            for (int i = tid; i < TG; i += NWAVES * 64) { const unsigned k = keys[i]; if ((k & mask) == prefix) __hip_atomic_fetch_add(&hist[wave * 256 + ((k >> shift) & 255u)], 1u, __ATOMIC_RELAXED, __HIP_MEMORY_SCOPE_WORKGROUP); }
            __syncthreads();
            if (wave == 0) {
                unsigned h[4];
#pragma unroll
                for (int b = 0; b < 4; ++b) { unsigned s = 0u;
#pragma unroll
                    for (int w = 0; w < NWAVES; ++w) s += hist[w * 256 + 4 * lane + b];
                    h[b] = s; }
                const unsigned mine = h[0] + h[1] + h[2] + h[3];
                unsigned inc = mine;
#pragma unroll
                for (int o = 1; o < 64; o <<= 1) { const unsigned t = __shfl_down(inc, o); if (lane + o < 64) inc += t; }
                unsigned c = inc - mine;
#pragma unroll
                for (int b = 3; b >= 0; --b) { if (c < need && c + h[b] >= need) { misc[0] = (unsigned)(4 * lane + b); misc[1] = need - c; } c += h[b]; }
            }
            __syncthreads();
            prefix |= misc[0] << shift; mask |= 255u << shift; need = misc[1];
            __syncthreads();
        }
        unsigned cg = 0u, ce = 0u;
        for (int r = 0; r < 32; ++r) { const unsigned k = keys[2048 * wave + 64 * r + lane];
            cg += (unsigned)__popcll(__ballot(k > prefix)); ce += (unsigned)__popcll(__ballot(k == prefix)); }
        if (lane == 0) { misc[16 + 2 * wave] = cg; misc[17 + 2 * wave] = ce; }
        __syncthreads();
        unsigned eq_base = 0u, slot_base = 0u;
        for (int w = 0; w < NWAVES; ++w) { const unsigned g = misc[16 + 2 * w], e = misc[17 + 2 * w];
            if (w < wave) { const unsigned take = eq_base >= need ? 0u : ((need - eq_base) < e ? (need - eq_base) : e); slot_base += g + take; eq_base += e; } }
        const unsigned long long below = (1ull << lane) - 1ull;
        for (int r = 0; r < 32; ++r) { const int t = 2048 * wave + 64 * r + lane; const unsigned k = keys[t];
            const unsigned long long beq = __ballot(k == prefix);
            const unsigned eq_rank = eq_base + (unsigned)__popcll(beq & below);
            const bool sel = (k > prefix) || (k == prefix && eq_rank < need);
            const unsigned long long bsel = __ballot(sel);
            const unsigned slot = slot_base + (unsigned)__popcll(bsel & below);
            SLOT[((size_t)(u >> 4) * TG + t) * NE + (u & 15)] = sel ? (int)slot : -1;
            if (sel) { IDX[(size_t)u * CAP + slot] = t; GV[(size_t)u * CAP + slot] = __builtin_bit_cast(float, k); }
            eq_base += (unsigned)__popcll(beq); slot_base += (unsigned)__popcll(bsel); }
        __syncthreads();
    }
}
__device__ __forceinline__ void rope_table(Frame& F) {
    f32x2* RT = (f32x2*)(F.ws + WS_ROPE);
    const int nthr = F.G * NWAVES * 64;
    for (int i = F.vcu * NWAVES * 64 + F.tid; i < TP * 32; i += nthr) { double rv = (double)(i >> 5) * ROPE_INV_REV[i & 31]; rv -= floor(rv); const float rf = (float)rv; RT[i] = (f32x2){cos_rev(rf), sin_rev(rf)}; }
}
constexpr int AT_KP = 72, AT_VP = 388;
__device__ __forceinline__ void attention_mfma(Frame& F, const InTab& A, int l) {
    LAS bf16* Ks = (LAS bf16*)(F.lds + RING_OFF);
    LAS bf16* Vt = (LAS bf16*)(F.lds + RING_OFF + 384 * AT_KP * 2);
    const bf16* P = (const bf16*)(F.ws + WS_PROJ); bf16* AT = (bf16*)(F.ws + WS_Z2AT) + HYW; const f32x2* RT = (const f32x2*)(F.ws + WS_ROPE);
    const float* gqp = A.in[I_QNG] + l * HD; const float* gkp = A.in[I_KNG] + l * HD;
    const int tid = F.tid, lane = F.lane, wave = F.wave, lr = lane & 31, hl = lane >> 5;
    for (int u = F.vcu; u < (T / 128) * NKV; u += F.G) {
        const int kv = u & 1, r0 = (u >> 1) * 128;
        int s0, len; seq_bounds(r0, s0, len);
        for (int i = tid; i < 384 * 8; i += NWAVES * 64) { const int kl = i >> 3, c8 = (i & 7) * 8, row = r0 - 128 + kl;
            const bool ok = row >= s0 && row < s0 + len; const int rc = ok ? row : r0;
            const v4u kraw = *(const v4u*)(P + (size_t)rc * INW + COL_K + kv * HD + c8), vraw = *(const v4u*)(P + (size_t)rc * INW + COL_V + kv * HD + c8);
            float x[8]; float ss = 0.f;
#pragma unroll
            for (int e = 0; e < 4; ++e) { x[2 * e] = bflo(kraw[e]); x[2 * e + 1] = bfhi(kraw[e]); ss += x[2 * e] * x[2 * e] + x[2 * e + 1] * x[2 * e + 1]; }
            ss += __shfl_xor(ss, 1); ss += __shfl_xor(ss, 2); ss += __shfl_xor(ss, 4);
            const float rstd = 1.0f / sqrtf(ss * (1.f / HD) + EPS);
            const f32x2* rt = RT + (size_t)(rc - s0) * 32 + (c8 & 31);
            float o[8];
#pragma unroll
            for (int e = 0; e < 8; ++e) { const float y = x[e] * rstd * gkp[c8 + e]; const float p = __shfl_xor(y, 4); const f32x2 cs = rt[e]; o[e] = c8 < 32 ? y * cs.x - p * cs.y : y * cs.x + p * cs.y; }
            v4u kw = {pk2(o[0], o[1]), pk2(o[2], o[3]), pk2(o[4], o[5]), pk2(o[6], o[7])}; v4u vw = vraw;
            if (!ok) { kw = (v4u){0u, 0u, 0u, 0u}; vw = (v4u){0u, 0u, 0u, 0u}; }
            *(LAS v4u*)(Ks + kl * AT_KP + c8) = kw;
#pragma unroll
            for (int e = 0; e < 4; ++e) { Vt[(c8 + 2 * e) * AT_VP + kl] = (bf16)(vw[e] & 0xffffu); Vt[(c8 + 2 * e + 1) * AT_VP + kl] = (bf16)(vw[e] >> 16); } }
        __syncthreads();
        const int h = kv * 4 + (wave >> 1);
        const float sink = A.in[I_SINK][l * NH + h];
        for (int qt = 0; qt < 2; ++qt) {
            const int qa = 64 * (wave & 1) + 32 * qt;
            bf16x8 Qf[4];
            {
                const int row = r0 + qa + lr; const bf16* qp = P + (size_t)row * INW + COL_Q + h * HD + 8 * hl;
                float x[4][8]; float ss = 0.f;
#pragma unroll
                for (int s = 0; s < 4; ++s) { const v4u w = *(const v4u*)(qp + 16 * s);
#pragma unroll
                    for (int e = 0; e < 4; ++e) { x[s][2 * e] = bflo(w[e]); x[s][2 * e + 1] = bfhi(w[e]); ss += x[s][2 * e] * x[s][2 * e] + x[s][2 * e + 1] * x[s][2 * e + 1]; } }
                ss += __shfl_xor(ss, 32);
                const float rstd = 0.125f / sqrtf(ss * (1.f / HD) + EPS);
                const f32x2* rt = RT + (size_t)(row - s0) * 32 + 8 * hl;
#pragma unroll
                for (int s = 0; s < 2; ++s) { float o1[8], o2[8];
#pragma unroll
                    for (int j = 0; j < 8; ++j) { const int d = 16 * s + 8 * hl + j; const float y1 = x[s][j] * rstd * gqp[d], y2 = x[s + 2][j] * rstd * gqp[d + 32]; const f32x2 cs = rt[16 * s + j];
                        o1[j] = y1 * cs.x - y2 * cs.y; o2[j] = y2 * cs.x + y1 * cs.y; }
                    const v4u a = {pk2(o1[0], o1[1]), pk2(o1[2], o1[3]), pk2(o1[4], o1[5]), pk2(o1[6], o1[7])}, b = {pk2(o2[0], o2[1]), pk2(o2[2], o2[3]), pk2(o2[4], o2[5]), pk2(o2[6], o2[7])};
                    Qf[s] = __builtin_bit_cast(bf16x8, a); Qf[s + 2] = __builtin_bit_cast(bf16x8, b); }
            }
            float m_run = sink, l_run = 0.f;
            f32x16 O0, O1;
#pragma unroll
            for (int r = 0; r < 16; ++r) { O0[r] = 0.f; O1[r] = 0.f; }
            for (int kt = qa >> 5; kt <= (qa >> 5) + 8; ++kt) {
                f32x16 S;
#pragma unroll
                for (int r = 0; r < 16; ++r) S[r] = 0.f;
#pragma unroll
                for (int s = 0; s < 4; ++s) { const bf16x8 Kf = *(const LAS bf16x8*)(Ks + (32 * kt + lr) * AT_KP + 16 * s + 8 * hl); S = __builtin_amdgcn_mfma_f32_32x32x16_bf16(Kf, Qf[s], S, 0, 0, 0); }
                float mt = -1e30f;
#pragma unroll
                for (int r = 0; r < 16; ++r) { const int kl = 32 * kt + (r & 3) + 8 * (r >> 2) + 4 * hl, dlt = qa + lr + 128 - kl, row = r0 - 128 + kl;
                    const bool ok = dlt <= WIN && dlt >= -WIN && row >= s0 && row < s0 + len;
                    S[r] = ok ? S[r] : -1e30f; mt = fmaxf(mt, S[r]); }
                mt = fmaxf(mt, __shfl_xor(mt, 32));
                const float m_new = fmaxf(m_run, mt), sc = fast_exp(m_run - m_new);
                float ps = 0.f;
#pragma unroll
                for (int r = 0; r < 16; ++r) { S[r] = fast_exp(S[r] - m_new); ps += S[r]; }
                l_run = l_run * sc + ps; m_run = m_new;
#pragma unroll
                for (int r = 0; r < 16; ++r) { O0[r] *= sc; O1[r] *= sc; }
#pragma unroll
                for (int sp = 0; sp < 2; ++sp) {
                    v4u pw; pw.x = pk2(S[8 * sp + 0], S[8 * sp + 1]); pw.y = pk2(S[8 * sp + 2], S[8 * sp + 3]); pw.z = pk2(S[8 * sp + 4], S[8 * sp + 5]); pw.w = pk2(S[8 * sp + 6], S[8 * sp + 7]);
                    const bf16x8 Pf = __builtin_bit_cast(bf16x8, pw);
                    const int kb = 32 * kt + 16 * sp + 4 * hl;
                    { const v2u a = *(const LAS v2u*)(Vt + lr * AT_VP + kb), b = *(const LAS v2u*)(Vt + lr * AT_VP + kb + 8); const v4u vv = {a.x, a.y, b.x, b.y};
                      O0 = __builtin_amdgcn_mfma_f32_32x32x16_bf16(__builtin_bit_cast(bf16x8, vv), Pf, O0, 0, 0, 0); }
                    { const v2u a = *(const LAS v2u*)(Vt + (32 + lr) * AT_VP + kb), b = *(const LAS v2u*)(Vt + (32 + lr) * AT_VP + kb + 8); const v4u vv = {a.x, a.y, b.x, b.y};
                      O1 = __builtin_amdgcn_mfma_f32_32x32x16_bf16(__builtin_bit_cast(bf16x8, vv), Pf, O1, 0, 0, 0); }
                }
            }
            const float l_tot = l_run + __shfl_xor(l_run, 32), inv = 1.0f / (l_tot + fast_exp(sink - m_run));
            bf16* orow = AT + (size_t)(r0 + qa + lr) * ZAP + h * HD + 4 * hl;
#pragma unroll
            for (int g = 0; g < 4; ++g) {
                v2u w0; w0.x = pk2(O0[4 * g + 0] * inv, O0[4 * g + 1] * inv); w0.y = pk2(O0[4 * g + 2] * inv, O0[4 * g + 3] * inv); *(v2u*)(orow + 8 * g) = w0;
                v2u w1; w1.x = pk2(O1[4 * g + 0] * inv, O1[4 * g + 1] * inv); w1.y = pk2(O1[4 * g + 2] * inv, O1[4 * g + 3] * inv); *(v2u*)(orow + 32 + 8 * g) = w1; }
        }
        __syncthreads();
    }
}

__device__ __forceinline__ void resid_norm_router2(Frame& F, const InTab& A, int l) {
    LAS float* rwT = (LAS float*)(F.lds + RING_OFF);
    const int gw = F.vcu * NWAVES + F.wave, NGW = F.G * NWAVES, lane = F.lane;
    const float* __restrict__ mod = (const float*)(F.ws + WS_MOD) + (size_t)l * NMOD * 6 * D;
    const float* __restrict__ MIX = (const float*)(F.ws + WS_MIX); bf16* __restrict__ H = (bf16*)(F.ws + WS_H); float* __restrict__ AFFT = (float*)(F.ws + WS_AFFT); float* __restrict__ AFFTOK = (float*)(F.ws + WS_AFFTOK);
    const float* __restrict__ g2 = A.in[I_N2G] + (size_t)l * D; const float* __restrict__ rw = A.in[I_RW] + (size_t)l * D * NE;
    for (int i = F.tid; i < D * NE / 4; i += NWAVES * 64) { const f32x4 w = ((const f32x4*)rw)[i]; const int k = i >> 2, e0 = (i & 3) * 4;
        rwT[(e0 + 0) * D + k] = w.x; rwT[(e0 + 1) * D + k] = w.y; rwT[(e0 + 2) * D + k] = w.z; rwT[(e0 + 3) * D + k] = w.w; }
    __syncthreads();
    f32x4 gg[4];
#pragma unroll
    for (int j = 0; j < 4; ++j) gg[j] = *(const f32x4*)(g2 + 4 * lane + 256 * j);
    f32x4 xn[4], scn[4], shn[4];
#define RR_ISSUE(mm) do { const f32x4* xr_ = (const f32x4*)(F.out + (size_t)(mm) * D) + lane; const float* mr_ = mod + (size_t)mod_row(mm) * 6 * D + 4 * lane; \
        _Pragma("unroll") for (int j = 0; j < 4; ++j) { xn[j] = xr_[64 * j]; scn[j] = *(const f32x4*)(mr_ + 4 * D + 256 * j); shn[j] = *(const f32x4*)(mr_ + 3 * D + 256 * j); } } while (0)
    if (gw < T) RR_ISSUE(gw);
    for (int m = gw; m < T; m += NGW) {
        f32x4 v[4], sc[4], sh[4]; float ss = 0.f;
#pragma unroll
        for (int j = 0; j < 4; ++j) { v[j] = xn[j]; sc[j] = scn[j]; sh[j] = shn[j]; }
        if (m + NGW < T) RR_ISSUE(m + NGW);
#pragma unroll
        for (int j = 0; j < 4; ++j) ss += (v[j].x * v[j].x + v[j].y * v[j].y) + (v[j].z * v[j].z + v[j].w * v[j].w);
        const float rstd = 1.0f / sqrtf(wave_sum(ss) * (1.f / D) + EPS);
        float lg[NE];
#pragma unroll
        for (int e = 0; e < NE; ++e) lg[e] = 0.f;
        unsigned long long* o8 = (unsigned long long*)(H + (size_t)m * D) + lane;
#pragma unroll
        for (int j = 0; j < 4; ++j) { const f32x4 o = v[j] * rstd * gg[j] * (sc[j] + 1.0f) + sh[j];
            o8[64 * j] = (unsigned long long)pk2(o.x, o.y) | ((unsigned long long)pk2(o.z, o.w) << 32);
#pragma unroll
            for (int eh = 0; eh < NE; eh += 8) {
#pragma unroll
                for (int e = eh; e < eh + 8; ++e) { const f32x4 w = *(const LAS f32x4*)(rwT + e * D + 4 * lane + 256 * j); lg[e] += (o.x * w.x + o.y * w.y) + (o.z * w.z + o.w * w.w); }
                asm volatile("" ::: "memory"); } }
        float k8[8], k4[4], k2[2], k1;
#pragma unroll
        for (int i = 0; i < 8; ++i) { const bool hi = lane & 32; const float send = hi ? lg[i] : lg[i + 8], keep = hi ? lg[i + 8] : lg[i]; k8[i] = keep + __shfl_xor(send, 32); }
#pragma unroll
        for (int i = 0; i < 4; ++i) { const bool hi = lane & 16; const float send = hi ? k8[i] : k8[i + 4], keep = hi ? k8[i + 4] : k8[i]; k4[i] = keep + __shfl_xor(send, 16); }
#pragma unroll
        for (int i = 0; i < 2; ++i) { const bool hi = lane & 8; const float send = hi ? k4[i] : k4[i + 2], keep = hi ? k4[i + 2] : k4[i]; k2[i] = keep + __shfl_xor(send, 8); }
        { const bool hi = lane & 4; const float send = hi ? k2[0] : k2[1], keep = hi ? k2[1] : k2[0]; k1 = keep + __shfl_xor(send, 4); }
        k1 += __shfl_xor(k1, 2); k1 += __shfl_xor(k1, 1);
        const int e = ((lane >> 5) & 1) * 8 + ((lane >> 4) & 1) * 4 + ((lane >> 3) & 1) * 2 + ((lane >> 2) & 1);
        const float mxl = wave_max(k1), ex = expf(k1 - mxl), den = wave_sum(ex) * 0.25f;
        const float aff = ex / den;
        const int grp = m >= TG, tg = m - grp * TG;
        if ((lane & 3) == 0) { AFFT[((size_t)grp * NE + e) * TG + tg] = aff; AFFTOK[(size_t)m * NE + e] = aff; }
    }
}
__device__ __forceinline__ void moe_combine2(Frame& F, int l, float zmul, int nl, const float* __restrict__ g1n) {
    const int gw = F.vcu * NWAVES + F.wave, NGW = F.G * NWAVES, lane = F.lane;
    const float* __restrict__ mod = (const float*)(F.ws + WS_MOD) + (size_t)l * NMOD * 6 * D;
    const int* __restrict__ SLOT = (const int*)(F.ws + WS_SLOT); const float* __restrict__ AFFTOK = (const float*)(F.ws + WS_AFFTOK); const bf16* __restrict__ YE = (const bf16*)(F.ws + WS_YE);
    for (int m = gw; m < T; m += NGW) {
        const int grp = m >= TG;
        const int sl = SLOT[(size_t)m * NE + (lane & 15)]; const float gtv = AFFTOK[(size_t)m * NE + (lane & 15)];
        f32x4* xo = (f32x4*)(F.out + (size_t)m * D) + lane;
        const float* __restrict__ mr = mod + (size_t)mod_row(m) * 6 * D;
        f32x4 xv[4], g2[4], acc[4];
#pragma unroll
        for (int j = 0; j < 4; ++j) { xv[j] = xo[64 * j]; g2[j] = *(const f32x4*)(mr + 5 * D + 4 * lane + 256 * j); acc[j] = (f32x4){0.f, 0.f, 0.f, 0.f}; }
        unsigned mask = (unsigned)(__ballot(sl >= 0) & 0xffffull);
        while (mask) {
            const int e0 = __builtin_ctz(mask); mask &= mask - 1u;
            const bool two = mask != 0u; const int e1 = two ? __builtin_ctz(mask) : e0; if (two) mask &= mask - 1u;
            const int s0 = __builtin_amdgcn_readlane(sl, e0), s1 = __builtin_amdgcn_readlane(sl, e1);
            const float t0 = rdlane(gtv, e0), t1 = two ? rdlane(gtv, e1) : 0.f;
            const v2u* __restrict__ y0 = (const v2u*)(YE + (((size_t)grp * NE + e0) * CAP + s0) * D) + lane; const v2u* __restrict__ y1 = (const v2u*)(YE + (((size_t)grp * NE + e1) * CAP + s1) * D) + lane;
            v2u a[4], b[4];
#pragma unroll
            for (int j = 0; j < 4; ++j) { a[j] = y0[64 * j]; b[j] = y1[64 * j]; }
#pragma unroll
            for (int j = 0; j < 4; ++j) { acc[j] += (f32x4){bflo(a[j].x), bfhi(a[j].x), bflo(a[j].y), bfhi(a[j].y)} * t0; acc[j] += (f32x4){bflo(b[j].x), bfhi(b[j].x), bflo(b[j].y), bfhi(b[j].y)} * t1; }
        }
#pragma unroll
        for (int j = 0; j < 4; ++j) { xv[j] = xv[j] + g2[j] * acc[j] * zmul; xo[64 * j] = xv[j]; }
        if (nl >= 0) {
            float ss = 0.f;
#pragma unroll
            for (int j = 0; j < 4; ++j) ss += (xv[j].x * xv[j].x + xv[j].y * xv[j].y) + (xv[j].z * xv[j].z + xv[j].w * xv[j].w);
            const float rstd = 1.0f / sqrtf(wave_sum(ss) * (1.f / D) + EPS);
            const float* __restrict__ mrn = (const float*)(F.ws + WS_MOD) + ((size_t)nl * NMOD + mod_row(m)) * 6 * D;
            unsigned long long* o8 = (unsigned long long*)((bf16*)(F.ws + WS_H) + (size_t)m * D) + lane;
#pragma unroll
            for (int j = 0; j < 4; ++j) { const int cc = 4 * lane + 256 * j;
                const f32x4 gg = *(const f32x4*)(g1n + cc), sc = *(const f32x4*)(mrn + D + cc), sh = *(const f32x4*)(mrn + cc);
                const f32x4 o = xv[j] * rstd * gg * (sc + 1.0f) + sh;
                o8[64 * j] = (unsigned long long)pk2(o.x, o.y) | ((unsigned long long)pk2(o.z, o.w) << 32); }
        }
    }
}

#ifdef PROBE_FP8
typedef int v8i_t __attribute__((ext_vector_type(8)));
__device__ __forceinline__ float fp8p_a(int i, int k) { return (float)(((i * 7 + k * 3) % 5) - 2); }
__device__ __forceinline__ float fp8p_b(int k, int j) { return (float)(((k * 5 + j * 11) % 7) - 3); }
__device__ __forceinline__ int fp8p_k(int lane, int b, int hyp) {
    const int g = lane >> 4;
    if (hyp == 1) return 32 * g + b;
    if (hyp == 2) return 16 * g + (b & 15) + 64 * (b >> 4);
    return 8 * g + (b & 7) + 32 * (b >> 3);
}
__device__ __forceinline__ bool fp8_probe(int lane) {
    v8i_t A, B;
#pragma unroll
    for (int v = 0; v < 8; ++v) { int wa = 0, wb = 0;
        { const int k0 = fp8p_k(lane, 4 * v + 0, PROBE_FP8_HA), k1 = fp8p_k(lane, 4 * v + 1, PROBE_FP8_HA), k2 = fp8p_k(lane, 4 * v + 2, PROBE_FP8_HA), k3 = fp8p_k(lane, 4 * v + 3, PROBE_FP8_HA);
          wa = __builtin_amdgcn_cvt_pk_fp8_f32(fp8p_a(lane & 15, k0), fp8p_a(lane & 15, k1), wa, false); wa = __builtin_amdgcn_cvt_pk_fp8_f32(fp8p_a(lane & 15, k2), fp8p_a(lane & 15, k3), wa, true); }
        { const int k0 = fp8p_k(lane, 4 * v + 0, PROBE_FP8_HB), k1 = fp8p_k(lane, 4 * v + 1, PROBE_FP8_HB), k2 = fp8p_k(lane, 4 * v + 2, PROBE_FP8_HB), k3 = fp8p_k(lane, 4 * v + 3, PROBE_FP8_HB);
          wb = __builtin_amdgcn_cvt_pk_fp8_f32(fp8p_b(k0, lane & 15), fp8p_b(k1, lane & 15), wb, false); wb = __builtin_amdgcn_cvt_pk_fp8_f32(fp8p_b(k2, lane & 15), fp8p_b(k3, lane & 15), wb, true); }
        A[v] = wa; B[v] = wb; }
    f32x4 acc = {0.f, 0.f, 0.f, 0.f};
    acc = __builtin_amdgcn_mfma_scale_f32_16x16x128_f8f6f4(A, B, acc, 0, 0, 0, 0x7F7F7F7F, 0, 0x7F7F7F7F);
    bool bad = false;
#pragma unroll
    for (int r = 0; r < 4; ++r) { const int row = 4 * (lane >> 4) + r, col = lane & 15; float s = 0.f;
        for (int k = 0; k < 128; ++k) s += fp8p_a(row, k) * fp8p_b(k, col);
        bad |= (acc[r] != s); }
    return bad;
}
#endif

#ifdef PROBE_FP4
typedef int v8i_p4 __attribute__((ext_vector_type(8)));
__device__ __forceinline__ float fp4p_a(int i, int k) { return (float)(((i * 7 + k * 3) % 5) - 2); }
__device__ __forceinline__ float fp4p_b(int k, int j) { return (float)(((k * 5 + j * 11) % 7) - 3); }
__device__ __forceinline__ bool fp4_probe(int lane) {
    v8i_p4 A, B;
#pragma unroll
    for (int v = 0; v < 8; ++v) { A[v] = 0; B[v] = 0; }
    const int g = lane >> 4;
#pragma unroll
    for (int v = 0; v < 4; ++v) { unsigned wa = 0u, wb = 0u;
#if PROBE_FP4 == 1
#define FP4P_K(by) const int k0 = 32 * g + 8 * v + 2 * (by), k1 = k0 + 1
#else
#define FP4P_K(by) const int k1 = 32 * g + 8 * v + 2 * (by), k0 = k1 + 1
#endif
#define FP4P_BYTE(by) { FP4P_K(by); wa = __builtin_amdgcn_cvt_scalef32_pk_fp4_f32(wa, fp4p_a(lane & 15, k0), fp4p_a(lane & 15, k1), 1.0f, by); wb = __builtin_amdgcn_cvt_scalef32_pk_fp4_f32(wb, fp4p_b(k0, lane & 15), fp4p_b(k1, lane & 15), 1.0f, by); }
        FP4P_BYTE(0) FP4P_BYTE(1) FP4P_BYTE(2) FP4P_BYTE(3)
#undef FP4P_BYTE
#undef FP4P_K
        A[v] = (int)wa; B[v] = (int)wb; }
    f32x4 acc = {0.f, 0.f, 0.f, 0.f};
    acc = __builtin_amdgcn_mfma_scale_f32_16x16x128_f8f6f4(A, B, acc, 4, 4, 0, 0x7F7F7F7F, 0, 0x7F7F7F7F);
    bool bad = false;
#pragma unroll
    for (int r = 0; r < 4; ++r) { const int row = 4 * (lane >> 4) + r, col = lane & 15; float s = 0.f;
        for (int k = 0; k < 128; ++k) s += fp4p_a(row, k) * fp4p_b(k, col);
        bad |= (acc[r] != s); }
    return bad;
}
#endif

constexpr int PH_PER_LAYER = 14, N_PHASES = 1 + DEPTH * PH_PER_LAYER;
__global__ void __launch_bounds__(NWAVES * 64, 2) mk_fwd(Args args) {
    extern __shared__ __attribute__((aligned(16))) unsigned char lds[];
    Frame F;
    F.lds = (LAS unsigned char*)lds;
    F.MISC = (volatile LAS unsigned*)(F.lds + MISC_OFF);
    F.tid = threadIdx.x; F.lane = F.tid & 63; F.wave = __builtin_amdgcn_readfirstlane(F.tid >> 6);
    F.G = gridDim.x; F.bid = blockIdx.x; { const int bx = blockIdx.x; F.vcu = (F.G % 8 == 0) ? (bx % 8) * (F.G / 8) + bx / 8 : bx; }
    F.ws = args.ws; F.out = args.out; F.ctl = (gu32*)(args.ws + WS_CTL);
    for (int u = F.tid; u < (SCR_OFF - LDSCTL_OFF) / 4; u += NWAVES * 64) ((LAS unsigned*)(F.lds + LDSCTL_OFF))[u] = 0u;
    __syncthreads();
    XcdBarrier bar; bar.bar = (unsigned*)(F.ctl + CW_BAR); bar.x = 0; bar.st = nullptr;
    if (!MK_PER_PHASE) bar = xcd_barrier_post((unsigned*)(F.ctl + CW_BAR), F.MISC + 8);
    const int lo = args.ph_lo, hi = args.ph_hi;
#ifndef PH_MASK
#define PH_MASK 0xFFFFu
#endif
#define PHON(j) (((PH_MASK) >> (j)) & 1u)
#define IN(k) (lo <= (k) && (k) < hi)
#define PH_ENTER() Frame P = F; InTab A; { KargTab t_ = (KargTab)__builtin_amdgcn_kernarg_segment_ptr(); asm volatile("" : "+s"(t_)); A.in.t = t_; { size_t z_ = 0; asm volatile("" : "+s"(z_)); P.ws = args.ws + z_; P.out = args.out + z_; } asm volatile("" : "+v"(P.tid)); asm volatile("" : "+s"(P.vcu)); asm volatile("" : "+s"(P.G)); asm volatile("" : "+s"(P.bid)); P.lane = P.tid & 63; P.wave = __builtin_amdgcn_readfirstlane(P.tid >> 6); }
#ifdef PROBE_SEAM2
#define SEAM(k) do { if (IN(k) && IN((k) + 1)) { xcd_barrier(bar); xcd_barrier(bar); } } while (0)
#else
#define SEAM(k) do { if (IN(k) && IN((k) + 1)) xcd_barrier(bar); } while (0)
#endif

    if (PHON(14) && IN(0)) { PH_ENTER(); adaln_mod(P, A); rope_table(P); convert_small_weights(P, A); convert_moe_weights(P, A, 0); }
    SEAM(0);

    for (int l = 0; l < DEPTH; ++l) {
        const int k0 = 1 + PH_PER_LAYER * l;
        if (PHON(0) && IN(k0 + 0)) { PH_ENTER(); filter_time_tiles(P, A, l); if (l == 0) norm_mod_rows(P, A, l, A.in[I_N1G] + (size_t)l * D, 0, D);
#ifdef PROBE_NORMROWS_TWICE
            norm_mod_rows(P, A, l, A.in[I_N1G] + (size_t)l * D, 0, D);
#endif
#ifdef PROBE_FTILES_TWICE
            filter_time_tiles(P, A, l);
#endif
        }
        SEAM(k0 + 0);
        if (PHON(1) && IN(k0 + 1)) { PH_ENTER();
            { pg8::Gemm g{(const bf16*)(P.ws + WS_H), (const bf16*)(P.ws + WS_WIN) + (size_t)l * INW * D, T, NHY, D, 1 << 30, 1, 0}; pg8::StaticOrder S; S.init(T, NHY, P.G, P.bid);
              pg8::EpiColMajor E{(float*)(P.ws + WS_HYT), TPAD}; pg8::gemm_phase<pg8::EpiColMajor, pg8::StaticOrder, true, true, true>(P.lds + RING_OFF, g, S, E);
#ifdef PROBE_PROJHY_TWICE
              pg8::gemm_phase<pg8::EpiColMajor, pg8::StaticOrder, true, true, true>(P.lds + RING_OFF, g, S, E);
#endif
            }
            { pg8::Gemm g{(const bf16*)(P.ws + WS_H), (const bf16*)(P.ws + WS_WIN) + (size_t)l * INW * D + (size_t)NHY * D, T, INW - NHY, D, 1 << 30, 1, 0}; pg8::StaticOrder S; S.init(T, INW - NHY, P.G, P.bid);
              pg8::EpiBf16<0> E{(bf16*)(P.ws + WS_PROJ) + NHY, INW, nullptr, 0, 0, 1.f}; pg8::gemm_phase<pg8::EpiBf16<0>, pg8::StaticOrder, true, true>(P.lds + RING_OFF, g, S, E);
#ifdef PROBE_PROJREST_TWICE
              pg8::gemm_phase<pg8::EpiBf16<0>, pg8::StaticOrder, true, true>(P.lds + RING_OFF, g, S, E);
#endif
            }
        }
        if (PHON(2) && IN(k0 + 2)) { PH_ENTER(); filter_fft_units(P); }
        SEAM(k0 + 2);
        if (PHON(3) && IN(k0 + 3)) { PH_ENTER(); hyena_units(P, A, l);
#if MK_ATTN_SIMPLE
            attention_simple(P, A, l);
#else
            attention_mfma(P, A, l);
#ifdef PROBE_ATTN_TWICE
            attention_mfma(P, A, l);
#endif
#ifdef PROBE_HYENA_TWICE
            hyena_units(P, A, l);
#endif
#endif
 }
        SEAM(k0 + 3);
        if (PHON(4) && IN(k0 + 4)) { PH_ENTER(); z2_transpose(P); }
        SEAM(k0 + 4);
        if (PHON(5) && IN(k0 + 5)) { PH_ENTER();
            pg8::Gemm g{(const bf16*)(P.ws + WS_Z2AT), (const bf16*)(P.ws + WS_WHY) + (size_t)l * D * ZAP, T, D, ZAP, 1 << 30, 1, 0}; pg8::StaticOrder S; S.init(T, D, P.G, P.bid);
            pg8::EpiGate2 E{(bf16*)(P.ws + WS_MERGED), D, (const bf16*)(P.ws + WS_PROJ) + COL_G, (const bf16*)(P.ws + WS_PROJ) + COL_G + D, INW};
            pg8::gemm_phase<pg8::EpiGate2, pg8::StaticOrder, true, true>(P.lds + RING_OFF, g, S, E); }
        SEAM(k0 + 5);
        if (PHON(7) && IN(k0 + 7)) { PH_ENTER(); pg8::Gemm g{(const bf16*)(P.ws + WS_MERGED), (const bf16*)(P.ws + WS_WO) + (size_t)l * D * D, T, D, D, 1 << 30, 1, 0}; pg8::StaticOrder S; S.init(T, D, P.G, P.bid);
            pg8::EpiResid E{l == 0 ? A.in[I_XP] : (const float*)P.out, l == 0 ? A.in[I_XS] : (const float*)P.out + (size_t)TP * D, P.out, (const float*)(P.ws + WS_MOD) + (size_t)l * NMOD * 6 * D + 2 * D, TP, TS, 6 * D, D};
            pg8::gemm_phase<pg8::EpiResid, pg8::StaticOrder, true, true>(P.lds + RING_OFF, g, S, E); }
        SEAM(k0 + 7);
        if (PHON(8) && IN(k0 + 8)) { PH_ENTER(); resid_norm_router2(P, A, l);
#ifdef PROBE_RESID_TWICE
            if (l == 0) resid_norm_router2(P, A, l);
#endif
        }
        SEAM(k0 + 8);
        if (PHON(9) && IN(k0 + 9)) { PH_ENTER();
#if MK_TOPK_RANK
            topk_rank(P);
#else
            topk_select(P);
#endif
        }
        SEAM(k0 + 9);
        if (PHON(10) && IN(k0 + 10)) { PH_ENTER(); gather_rows(P); }
        SEAM(k0 + 10);
        if (PHON(11) && IN(k0 + 11)) { PH_ENTER(); pg8::Gemm g{(const bf16*)(P.ws + WS_XE), (const bf16*)(P.ws + WS_WGU), NSLOT, 2 * FF, KB_UP / 2, CAP / 256, NE, (size_t)2 * FF * KB_UP}; pg8::StaticOrder S; S.init(NSLOT, 2 * FF, P.G, P.bid);
            pg8::EpiSwiGLU4 E{(unsigned char*)(P.ws + WS_HID), KB_DN, 1.0f / 64.0f, 2.0f}; pg8::gemm_phase4<pg8::EpiSwiGLU4, pg8::StaticOrder, true, true>(P.lds + RING_OFF, g, S, E);
#ifdef PROBE_UPVAR
            __syncthreads(); { pg8::EpiSwiGLU4 E2{(unsigned char*)(P.ws + WS_YE), KB_DN, 1.0f / 64.0f, 2.0f}; pg8::gemm_phase4<pg8::EpiSwiGLU4, pg8::StaticOrder, true, true, PROBE_UPVAR>(P.lds + RING_OFF, g, S, E2); }
#endif
        }
        SEAM(k0 + 11);
        if (PHON(12) && IN(k0 + 12)) { PH_ENTER(); pg8::Gemm g{(const bf16*)(P.ws + WS_HID), (const bf16*)(P.ws + WS_WD), NSLOT, D, KB_DN / 2, CAP / 256, NE, (size_t)D * KB_DN}; pg8::StaticOrder S; S.init(NSLOT, D, P.G, P.bid);
            pg8::EpiBf16S E{(bf16*)(P.ws + WS_YE), D, 1.0f / 256.0f}; pg8::gemm_phase4<pg8::EpiBf16S, pg8::StaticOrder, true, true>(P.lds + RING_OFF, g, S, E); }
        SEAM(k0 + 12);
        if (PHON(13) && IN(k0 + 13)) { PH_ENTER(); moe_combine2(P, l, 1.0f, l + 1 < DEPTH ? l + 1 : -1, A.in[I_N1G] + (size_t)(l + 1 < DEPTH ? l + 1 : 0) * D);
#ifdef PROBE_COMBINE_TWICE
            moe_combine2(P, l, (float)__hip_atomic_load(P.ctl + 8, __ATOMIC_RELAXED, __HIP_MEMORY_SCOPE_AGENT), -1, nullptr);
#endif
            if (l + 1 < DEPTH) convert_moe_weights(P, A, l + 1);
#ifdef PROBE_CONVERT_TWICE
            if (l + 1 < DEPTH) convert_moe_weights<PROBE_CONVERT_TWICE>(P, A, l + 1);
#endif
        }
        SEAM(k0 + 13);
    }
#ifdef PROBE_MFMA
    if (hi == N_PHASES) {
        typedef int pv4 __attribute__((ext_vector_type(4))); typedef int pv8 __attribute__((ext_vector_type(8)));
        f32x4 c0 = {0.f, 0.f, 0.f, 0.f}, c1 = c0, c2 = c0, c3 = c0, c4 = c0, c5 = c0, c6 = c0, c7 = c0; f32x16 d0 = {}, d1 = {}, d2 = {}, d3 = {};
        pv4 a = {0, 0, 0, 0}, b = {0, 0, 0, 0}; pv8 a8 = {}, b8 = {}; int sc = 0x7F7F7F7F; asm volatile("" : "+v"(a), "+v"(b), "+v"(sc), "+v"(a8), "+v"(b8));
#pragma unroll 1
        for (int it = 0; it < PROBE_MFMA_N; ++it) {
#if PROBE_MFMA == 1
#define PM(c) asm volatile("v_mfma_scale_f32_16x16x128_f8f6f4 %0, %1, %2, %0, %3, %3 op_sel_hi:[0,0,0] cbsz:4 blgp:4" : "+v"(c) : "v"(a), "v"(b), "v"(sc))
            PM(c0); PM(c1); PM(c2); PM(c3); PM(c4); PM(c5); PM(c6); PM(c7);
#elif PROBE_MFMA == 2
#define PM(c) asm volatile("v_mfma_f32_16x16x128_f8f6f4 %0, %1, %2, %0 cbsz:4 blgp:4" : "+v"(c) : "v"(a), "v"(b))
            PM(c0); PM(c1); PM(c2); PM(c3); PM(c4); PM(c5); PM(c6); PM(c7);
#elif PROBE_MFMA == 3
#define PM(c) asm volatile("v_mfma_scale_f32_32x32x64_f8f6f4 %0, %1, %2, %0, %3, %3 op_sel_hi:[0,0,0] cbsz:4 blgp:4" : "+v"(c) : "v"(a), "v"(b), "v"(sc))
            PM(d0); PM(d1); PM(d2); PM(d3);
#elif PROBE_MFMA == 4
#define PM(c) asm volatile("v_mfma_scale_f32_16x16x128_f8f6f4 %0, %1, %2, %0, %3, %3 op_sel_hi:[0,0,0]" : "+v"(c) : "v"(a8), "v"(b8), "v"(sc))
            PM(c0); PM(c1); PM(c2); PM(c3); PM(c4); PM(c5); PM(c6); PM(c7);
#elif PROBE_MFMA == 5
#define PM(c) asm volatile("v_mfma_f32_16x16x32_bf16 %0, %1, %2, %0" : "+v"(c) : "v"(a), "v"(b))
            PM(c0); PM(c1); PM(c2); PM(c3); PM(c4); PM(c5); PM(c6); PM(c7);
#endif
        }
        asm volatile("s_nop 15\n\ts_nop 15" ::: "memory");
        const float sum = c0[0] + c1[1] + c2[2] + c3[3] + c4[0] + c5[1] + c6[2] + c7[3] + d0[0] + d1[5] + d2[9] + d3[15];
        if (sum != 0.f) F.out[1] = __builtin_nanf("");
    }
#endif
#ifdef PROBE_FP4
    if (blockIdx.x == 0 && threadIdx.x < 64 && hi == N_PHASES) { const bool bad = fp4_probe((int)threadIdx.x); if (__any(bad) && threadIdx.x == 0) F.out[0] = __builtin_nanf(""); }
#endif
#ifdef PROBE_FP8
    if (blockIdx.x == 0 && threadIdx.x < 64 && hi == N_PHASES) { const bool bad = fp8_probe((int)threadIdx.x); if (__any(bad) && threadIdx.x == 0) F.out[0] = __builtin_nanf(""); }
#endif
#undef IN
#undef SEAM
}

#if defined(__HIP_DEVICE_COMPILE__) && MK_NOPK
#pragma clang attribute pop
#endif
extern "C" void kernel_launch(void* const* d_in, const int* in_sizes, int n_in, void* d_out, int out_size, void* d_ws, size_t ws_size, hipStream_t stream) {
    static int grid = 0;
    if (grid == 0) {
        if (n_in != 30 || in_sizes[0] != TP * D || out_size != T * D || ws_size < WS_END) { fprintf(stderr, "kernel_launch: shape/workspace mismatch: n_in %d in0 %d out %d ws %zu (need %zu); nothing launched\n", n_in, n_in > 0 ? in_sizes[0] : -1, out_size, ws_size, (size_t)WS_END); grid = -1; return; }
        int dev = 0, cus = 0, per_cu = 0;
        if (hipGetDevice(&dev) != hipSuccess || hipDeviceGetAttribute(&cus, hipDeviceAttributeMultiprocessorCount, dev) != hipSuccess) { fprintf(stderr, "kernel_launch: device query failed\n"); grid = -1; return; }
        if (hipFuncSetAttribute((const void*)mk_fwd, hipFuncAttributeMaxDynamicSharedMemorySize, LDS_BYTES) != hipSuccess) { fprintf(stderr, "kernel_launch: hipFuncSetAttribute failed\n"); grid = -1; return; }
        if (hipOccupancyMaxActiveBlocksPerMultiprocessor(&per_cu, (const void*)mk_fwd, NWAVES * 64, LDS_BYTES) != hipSuccess || per_cu < 1) fprintf(stderr, "kernel_launch: note: occupancy query reports %d\n", per_cu);
        (void)hipGetLastError();
        grid = cus;
    }
    if (grid < 0) return;
    if (hipMemsetAsync((char*)d_ws + WS_CTL, 0, CTL_ZERO_BYTES, stream) != hipSuccess) { fprintf(stderr, "kernel_launch: memset failed\n"); return; }
    Args a{};
    for (int i = 0; i < 30; ++i) a.in[i] = (const float*)d_in[i];
    a.out = (float*)d_out; a.ws = (unsigned char*)d_ws;
#if MK_PER_PHASE
    for (int k = 0; k < N_PHASES; ++k) { a.ph_lo = k; a.ph_hi = k + 1; hipLaunchKernelGGL(mk_fwd, dim3(grid), dim3(NWAVES * 64), LDS_BYTES, stream, a); }
#else
    a.ph_lo = 0; a.ph_hi = N_PHASES; hipLaunchKernelGGL(mk_fwd, dim3(grid), dim3(NWAVES * 64), LDS_BYTES, stream, a);
#endif
    const hipError_t le = hipPeekAtLastError();
    if (le != hipSuccess) fprintf(stderr, "kernel_launch: launch failed: %s\n", hipGetErrorName(le));
}
```

```cpp
#include <hip/hip_runtime.h>
#include <cstdio>
#include <cstdint>
#define MK_PER_PHASE 0
#ifndef MK_NOPK
#define MK_NOPK 0
#endif
#if defined(__HIP_DEVICE_COMPILE__) && MK_NOPK
#pragma clang attribute push(__attribute__((target("no-packed-fp32-ops"))), apply_to = function)
#endif
namespace pg8 {
#define PG8_LAS __attribute__((address_space(3)))
typedef unsigned short bf16_t;
typedef short bf16x8 __attribute__((ext_vector_type(8)));
typedef float f32x4 __attribute__((ext_vector_type(4)));
typedef unsigned u32x4 __attribute__((ext_vector_type(4)));
constexpr int BM = 256, BK = 64, HALF = 128, HTB = HALF * BK * 2  , STAGE_BYTES = 8 * HTB, NXCD = 8, WGM = 8;

__host__ __device__ __forceinline__ int lds_byte(int r, int c) { const int st = (r >> 4) * 2 + (c >> 5), rr = r & 15, cc = c & 31, ob = rr * 64 + cc * 2; return st * 1024 + (ob ^ (((ob >> 9) & 1) << 5)); }
__host__ __device__ __forceinline__ void stage_rc(int b, int& R, int& C) { const int st = b / 1024, sb = b % 1024, swz = sb ^ (((sb >> 9) & 1) << 5); R = (st >> 1) * 16 + swz / 64; C = (st & 1) * 32 + (swz % 64) / 2; }
__host__ __device__ __forceinline__ int perm32(int rho) { const int n = rho >> 4, i = rho & 15; return 8 * (i >> 2) + 4 * n + (i & 3); }

struct Unit { int pm, pn; };
struct Gemm { const bf16_t* A; const bf16_t* Bt; int M, N, K; int tpg, ng; size_t gstride; };

struct StaticOrder {
    int nM, nN, nwg, G, c;
    __host__ __device__ void init(int M, int N, int G_, int c_) { nM = M / BM; nN = N / BM; nwg = nM * nN; G = G_; c = c_; }
    __host__ __device__ bool next(int i, Unit& u) const {
        const long L = (long)i * G + c; if (L >= nwg) return false;
        int wgid = (int)L; { const int q = nwg / NXCD, r = nwg % NXCD, xcd = wgid % NXCD, off = wgid / NXCD; wgid = (xcd < r ? xcd * (q + 1) : r * (q + 1) + (xcd - r) * q) + off; }
        const int nig = WGM * nN, gid = wgid / nig, fm = gid * WGM, gsz = (nM - fm) < WGM ? (nM - fm) : WGM;
        u.pm = fm + ((wgid % nig) % gsz); u.pn = (wgid % nig) / gsz; return true;
    }
    __device__ __forceinline__ void a_ready(const Unit&) const {}
    __device__ __forceinline__ void done(const Unit&) const {}
};

__device__ __forceinline__ unsigned cvt_pk_bf16(float lo, float hi) { unsigned r; asm volatile("v_cvt_pk_bf16_f32 %0, %1, %2" : "=v"(r) : "v"(lo), "v"(hi)); return r; }
typedef float f32x2 __attribute__((ext_vector_type(2)));
__device__ __forceinline__ f32x2 gelu_pk(f32x2 v) {
    const f32x2 av = __builtin_elementwise_abs(v), d = av * 0.2316418882f + 1.0f;
    f32x2 t; t.x = __builtin_amdgcn_rcpf(d.x); t.y = __builtin_amdgcn_rcpf(d.y);
    f32x2 q = t * 0.5307027145f + (-0.7265760135f); q = q * t + 0.7107068705f; q = q * t + (-0.142248368f); q = q * t + 0.127414796f; q = q * t;
    const f32x2 s = (v * v) * (-0.72134752044f);
    f32x2 e; e.x = __builtin_amdgcn_exp2f(s.x); e.y = __builtin_amdgcn_exp2f(s.y);
    const f32x2 m = v * (q * e), r = v - m;
    f32x2 o; o.x = v.x < 0.f ? m.x : r.x; o.y = v.y < 0.f ? m.y : r.y; return o;
}

template <int ACT  > struct EpiBf16 {
    static constexpr bool PERM = true, AFTER_DRAIN = false; static constexpr int MID_T = 0; static_assert(ACT == 0 || ACT == 1, "EpiBf16: ACT is 0 (none) or 1 (gelu_pk)");
    bf16_t* O; int ldc; const float* bias; int split_cols; size_t split_stride; float scale0;
    __device__ __forceinline__ void operator()(const f32x4 (&acc)[2][2][4][2], const Unit& u, int wr, int wc, int fr, int fq) const {
        const int row0 = u.pm * BM + wr * 64 + fr; int colt = u.pn * BM; bf16_t* base = O;
        float sc = 1.f; if (split_cols) { const int t = colt / split_cols; base += (size_t)t * split_stride; colt -= t * split_cols; if (t == 0) sc = scale0; }
        const int col0 = colt + wc * 32 + 8 * fq, bcol0 = u.pn * BM + wc * 32 + 8 * fq;
        f32x4 bv[2][2];
#pragma unroll
        for (int bj = 0; bj < 2; ++bj)
#pragma unroll
            for (int n = 0; n < 2; ++n) bv[bj][n] = bias ? *(const f32x4*)(bias + bcol0 + bj * HALF + 4 * n) : (f32x4){0.f, 0.f, 0.f, 0.f};
#pragma unroll
        for (int ai = 0; ai < 2; ++ai)
#pragma unroll
            for (int m = 0; m < 4; ++m) { bf16_t* rowp = base + (size_t)(row0 + ai * HALF + m * 16) * ldc + col0;
#pragma unroll
                for (int bj = 0; bj < 2; ++bj) { f32x4 v0 = acc[ai][bj][m][0] + bv[bj][0], v1 = acc[ai][bj][m][1] + bv[bj][1];
                    if (ACT == 1) { f32x2 a = gelu_pk((f32x2){v0[0], v0[1]}), b = gelu_pk((f32x2){v0[2], v0[3]}), c = gelu_pk((f32x2){v1[0], v1[1]}), d = gelu_pk((f32x2){v1[2], v1[3]});
                        v0 = (f32x4){a.x, a.y, b.x, b.y}; v1 = (f32x4){c.x, c.y, d.x, d.y}; }
                    v0 = v0 * sc; v1 = v1 * sc; u32x4 w; w.x = cvt_pk_bf16(v0[0], v0[1]); w.y = cvt_pk_bf16(v0[2], v0[3]); w.z = cvt_pk_bf16(v1[0], v1[1]); w.w = cvt_pk_bf16(v1[2], v1[3]);
                    *(u32x4*)(rowp + bj * HALF) = w; } }
    }
};

struct EpiF32 {
    static constexpr bool PERM = false, AFTER_DRAIN = false; static constexpr int MID_T = 0;
    float* C; int ldc;
    __device__ __forceinline__ void operator()(const f32x4 (&acc)[2][2][4][2], const Unit& u, int wr, int wc, int fr, int fq) const {
        const int row0 = u.pm * BM + wr * 64 + fr, col0 = u.pn * BM + wc * 32 + 4 * fq;
#pragma unroll
        for (int ai = 0; ai < 2; ++ai)
#pragma unroll
            for (int m = 0; m < 4; ++m) { float* rowp = C + (size_t)(row0 + ai * HALF + m * 16) * ldc + col0;
#pragma unroll
                for (int bj = 0; bj < 2; ++bj)
#pragma unroll
                    for (int n = 0; n < 2; ++n) *(f32x4*)(rowp + bj * HALF + n * 16) = acc[ai][bj][m][n]; }
    }
};
struct EpiSwiGLU {
    static constexpr bool PERM = true, AFTER_DRAIN = false; static constexpr int MID_T = 0;
    bf16_t* O; int ldc;
    __device__ __forceinline__ static float silu(float x) { return x * __builtin_amdgcn_rcpf(1.0f + __builtin_amdgcn_exp2f(-1.4426950408889634f * x)); }
    __device__ __forceinline__ void operator()(const f32x4 (&acc)[2][2][4][2], const Unit& u, int wr, int wc, int fr, int fq) const {
        const int row0 = u.pm * BM + wr * 64 + fr, col0 = u.pn * HALF + wc * 32 + 8 * fq;
#pragma unroll
        for (int ai = 0; ai < 2; ++ai)
#pragma unroll
            for (int m = 0; m < 4; ++m) { bf16_t* rowp = O + (size_t)(row0 + ai * HALF + m * 16) * ldc + col0;
                const f32x4 g0 = acc[ai][0][m][0], g1 = acc[ai][0][m][1], u0 = acc[ai][1][m][0], u1 = acc[ai][1][m][1];
                u32x4 w; w.x = cvt_pk_bf16(silu(g0[0]) * u0[0], silu(g0[1]) * u0[1]); w.y = cvt_pk_bf16(silu(g0[2]) * u0[2], silu(g0[3]) * u0[3]);
                w.z = cvt_pk_bf16(silu(g1[0]) * u1[0], silu(g1[1]) * u1[1]); w.w = cvt_pk_bf16(silu(g1[2]) * u1[2], silu(g1[3]) * u1[3]);
                *(u32x4*)rowp = w; }
    }
};
struct EpiProj {
    static constexpr bool PERM = true, AFTER_DRAIN = false; static constexpr int MID_T = 0;
    bf16_t* O; int ldc; float* HT; int ldt; int NT;
    __device__ __forceinline__ void operator()(const f32x4 (&acc)[2][2][4][2], const Unit& u, int wr, int wc, int fr, int fq) const {
        const int row0 = u.pm * BM + wr * 64 + fr, col0 = u.pn * BM + wc * 32 + 8 * fq;
        if (u.pn < NT) {
#pragma unroll
            for (int ai = 0; ai < 2; ++ai)
#pragma unroll
                for (int m = 0; m < 4; ++m) { float* cp = HT + (size_t)col0 * ldt + (row0 + ai * HALF + m * 16);
#pragma unroll
                    for (int bj = 0; bj < 2; ++bj)
#pragma unroll
                        for (int n = 0; n < 2; ++n)
#pragma unroll
                            for (int e = 0; e < 4; ++e) cp[(size_t)(bj * HALF + 4 * n + e) * ldt] = acc[ai][bj][m][n][e]; }
        } else {
#pragma unroll
            for (int ai = 0; ai < 2; ++ai)
#pragma unroll
                for (int m = 0; m < 4; ++m) { bf16_t* rowp = O + (size_t)(row0 + ai * HALF + m * 16) * ldc + col0;
#pragma unroll
                    for (int bj = 0; bj < 2; ++bj) { const f32x4 v0 = acc[ai][bj][m][0], v1 = acc[ai][bj][m][1];
                        u32x4 w; w.x = cvt_pk_bf16(v0[0], v0[1]); w.y = cvt_pk_bf16(v0[2], v0[3]); w.z = cvt_pk_bf16(v1[0], v1[1]); w.w = cvt_pk_bf16(v1[2], v1[3]);
                        *(u32x4*)(rowp + bj * HALF) = w; } }
        }
    }
};
struct EpiGate {
    static constexpr bool PERM = true, AFTER_DRAIN = false; static constexpr int MID_T = 0;
    bf16_t* O; int ldc; const bf16_t* G; int ldg; int first;
    __device__ __forceinline__ static float sig(float x) { return __builtin_amdgcn_rcpf(1.0f + __builtin_amdgcn_exp2f(-1.4426950408889634f * x)); }
    __device__ __forceinline__ static float lo(unsigned w) { return __builtin_bit_cast(float, w << 16); }
    __device__ __forceinline__ static float hi(unsigned w) { return __builtin_bit_cast(float, w & 0xffff0000u); }
    __device__ __forceinline__ void operator()(const f32x4 (&acc)[2][2][4][2], const Unit& u, int wr, int wc, int fr, int fq) const {
        const int row0 = u.pm * BM + wr * 64 + fr, col0 = u.pn * BM + wc * 32 + 8 * fq;
#pragma unroll
        for (int ai = 0; ai < 2; ++ai)
#pragma unroll
            for (int m = 0; m < 4; ++m) { const size_t row = (size_t)(row0 + ai * HALF + m * 16);
#pragma unroll
                for (int bj = 0; bj < 2; ++bj) { const f32x4 v0 = acc[ai][bj][m][0], v1 = acc[ai][bj][m][1];
                    const u32x4 g = *(const u32x4*)(G + row * ldg + col0 + bj * HALF);
                    float o[8] = {sig(lo(g.x)) * v0[0], sig(hi(g.x)) * v0[1], sig(lo(g.y)) * v0[2], sig(hi(g.y)) * v0[3], sig(lo(g.z)) * v1[0], sig(hi(g.z)) * v1[1], sig(lo(g.w)) * v1[2], sig(hi(g.w)) * v1[3]};
                    u32x4* op = (u32x4*)(O + row * ldc + col0 + bj * HALF);
                    if (!first) { const u32x4 p = *op; o[0] += lo(p.x); o[1] += hi(p.x); o[2] += lo(p.y); o[3] += hi(p.y); o[4] += lo(p.z); o[5] += hi(p.z); o[6] += lo(p.w); o[7] += hi(p.w); }
                    u32x4 w; w.x = cvt_pk_bf16(o[0], o[1]); w.y = cvt_pk_bf16(o[2], o[3]); w.z = cvt_pk_bf16(o[4], o[5]); w.w = cvt_pk_bf16(o[6], o[7]);
                    *op = w; } }
    }
};
struct EpiResid {
    static constexpr bool PERM = false, AFTER_DRAIN = false; static constexpr int MID_T = 0;
    const float* xa; const float* xb; float* out; const float* gbase; int row_split, sub_rows, gstride, ldc;
    __device__ __forceinline__ void operator()(const f32x4 (&acc)[2][2][4][2], const Unit& u, int wr, int wc, int fr, int fq) const {
        const int row0 = u.pm * BM + wr * 64 + fr, col0 = u.pn * BM + wc * 32 + 4 * fq;
#pragma unroll
        for (int ai = 0; ai < 2; ++ai)
#pragma unroll
            for (int m = 0; m < 4; ++m) { const int row = row0 + ai * HALF + m * 16;
                const float* xr = (row < row_split ? xa + (size_t)row * ldc : xb + (size_t)(row - row_split) * ldc) + col0;
                const float* gr = gbase + (size_t)(row < row_split ? 0 : 1 + (row - row_split) / sub_rows) * gstride + col0;
                float* orow = out + (size_t)row * ldc + col0;
                f32x4 xv[2][2], gv[2][2];
#pragma unroll
                for (int bj = 0; bj < 2; ++bj)
#pragma unroll
                    for (int n = 0; n < 2; ++n) { xv[bj][n] = *(const f32x4*)(xr + bj * HALF + n * 16); gv[bj][n] = *(const f32x4*)(gr + bj * HALF + n * 16); }
#pragma unroll
                for (int bj = 0; bj < 2; ++bj)
#pragma unroll
                    for (int n = 0; n < 2; ++n) *(f32x4*)(orow + bj * HALF + n * 16) = xv[bj][n] + gv[bj][n] * acc[ai][bj][m][n]; }
    }
};
struct EpiGate2 {
    static constexpr bool PERM = true, AFTER_DRAIN = false; static constexpr int MID_T = 8;
    bf16_t* O; int ldc; const bf16_t* G1; const bf16_t* G2; int ldg;
    __device__ __forceinline__ static float en(float x) { return __builtin_amdgcn_exp2f(-1.4426950408889634f * x); }
    __device__ __forceinline__ static float lo(unsigned w) { return __builtin_bit_cast(float, w << 16); }
    __device__ __forceinline__ static float hi(unsigned w) { return __builtin_bit_cast(float, w & 0xffff0000u); }
    __device__ __forceinline__ static f32x4 rho4(unsigned a0, unsigned a1, unsigned b0, unsigned b1) {
        f32x4 r; r[0] = (1.f + en(lo(b0))) * __builtin_amdgcn_rcpf(1.f + en(lo(a0))); r[1] = (1.f + en(hi(b0))) * __builtin_amdgcn_rcpf(1.f + en(hi(a0)));
        r[2] = (1.f + en(lo(b1))) * __builtin_amdgcn_rcpf(1.f + en(lo(a1))); r[3] = (1.f + en(hi(b1))) * __builtin_amdgcn_rcpf(1.f + en(hi(a1))); return r; }
    __device__ __forceinline__ void mid(f32x4 (&acc)[2][2][4][2], const Unit& u, int wr, int wc, int fr_, int fq_) const {
        int fr = fr_, fq = fq_; asm volatile("" : "+v"(fr), "+v"(fq));
        const int row0 = u.pm * BM + wr * 64 + fr, col0 = u.pn * BM + wc * 32 + 8 * fq;
#pragma unroll
        for (int ai = 0; ai < 2; ++ai)
#pragma unroll
            for (int mh = 0; mh < 4; mh += 2) {
                u32x4 a[2][2], b[2][2];
#pragma unroll
                for (int mm = 0; mm < 2; ++mm) { const size_t row = (size_t)(row0 + ai * HALF + (mh + mm) * 16);
#pragma unroll
                    for (int bj = 0; bj < 2; ++bj) { a[mm][bj] = *(const u32x4*)(G1 + row * ldg + col0 + bj * HALF); b[mm][bj] = *(const u32x4*)(G2 + row * ldg + col0 + bj * HALF); } }
                asm volatile("" ::: "memory");
#pragma unroll
                for (int mm = 0; mm < 2; ++mm)
#pragma unroll
                    for (int bj = 0; bj < 2; ++bj) { const int m = mh + mm;
                        acc[ai][bj][m][0] = acc[ai][bj][m][0] * rho4(a[mm][bj].x, a[mm][bj].y, b[mm][bj].x, b[mm][bj].y);
                        acc[ai][bj][m][1] = acc[ai][bj][m][1] * rho4(a[mm][bj].z, a[mm][bj].w, b[mm][bj].z, b[mm][bj].w); }
                asm volatile("" ::: "memory");
            }
    }
    __device__ __forceinline__ void operator()(const f32x4 (&acc)[2][2][4][2], const Unit& u, int wr, int wc, int fr, int fq) const {
        const int row0 = u.pm * BM + wr * 64 + fr, col0 = u.pn * BM + wc * 32 + 8 * fq;
#pragma unroll
        for (int ai = 0; ai < 2; ++ai)
#pragma unroll
            for (int m = 0; m < 4; ++m) { const size_t row = (size_t)(row0 + ai * HALF + m * 16);
#pragma unroll
                for (int bj = 0; bj < 2; ++bj) { const f32x4 v0 = acc[ai][bj][m][0], v1 = acc[ai][bj][m][1];
                    const u32x4 b = *(const u32x4*)(G2 + row * ldg + col0 + bj * HALF);
                    u32x4 w;
                    w.x = cvt_pk_bf16(v0[0] * __builtin_amdgcn_rcpf(1.f + en(lo(b.x))), v0[1] * __builtin_amdgcn_rcpf(1.f + en(hi(b.x))));
                    w.y = cvt_pk_bf16(v0[2] * __builtin_amdgcn_rcpf(1.f + en(lo(b.y))), v0[3] * __builtin_amdgcn_rcpf(1.f + en(hi(b.y))));
                    w.z = cvt_pk_bf16(v1[0] * __builtin_amdgcn_rcpf(1.f + en(lo(b.z))), v1[1] * __builtin_amdgcn_rcpf(1.f + en(hi(b.z))));
                    w.w = cvt_pk_bf16(v1[2] * __builtin_amdgcn_rcpf(1.f + en(lo(b.w))), v1[3] * __builtin_amdgcn_rcpf(1.f + en(hi(b.w))));
                    *(u32x4*)(O + row * ldc + col0 + bj * HALF) = w; } }
    }
};
struct EpiColMajor {
    static constexpr bool PERM = false, AFTER_DRAIN = false; static constexpr int MID_T = 0;
    float* HT; int ldt;
    __device__ __forceinline__ void operator()(const f32x4 (&acc)[2][2][4][2], const Unit& u, int wr, int wc, int fr, int fq) const {
        const int row0 = u.pm * BM + wr * 64 + 4 * fq, col0 = u.pn * BM + wc * 32 + fr;
#pragma unroll
        for (int bj = 0; bj < 2; ++bj)
#pragma unroll
            for (int n = 0; n < 2; ++n) { float* cp = HT + (size_t)(col0 + bj * HALF + 16 * n) * ldt + row0;
#pragma unroll
                for (int ai = 0; ai < 2; ++ai)
#pragma unroll
                    for (int m = 0; m < 4; ++m) *(f32x4*)(cp + ai * HALF + 16 * m) = acc[ai][bj][m][n]; }
    }
};
__device__ __forceinline__ float clamp448(float x) { return __builtin_fminf(__builtin_fmaxf(x, -448.f), 448.f); }
__device__ __forceinline__ unsigned pack4_fp8(float a, float b, float c, float d) { int w = __builtin_amdgcn_cvt_pk_fp8_f32(clamp448(a), clamp448(b), 0, false); w = __builtin_amdgcn_cvt_pk_fp8_f32(clamp448(c), clamp448(d), w, true); return (unsigned)w; }
struct EpiSwiGLU8 {
    static constexpr bool PERM = true, AFTER_DRAIN = false; static constexpr int MID_T = 0;
    unsigned char* O; int ldc; float sin, sout;
    __device__ __forceinline__ static float silu(float x) { return x * __builtin_amdgcn_rcpf(1.0f + __builtin_amdgcn_exp2f(-1.4426950408889634f * x)); }
    __device__ __forceinline__ void operator()(const f32x4 (&acc)[2][2][4][2], const Unit& u, int wr, int wc, int fr, int fq) const {
        const int row0 = u.pm * BM + wr * 64 + fr, col0 = u.pn * HALF + wc * 32 + 8 * fq;
#pragma unroll
        for (int ai = 0; ai < 2; ++ai)
#pragma unroll
            for (int m = 0; m < 4; ++m) { unsigned char* rowp = O + (size_t)(row0 + ai * HALF + m * 16) * ldc + col0;
                const f32x4 g0 = acc[ai][0][m][0] * sin, g1 = acc[ai][0][m][1] * sin, u0 = acc[ai][1][m][0] * (sin * sout), u1 = acc[ai][1][m][1] * (sin * sout);
                typedef unsigned u32x2 __attribute__((ext_vector_type(2)));
                u32x2 w; w.x = pack4_fp8(silu(g0[0]) * u0[0], silu(g0[1]) * u0[1], silu(g0[2]) * u0[2], silu(g0[3]) * u0[3]); w.y = pack4_fp8(silu(g1[0]) * u1[0], silu(g1[1]) * u1[1], silu(g1[2]) * u1[2], silu(g1[3]) * u1[3]);
                *(u32x2*)rowp = w; asm volatile("" ::: "memory"); }
    }
};
struct EpiBf16S {
    static constexpr bool PERM = true, AFTER_DRAIN = false; static constexpr int MID_T = 0;
    bf16_t* O; int ldc; float s;
    __device__ __forceinline__ void operator()(const f32x4 (&acc)[2][2][4][2], const Unit& u, int wr, int wc, int fr, int fq) const {
        const int row0 = u.pm * BM + wr * 64 + fr, col0 = u.pn * BM + wc * 32 + 8 * fq;
#pragma unroll
        for (int ai = 0; ai < 2; ++ai)
#pragma unroll
            for (int m = 0; m < 4; ++m) { bf16_t* rowp = O + (size_t)(row0 + ai * HALF + m * 16) * ldc + col0;
#pragma unroll
                for (int bj = 0; bj < 2; ++bj) { const f32x4 v0 = acc[ai][bj][m][0] * s, v1 = acc[ai][bj][m][1] * s;
                    u32x4 w; w.x = cvt_pk_bf16(v0[0], v0[1]); w.y = cvt_pk_bf16(v0[2], v0[3]); w.z = cvt_pk_bf16(v1[0], v1[1]); w.w = cvt_pk_bf16(v1[2], v1[3]);
                    *(u32x4*)(rowp + bj * HALF) = w; } }
    }
};
#define PG8_FP4_PACK8(w, x0, x1, x2, x3, x4, x5, x6, x7) do { (w) = 0u; (w) = __builtin_amdgcn_cvt_scalef32_pk_fp4_f32((w), (x0), (x1), 1.0f, 0); (w) = __builtin_amdgcn_cvt_scalef32_pk_fp4_f32((w), (x2), (x3), 1.0f, 1); \
        (w) = __builtin_amdgcn_cvt_scalef32_pk_fp4_f32((w), (x4), (x5), 1.0f, 2); (w) = __builtin_amdgcn_cvt_scalef32_pk_fp4_f32((w), (x6), (x7), 1.0f, 3); } while (0)
__device__ __forceinline__ float clamp6(float x) { return x; }
struct EpiSwiGLU4 {
    static constexpr bool PERM = true, AFTER_DRAIN = false; static constexpr int MID_T = 0;
    unsigned char* O; int ldc; float sin, sout;
    __device__ __forceinline__ static float silu(float x) { return x * __builtin_amdgcn_rcpf(1.0f + __builtin_amdgcn_exp2f(-1.4426950408889634f * x)); }
    __device__ __forceinline__ void operator()(const f32x4 (&acc)[2][2][4][2], const Unit& u, int wr, int wc, int fr, int fq) const {
        const int row0 = u.pm * BM + wr * 64 + fr, col0 = u.pn * HALF + wc * 32 + 8 * fq;
        const float kexp = -1.4426950408889634f * sin, cden = 1.0f / (sin * sin * sout);
#pragma unroll
        for (int ai = 0; ai < 2; ++ai)
#pragma unroll
            for (int m = 0; m < 4; ++m) { unsigned char* rowp = O + (size_t)(row0 + ai * HALF + m * 16) * ldc + (col0 >> 1);
                const f32x4 ag0 = acc[ai][0][m][0], ag1 = acc[ai][0][m][1], au0 = acc[ai][1][m][0], au1 = acc[ai][1][m][1];
                const f32x4 y0 = ag0 * kexp, y1 = ag1 * kexp; f32x4 e0, e1;
#pragma unroll
                for (int i = 0; i < 4; ++i) { e0[i] = __builtin_amdgcn_exp2f(y0[i]); e1[i] = __builtin_amdgcn_exp2f(y1[i]); }
                const f32x4 d0 = e0 * cden + cden, d1 = e1 * cden + cden; f32x4 r0, r1;
#pragma unroll
                for (int i = 0; i < 4; ++i) { r0[i] = __builtin_amdgcn_rcpf(d0[i]); r1[i] = __builtin_amdgcn_rcpf(d1[i]); }
                const f32x4 o0 = (ag0 * au0) * r0, o1 = (ag1 * au1) * r1;
                unsigned w; PG8_FP4_PACK8(w, o0[0], o0[1], o0[2], o0[3], o1[0], o1[1], o1[2], o1[3]);
                *(unsigned*)rowp = w; asm volatile("" ::: "memory"); }
    }
};

template <class Epi, class Sched, bool ALIGN_EPI = false, bool SP2 = false, bool SWAP = false>
__device__ __forceinline__ void gemm_phase(PG8_LAS unsigned char* lds, const Gemm g, const Sched& S, const Epi& E) {
    int tid_ = threadIdx.x; asm volatile("" : "+v"(tid_));
    const int tid = tid_, wid = __builtin_amdgcn_readfirstlane(tid >> 6), lane = tid & 63, wr = wid >> 2, wc = wid & 3, fr = lane & 15, fq = lane >> 4;
    const int K = g.K, nt = K / BK;
    unsigned voffA[2], voffB[2];
#pragma unroll
    for (int i = 0; i < 2; ++i) { int R, C; stage_rc(tid * 16 + i * 8192, R, C); const int Rb = Epi::PERM ? ((R & ~31) + perm32(R & 31)) : R;
        voffA[i] = (unsigned)(R * K + C) * 2u; voffB[i] = (unsigned)(Rb * K + C) * 2u; }
    const size_t kstep = (size_t)(BK * 2);
    const size_t hstep = (size_t)HALF * K * 2;
    const size_t tstep = 2 * hstep;
    const unsigned ldsw = (unsigned)wid * 1024u;
    const int aoff = lds_byte(wr * 64 + fr, fq * 8), boff = lds_byte(wc * 32 + fr, fq * 8);
#define PG8_SA(b, h) (((b) * 2 + (h)) * HTB)
#define PG8_SB(b, h) ((4 + (b) * 2 + (h)) * HTB)
#define PG8_STAGE(bufoff, gbase, voff) do { _Pragma("unroll") for (int _i = 0; _i < 2; ++_i) \
        __builtin_amdgcn_global_load_lds((const unsigned*)((const char*)(gbase) + (voff)[_i]), (PG8_LAS unsigned*)(lds + (bufoff) + ldsw + _i * 8192), 16, 0, 0); } while (0)
#define PG8_LDA(dst, b, h) do { _Pragma("unroll") for (int m = 0; m < 4; ++m) _Pragma("unroll") for (int k = 0; k < 2; ++k) dst[m][k] = *(const PG8_LAS bf16x8*)(lds + PG8_SA(b, h) + aoff + m * 2048 + k * 1024); } while (0)
#define PG8_LDB(dst, b, h) do { _Pragma("unroll") for (int n = 0; n < 2; ++n) _Pragma("unroll") for (int k = 0; k < 2; ++k) dst[n][k] = *(const PG8_LAS bf16x8*)(lds + PG8_SB(b, h) + boff + n * 2048 + k * 1024); } while (0)
#define PG8_MMA(ai, bj, At, Bt) do { __builtin_amdgcn_s_setprio(1); _Pragma("unroll") for (int m = 0; m < 4; ++m) _Pragma("unroll") for (int n = 0; n < 2; ++n) _Pragma("unroll") for (int k = 0; k < 2; ++k) \
        acc[ai][bj][m][n] = SWAP ? __builtin_amdgcn_mfma_f32_16x16x32_bf16(At[m][k], Bt[n][k], acc[ai][bj][m][n], 0, 0, 0) : __builtin_amdgcn_mfma_f32_16x16x32_bf16(Bt[n][k], At[m][k], acc[ai][bj][m][n], 0, 0, 0); __builtin_amdgcn_s_setprio(0); } while (0)
#define PG8_WAIT_V(n) asm volatile("s_waitcnt vmcnt(" #n ")" ::: "memory")
#define PG8_WAIT_L(n) asm volatile("s_waitcnt lgkmcnt(" #n ")" ::: "memory")
#define PG8_BAR __builtin_amdgcn_s_barrier()
#define PG8_SCHED __builtin_amdgcn_sched_barrier(0)
    Unit cur, nxt; int ui = 0;
    if (!S.next(0, cur)) return;
    f32x4 acc[2][2][4][2];
#pragma unroll
    for (int a = 0; a < 2; ++a)
#pragma unroll
        for (int b = 0; b < 2; ++b)
#pragma unroll
            for (int m = 0; m < 4; ++m)
#pragma unroll
                for (int n = 0; n < 2; ++n) acc[a][b][m][n] = (f32x4){0.f, 0.f, 0.f, 0.f};
    bf16x8 At[4][2], B0[2][2], B1[2][2];
    const char* cA = (const char*)g.A + (size_t)cur.pm * tstep; const char* cB = (const char*)g.Bt + (size_t)((cur.pm / g.tpg) % g.ng) * g.gstride + (size_t)cur.pn * tstep;
    S.a_ready(cur);
    if constexpr (SP2) {
        PG8_STAGE(PG8_SB(0, 0), cB, voffB); PG8_STAGE(PG8_SB(0, 1), cB + hstep, voffB); PG8_STAGE(PG8_SA(0, 0), cA, voffA); PG8_STAGE(PG8_SA(0, 1), cA + hstep, voffA);
        if (wr == 1) PG8_BAR;
        PG8_WAIT_V(2); PG8_BAR;
        PG8_STAGE(PG8_SB(1, 0), cB + kstep, voffB); PG8_STAGE(PG8_SA(1, 0), cA + kstep, voffA); PG8_STAGE(PG8_SB(1, 1), cB + hstep + kstep, voffB);
        PG8_WAIT_V(6); PG8_BAR;
    } else {
        PG8_STAGE(PG8_SB(0, 0), cB, voffB); PG8_STAGE(PG8_SA(0, 0), cA, voffA); PG8_STAGE(PG8_SB(0, 1), cB + hstep, voffB); PG8_STAGE(PG8_SA(0, 1), cA + hstep, voffA);
        if (wr == 1) PG8_BAR;
        PG8_WAIT_V(4); PG8_BAR;
        PG8_STAGE(PG8_SB(1, 0), cB + kstep, voffB); PG8_STAGE(PG8_SA(1, 0), cA + kstep, voffA); PG8_STAGE(PG8_SB(1, 1), cB + hstep + kstep, voffB);
        PG8_WAIT_V(6); PG8_BAR;
    }
    for (;;) {
        const bool has_next = S.next(ui + 1, nxt);
        const char* nA = has_next ? (const char*)g.A + (size_t)nxt.pm * tstep : cA; const char* nB = has_next ? (const char*)g.Bt + (size_t)((nxt.pm / g.tpg) % g.ng) * g.gstride + (size_t)nxt.pn * tstep : cB;
        for (int t = 0; t < nt; t += 2) {
            if constexpr (Epi::MID_T > 0) { if (t == Epi::MID_T) E.mid(acc, cur, wr, wc, fr, fq); }
            const bool last = (t == nt - 2);
            const char* a1 = cA + (size_t)(t + 1) * kstep;
            const char* a2 = last ? nA : cA + (size_t)(t + 2) * kstep; const char* b2 = last ? nB : cB + (size_t)(t + 2) * kstep;
            const char* a3 = a2 + kstep; const char* b3 = b2 + kstep;
            if (last && has_next) S.a_ready(nxt);
            if constexpr (SP2) {
            PG8_LDB(B0, 0, 0); PG8_LDB(B1, 0, 1); PG8_SCHED; PG8_LDA(At, 0, 0); PG8_STAGE(PG8_SA(1, 1), a1 + hstep, voffA);
            PG8_WAIT_V(8); PG8_WAIT_L(0); PG8_BAR; PG8_MMA(0, 0, At, B0); PG8_MMA(0, 1, At, B1); PG8_BAR; PG8_SCHED;
            PG8_LDA(At, 0, 1); PG8_STAGE(PG8_SB(0, 0), b2, voffB); PG8_STAGE(PG8_SB(0, 1), b2 + hstep, voffB); PG8_STAGE(PG8_SA(0, 0), a2, voffA);
            PG8_WAIT_V(8); PG8_WAIT_L(0); PG8_BAR; PG8_MMA(1, 0, At, B0); PG8_MMA(1, 1, At, B1); PG8_BAR; PG8_SCHED;
            PG8_LDB(B0, 1, 0); PG8_LDB(B1, 1, 1); PG8_SCHED; PG8_LDA(At, 1, 0); PG8_STAGE(PG8_SA(0, 1), a2 + hstep, voffA);
            PG8_WAIT_V(8); PG8_WAIT_L(0); PG8_BAR; PG8_MMA(0, 0, At, B0); PG8_MMA(0, 1, At, B1); PG8_BAR; PG8_SCHED;
            PG8_LDA(At, 1, 1); PG8_STAGE(PG8_SB(1, 0), b3, voffB); PG8_STAGE(PG8_SB(1, 1), b3 + hstep, voffB); PG8_STAGE(PG8_SA(1, 0), a3, voffA);
            PG8_WAIT_V(8); PG8_WAIT_L(0); PG8_BAR; PG8_MMA(1, 0, At, B0); PG8_MMA(1, 1, At, B1); PG8_BAR; PG8_SCHED;
            } else {
            PG8_LDB(B0, 0, 0); PG8_SCHED; PG8_LDA(At, 0, 0); PG8_STAGE(PG8_SA(1, 1), a1 + hstep, voffA);
            PG8_WAIT_L(8); PG8_BAR; PG8_WAIT_L(0); PG8_MMA(0, 0, At, B0); PG8_BAR; PG8_SCHED;
            PG8_LDB(B1, 0, 1); PG8_STAGE(PG8_SB(0, 0), b2, voffB);
            PG8_BAR; PG8_WAIT_L(0); PG8_MMA(0, 1, At, B1); PG8_BAR;
            PG8_LDA(At, 0, 1); PG8_STAGE(PG8_SA(0, 0), a2, voffA);
            PG8_BAR; PG8_WAIT_L(0); PG8_MMA(1, 0, At, B0); PG8_BAR; PG8_SCHED;
            PG8_STAGE(PG8_SB(0, 1), b2 + hstep, voffB);
            PG8_WAIT_V(6); PG8_BAR; PG8_MMA(1, 1, At, B1); PG8_BAR;
            PG8_LDB(B0, 1, 0); PG8_SCHED; PG8_LDA(At, 1, 0); PG8_STAGE(PG8_SA(0, 1), a2 + hstep, voffA);
            PG8_WAIT_L(8); PG8_BAR; PG8_WAIT_L(0); PG8_MMA(0, 0, At, B0); PG8_BAR; PG8_SCHED;
            PG8_LDB(B1, 1, 1); PG8_STAGE(PG8_SB(1, 0), b3, voffB);
            PG8_BAR; PG8_WAIT_L(0); PG8_MMA(0, 1, At, B1); PG8_BAR;
            PG8_LDA(At, 1, 1); PG8_STAGE(PG8_SA(1, 0), a3, voffA);
            PG8_BAR; PG8_WAIT_L(0); PG8_MMA(1, 0, At, B0); PG8_BAR; PG8_SCHED;
            PG8_STAGE(PG8_SB(1, 1), b3 + hstep, voffB);
            PG8_WAIT_V(6); PG8_BAR; PG8_MMA(1, 1, At, B1); PG8_BAR;
            }
        }
        if constexpr (ALIGN_EPI) { if (wr == 0) PG8_BAR; }
        if constexpr (!Epi::AFTER_DRAIN) { E(acc, cur, wr, wc, fr, fq); S.done(cur); }
        if (!has_next) break;
#pragma unroll
        for (int a = 0; a < 2; ++a)
#pragma unroll
            for (int b = 0; b < 2; ++b)
#pragma unroll
                for (int m = 0; m < 4; ++m)
#pragma unroll
                    for (int n = 0; n < 2; ++n) acc[a][b][m][n] = (f32x4){0.f, 0.f, 0.f, 0.f};
        cur = nxt; cA = nA; cB = nB; ++ui;
        if constexpr (ALIGN_EPI) { if (wr == 1) PG8_BAR; }
    }
    PG8_WAIT_V(0);
    if constexpr (!ALIGN_EPI) { if (wr == 0) PG8_BAR; }
    PG8_BAR;
    if constexpr (Epi::AFTER_DRAIN) { E.fused(acc, cur, wr, wc, fr, fq, lds, wid, lane); S.done(cur); }
#undef PG8_SA
#undef PG8_SB
#undef PG8_STAGE
#undef PG8_LDA
#undef PG8_LDB
#undef PG8_MMA
#undef PG8_WAIT_V
#undef PG8_WAIT_L
#undef PG8_BAR
#undef PG8_SCHED
}
typedef int v8i_t __attribute__((ext_vector_type(8)));
__host__ __device__ __forceinline__ int lds_byte8(int r, int c16) { return (r >> 4) * 2048 + c16 * 256 + (r & 15) * 16; }
__host__ __device__ __forceinline__ void stage_rc8(int b, int& R, int& C) { R = (b / 2048) * 16 + (b % 256) / 16; C = ((b % 2048) / 256) * 8; }
__device__ __forceinline__ v8i_t ld_frag8(const PG8_LAS unsigned char* p) { const u32x4 a = *(const PG8_LAS u32x4*)p, b = *(const PG8_LAS u32x4*)(p + 256);
    v8i_t r; r[0] = (int)a.x; r[1] = (int)a.y; r[2] = (int)a.z; r[3] = (int)a.w; r[4] = (int)b.x; r[5] = (int)b.y; r[6] = (int)b.z; r[7] = (int)b.w; return r; }
template <class Epi, class Sched, bool ALIGN_EPI = false, bool SP2 = false>
__device__ __forceinline__ void gemm_phase8(PG8_LAS unsigned char* lds, const Gemm g, const Sched& S, const Epi& E) {
    int tid_ = threadIdx.x; asm volatile("" : "+v"(tid_));
    const int tid = tid_, wid = __builtin_amdgcn_readfirstlane(tid >> 6), lane = tid & 63, wr = wid >> 2, wc = wid & 3, fr = lane & 15, fq = lane >> 4;
    const int K = g.K, nt = K / BK;
    unsigned voffA[2], voffB[2];
#pragma unroll
    for (int i = 0; i < 2; ++i) { int R, C; stage_rc8(tid * 16 + i * 8192, R, C); const int Rb = Epi::PERM ? ((R & ~31) + perm32(R & 31)) : R;
        voffA[i] = (unsigned)(R * K + C) * 2u; voffB[i] = (unsigned)(Rb * K + C) * 2u; }
    const size_t kstep = (size_t)(BK * 2);
    const size_t hstep = (size_t)HALF * K * 2;
    const size_t tstep = 2 * hstep;
    const unsigned ldsw = (unsigned)wid * 1024u;
    const int aoff = lds_byte8(wr * 64 + fr, 2 * fq), boff = lds_byte8(wc * 32 + fr, 2 * fq);
#define PG8_SA(b, h) (((b) * 2 + (h)) * HTB)
#define PG8_SB(b, h) ((4 + (b) * 2 + (h)) * HTB)
#define PG8_STAGE(bufoff, gbase, voff) do { _Pragma("unroll") for (int _i = 0; _i < 2; ++_i) \
        __builtin_amdgcn_global_load_lds((const unsigned*)((const char*)(gbase) + (voff)[_i]), (PG8_LAS unsigned*)(lds + (bufoff) + ldsw + _i * 8192), 16, 0, 0); } while (0)
#define PG8_LDA(dst, b, h) do { _Pragma("unroll") for (int m = 0; m < 4; ++m) dst[m] = ld_frag8(lds + PG8_SA(b, h) + aoff + m * 2048); } while (0)
#define PG8_LDB(dst, b, h) do { _Pragma("unroll") for (int n = 0; n < 2; ++n) dst[n] = ld_frag8(lds + PG8_SB(b, h) + boff + n * 2048); } while (0)
#define PG8_MMA(ai, bj, At, Bt) do { __builtin_amdgcn_s_setprio(1); _Pragma("unroll") for (int m = 0; m < 4; ++m) _Pragma("unroll") for (int n = 0; n < 2; ++n) \
        asm volatile("v_mfma_scale_f32_16x16x128_f8f6f4 %0, %1, %2, %0, %3, %3 op_sel_hi:[0,0,0]" : "+v"(acc[ai][bj][m][n]) : "v"(Bt[n]), "v"(At[m]), "v"(one_scale)); __builtin_amdgcn_s_setprio(0); } while (0)
#define PG8_WAIT_V(n) asm volatile("s_waitcnt vmcnt(" #n ")" ::: "memory")
#define PG8_WAIT_L(n) asm volatile("s_waitcnt lgkmcnt(" #n ")" ::: "memory")
#define PG8_BAR __builtin_amdgcn_s_barrier()
#define PG8_SCHED __builtin_amdgcn_sched_barrier(0)
    Unit cur, nxt; int ui = 0;
    if (!S.next(0, cur)) return;
    f32x4 acc[2][2][4][2];
#pragma unroll
    for (int a = 0; a < 2; ++a)
#pragma unroll
        for (int b = 0; b < 2; ++b)
#pragma unroll
            for (int m = 0; m < 4; ++m)
#pragma unroll
                for (int n = 0; n < 2; ++n) acc[a][b][m][n] = (f32x4){0.f, 0.f, 0.f, 0.f};
    v8i_t At[4], B0[2], B1[2]; int one_scale = 0x7F7F7F7F; asm volatile("" : "+v"(one_scale));

    const char* cA = (const char*)g.A + (size_t)cur.pm * tstep; const char* cB = (const char*)g.Bt + (size_t)((cur.pm / g.tpg) % g.ng) * g.gstride + (size_t)cur.pn * tstep;
    S.a_ready(cur);
    if constexpr (SP2) {
        PG8_STAGE(PG8_SB(0, 0), cB, voffB); PG8_STAGE(PG8_SB(0, 1), cB + hstep, voffB); PG8_STAGE(PG8_SA(0, 0), cA, voffA); PG8_STAGE(PG8_SA(0, 1), cA + hstep, voffA);
        if (wr == 1) PG8_BAR;
        PG8_WAIT_V(2); PG8_BAR;
        PG8_STAGE(PG8_SB(1, 0), cB + kstep, voffB); PG8_STAGE(PG8_SA(1, 0), cA + kstep, voffA); PG8_STAGE(PG8_SB(1, 1), cB + hstep + kstep, voffB);
        PG8_WAIT_V(6); PG8_BAR;
    } else {
        PG8_STAGE(PG8_SB(0, 0), cB, voffB); PG8_STAGE(PG8_SA(0, 0), cA, voffA); PG8_STAGE(PG8_SB(0, 1), cB + hstep, voffB); PG8_STAGE(PG8_SA(0, 1), cA + hstep, voffA);
        if (wr == 1) PG8_BAR;
        PG8_WAIT_V(4); PG8_BAR;
        PG8_STAGE(PG8_SB(1, 0), cB + kstep, voffB); PG8_STAGE(PG8_SA(1, 0), cA + kstep, voffA); PG8_STAGE(PG8_SB(1, 1), cB + hstep + kstep, voffB);
        PG8_WAIT_V(6); PG8_BAR;
    }
    for (;;) {
        const bool has_next = S.next(ui + 1, nxt);
        const char* nA = has_next ? (const char*)g.A + (size_t)nxt.pm * tstep : cA; const char* nB = has_next ? (const char*)g.Bt + (size_t)((nxt.pm / g.tpg) % g.ng) * g.gstride + (size_t)nxt.pn * tstep : cB;
#pragma unroll 1
        for (int t = 0; t < nt; t += 2) {
            if constexpr (Epi::MID_T > 0) { if (t == Epi::MID_T) E.mid(acc, cur, wr, wc, fr, fq); }
            const bool last = (t == nt - 2);
            const char* a1 = cA + (size_t)(t + 1) * kstep;
            const char* a2 = last ? nA : cA + (size_t)(t + 2) * kstep; const char* b2 = last ? nB : cB + (size_t)(t + 2) * kstep;
            const char* a3 = a2 + kstep; const char* b3 = b2 + kstep;
            if (last && has_next) S.a_ready(nxt);
            if constexpr (SP2) {
            PG8_LDB(B0, 0, 0); PG8_LDB(B1, 0, 1); PG8_SCHED; PG8_LDA(At, 0, 0); PG8_STAGE(PG8_SA(1, 1), a1 + hstep, voffA);
            PG8_WAIT_V(8); PG8_WAIT_L(0); PG8_BAR; PG8_MMA(0, 0, At, B0); PG8_MMA(0, 1, At, B1); PG8_BAR; PG8_SCHED;
            PG8_LDA(At, 0, 1); PG8_STAGE(PG8_SB(0, 0), b2, voffB); PG8_STAGE(PG8_SB(0, 1), b2 + hstep, voffB); PG8_STAGE(PG8_SA(0, 0), a2, voffA);
            PG8_WAIT_V(8); PG8_WAIT_L(0); PG8_BAR; PG8_MMA(1, 0, At, B0); PG8_MMA(1, 1, At, B1); PG8_BAR; PG8_SCHED;
            PG8_LDB(B0, 1, 0); PG8_LDB(B1, 1, 1); PG8_SCHED; PG8_LDA(At, 1, 0); PG8_STAGE(PG8_SA(0, 1), a2 + hstep, voffA);
            PG8_WAIT_V(8); PG8_WAIT_L(0); PG8_BAR; PG8_MMA(0, 0, At, B0); PG8_MMA(0, 1, At, B1); PG8_BAR; PG8_SCHED;
            PG8_LDA(At, 1, 1); PG8_STAGE(PG8_SB(1, 0), b3, voffB); PG8_STAGE(PG8_SB(1, 1), b3 + hstep, voffB); PG8_STAGE(PG8_SA(1, 0), a3, voffA);
            PG8_WAIT_V(8); PG8_WAIT_L(0); PG8_BAR; PG8_MMA(1, 0, At, B0); PG8_MMA(1, 1, At, B1); PG8_BAR; PG8_SCHED;
            } else {
            PG8_LDB(B0, 0, 0); PG8_SCHED; PG8_LDA(At, 0, 0); PG8_STAGE(PG8_SA(1, 1), a1 + hstep, voffA);
            PG8_WAIT_L(8); PG8_BAR; PG8_WAIT_L(0); PG8_MMA(0, 0, At, B0); PG8_BAR; PG8_SCHED;
            PG8_LDB(B1, 0, 1); PG8_STAGE(PG8_SB(0, 0), b2, voffB);
            PG8_BAR; PG8_WAIT_L(0); PG8_MMA(0, 1, At, B1); PG8_BAR;
            PG8_LDA(At, 0, 1); PG8_STAGE(PG8_SA(0, 0), a2, voffA);
            PG8_BAR; PG8_WAIT_L(0); PG8_MMA(1, 0, At, B0); PG8_BAR; PG8_SCHED;
            PG8_STAGE(PG8_SB(0, 1), b2 + hstep, voffB);
            PG8_WAIT_V(6); PG8_BAR; PG8_MMA(1, 1, At, B1); PG8_BAR;
            PG8_LDB(B0, 1, 0); PG8_SCHED; PG8_LDA(At, 1, 0); PG8_STAGE(PG8_SA(0, 1), a2 + hstep, voffA);
            PG8_WAIT_L(8); PG8_BAR; PG8_WAIT_L(0); PG8_MMA(0, 0, At, B0); PG8_BAR; PG8_SCHED;
            PG8_LDB(B1, 1, 1); PG8_STAGE(PG8_SB(1, 0), b3, voffB);
            PG8_BAR; PG8_WAIT_L(0); PG8_MMA(0, 1, At, B1); PG8_BAR;
            PG8_LDA(At, 1, 1); PG8_STAGE(PG8_SA(1, 0), a3, voffA);
            PG8_BAR; PG8_WAIT_L(0); PG8_MMA(1, 0, At, B0); PG8_BAR; PG8_SCHED;
            PG8_STAGE(PG8_SB(1, 1), b3 + hstep, voffB);
            PG8_WAIT_V(6); PG8_BAR; PG8_MMA(1, 1, At, B1); PG8_BAR;
            }
        }
        if constexpr (ALIGN_EPI) { if (wr == 0) PG8_BAR; }
        asm volatile("s_nop 15\n\ts_nop 15" ::: "memory");
        if constexpr (!Epi::AFTER_DRAIN) { E(acc, cur, wr, wc, fr, fq); S.done(cur); }
        if (!has_next) break;
#pragma unroll
        for (int a = 0; a < 2; ++a)
#pragma unroll
            for (int b = 0; b < 2; ++b)
#pragma unroll
                for (int m = 0; m < 4; ++m)
#pragma unroll
                    for (int n = 0; n < 2; ++n) acc[a][b][m][n] = (f32x4){0.f, 0.f, 0.f, 0.f};
        cur = nxt; cA = nA; cB = nB; ++ui;
        if constexpr (ALIGN_EPI) { if (wr == 1) PG8_BAR; }
    }
    PG8_WAIT_V(0);
    if constexpr (!ALIGN_EPI) { if (wr == 0) PG8_BAR; }
    PG8_BAR;
    if constexpr (Epi::AFTER_DRAIN) { E.fused(acc, cur, wr, wc, fr, fq, lds, wid, lane); S.done(cur); }
#undef PG8_SA
#undef PG8_SB
#undef PG8_STAGE
#undef PG8_LDA
#undef PG8_LDB
#undef PG8_MMA
#undef PG8_WAIT_V
#undef PG8_WAIT_L
#undef PG8_BAR
#undef PG8_SCHED
}
#ifndef PG8_PRIO_MMA
#define PG8_PRIO_MMA 1
#endif
typedef int v4i_t __attribute__((ext_vector_type(4)));
__host__ __device__ __forceinline__ int lds_byte4(int r, int c16) { return r * 128 + ((c16 ^ ((r >> 1) & 7)) << 4); }
__host__ __device__ __forceinline__ void stage_rc4(int b, int& R, int& C) { R = b / 128; C = ((((b % 128) / 16) ^ ((R >> 1) & 7))) * 8; }
template <class Epi, class Sched, bool ALIGN_EPI = false, bool SP2 = false, int VAR = 0  >
__device__ __forceinline__ void gemm_phase4(PG8_LAS unsigned char* lds, const Gemm g, const Sched& S, const Epi& E) {
    int tid_ = threadIdx.x; asm volatile("" : "+v"(tid_));
    const int tid = tid_, wid = __builtin_amdgcn_readfirstlane(tid >> 6), lane = tid & 63, wr = wid >> 2, wc = wid & 3, fr = lane & 15, fq = lane >> 4;
    const int K = g.K, nt = K / BK;
    unsigned voffA[2], voffB[2];
#pragma unroll
    for (int i = 0; i < 2; ++i) { int R, C; stage_rc4(tid * 16 + i * 8192, R, C); const int Rb = Epi::PERM ? ((R & ~31) + perm32(R & 31)) : R;
        voffA[i] = (unsigned)(R * K + C) * 2u; voffB[i] = (unsigned)(Rb * K + C) * 2u; }
    const size_t kstep = (size_t)(BK * 2);
    const size_t hstep = (size_t)HALF * K * 2;
    const size_t tstep = 2 * hstep;
    const unsigned ldsw = (unsigned)wid * 1024u;
    const int aoff[2] = {lds_byte4(wr * 64 + fr, fq), lds_byte4(wr * 64 + fr, 4 + fq)}, boff[2] = {lds_byte4(wc * 32 + fr, fq), lds_byte4(wc * 32 + fr, 4 + fq)};
#define PG8_SA(b, h) (((b) * 2 + (h)) * HTB)
#define PG8_SB(b, h) ((4 + (b) * 2 + (h)) * HTB)
#define PG8_STAGE(bufoff, gbase, voff) do { if constexpr ((VAR & 4) == 0) _Pragma("unroll") for (int _i = 0; _i < 2; ++_i) \
        __builtin_amdgcn_global_load_lds((const unsigned*)((const char*)(gbase) + (voff)[_i]), (PG8_LAS unsigned*)(lds + (bufoff) + ldsw + _i * 8192), 16, 0, 0); } while (0)
#define PG8_LDA(dst, b, h) do { if constexpr ((VAR & 2) == 0) _Pragma("unroll") for (int m = 0; m < 4; ++m) _Pragma("unroll") for (int k = 0; k < 2; ++k) dst[m][k] = *(const PG8_LAS v4i_t*)(lds + PG8_SA(b, h) + aoff[k] + m * 2048); } while (0)
#define PG8_LDB(dst, b, h) do { if constexpr ((VAR & 2) == 0) _Pragma("unroll") for (int n = 0; n < 2; ++n) _Pragma("unroll") for (int k = 0; k < 2; ++k) dst[n][k] = *(const PG8_LAS v4i_t*)(lds + PG8_SB(b, h) + boff[k] + n * 2048); } while (0)
#define PG8_MMA(ai, bj, At, Bt) do { __builtin_amdgcn_s_setprio(PG8_PRIO_MMA); if constexpr ((VAR & 1) == 0) _Pragma("unroll") for (int k = 0; k < 2; ++k) _Pragma("unroll") for (int m = 0; m < 4; ++m) _Pragma("unroll") for (int n = 0; n < 2; ++n)   \
        asm volatile("v_mfma_scale_f32_16x16x128_f8f6f4 %0, %1, %2, %0, %3, %3 op_sel_hi:[0,0,0] cbsz:4 blgp:4" : "+v"(acc[ai][bj][m][n]) : "v"(Bt[n][k]), "v"(At[m][k]), "v"(one_scale)); __builtin_amdgcn_s_setprio(1 - PG8_PRIO_MMA); } while (0)
#define PG8_WAIT_V(n) asm volatile("s_waitcnt vmcnt(" #n ")" ::: "memory")
#define PG8_WAIT_L(n) asm volatile("s_waitcnt lgkmcnt(" #n ")" ::: "memory")
#define PG8_BAR __builtin_amdgcn_s_barrier()
#define PG8_SCHED __builtin_amdgcn_sched_barrier(0)
    Unit cur, nxt; int ui = 0;
    if (!S.next(0, cur)) return;
    f32x4 acc[2][2][4][2];
#pragma unroll
    for (int a = 0; a < 2; ++a)
#pragma unroll
        for (int b = 0; b < 2; ++b)
#pragma unroll
            for (int m = 0; m < 4; ++m)
#pragma unroll
                for (int n = 0; n < 2; ++n) acc[a][b][m][n] = (f32x4){0.f, 0.f, 0.f, 0.f};
    v4i_t At[4][2] = {}, B0[2][2] = {}, B1[2][2] = {}; if constexpr (VAR != 0) { _Pragma("unroll") for (int m = 0; m < 4; ++m) _Pragma("unroll") for (int k = 0; k < 2; ++k) asm volatile("" : "+v"(At[m][k])); _Pragma("unroll") for (int n = 0; n < 2; ++n) _Pragma("unroll") for (int k = 0; k < 2; ++k) asm volatile("" : "+v"(B0[n][k]), "+v"(B1[n][k])); }
    int one_scale = 0x7F7F7F7F; asm volatile("" : "+v"(one_scale));

    const char* cA = (const char*)g.A + (size_t)cur.pm * tstep; const char* cB = (const char*)g.Bt + (size_t)((cur.pm / g.tpg) % g.ng) * g.gstride + (size_t)cur.pn * tstep;
    S.a_ready(cur);
    if constexpr (SP2) {
        PG8_STAGE(PG8_SB(0, 0), cB, voffB); PG8_STAGE(PG8_SB(0, 1), cB + hstep, voffB); PG8_STAGE(PG8_SA(0, 0), cA, voffA); PG8_STAGE(PG8_SA(0, 1), cA + hstep, voffA);
        if (wr == 1) PG8_BAR;
        PG8_WAIT_V(2); PG8_BAR;
        PG8_STAGE(PG8_SB(1, 0), cB + kstep, voffB); PG8_STAGE(PG8_SA(1, 0), cA + kstep, voffA); PG8_STAGE(PG8_SB(1, 1), cB + hstep + kstep, voffB);
        PG8_WAIT_V(6); PG8_BAR;
    } else {
        PG8_STAGE(PG8_SB(0, 0), cB, voffB); PG8_STAGE(PG8_SA(0, 0), cA, voffA); PG8_STAGE(PG8_SB(0, 1), cB + hstep, voffB); PG8_STAGE(PG8_SA(0, 1), cA + hstep, voffA);
        if (wr == 1) PG8_BAR;
        PG8_WAIT_V(4); PG8_BAR;
        PG8_STAGE(PG8_SB(1, 0), cB + kstep, voffB); PG8_STAGE(PG8_SA(1, 0), cA + kstep, voffA); PG8_STAGE(PG8_SB(1, 1), cB + hstep + kstep, voffB);
        PG8_WAIT_V(6); PG8_BAR;
    }
    for (;;) {
        const bool has_next = S.next(ui + 1, nxt);
        const char* nA = has_next ? (const char*)g.A + (size_t)nxt.pm * tstep : cA; const char* nB = has_next ? (const char*)g.Bt + (size_t)((nxt.pm / g.tpg) % g.ng) * g.gstride + (size_t)nxt.pn * tstep : cB;
#pragma unroll 1
        for (int t = 0; t < nt; t += 2) {
            if constexpr (Epi::MID_T > 0) { if (t == Epi::MID_T) E.mid(acc, cur, wr, wc, fr, fq); }
            const bool last = (t == nt - 2);
            const char* a1 = cA + (size_t)(t + 1) * kstep;
            const char* a2 = last ? nA : cA + (size_t)(t + 2) * kstep; const char* b2 = last ? nB : cB + (size_t)(t + 2) * kstep;
            const char* a3 = a2 + kstep; const char* b3 = b2 + kstep;
            if (last && has_next) S.a_ready(nxt);
            if constexpr (SP2) {
            PG8_LDB(B0, 0, 0); PG8_LDB(B1, 0, 1); PG8_SCHED; PG8_LDA(At, 0, 0); PG8_STAGE(PG8_SA(1, 1), a1 + hstep, voffA);
            PG8_WAIT_V(8); PG8_WAIT_L(0); PG8_BAR; PG8_MMA(0, 0, At, B0); PG8_MMA(0, 1, At, B1); PG8_BAR; PG8_SCHED;
            PG8_LDA(At, 0, 1); PG8_STAGE(PG8_SB(0, 0), b2, voffB); PG8_STAGE(PG8_SB(0, 1), b2 + hstep, voffB); PG8_STAGE(PG8_SA(0, 0), a2, voffA);
            PG8_WAIT_V(8); PG8_WAIT_L(0); PG8_BAR; PG8_MMA(1, 0, At, B0); PG8_MMA(1, 1, At, B1); PG8_BAR; PG8_SCHED;
            PG8_LDB(B0, 1, 0); PG8_LDB(B1, 1, 1); PG8_SCHED; PG8_LDA(At, 1, 0); PG8_STAGE(PG8_SA(0, 1), a2 + hstep, voffA);
            PG8_WAIT_V(8); PG8_WAIT_L(0); PG8_BAR; PG8_MMA(0, 0, At, B0); PG8_MMA(0, 1, At, B1); PG8_BAR; PG8_SCHED;
            PG8_LDA(At, 1, 1); PG8_STAGE(PG8_SB(1, 0), b3, voffB); PG8_STAGE(PG8_SB(1, 1), b3 + hstep, voffB); PG8_STAGE(PG8_SA(1, 0), a3, voffA);
            PG8_WAIT_V(8); PG8_WAIT_L(0); PG8_BAR; PG8_MMA(1, 0, At, B0); PG8_MMA(1, 1, At, B1); PG8_BAR; PG8_SCHED;
            } else {
            PG8_LDB(B0, 0, 0); PG8_SCHED; PG8_LDA(At, 0, 0); PG8_STAGE(PG8_SA(1, 1), a1 + hstep, voffA);
            PG8_WAIT_L(8); PG8_BAR; PG8_WAIT_L(0); PG8_MMA(0, 0, At, B0); PG8_BAR; PG8_SCHED;
            PG8_LDB(B1, 0, 1); PG8_STAGE(PG8_SB(0, 0), b2, voffB);
            PG8_BAR; PG8_WAIT_L(0); PG8_MMA(0, 1, At, B1); PG8_BAR;
            PG8_LDA(At, 0, 1); PG8_STAGE(PG8_SA(0, 0), a2, voffA);
            PG8_BAR; PG8_WAIT_L(0); PG8_MMA(1, 0, At, B0); PG8_BAR; PG8_SCHED;
            PG8_STAGE(PG8_SB(0, 1), b2 + hstep, voffB);
            PG8_WAIT_V(6); PG8_BAR; PG8_MMA(1, 1, At, B1); PG8_BAR;
            PG8_LDB(B0, 1, 0); PG8_SCHED; PG8_LDA(At, 1, 0); PG8_STAGE(PG8_SA(0, 1), a2 + hstep, voffA);
            PG8_WAIT_L(8); PG8_BAR; PG8_WAIT_L(0); PG8_MMA(0, 0, At, B0); PG8_BAR; PG8_SCHED;
            PG8_LDB(B1, 1, 1); PG8_STAGE(PG8_SB(1, 0), b3, voffB);
            PG8_BAR; PG8_WAIT_L(0); PG8_MMA(0, 1, At, B1); PG8_BAR;
            PG8_LDA(At, 1, 1); PG8_STAGE(PG8_SA(1, 0), a3, voffA);
            PG8_BAR; PG8_WAIT_L(0); PG8_MMA(1, 0, At, B0); PG8_BAR; PG8_SCHED;
            PG8_STAGE(PG8_SB(1, 1), b3 + hstep, voffB);
            PG8_WAIT_V(6); PG8_BAR; PG8_MMA(1, 1, At, B1); PG8_BAR;
            }
        }
        if constexpr (ALIGN_EPI) { if (wr == 0) PG8_BAR; }
        asm volatile("s_nop 15\n\ts_nop 15" ::: "memory");
        if constexpr (!Epi::AFTER_DRAIN && (VAR & 8) == 0) { E(acc, cur, wr, wc, fr, fq); S.done(cur); }
        if (!has_next) break;
#pragma unroll
        for (int a = 0; a < 2; ++a)
#pragma unroll
            for (int b = 0; b < 2; ++b)
#pragma unroll
                for (int m = 0; m < 4; ++m)
#pragma unroll
                    for (int n = 0; n < 2; ++n) acc[a][b][m][n] = (f32x4){0.f, 0.f, 0.f, 0.f};
        cur = nxt; cA = nA; cB = nB; ++ui;
        if constexpr (ALIGN_EPI) { if (wr == 1) PG8_BAR; }
    }
    PG8_WAIT_V(0);
    if constexpr (!ALIGN_EPI) { if (wr == 0) PG8_BAR; }
    PG8_BAR;
    if constexpr (Epi::AFTER_DRAIN) { E.fused(acc, cur, wr, wc, fr, fq, lds, wid, lane); S.done(cur); }
#undef PG8_SA
#undef PG8_SB
#undef PG8_STAGE
#undef PG8_LDA
#undef PG8_LDB
#undef PG8_MMA
#undef PG8_WAIT_V
#undef PG8_WAIT_L
#undef PG8_BAR
#undef PG8_SCHED
}
}
constexpr int NWAVES = 8;
#ifndef MK_ATTN_SIMPLE
#define MK_ATTN_SIMPLE 0
#endif
#ifndef MK_TOPK_RANK
#define MK_TOPK_RANK 0
#endif
#ifndef MK_PER_PHASE
#define MK_PER_PHASE 0
#endif

constexpr int D = 1024, TP = 16384, TS = 4096, NSB = 4, T = TP + NSB * TS;
constexpr int DEPTH = 2, NMOD = 5;
constexpr int HYW = 512, NHY = 3 * HYW, ATW = 512, KVW = 128, INW = 4352;
constexpr int COL_Q = 1536, COL_K = 2048, COL_V = 2176, COL_G = 2304;
constexpr int NH = 8, NKV = 2, HD = 64, WIN = 128;
constexpr int NE = 16, CAP = 2048, FF = 2816, NGRP = 2, TG = 16384;
constexpr int NSLOT = NGRP * NE * CAP;
constexpr float EPS = 1e-6f;
constexpr int FH = 64, FEMB = 33, FOUT = 2048;
constexpr int TPAD = T + 64;
constexpr int KB_UP = D / 2, KB_DN = 1536;
constexpr int KFS_P = 16392, KFS_S = 4104;

constexpr size_t MiB = 1u << 20;
constexpr size_t WS_CTL = 0, CTL_ZERO_BYTES = 1 * MiB;
constexpr size_t WS_MOD = 1 * MiB;
constexpr size_t WS_PSUM = 2 * MiB;
constexpr size_t WS_AFFT = 7 * MiB;
constexpr size_t WS_SLOT = 9 * MiB;
constexpr size_t WS_IDX = 11 * MiB;
constexpr size_t WS_GATEV = 11 * MiB + 512 * 1024;
constexpr size_t WS_ROPE = 12 * MiB;
constexpr size_t WS_WIN = 16 * MiB;
constexpr size_t WS_WHY = 33 * MiB;
constexpr size_t WS_WAT = 35 * MiB;
constexpr size_t WS_WO = 37 * MiB;
constexpr size_t WS_AFFTOK = 41 * MiB;
constexpr size_t WS_WOUT = 43 * MiB;
constexpr size_t WS_WGU = 48 * MiB;
constexpr size_t WS_WD = 224 * MiB;
constexpr size_t WS_H = 312 * MiB;
constexpr size_t WS_R1 = 376 * MiB;
constexpr size_t WS_HRAW_P = WS_R1, WS_HRAW_S = WS_R1 + 128 * MiB;
constexpr size_t WS_Z2T = WS_R1, WS_Z2AT = WS_R1 + 65 * MiB;
constexpr int ZAP = 2 * HYW;
constexpr size_t WS_KF_P = 536 * MiB, WS_KF_S = 665 * MiB;
constexpr size_t WS_YHY = 536 * MiB, WS_YAT = 600 * MiB;
constexpr size_t WS_HYT = 698 * MiB;
constexpr size_t WS_MERGED = 698 * MiB, WS_MIX = 762 * MiB;
constexpr size_t WS_PROJ = 891 * MiB;
constexpr size_t WS_QN = 1162 * MiB, WS_KN = 1194 * MiB;
constexpr size_t WS_XE = 376 * MiB, WS_HID = 504 * MiB, WS_YE = 856 * MiB;
constexpr size_t WS_END = 1202 * MiB;
static_assert(WS_KF_P + (size_t)1024 * KFS_P * 8 <= WS_KF_S && WS_KF_S + (size_t)1024 * KFS_S * 8 <= WS_HYT && WS_HYT + (size_t)NHY * TPAD * 4 <= WS_PROJ && WS_PROJ + (size_t)T * INW * 2 <= WS_END && WS_Z2T + (size_t)HYW * TPAD * 4 <= WS_Z2AT && WS_Z2AT + (size_t)T * ZAP * 2 <= WS_R1 + 160 * MiB, "ws map");
static_assert(WS_HID + (size_t)NSLOT * FF * 2 <= WS_YE && WS_YE + (size_t)NSLOT * D * 2 <= WS_END && WS_WGU + (size_t)NE * 2 * FF * D * 2 <= WS_WD && WS_WD + (size_t)NE * D * FF * 2 <= WS_H, "ws map 2");
constexpr int CW_BAR = 4096;

constexpr int RING_OFF = 0, RING_BYTES = 139264;
constexpr int LDSCTL_OFF = RING_BYTES, MISC_OFF = LDSCTL_OFF + 320;
constexpr int SCR_OFF = RING_BYTES + 1024;
constexpr int LDS_BYTES = 151552;
static_assert(MISC_OFF + 128 <= SCR_OFF && SCR_OFF + 8192 <= LDS_BYTES, "LDS map");

#define GAS __attribute__((address_space(1)))
#define LAS __attribute__((address_space(3)))
typedef unsigned short bf16;
typedef unsigned v4u __attribute__((ext_vector_type(4)));
typedef unsigned v2u __attribute__((ext_vector_type(2)));
typedef float f32x4 __attribute__((ext_vector_type(4)));
typedef float f32x2 __attribute__((ext_vector_type(2)));
typedef float f32x16 __attribute__((ext_vector_type(16)));
typedef short bf16x8 __attribute__((ext_vector_type(8)));
typedef GAS unsigned gu32;
#define RLX_AGENT __ATOMIC_RELAXED, __HIP_MEMORY_SCOPE_AGENT
#define LDS_WAIT() asm volatile("s_waitcnt lgkmcnt(0)" ::: "memory")
#define VM_WAIT() asm volatile("s_waitcnt vmcnt(0)" ::: "memory")
__device__ __forceinline__ unsigned f2bf(float f) { unsigned u = __builtin_bit_cast(unsigned, f); return (u + 0x7fffu + ((u >> 16) & 1u)) >> 16; }
__device__ __forceinline__ unsigned pk2(float lo, float hi) { return f2bf(lo) | (f2bf(hi) << 16); }
__device__ __forceinline__ float bf2f(unsigned b) { return __builtin_bit_cast(float, b << 16); }
__device__ __forceinline__ float bflo(unsigned w) { return __builtin_bit_cast(float, w << 16); }
__device__ __forceinline__ float bfhi(unsigned w) { return __builtin_bit_cast(float, w & 0xffff0000u); }
__device__ __forceinline__ float wave_sum(float v) {
#pragma unroll
    for (int o = 1; o < 64; o <<= 1) v += __shfl_xor(v, o);
    return v;
}
__device__ __forceinline__ float wave_max(float v) {
#pragma unroll
    for (int o = 1; o < 64; o <<= 1) v = fmaxf(v, __shfl_xor(v, o));
    return v;
}
__device__ __forceinline__ float rdlane(float v, int l) { return __builtin_bit_cast(float, __builtin_amdgcn_readlane(__builtin_bit_cast(int, v), l)); }
__device__ __forceinline__ float sin_rev(float x) { return __builtin_amdgcn_sinf(x); }
__device__ __forceinline__ float cos_rev(float x) { return __builtin_amdgcn_cosf(x); }
__device__ __forceinline__ float fast_exp(float x) { return __builtin_amdgcn_exp2f(1.4426950408889634f * x); }
__device__ __forceinline__ float sigmoidf(float x) { return __builtin_amdgcn_rcpf(1.0f + fast_exp(-x)); }
__device__ __forceinline__ float siluf(float x) { return x * sigmoidf(x); }
__device__ __forceinline__ float siluf_acc(float x) { return x / (1.0f + expf(-x)); }

#define XB_TMO      128
#define XB_XCNT(j)  (256  + 64 * (j))
#define XB_XSUB(j)  (1280 + 64 * (j))
#define XB_XGEN(j)  (2304 + 64 * (j))
#define XB_TOP      3328
#define XB_TOPGEN   3392
#define XCD_BAR_WORDS 3456
#define XB_SPIN_CAP (1u << 22)

__device__ __forceinline__ unsigned xb_ld(unsigned* p)              { return __hip_atomic_load(p, __ATOMIC_RELAXED, __HIP_MEMORY_SCOPE_AGENT); }
__device__ __forceinline__ unsigned xb_add(unsigned* p, unsigned v) { return __hip_atomic_fetch_add(p, v, __ATOMIC_RELAXED, __HIP_MEMORY_SCOPE_AGENT); }
__device__ __forceinline__ unsigned xb_xcc_id() { return (unsigned)__builtin_amdgcn_s_getreg((3 << 11) | 20) & 0xFu; }
#define XB_SPIN(cond, bar) do { unsigned _sp = 0; while (cond) { __builtin_amdgcn_s_sleep(1); \
    if ((++_sp & 255u) == 0u) { if (xb_ld(&(bar)[XB_TMO])) break; if (_sp > XB_SPIN_CAP) { atomicAdd(&(bar)[XB_TMO], 1u); break; } } } } while (0)

struct XcdBarrier {
    unsigned* bar; unsigned x;
    volatile LAS unsigned* st;
};

__device__ __forceinline__ XcdBarrier xcd_barrier_post(unsigned* bar, volatile LAS unsigned* st) {
    XcdBarrier b; b.bar = bar; b.x = xb_xcc_id(); b.st = st;
    if (threadIdx.x == 0) (void)xb_add(&bar[XB_XCNT(b.x)], 1u);
    return b;
}
__device__ __forceinline__ void xcd_barrier_complete(unsigned* bar, unsigned x, unsigned& nloc, unsigned& nx) {
    const unsigned G = gridDim.x * gridDim.y * gridDim.z;
    unsigned sum, cnt, mine, sp = 0u;
    for (;;) {
        sum = 0u; cnt = 0u; mine = 0u;
#pragma unroll
        for (unsigned j = 0; j < 16; ++j) { const unsigned c = xb_ld(&bar[XB_XCNT(j)]); sum += c; cnt += (c > 0u) ? 1u : 0u; mine = (j == x) ? c : mine; }
        if (sum == G) break;
        __builtin_amdgcn_s_sleep(1);
        if ((++sp & 255u) == 0u) { if (xb_ld(&bar[XB_TMO])) break; if (sp > XB_SPIN_CAP) { atomicAdd(&bar[XB_TMO], 1u); break; } }
    }
    nloc = mine > 0u ? mine : 1u; nx = cnt > 0u ? cnt : 1u;
}

__device__ __forceinline__ void xcd_barrier(const XcdBarrier& b) {
    asm volatile("s_waitcnt vmcnt(0)" ::: "memory");
    __syncthreads();
    if (threadIdx.x == 0) {
        unsigned* bar = b.bar;
        __builtin_amdgcn_s_waitcnt(0);
        unsigned nloc = b.st[0], nx = b.st[1];
        if (nloc == 0u) { xcd_barrier_complete(bar, b.x, nloc, nx); b.st[0] = nloc; b.st[1] = nx; }
        const unsigned old = xb_add(&bar[XB_XSUB(b.x)], 1u);
        const unsigned gen = old / nloc;
        if (old + 1u == (gen + 1u) * nloc) {
            __builtin_amdgcn_fence(__ATOMIC_RELEASE, "agent");
            asm volatile("s_waitcnt vmcnt(0)" ::: "memory");
            const unsigned og = xb_add(&bar[XB_TOP], 1u);
            const unsigned tg = og / nx;
            if (og + 1u == (tg + 1u) * nx) xb_add(&bar[XB_TOPGEN], 1u);
            else XB_SPIN(xb_ld(&bar[XB_TOPGEN]) == tg, bar);
            __builtin_amdgcn_fence(__ATOMIC_ACQUIRE, "agent");
            xb_add(&bar[XB_XGEN(b.x)], 1u);
            asm volatile("s_waitcnt vmcnt(0)" ::: "memory");
        } else {
            XB_SPIN(xb_ld(&bar[XB_XGEN(b.x)]) == gen, bar);
            __builtin_amdgcn_fence(__ATOMIC_ACQUIRE, "agent");
            asm volatile("s_waitcnt vmcnt(0)" ::: "memory");
        }
    }
    __syncthreads();
}


#define FFT_DEV __device__ __forceinline__
#define FFT_LDS LAS
__device__ __forceinline__ int fft_tid_() { int t = threadIdx.x; asm volatile("" : "+v"(t)); return t; }
#define FFT_TID fft_tid_()
#define FFT_NTHR (NWAVES * 64)
#define FFT_SYNC() __syncthreads()
__device__ __forceinline__ float fft_sin_rev(float x) { return __builtin_amdgcn_sinf(x); }
__device__ __forceinline__ float fft_cos_rev(float x) { return __builtin_amdgcn_cosf(x); }
__device__ __forceinline__ unsigned fft_brev(unsigned x) { return __builtin_bitreverse32(x); }
typedef float c32 __attribute__((ext_vector_type(2)));
#define FFT_PIDX(i) ((i) + (((i) >> 6) << 2))
typedef float fft_v4 __attribute__((ext_vector_type(4)));
FFT_DEV c32 c_mk(float a, float b) { c32 r; r.x = a; r.y = b; return r; }
FFT_DEV c32 c_add(c32 a, c32 b) { return a + b; }
FFT_DEV c32 c_sub(c32 a, c32 b) { return a - b; }
FFT_DEV c32 c_mul(c32 a, c32 b) { return b * a.x + c_mk(-b.y, b.x) * a.y; }
FFT_DEV c32 c_mulc(c32 a, c32 b) { return a * b.x + c_mk(a.y, -a.x) * b.y; }
FFT_DEV c32 c_conj(c32 a) { return c_mk(a.x, -a.y); }
FFT_DEV c32 c_scale(c32 a, float s) { return a * s; }
FFT_DEV c32 c_twid(float rev) { return c_mk(fft_cos_rev(rev), -fft_sin_rev(rev)); }
FFT_DEV c32 c_root16(int j) {
    const float C1 = 0.92387953251128674f, S1 = 0.38268343236508977f, H = 0.70710678118654752f;
    switch (j) { case 0: return c_mk(1.f, 0.f); case 1: return c_mk(C1, -S1); case 2: return c_mk(H, -H); case 3: return c_mk(S1, -C1);
                 case 4: return c_mk(0.f, -1.f); case 5: return c_mk(-S1, -C1); case 6: return c_mk(-H, -H); default: return c_mk(-C1, -S1); }
}
template <int LOGM, int NST, bool INV, int NB, int PRUNE> FFT_DEV void fft_pass(FFT_LDS c32* buf0, int s) {
    constexpr int M = 1 << LOGM, R = 1 << NST, G = M / R, PADM = FFT_PIDX(M);
    const int lq = LOGM - s - NST, q = 1 << lq;
    for (int gi = FFT_TID; gi < NB * G; gi += FFT_NTHR) {
        const int g = gi & (G - 1); FFT_LDS c32* buf = buf0 + (gi / G) * PADM;
        const int r = g & (q - 1), i0 = ((g >> lq) << (lq + NST)) + r;
        const int pb = FFT_PIDX(i0);
        c32 x[R];
#pragma unroll
        for (int j = 0; j < R; ++j) x[j] = (PRUNE == 1 && j >= R / 2) ? c_mk(0.f, 0.f) : buf[pb + FFT_PIDX(j * q)];
        c32 Ts[NST];
        Ts[0] = c_twid((float)(r << s) * (1.0f / M));
#pragma unroll
        for (int t = 1; t < NST; ++t) Ts[t] = c_mul(Ts[t - 1], Ts[t - 1]);
#pragma unroll
        for (int tt = 0; tt < NST; ++tt) {
            const int t = INV ? NST - 1 - tt : tt, h = R >> (t + 1);
            c32 Pq[R / 2], Qq[R / 2];
#pragma unroll
            for (int jj = 0; jj < h; ++jj) {
                c32 tw;
                if (jj < (h + 1) / 2) tw = jj == 0 ? Ts[t] : c_mul(Ts[t], c_root16(jj * (8 / h)));
                else { const c32 b = INV ? c_mk(Pq[jj - h / 2].x, -Pq[jj - h / 2].y) : Pq[jj - h / 2]; tw = c_mk(b.y, -b.x); }
                if (!INV) { Pq[jj] = tw; Qq[jj] = c_mk(-tw.y, tw.x); } else { Pq[jj] = c_mk(tw.x, -tw.y); Qq[jj] = c_mk(tw.y, tw.x); }
            }
#pragma unroll
            for (int j = 0; j < R / 2; ++j) { const int jj = j % h, b = (j / h) * 2 * h + jj;
                if (!INV) {
                    if (PRUNE == 1 && t == 0) { const c32 a = x[b]; x[b + h] = Pq[jj] * a.x + Qq[jj] * a.y; }
                    else { const c32 a = x[b], c = x[b + h], d = a - c; x[b] = a + c; x[b + h] = Pq[jj] * d.x + Qq[jj] * d.y; }
                } else {
                    const c32 a = x[b], cr = x[b + h], c = Pq[jj] * cr.x + Qq[jj] * cr.y; x[b] = a + c;
                    if (!(PRUNE == 2 && t == 0)) x[b + h] = a - c;
                }
            }
        }
#pragma unroll
        for (int j = 0; j < R; ++j) if (!(PRUNE == 2 && j >= R / 2)) buf[pb + FFT_PIDX(j * q)] = x[j];
    }
}
template <int LOGM, int NB, bool ZP> FFT_DEV void fft_fwd(FFT_LDS c32* buf) {
    static_assert(LOGM % 4 == 0 || LOGM % 4 == 2, "radix-16 passes + one radix-4 pass");
    FFT_SYNC(); fft_pass<LOGM, 4, false, NB, ZP ? 1 : 0>(buf, 0);
    int s = 4;
#pragma unroll
    for (int p = 1; p < LOGM / 4; ++p) { FFT_SYNC(); fft_pass<LOGM, 4, false, NB, 0>(buf, s); s += 4; }
    if (LOGM % 4 == 2) { FFT_SYNC(); fft_pass<LOGM, 2, false, NB, 0>(buf, s); }
    FFT_SYNC();
}
template <int LOGM, int NB, bool HO> FFT_DEV void fft_inv(FFT_LDS c32* buf) {
    int s = LOGM;
    if (LOGM % 4 == 2) { s -= 2; FFT_SYNC(); fft_pass<LOGM, 2, true, NB, 0>(buf, s); }
#pragma unroll
    for (int p = 1; p < LOGM / 4; ++p) { s -= 4; FFT_SYNC(); fft_pass<LOGM, 4, true, NB, 0>(buf, s); }
    FFT_SYNC(); fft_pass<LOGM, 4, true, NB, HO ? 2 : 0>(buf, 0);
    FFT_SYNC();
}
template <int LOGM> FFT_DEV void filt_untangle(FFT_LDS const c32* buf, c32* KfP, float scale) {
    constexpr int M = 1 << LOGM;
    for (int t = FFT_TID; t <= M / 2; t += FFT_NTHR) {
        if (t == 0) { const c32 Z0 = buf[FFT_PIDX(0)]; KfP[0] = c_mk((Z0.x + Z0.y) * scale, 0.f); KfP[1] = c_mk((Z0.x - Z0.y) * scale, 0.f); }
        else {
            const int p1 = t == M / 2 ? 1 : 2 * t, kk = (int)(fft_brev((unsigned)p1) >> (32 - LOGM)), p2 = (int)(fft_brev((unsigned)(M - kk)) >> (32 - LOGM));
            const c32 A = buf[FFT_PIDX(p1)], B = buf[FFT_PIDX(p2)];
            const c32 E = c_mk(0.5f * (A.x + B.x), 0.5f * (A.y - B.y)), O = c_mk(0.5f * (A.y + B.y), -0.5f * (A.x - B.x));
            const c32 wk = c_twid((float)kk * (0.5f / M)), Tt = c_mul(wk, O);
            const c32 K1 = c_scale(c_add(E, Tt), scale), K2 = c_scale(c_conj(c_sub(E, Tt)), scale);
            if (t == M / 2) KfP[M] = K1;
            else { fft_v4 v; v.x = K1.x; v.y = K1.y; v.z = K2.x; v.w = K2.y; *(fft_v4*)(KfP + 2 * t) = v; }
        }
    }
}
template <int LOGM, int NB, int CH> FFT_DEV void pw_fetch(const c32* __restrict__ KfP, c32 (&K1)[CH], c32 (&K2)[CH], int i0) {
    constexpr int M = 1 << LOGM;
#pragma unroll
    for (int j = 0; j < CH; ++j) { const int t = (i0 + j * FFT_NTHR) & (M / 2 - 1); const fft_v4 v = *(const fft_v4*)(KfP + 2 * t); K1[j] = c_mk(v.x, v.y); K2[j] = c_mk(v.z, v.w); }
}
template <int LOGM, int NB, int CH> FFT_DEV void conv_pointwise(FFT_LDS c32* buf0, const c32* __restrict__ KfP, float invM, c32 (&K1)[CH], c32 (&K2)[CH]) {
    constexpr int M = 1 << LOGM, PADM = FFT_PIDX(M), NP = NB * (M / 2);
    for (int i0 = FFT_TID; i0 < NP; i0 += CH * FFT_NTHR) {
        c32 N1[CH], N2[CH];
        const bool more = i0 + CH * FFT_NTHR < NP;
        if (more) pw_fetch<LOGM, NB, CH>(KfP, N1, N2, i0 + CH * FFT_NTHR);
#pragma unroll
        for (int j = 0; j < CH; ++j) { const int i = i0 + j * FFT_NTHR, t = i & (M / 2 - 1), p1 = 2 * t, kk = (int)(fft_brev((unsigned)p1) >> (32 - LOGM)); FFT_LDS c32* buf = buf0 + (i / (M / 2)) * PADM;
            if (t == 0) { const c32 Z0 = buf[FFT_PIDX(0)]; const float Y0 = (Z0.x + Z0.y) * K1[j].x * invM, YM = (Z0.x - Z0.y) * K2[j].x * invM; buf[FFT_PIDX(0)] = c_mk(0.5f * (Y0 + YM), 0.5f * (Y0 - YM)); }
            else {
                const int p2 = (int)(fft_brev((unsigned)(M - kk)) >> (32 - LOGM));
                const c32 A = buf[FFT_PIDX(p1)], B = buf[FFT_PIDX(p2)];
                const c32 E = c_mk(0.5f * (A.x + B.x), 0.5f * (A.y - B.y)), O = c_mk(0.5f * (A.y + B.y), -0.5f * (A.x - B.x));
                const c32 wk = c_twid((float)kk * (0.5f / M)), Tt = c_mul(wk, O);
                const c32 Yk = c_scale(c_mul(c_add(E, Tt), K1[j]), invM), Ymk = c_scale(c_mul(c_conj(c_sub(E, Tt)), K2[j]), invM);
                const c32 Ep = c_scale(c_add(Yk, c_conj(Ymk)), 0.5f), Op = c_scale(c_mulc(c_sub(Yk, c_conj(Ymk)), wk), 0.5f);
                buf[FFT_PIDX(p1)] = c_mk(Ep.x - Op.y, Ep.y + Op.x); buf[FFT_PIDX(p2)] = c_mk(Ep.x + Op.y, Op.x - Ep.y);
            }
        }
        if (more) {
#pragma unroll
            for (int j = 0; j < CH; ++j) { K1[j] = N1[j]; K2[j] = N2[j]; } }
    }
    for (int sb = FFT_TID; sb < NB; sb += FFT_NTHR) {
        FFT_LDS c32* buf = buf0 + sb * PADM; const c32 Zh = buf[FFT_PIDX(1)], Y = c_scale(c_mul(c_conj(Zh), KfP[M]), invM); buf[FFT_PIDX(1)] = c_conj(Y); }
}
FFT_DEV c32 conv_pair(const float* __restrict__ p, int m, int L, float w0, float w1, float w2, float b) {
    const float a = m > 0 ? p[2 * m - 1] : 0.f, x0 = p[2 * m], x1 = p[2 * m + 1], c = 2 * m + 2 < L ? p[2 * m + 2] : 0.f;
    return c_mk(w0 * a + w1 * x0 + w2 * x1 + b, w0 * x0 + w1 * x1 + w2 * c + b);
}
template <int LOGM, int NB, int CH> FFT_DEV void hyena_unit(FFT_LDS c32* buf, const float* __restrict__ pz, const float* __restrict__ pg0, const float* __restrict__ pg1, const float* cw, const c32* __restrict__ Kf0, const c32* __restrict__ Kf1, float bias0, float bias1, float* __restrict__ zout) {
    constexpr int M = 1 << LOGM, H = M / 2, L = M, PADM = FFT_PIDX(M); const float invM = 1.0f / M;
    for (int i0 = FFT_TID; i0 < NB * H; i0 += CH * FFT_NTHR) {
        c32 z[CH];
#pragma unroll
        for (int j = 0; j < CH; ++j) { const int i = i0 + j * FFT_NTHR, sq = i / H, m = i & (H - 1); z[j] = conv_pair(pz + sq * L, m, L, cw[0], cw[1], cw[2], cw[3]); }
#pragma unroll
        for (int j = 0; j < CH; ++j) { const int i = i0 + j * FFT_NTHR, sq = i / H, m = i & (H - 1); *(c32*)(zout + sq * L + 2 * m) = z[j]; buf[sq * PADM + FFT_PIDX(m)] = z[j]; }
    }
#ifdef PROBE_FFT_EXTRA
    fft_fwd<LOGM, NB, false>(buf); fft_inv<LOGM, NB, false>(buf);
    for (int i = FFT_TID; i < NB * M; i += FFT_NTHR) { const int sq = i / M, m = i & (M - 1); buf[sq * PADM + FFT_PIDX(m)] = buf[sq * PADM + FFT_PIDX(m)] * invM; }
#endif
    c32 KA[CH], KB[CH];
    pw_fetch<LOGM, NB, CH>(Kf0, KA, KB, FFT_TID);
    fft_fwd<LOGM, NB, true>(buf); conv_pointwise<LOGM, NB, CH>(buf, Kf0, invM, KA, KB); fft_inv<LOGM, NB, true>(buf);
    for (int i0 = FFT_TID; i0 < NB * H; i0 += CH * FFT_NTHR) {
        c32 g[CH], u[CH];
#pragma unroll
        for (int j = 0; j < CH; ++j) { const int i = i0 + j * FFT_NTHR, sq = i / H, m = i & (H - 1); g[j] = conv_pair(pg0 + sq * L, m, L, cw[4], cw[5], cw[6], cw[7]); u[j] = *(const c32*)(zout + sq * L + 2 * m); }
#pragma unroll
        for (int j = 0; j < CH; ++j) { const int i = i0 + j * FFT_NTHR, sq = i / H, m = i & (H - 1); const c32 y = buf[sq * PADM + FFT_PIDX(m)]; const c32 v = g[j] * (y + u[j] * bias0);
            *(c32*)(zout + sq * L + 2 * m) = v; buf[sq * PADM + FFT_PIDX(m)] = v; }
    }
    pw_fetch<LOGM, NB, CH>(Kf1, KA, KB, FFT_TID);
    fft_fwd<LOGM, NB, true>(buf); conv_pointwise<LOGM, NB, CH>(buf, Kf1, invM, KA, KB); fft_inv<LOGM, NB, true>(buf);
    for (int i0 = FFT_TID; i0 < NB * H; i0 += CH * FFT_NTHR) {
        c32 g[CH], u[CH];
#pragma unroll
        for (int j = 0; j < CH; ++j) { const int i = i0 + j * FFT_NTHR, sq = i / H, m = i & (H - 1); g[j] = conv_pair(pg1 + sq * L, m, L, cw[8], cw[9], cw[10], cw[11]); u[j] = *(const c32*)(zout + sq * L + 2 * m); }
#pragma unroll
        for (int j = 0; j < CH; ++j) { const int i = i0 + j * FFT_NTHR, sq = i / H, m = i & (H - 1); const c32 y = buf[sq * PADM + FFT_PIDX(m)]; *(c32*)(zout + sq * L + 2 * m) = g[j] * (y + u[j] * bias1); }
    }
    FFT_SYNC();
}
template <int LOGM, int CH> FFT_DEV void filter_unit(FFT_LDS c32* buf, const float* __restrict__ fwd, const float* __restrict__ bwd, int tstride, c32* __restrict__ KfP, float scale) {
    constexpr int M = 1 << LOGM, L = M, H = M / 2;
#define FFT_TIX(t) ((size_t)((t) >> 5) * tstride + ((t) & 31))
    for (int m0 = FFT_TID; m0 < H; m0 += CH * FFT_NTHR) {
        c32 a[CH], b[CH];
#pragma unroll
        for (int j = 0; j < CH; ++j) { const int m = m0 + j * FFT_NTHR; a[j] = *(const c32*)(fwd + FFT_TIX(2 * m));
            b[j] = m == 0 ? c_mk(0.f, bwd[FFT_TIX(L - 1)]) : c_mk(bwd[FFT_TIX(L - 2 * m)], bwd[FFT_TIX(L - 2 * m - 1)]); }
#pragma unroll
        for (int j = 0; j < CH; ++j) { const int m = m0 + j * FFT_NTHR; buf[FFT_PIDX(m)] = a[j]; buf[FFT_PIDX(m + H)] = b[j]; }
    }
#undef FFT_TIX
    fft_fwd<LOGM, 1, false>(buf); filt_untangle<LOGM>(buf, KfP, scale);
    FFT_SYNC();
}

struct Frame {
    LAS unsigned char* lds;
    volatile LAS unsigned* MISC;
    gu32* ctl;
    int tid, lane, wave;
    int vcu, G, bid;
    float* out; unsigned char* ws;
};
struct Args { const float* in[30]; float* out; unsigned char* ws; int ph_lo, ph_hi; };
typedef GAS const float* cfp_t;
typedef __attribute__((address_space(4))) const cfp_t* KargTab;
struct InPtrs { KargTab t; __device__ __forceinline__ const float* operator[](int i) const { return (const float*)t[i]; } };
struct InTab { InPtrs in; };
enum { I_XP = 0, I_XS, I_CP, I_CS, I_ADAW, I_ADAB, I_N1G, I_N2G, I_WIN, I_HCW, I_HCB, I_FW1, I_FB1, I_FW2, I_FB2, I_FW3, I_FB3, I_FFREQ, I_FWOUT, I_HYB, I_QNG, I_KNG, I_SINK, I_WHY, I_WAT, I_WO, I_RW, I_EWG, I_EWU, I_EWD };

__device__ __forceinline__ int mod_row(int r) { return r < TP ? 0 : 1 + ((r - TP) >> 12); }
__device__ __forceinline__ void seq_bounds(int r, int& s0, int& len) { if (r < TP) { s0 = 0; len = TP; } else { s0 = TP + (((r - TP) >> 12) << 12); len = TS; } }
__device__ __forceinline__ const float* x_row(const Frame& F, const InTab& A, int l, int r) { return l == 0 ? (r < TP ? A.in[I_XP] + (size_t)r * D : A.in[I_XS] + (size_t)(r - TP) * D) : F.out + (size_t)r * D; }

__device__ __forceinline__ void transpose_item(const float* W, int N, int K, int k0, int n0, bf16* WT, int dst_row0, LAS float* scr, int lane) {
    float r_[32];
#pragma unroll
    for (int i = 0; i < 32; ++i) r_[i] = W[(size_t)(k0 + 2 * i + (lane >> 5)) * N + n0 + (lane & 31)];
#pragma unroll
    for (int i = 0; i < 32; ++i) scr[(2 * i + (lane >> 5)) * 33 + (lane & 31)] = r_[i];
    LDS_WAIT(); asm volatile("" ::: "memory");
    const int c = lane & 7;
#pragma unroll
    for (int j = 0; j < 4; ++j) { const int n = (lane >> 3) + 8 * j; const LAS float* s = scr + (8 * c) * 33 + n;
        v4u o; o.x = pk2(s[0 * 33], s[1 * 33]); o.y = pk2(s[2 * 33], s[3 * 33]); o.z = pk2(s[4 * 33], s[5 * 33]); o.w = pk2(s[6 * 33], s[7 * 33]);
        *(v4u*)(WT + (size_t)(dst_row0 + n) * K + k0 + 8 * c) = o; }
    LDS_WAIT(); asm volatile("" ::: "memory");
}
__device__ __forceinline__ void convert_small_weights(Frame& F, const InTab& A) {
    LAS float* scr = (LAS float*)(F.lds + RING_OFF + F.wave * 16384);
    const int gw = F.vcu * NWAVES + F.wave, NGW = F.G * NWAVES;
    constexpr int I_IN = (D / 64) * (INW / 32), I_P = (HYW / 64) * (D / 32), I_O = (D / 64) * (D / 32), I_F = FOUT / 32, PER_L = I_IN + 2 * I_P + I_O + I_F;
    for (int it = gw; it < DEPTH * PER_L; it += NGW) {
        const int l = it / PER_L; int r = it % PER_L;
        if (r < I_IN) { const int nb = INW / 32; transpose_item(A.in[I_WIN] + (size_t)l * D * INW, INW, D, 64 * (r / nb), 32 * (r % nb), (bf16*)(F.ws + WS_WIN) + (size_t)l * INW * D, 32 * (r % nb), scr, F.lane); continue; } r -= I_IN;
        if (r < I_P) { const int nb = D / 32; transpose_item(A.in[I_WHY] + (size_t)l * HYW * D, D, 2 * HYW, 64 * (r / nb), 32 * (r % nb), (bf16*)(F.ws + WS_WHY) + (size_t)l * D * 2 * HYW, 32 * (r % nb), scr, F.lane); continue; } r -= I_P;
        if (r < I_P) { const int nb = D / 32; transpose_item(A.in[I_WAT] + (size_t)l * ATW * D, D, 2 * HYW, 64 * (r / nb), 32 * (r % nb), (bf16*)(F.ws + WS_WHY) + (size_t)l * D * 2 * HYW + HYW, 32 * (r % nb), scr, F.lane); continue; } r -= I_P;
        if (r < I_O) { const int nb = D / 32; transpose_item(A.in[I_WO] + (size_t)l * D * D, D, D, 64 * (r / nb), 32 * (r % nb), (bf16*)(F.ws + WS_WO) + (size_t)l * D * D, 32 * (r % nb), scr, F.lane); continue; } r -= I_O;
        transpose_item(A.in[I_FWOUT] + (size_t)l * FH * FOUT, FOUT, FH, 0, 32 * r, (bf16*)(F.ws + WS_WOUT) + (size_t)l * FOUT * FH, 32 * r, scr, F.lane);
    }
}
struct CvItem { const float* src; unsigned char* dst; int N, K; float sc; };
__device__ __forceinline__ CvItem cv_moe_item(const Frame& F, const InTab& A, int l, int it) {
    constexpr int I_G = (D / 64) * (FF / 32), I_D = (FF / 64) * (D / 32), PER_E = 2 * I_G + I_D;
    const int e = it / PER_E; int r = it % PER_E; CvItem c;
    if (r < 2 * I_G) { const int up = r >= I_G; if (up) r -= I_G; const int nb = FF / 32, k0 = 64 * (r / nb), n0 = 32 * (r % nb);
        c.src = A.in[up ? I_EWU : I_EWG] + ((size_t)l * NE + e) * D * FF + (size_t)k0 * FF + n0; c.N = FF; c.K = KB_UP; c.sc = 64.f;
        c.dst = (unsigned char*)(F.ws + WS_WGU) + ((size_t)e * (2 * FF) + (256 * (n0 >> 7) + (up ? 128 : 0) + (n0 & 127))) * KB_UP + (k0 >> 1); }
    else { r -= 2 * I_G; const int nb = D / 32, k0 = 64 * (r / nb), n0 = 32 * (r % nb);
        c.src = A.in[I_EWD] + ((size_t)l * NE + e) * FF * D + (size_t)k0 * D + n0; c.N = D; c.K = KB_DN; c.sc = 128.f;
        c.dst = (unsigned char*)(F.ws + WS_WD) + ((size_t)e * D + n0) * KB_DN + (k0 >> 1); }
    return c;
}
template <int VAR = 0  >
__device__ __forceinline__ void convert_moe_weights(Frame& F, const InTab& A, int l) {
    const int gw = F.vcu * NWAVES + F.wave, NGW = F.G * NWAVES, lane = F.lane, g = lane >> 3, c = lane & 7;
    constexpr int TOTAL = NE * (2 * (D / 64) * (FF / 32) + (FF / 64) * (D / 32));
    for (int i = (F.vcu * NWAVES + F.wave) * 64 + lane; i < NE * D * ((KB_DN - FF / 2) / 16); i += NGW * 64) { const int row = i >> 3, ch = i & 7;
        *(v4u*)((unsigned char*)(F.ws + WS_WD) + (size_t)row * KB_DN + FF / 2 + 16 * ch) = (v4u){0u, 0u, 0u, 0u}; }
    if constexpr (VAR == 2) {
        f32x4 acc = {0.f, 0.f, 0.f, 0.f};
        for (int m = 0; m < 3; ++m) { const float* base = A.in[m == 0 ? I_EWG : m == 1 ? I_EWU : I_EWD] + (size_t)l * NE * D * FF; const int nch = NE * D * FF / 2048;
            for (int ch = gw; ch < nch; ch += NGW) { const float* p = base + (size_t)ch * 2048 + 4 * lane; f32x4 r[8];
#pragma unroll
                for (int i = 0; i < 8; ++i) r[i] = *(const f32x4*)(p + 256 * i);
#pragma unroll
                for (int i = 0; i < 8; ++i) acc += r[i]; } }
        if (acc[0] + acc[1] + acc[2] + acc[3] == 1.2345e-30f) *(float*)(F.ws + WS_WD) = 0.f;
        return;
    }
    f32x4 ra[8], rb[8]; CvItem cur, nxt;
    if (gw < TOTAL) { cur = cv_moe_item(F, A, l, gw); const float* p = cur.src + (size_t)(8 * g) * cur.N + 4 * c;
#pragma unroll
        for (int i = 0; i < 8; ++i) ra[i] = *(const f32x4*)(p + (size_t)i * cur.N); }
    for (int it = gw; it < TOTAL; it += NGW) {
        const bool more = it + NGW < TOTAL;
        if (more) { nxt = cv_moe_item(F, A, l, it + NGW); const float* p = nxt.src + (size_t)(8 * g) * nxt.N + 4 * c;
#pragma unroll
            for (int i = 0; i < 8; ++i) rb[i] = *(const f32x4*)(p + (size_t)i * nxt.N); }
        const float sc = cur.sc;
#pragma unroll
        for (int j = 0; j < 4; ++j) { unsigned w; PG8_FP4_PACK8(w, ra[0][j] * sc, ra[1][j] * sc, ra[2][j] * sc, ra[3][j] * sc, ra[4][j] * sc, ra[5][j] * sc, ra[6][j] * sc, ra[7][j] * sc);
            if (VAR == 0 || w == 0x12345678u) *(unsigned*)(cur.dst + (size_t)(4 * c + j) * cur.K + 4 * g) = w; }
        if (more) { cur = nxt;
#pragma unroll
            for (int i = 0; i < 8; ++i) ra[i] = rb[i]; }
    }
}
__device__ __forceinline__ void adaln_mod(Frame& F, const InTab& A) {
    LAS float* sc = (LAS float*)(F.lds + RING_OFF);
    LAS float* red = (LAS float*)(F.lds + RING_OFF + 32768);
    for (int i = F.tid; i < NMOD * D; i += NWAVES * 64) { const int b = i / D, k = i % D; const float c = b == 0 ? A.in[I_CP][k] : A.in[I_CS][(b - 1) * D + k]; sc[i] = siluf_acc(c); }
    __syncthreads();
    float* mod = (float*)(F.ws + WS_MOD);
    for (int u = F.vcu; u < DEPTH * 96; u += F.G) {
        const int l = u / 96, n = (u % 96) * 64 + F.lane;
        const float* W = A.in[I_ADAW] + (size_t)l * D * 6 * D + n;
        float a[NMOD] = {0.f, 0.f, 0.f, 0.f, 0.f};
#pragma unroll 4
        for (int k = 128 * F.wave; k < 128 * F.wave + 128; ++k) { const float w = W[(size_t)k * 6 * D];
#pragma unroll
            for (int b = 0; b < NMOD; ++b) a[b] += sc[b * D + k] * w; }
#pragma unroll
        for (int b = 0; b < NMOD; ++b) red[(F.wave * NMOD + b) * 64 + F.lane] = a[b];
        __syncthreads();
        if (F.tid < NMOD * 64) { const int b = F.tid >> 6, ln = F.tid & 63; float s = A.in[I_ADAB][l * 6 * D + (u % 96) * 64 + ln];
#pragma unroll
            for (int w = 0; w < NWAVES; ++w) s += red[(w * NMOD + b) * 64 + ln];
            mod[((size_t)l * NMOD + b) * 6 * D + (u % 96) * 64 + ln] = s; }
        __syncthreads();
    }
}
__device__ __forceinline__ void norm_mod_rows(Frame& F, const InTab& A, int l, const float* g, int sh_off, int sc_off) {
    const int gw = F.vcu * NWAVES + F.wave, NGW = F.G * NWAVES;
    const float* mod = (const float*)(F.ws + WS_MOD) + (size_t)l * NMOD * 6 * D;
    bf16* H = (bf16*)(F.ws + WS_H);
    for (int m = gw; m < T; m += NGW) {
        const f32x4* xr = (const f32x4*)x_row(F, A, l, m) + F.lane;
        f32x4 v[4]; float ss = 0.f;
#pragma unroll
        for (int j = 0; j < 4; ++j) { v[j] = xr[64 * j]; ss += (v[j].x * v[j].x + v[j].y * v[j].y) + (v[j].z * v[j].z + v[j].w * v[j].w); }
        const float rstd = 1.0f / sqrtf(wave_sum(ss) * (1.f / D) + EPS);
        const float* mr = mod + (size_t)mod_row(m) * 6 * D;
        unsigned long long* o8 = (unsigned long long*)(H + (size_t)m * D) + F.lane;
#pragma unroll
        for (int j = 0; j < 4; ++j) { const int c = 4 * F.lane + 256 * j;
            const f32x4 gg = *(const f32x4*)(g + c), sc = *(const f32x4*)(mr + sc_off + c), sh = *(const f32x4*)(mr + sh_off + c);
            const f32x4 o = v[j] * rstd * gg * (sc + 1.0f) + sh;
            o8[64 * j] = (unsigned long long)pk2(o.x, o.y) | ((unsigned long long)pk2(o.z, o.w) << 32); }
    }
}

__device__ __forceinline__ void filter_time_tiles(Frame& F, const InTab& A, int l) {
    LAS bf16* h3s = (LAS bf16*)(F.lds + RING_OFF);
    const float* w1 = A.in[I_FW1] + (size_t)l * FEMB * FH; const float* b1 = A.in[I_FB1] + l * FH;
    const float* w2 = A.in[I_FW2] + (size_t)l * FH * FH;   const float* b2 = A.in[I_FB2] + l * FH;
    const float* w3 = A.in[I_FW3] + (size_t)l * FH * FH;   const float* b3 = A.in[I_FB3] + l * FH;
    const bf16* woT = (const bf16*)(F.ws + WS_WOUT) + (size_t)l * FOUT * FH;
    const float fr = A.in[I_FFREQ][l * FH + F.lane] * 0.15915494309189535f;
    const float bb1 = b1[F.lane], bb2 = b2[F.lane], bb3 = b3[F.lane];
    const int lane = F.lane;
    LAS float* wl1 = (LAS float*)(F.lds + RING_OFF + 16384); LAS float* wl2 = wl1 + FEMB * FH; LAS float* wl3 = wl2 + FH * FH;
    for (int i = F.tid; i < FEMB * FH; i += NWAVES * 64) wl1[i] = w1[i];
    for (int i = F.tid; i < FH * FH; i += NWAVES * 64) { wl2[i] = w2[i]; wl3[i] = w3[i]; }
    __syncthreads();
    for (int tile = F.vcu; tile < 640; tile += F.G) {
        const int set = tile >= 512, tl0 = set ? tile - 512 : tile, L = set ? TS : TP, j0 = 32 * tl0;
        float* hraw = (float*)(F.ws + (set ? WS_HRAW_S : WS_HRAW_P));
        float* psum = (float*)(F.ws + WS_PSUM) + (set ? (size_t)512 * FOUT : 0) + (size_t)tl0 * FOUT;
        const float invL = 1.0f / (float)L, invLm1 = 1.0f / (float)(L - 1);
        {
            float zv[4], h[4], pre[4];
#pragma unroll
            for (int i = 0; i < 4; ++i) { const int j = j0 + F.wave + 8 * i; float z = 0.f;
                if (lane == 0) z = (float)j * invLm1;
                else if (lane <= 32) { const int b = (lane - 1) & 15; const float fb = 1e-4f + (float)b * ((15.0f - 1e-4f) / 15.0f); const float rev = fb * (float)j * invL; z = lane <= 16 ? cos_rev(rev) : -sin_rev(rev); }
                zv[i] = z; pre[i] = bb1; }
#define FT_LAYER(WL, NK, SRC) do { _Pragma("unroll 1") for (int k0 = 0; k0 < (NK); k0 += 16) { float w_[16]; \
                _Pragma("unroll") for (int j = 0; j < 16; ++j) w_[j] = (k0 + j < (NK)) ? (WL)[(k0 + j) * FH + lane] : 0.f; \
                _Pragma("unroll") for (int j = 0; j < 16; ++j) { _Pragma("unroll") for (int i = 0; i < 4; ++i) pre[i] += rdlane(SRC[i], (k0 + j) & 63) * w_[j]; } } } while (0)
            FT_LAYER(wl1, FEMB, zv);
#pragma unroll
            for (int i = 0; i < 4; ++i) { h[i] = sin_rev(fr * pre[i]); pre[i] = bb2; }
            FT_LAYER(wl2, FH, h);
#pragma unroll
            for (int i = 0; i < 4; ++i) { h[i] = sin_rev(fr * pre[i]); pre[i] = bb3; }
            FT_LAYER(wl3, FH, h);
#undef FT_LAYER
#pragma unroll
            for (int i = 0; i < 4; ++i) h3s[(F.wave + 8 * i) * 72 + lane] = (bf16)f2bf(sin_rev(fr * pre[i]));
        }
        __syncthreads();
        {
            const int hi = lane >> 5, lr = lane & 31;
            bf16x8 af[4], bcur[4], bnxt[4];
#pragma unroll
            for (int s = 0; s < 4; ++s) { af[s] = *(const LAS bf16x8*)(h3s + lr * 72 + 16 * s + 8 * hi); bcur[s] = *(const bf16x8*)(woT + (size_t)((F.wave * 8) * 32 + lr) * FH + 16 * s + 8 * hi); }
#pragma unroll 1
            for (int r = 0; r < 8; ++r) {
                const int n = (F.wave * 8 + r) * 32 + lr;
                if (r < 7) {
#pragma unroll
                    for (int s = 0; s < 4; ++s) bnxt[s] = *(const bf16x8*)(woT + (size_t)(n + 32) * FH + 16 * s + 8 * hi); }
                f32x16 acc = {0.f, 0.f, 0.f, 0.f, 0.f, 0.f, 0.f, 0.f, 0.f, 0.f, 0.f, 0.f, 0.f, 0.f, 0.f, 0.f};
#pragma unroll
                for (int s = 0; s < 4; ++s) acc = __builtin_amdgcn_mfma_f32_32x32x16_bf16(af[s], bcur[s], acc, 0, 0, 0);
                const int dir = n >> 10, c = n & 511;
                const float delta = 3.070113457325394f + (float)c * ((15.350567286626971f - 3.070113457325394f) / 511.0f);
                float ssq = 0.f;
#pragma unroll
                for (int g = 0; g < 4; ++g) { f32x4 v;
#pragma unroll
                    for (int e = 0; e < 4; ++e) { const int j = j0 + 8 * g + 4 * hi + e; const float val = acc[4 * g + e] * fast_exp(-(float)j * invLm1 * delta); v[e] = val; if (!(dir == 1 && j == 0)) ssq += val * val; }
                    *(f32x4*)(hraw + ((size_t)tl0 * FOUT + n) * 32 + 8 * g + 4 * hi) = v; }
                ssq += __shfl_xor(ssq, 32);
                if (lane < 32) psum[n] = ssq;
#pragma unroll
                for (int s = 0; s < 4; ++s) bcur[s] = bnxt[s];
            }
        }
        __syncthreads();
    }
}

__device__ __forceinline__ void filter_fft_units(Frame& F) {
    LAS c32* buf = (LAS c32*)(F.lds + RING_OFF);
    LAS float* red = (LAS float*)(F.lds + SCR_OFF);
    const bool deal = F.G == 256, heavy = F.bid < 128;
    for (int k = 0; k < (deal ? 9 : (2048 + F.G - 1) / F.G); ++k) {
        int u;
        if (!deal) { u = F.vcu + k * F.G; if (u >= 2048) break; }
        else if (k < 5) { if (heavy) { if (k >= 3) continue; u = F.bid + 128 * k; } else u = 384 + (F.bid - 128) + 128 * k; }
        else u = 1024 + F.bid + 256 * (k - 5);
        const int set = u >= 1024, oc = u & 1023, ntile = set ? 128 : 512;
        const float* psum = (const float*)(F.ws + WS_PSUM) + (set ? (size_t)512 * FOUT : 0);
        float s = 0.f;
        if (F.tid < ntile) s = psum[(size_t)F.tid * FOUT + oc] + psum[(size_t)F.tid * FOUT + 1024 + oc];
        s = wave_sum(s);
        if (F.lane == 0) red[F.wave] = s;
        __syncthreads();
        float tot = 0.f;
#pragma unroll
        for (int w = 0; w < NWAVES; ++w) tot += red[w];
        const float scale = 1.0f / sqrtf(tot + EPS);
        if (set == 0) { const float* hr = (const float*)(F.ws + WS_HRAW_P); filter_unit<14, 8>(buf, hr + (size_t)oc * 32, hr + (size_t)(1024 + oc) * 32, FOUT * 32, (c32*)(F.ws + WS_KF_P) + (size_t)oc * KFS_P, scale); }
        else          { const float* hr = (const float*)(F.ws + WS_HRAW_S); filter_unit<12, 4>(buf, hr + (size_t)oc * 32, hr + (size_t)(1024 + oc) * 32, FOUT * 32, (c32*)(F.ws + WS_KF_S) + (size_t)oc * KFS_S, scale); }
    }
}
__device__ __forceinline__ void shortconv_transpose(Frame& F, const InTab& A, int l) {
    LAS float* scr = (LAS float*)(F.lds + RING_OFF + F.wave * 16384);
    const int gw = F.vcu * NWAVES + F.wave, NGW = F.G * NWAVES, lane = F.lane;
    const bf16* P = (const bf16*)(F.ws + WS_PROJ); float* HYT = (float*)(F.ws + WS_HYT);
    const float* cw = A.in[I_HCW] + (size_t)l * 3 * NHY; const float* cb = A.in[I_HCB] + (size_t)l * NHY;
    for (int it = gw; it < (T / 64) * (NHY / 32); it += NGW) {
        const int rt = it / (NHY / 32), ct = it % (NHY / 32), r0 = 64 * rt, c0 = 32 * ct;
        int s0, len; seq_bounds(r0, s0, len);
        for (int i = 0; i < 33; ++i) { const int rr = 2 * i + (lane >> 5), r = r0 - 1 + rr;
            float v = 0.f; if (r >= s0 && r < s0 + len) v = bf2f(P[(size_t)r * INW + c0 + (lane & 31)]);
            scr[rr * 33 + (lane & 31)] = v; }
        LDS_WAIT(); asm volatile("" ::: "memory");
        for (int cc = 0; cc < 32; ++cc) { const int c = c0 + cc; const float w0 = cw[c], w1 = cw[NHY + c], w2 = cw[2 * NHY + c], b = cb[c];
            const float v = w0 * scr[lane * 33 + cc] + w1 * scr[(lane + 1) * 33 + cc] + w2 * scr[(lane + 2) * 33 + cc] + b;
            HYT[(size_t)c * T + r0 + lane] = v; }
        LDS_WAIT(); asm volatile("" ::: "memory");
    }
}
__device__ const double ROPE_INV_REV[32] = {0.15915494309189535, 0.11934937021124886, 0.08949940160889101, 0.06711508300522726, 0.050329212104487035, 0.03774158471741977, 0.0283021958306234, 0.02122365276477766,
    0.015915494309189534, 0.011934937021124886, 0.008949940160889102, 0.006711508300522725, 0.005032921210448704, 0.003774158471741977, 0.00283021958306234, 0.0021223652764777662,
    0.0015915494309189536, 0.0011934937021124885, 0.0008949940160889102, 0.0006711508300522726, 0.0005032921210448703, 0.00037741584717419774, 0.00028302195830623395, 0.0002122365276477766,
    0.00015915494309189535, 0.00011934937021124886, 8.949940160889102e-05, 6.711508300522725e-05, 5.0329212104487035e-05, 3.774158471741978e-05, 2.8302195830623396e-05, 2.122365276477766e-05};
__device__ __forceinline__ void qk_norm_rope(Frame& F, const InTab& A, int l) {
    const int gw = F.vcu * NWAVES + F.wave, NGW = F.G * NWAVES, lane = F.lane;
    const bf16* P = (const bf16*)(F.ws + WS_PROJ); bf16* QN = (bf16*)(F.ws + WS_QN); bf16* KN = (bf16*)(F.ws + WS_KN);
    const float gq = A.in[I_QNG][l * HD + lane], gk = A.in[I_KNG][l * HD + lane];
    const double invr = ROPE_INV_REV[lane & 31];
    for (int m = gw; m < T; m += NGW) {
        int s0, len; seq_bounds(m, s0, len);
        double rv = (double)(m - s0) * invr; rv -= floor(rv);
        const float rf = (float)rv, cs = cos_rev(rf), sn = sin_rev(rf);
        for (int h = 0; h < NH + NKV; ++h) {
            const float x = bf2f(P[(size_t)m * INW + COL_Q + h * HD + lane]);
            const float ss = wave_sum(x * x);
            float y = x * (1.0f / sqrtf(ss * (1.f / HD) + EPS)) * (h < NH ? gq : gk);
            const float p = __shfl_xor(y, 32);
            float o = lane < 32 ? y * cs - p * sn : y * cs + p * sn;
            if (h < NH) QN[(size_t)m * ATW + h * HD + lane] = (bf16)f2bf(o * 0.125f); else KN[(size_t)m * KVW + (h - NH) * HD + lane] = (bf16)f2bf(o);
        }
    }
}
__device__ __forceinline__ void hyena_units(Frame& F, const InTab& A, int l) {
    LAS c32* buf = (LAS c32*)(F.lds + RING_OFF);
    LAS float* cws = (LAS float*)(F.lds + SCR_OFF);
    const float* HYT = (const float*)(F.ws + WS_HYT); float* Z2T = (float*)(F.ws + WS_Z2T);
    const float* hb = A.in[I_HYB] + (size_t)l * 2 * HYW;
    const float* cw = A.in[I_HCW] + (size_t)l * 3 * NHY; const float* cb = A.in[I_HCB] + (size_t)l * NHY;
    for (int u = F.vcu; u < 2 * HYW; u += F.G) {
        const int c = u & 511;
        if (F.tid < 12) { const int j = F.tid >> 2, k = F.tid & 3; cws[F.tid] = k < 3 ? cw[k * NHY + j * HYW + c] : cb[j * HYW + c]; }
        __syncthreads();
        float w[12];
#pragma unroll
        for (int i = 0; i < 12; ++i) w[i] = cws[i];
        if (u < HYW) { const size_t o = (size_t)c * TPAD;
            hyena_unit<14, 1, 8>(buf, HYT + o, HYT + (size_t)HYW * TPAD + o, HYT + (size_t)2 * HYW * TPAD + o, w, (const c32*)(F.ws + WS_KF_P) + (size_t)c * KFS_P, (const c32*)(F.ws + WS_KF_P) + (size_t)(512 + c) * KFS_P, hb[c], hb[HYW + c], Z2T + o); }
        else { const size_t o = (size_t)c * TPAD + TP;
            hyena_unit<12, NSB, 8>(buf, HYT + o, HYT + (size_t)HYW * TPAD + o, HYT + (size_t)2 * HYW * TPAD + o, w, (const c32*)(F.ws + WS_KF_S) + (size_t)c * KFS_S, (const c32*)(F.ws + WS_KF_S) + (size_t)(512 + c) * KFS_S, hb[c], hb[HYW + c], Z2T + o); }
    }
}
__device__ __forceinline__ void z2_transpose(Frame& F) {
    LAS float* scr = (LAS float*)(F.lds + RING_OFF + F.wave * 16384);
    const int gw = F.vcu * NWAVES + F.wave, NGW = F.G * NWAVES, lane = F.lane;
    const float* Z2T = (const float*)(F.ws + WS_Z2T); bf16* Z2 = (bf16*)(F.ws + WS_Z2AT);
    for (int it = gw; it < (T / 64) * (HYW / 32); it += NGW) {
        const int rt = it / (HYW / 32), ct = it % (HYW / 32), r0 = 64 * rt, c0 = 32 * ct;
        float r_[32];
#pragma unroll
        for (int cc = 0; cc < 32; ++cc) r_[cc] = Z2T[(size_t)(c0 + cc) * TPAD + r0 + lane];
#pragma unroll
        for (int cc = 0; cc < 32; ++cc) scr[cc * 65 + lane] = r_[cc];
        LDS_WAIT(); asm volatile("" ::: "memory");
        for (int i = 0; i < 32; ++i) { const int rr = 2 * i + (lane >> 5); Z2[(size_t)(r0 + rr) * ZAP + c0 + (lane & 31)] = (bf16)f2bf(scr[(lane & 31) * 65 + rr]); }
        LDS_WAIT(); asm volatile("" ::: "memory");
    }
}
__device__ __forceinline__ void attention_simple(Frame& F, const InTab& A, int l) {
    LAS float* qs = (LAS float*)(F.lds + RING_OFF + F.wave * 4096);
    LAS float* ps = qs + 64;
    const int gw = F.vcu * NWAVES + F.wave, NGW = F.G * NWAVES, lane = F.lane;
    const bf16* P = (const bf16*)(F.ws + WS_PROJ); const bf16* QN = (const bf16*)(F.ws + WS_QN); const bf16* KN = (const bf16*)(F.ws + WS_KN); bf16* AT = (bf16*)(F.ws + WS_Z2AT) + HYW;
    for (int it = gw; it < T * NH; it += NGW) {
        const int m = it >> 3, h = it & 7, kv = h >> 2;
        int s0, len; seq_bounds(m, s0, len);
        const int jlo = max(m - WIN, s0), jhi = min(m + WIN, s0 + len - 1), nk = jhi - jlo + 1;
        qs[lane] = bf2f(QN[(size_t)m * ATW + h * HD + lane]);
        LDS_WAIT(); asm volatile("" ::: "memory");
        const float sink = A.in[I_SINK][l * NH + h];
        float sc[5]; float mx = sink;
#pragma unroll
        for (int r = 0; r < 5; ++r) { const int jj = lane + 64 * r; float s = -1e30f;
            if (jj < nk) { const v4u* kp = (const v4u*)(KN + (size_t)(jlo + jj) * KVW + kv * HD); float a = 0.f;
#pragma unroll
                for (int c = 0; c < 8; ++c) { const v4u w = kp[c]; const LAS float* q = qs + 8 * c;
                    a += q[0] * bflo(w.x) + q[1] * bfhi(w.x) + q[2] * bflo(w.y) + q[3] * bfhi(w.y) + q[4] * bflo(w.z) + q[5] * bfhi(w.z) + q[6] * bflo(w.w) + q[7] * bfhi(w.w); }
                s = a; }
            sc[r] = s; mx = fmaxf(mx, s); }
        mx = wave_max(mx);
        float den = 0.f;
#pragma unroll
        for (int r = 0; r < 5; ++r) { const int jj = lane + 64 * r; const float p = jj < nk ? fast_exp(sc[r] - mx) : 0.f; den += p; ps[jj] = p; }
        den = wave_sum(den) + fast_exp(sink - mx);
        LDS_WAIT(); asm volatile("" ::: "memory");
        float o = 0.f;
        const bf16* vp = P + (size_t)jlo * INW + COL_V + kv * HD + lane;
        for (int j = 0; j < nk; ++j) o += ps[j] * bf2f(vp[(size_t)j * INW]);
        AT[(size_t)m * ZAP + h * HD + lane] = (bf16)f2bf(o / den);
        LDS_WAIT(); asm volatile("" ::: "memory");
    }
}
__device__ __forceinline__ void merge_gates(Frame& F) {
    const bf16* P = (const bf16*)(F.ws + WS_PROJ); const bf16* YH = (const bf16*)(F.ws + WS_YHY); const bf16* YA = (const bf16*)(F.ws + WS_YAT); bf16* MG = (bf16*)(F.ws + WS_MERGED);
    const size_t nthr = (size_t)F.G * NWAVES * 64, t0 = (size_t)F.vcu * NWAVES * 64 + F.tid;
    for (size_t i = t0; i < (size_t)T * D / 8; i += nthr) {
        const size_t m = i >> 7; const int c = (int)(i & 127) * 8;
        const v4u gh = *(const v4u*)(P + m * INW + COL_G + c), ga = *(const v4u*)(P + m * INW + COL_G + D + c), yh = *(const v4u*)(YH + m * D + c), ya = *(const v4u*)(YA + m * D + c);
        v4u o;
#pragma unroll
        for (int k = 0; k < 4; ++k) { const float a = sigmoidf(bflo(gh[k])) * bflo(yh[k]) + sigmoidf(bflo(ga[k])) * bflo(ya[k]), b = sigmoidf(bfhi(gh[k])) * bfhi(yh[k]) + sigmoidf(bfhi(ga[k])) * bfhi(ya[k]); o[k] = pk2(a, b); }
        *(v4u*)(MG + m * D + c) = o;
    }
}
__device__ __forceinline__ void resid_norm_router(Frame& F, const InTab& A, int l) {
    const int gw = F.vcu * NWAVES + F.wave, NGW = F.G * NWAVES, lane = F.lane;
    const float* mod = (const float*)(F.ws + WS_MOD) + (size_t)l * NMOD * 6 * D;
    const float* MIX = (const float*)(F.ws + WS_MIX); bf16* H = (bf16*)(F.ws + WS_H); float* AFFT = (float*)(F.ws + WS_AFFT);
    const float* g2 = A.in[I_N2G] + (size_t)l * D; const float* rw = A.in[I_RW] + (size_t)l * D * NE;
    for (int m = gw; m < T; m += NGW) {
        const f32x4* xr = (const f32x4*)x_row(F, A, l, m) + lane; const f32x4* mx = (const f32x4*)(MIX + (size_t)m * D) + lane;
        const float* mr = mod + (size_t)mod_row(m) * 6 * D;
        f32x4 v[4]; float ss = 0.f;
#pragma unroll
        for (int j = 0; j < 4; ++j) { const int c = 4 * lane + 256 * j; const f32x4 g1 = *(const f32x4*)(mr + 2 * D + c);
            v[j] = xr[64 * j] + g1 * mx[64 * j]; ((f32x4*)(F.out + (size_t)m * D))[lane + 64 * j] = v[j];
            ss += (v[j].x * v[j].x + v[j].y * v[j].y) + (v[j].z * v[j].z + v[j].w * v[j].w); }
        const float rstd = 1.0f / sqrtf(wave_sum(ss) * (1.f / D) + EPS);
        float lg[NE];
#pragma unroll
        for (int e = 0; e < NE; ++e) lg[e] = 0.f;
        unsigned long long* o8 = (unsigned long long*)(H + (size_t)m * D) + lane;
#pragma unroll
        for (int j = 0; j < 4; ++j) { const int c = 4 * lane + 256 * j;
            const f32x4 gg = *(const f32x4*)(g2 + c), sc = *(const f32x4*)(mr + 4 * D + c), sh = *(const f32x4*)(mr + 3 * D + c);
            const f32x4 o = v[j] * rstd * gg * (sc + 1.0f) + sh;
            o8[64 * j] = (unsigned long long)pk2(o.x, o.y) | ((unsigned long long)pk2(o.z, o.w) << 32);
#pragma unroll
            for (int q = 0; q < 4; ++q) { const f32x4* wr = (const f32x4*)(rw + (size_t)(c + q) * NE);
#pragma unroll
                for (int e4 = 0; e4 < 4; ++e4) { const f32x4 w = wr[e4]; lg[4 * e4 + 0] += o[q] * w.x; lg[4 * e4 + 1] += o[q] * w.y; lg[4 * e4 + 2] += o[q] * w.z; lg[4 * e4 + 3] += o[q] * w.w; } } }
        float mxl = -1e30f;
#pragma unroll
        for (int e = 0; e < NE; ++e) { lg[e] = wave_sum(lg[e]); mxl = fmaxf(mxl, lg[e]); }
        float den = 0.f;
#pragma unroll
        for (int e = 0; e < NE; ++e) { lg[e] = expf(lg[e] - mxl); den += lg[e]; }
        const int grp = m >= TG, tg = m - grp * TG;
        float mine = 0.f;
#pragma unroll
        for (int e = 0; e < NE; ++e) mine = lane == e ? lg[e] / den : mine;
        if (lane < NE) AFFT[((size_t)grp * NE + lane) * TG + tg] = mine;
    }
}
__device__ __forceinline__ void topk_rank(Frame& F) {
    const float* AFFT = (const float*)(F.ws + WS_AFFT); int* SLOT = (int*)(F.ws + WS_SLOT); int* IDX = (int*)(F.ws + WS_IDX); float* GV = (float*)(F.ws + WS_GATEV);
    const size_t nthr = (size_t)F.G * NWAVES * 64, t0 = (size_t)F.vcu * NWAVES * 64 + F.tid;
    for (size_t i = t0; i < (size_t)NGRP * NE * TG; i += nthr) {
        const int ge = (int)(i >> 14), t = (int)(i & (TG - 1));
        const float* a = AFFT + (size_t)ge * TG; const float mine = a[t];
        int rank = 0;
        for (int j = 0; j < TG; j += 4) { const f32x4 v = *(const f32x4*)(a + j);
            rank += (v.x > mine || (v.x == mine && j + 0 < t)) ? 1 : 0; rank += (v.y > mine || (v.y == mine && j + 1 < t)) ? 1 : 0;
            rank += (v.z > mine || (v.z == mine && j + 2 < t)) ? 1 : 0; rank += (v.w > mine || (v.w == mine && j + 3 < t)) ? 1 : 0; }
        SLOT[i] = rank < CAP ? rank : -1;
        if (rank < CAP) { IDX[(size_t)ge * CAP + rank] = t; GV[(size_t)ge * CAP + rank] = mine; }
    }
}
__device__ __forceinline__ void gather_rows(Frame& F) {
    const int gw = F.vcu * NWAVES + F.wave, NGW = F.G * NWAVES, lane = F.lane;
    const bf16* __restrict__ H = (const bf16*)(F.ws + WS_H); unsigned char* __restrict__ XE = (unsigned char*)(F.ws + WS_XE); unsigned char* __restrict__ HID = (unsigned char*)(F.ws + WS_HID); const int* __restrict__ IDX = (const int*)(F.ws + WS_IDX);
    for (int sb = gw * 32; sb < NSLOT; sb += NGW * 32) {
        const int grp = sb >> 15, tix = IDX[sb + (lane & 31)];
#pragma unroll
        for (int j = 0; j < 4; ++j) { const int q = j * 64 + lane; *(v4u*)(HID + (size_t)(sb + (q >> 3)) * KB_DN + FF / 2 + 16 * (q & 7)) = (v4u){0u, 0u, 0u, 0u}; }
        for (int i = 0; i < 32; i += 8) {
            v4u a[8], b[8];
#pragma unroll
            for (int k = 0; k < 8; ++k) { const int t = __builtin_amdgcn_readlane(tix, i + k); const v4u* src = (const v4u*)(H + ((size_t)grp * TG + t) * D); a[k] = src[lane]; b[k] = src[64 + lane]; }
#pragma unroll
            for (int k = 0; k < 8; ++k) { unsigned char* dst = XE + (size_t)(sb + i + k) * KB_UP;
                unsigned wa, wb;
                PG8_FP4_PACK8(wa, bflo(a[k].x), bfhi(a[k].x), bflo(a[k].y), bfhi(a[k].y), bflo(a[k].z), bfhi(a[k].z), bflo(a[k].w), bfhi(a[k].w));
                PG8_FP4_PACK8(wb, bflo(b[k].x), bfhi(b[k].x), bflo(b[k].y), bfhi(b[k].y), bflo(b[k].z), bfhi(b[k].z), bflo(b[k].w), bfhi(b[k].w));
                *(unsigned*)(dst + 4 * lane) = wa; *(unsigned*)(dst + 256 + 4 * lane) = wb; }
        }
    }
}
__device__ __forceinline__ void moe_combine(Frame& F, int l) {
    const int gw = F.vcu * NWAVES + F.wave, NGW = F.G * NWAVES, lane = F.lane;
    const float* mod = (const float*)(F.ws + WS_MOD) + (size_t)l * NMOD * 6 * D;
    const int* SLOT = (const int*)(F.ws + WS_SLOT); const float* GV = (const float*)(F.ws + WS_GATEV); const bf16* YE = (const bf16*)(F.ws + WS_YE);
    for (int m = gw; m < T; m += NGW) {
        const int grp = m >= TG, tg = m - grp * TG;
        const float* mr = mod + (size_t)mod_row(m) * 6 * D;
        f32x4 acc[4];
#pragma unroll
        for (int j = 0; j < 4; ++j) acc[j] = (f32x4){0.f, 0.f, 0.f, 0.f};
        for (int e = 0; e < NE; ++e) {
            const int sl = SLOT[((size_t)grp * NE + e) * TG + tg];
            if (sl >= 0) { const size_t row = ((size_t)grp * NE + e) * CAP + sl; const float gt = GV[row]; const v2u* yr = (const v2u*)(YE + row * D) + lane;
#pragma unroll
                for (int j = 0; j < 4; ++j) { const v2u w = yr[64 * j]; acc[j] += (f32x4){bflo(w.x), bfhi(w.x), bflo(w.y), bfhi(w.y)} * gt; } }
        }
        f32x4* xo = (f32x4*)(F.out + (size_t)m * D) + lane;
#pragma unroll
        for (int j = 0; j < 4; ++j) { const f32x4 g2 = *(const f32x4*)(mr + 5 * D + 4 * lane + 256 * j); xo[64 * j] = xo[64 * j] + g2 * acc[j]; }
    }
}

__device__ __forceinline__ void topk_select(Frame& F) {
    LAS unsigned* keys = (LAS unsigned*)(F.lds + RING_OFF);
    LAS unsigned* hist = (LAS unsigned*)(F.lds + RING_OFF + 65536);
    LAS unsigned* misc = (LAS unsigned*)(F.lds + RING_OFF + 65536 + 8192);
    const float* AFFT = (const float*)(F.ws + WS_AFFT); int* SLOT = (int*)(F.ws + WS_SLOT); int* IDX = (int*)(F.ws + WS_IDX); float* GV = (float*)(F.ws + WS_GATEV);
    const int tid = F.tid, lane = F.lane, wave = F.wave;
    for (int u = F.vcu; u < NGRP * NE; u += F.G) {
        const float* a = AFFT + (size_t)u * TG;
        for (int i = tid; i < TG; i += NWAVES * 64) keys[i] = __builtin_bit_cast(unsigned, a[i]);
        unsigned prefix = 0u, mask = 0u, need = CAP;
        for (int pass = 0; pass < 4; ++pass) {
            const int shift = 24 - 8 * pass;
            for (int i = tid; i < NWAVES * 256; i += NWAVES * 64) hist[i] = 0u;
            __syncthreads();
            for (int i = tid; i < TG; i += NWAVES * 64) { const unsigned k = keys[i]; if ((k & mask) == prefix) __hip_atomic_fetch_add(&hist[wave * 256 + ((k >> shift) & 255u)], 1u, __ATOMIC_RELAXED, __HIP_MEMORY_SCOPE_WORKGROUP); }
            __syncthreads();
            if (wave == 0) {
                unsigned h[4];
#pragma unroll
                for (int b = 0; b < 4; ++b) { unsigned s = 0u;
#pragma unroll
                    for (int w = 0; w < NWAVES; ++w) s += hist[w * 256 + 4 * lane + b];
                    h[b] = s; }
                const unsigned mine = h[0] + h[1] + h[2] + h[3];
                unsigned inc = mine;
#pragma unroll
                for (int o = 1; o < 64; o <<= 1) { const unsigned t = __shfl_down(inc, o); if (lane + o < 64) inc += t; }
                unsigned c = inc - mine;
#pragma unroll
                for (int b = 3; b >= 0; --b) { if (c < need && c + h[b] >= need) { misc[0] = (unsigned)(4 * lane + b); misc[1] = need - c; } c += h[b]; }
            }
            __syncthreads();
            prefix |= misc[0] << shift; mask |= 255u << shift; need = misc[1];
            __syncthreads();
        }
        unsigned cg = 0u, ce = 0u;
        for (int r = 0; r < 32; ++r) { const unsigned k = keys[2048 * wave + 64 * r + lane];
            cg += (unsigned)__popcll(__ballot(k > prefix)); ce += (unsigned)__popcll(__ballot(k == prefix)); }
        if (lane == 0) { misc[16 + 2 * wave] = cg; misc[17 + 2 * wave] = ce; }
        __syncthreads();
        unsigned eq_base = 0u, slot_base = 0u;
        for (int w = 0; w < NWAVES; ++w) { const unsigned g = misc[16 + 2 * w], e = misc[17 + 2 * w];
            if (w < wave) { const unsigned take = eq_base >= need ? 0u : ((need - eq_base) < e ? (need - eq_base) : e); slot_base += g + take; eq_base += e; } }
        const unsigned long long below = (1ull << lane) - 1ull;
        for (int r = 0; r < 32; ++r) { const int t = 2048 * wave + 64 * r + lane; const unsigned k = keys[t];
            const unsigned long long beq = __ballot(k == prefix);
            const unsigned eq_rank = eq_base + (unsigned)__popcll(beq & below);
            const bool sel = (k > prefix) || (k == prefix && eq_rank < need);
            const unsigned long long bsel = __ballot(sel);
            const unsigned slot = slot_base + (unsigned)__popcll(bsel & below);
            SLOT[((size_t)(u >> 4) * TG + t) * NE + (u & 15)] = sel ? (int)slot : -1;
            if (sel) { IDX[(size_t)u * CAP + slot] = t; GV[(size_t)u * CAP + slot] = __builtin_bit_cast(float, k); }
            eq_base += (unsigned)__popcll(beq); slot_base += (unsigned)__popcll(bsel); }
        __syncthreads();
    }
}
__device__ __forceinline__ void rope_table(Frame& F) {
    f32x2* RT = (f32x2*)(F.ws + WS_ROPE);
    const int nthr = F.G * NWAVES * 64;
    for (int i = F.vcu * NWAVES * 64 + F.tid; i < TP * 32; i += nthr) { double rv = (double)(i >> 5) * ROPE_INV_REV[i & 31]; rv -= floor(rv); const float rf = (float)rv; RT[i] = (f32x2){cos_rev(rf), sin_rev(rf)}; }
}
constexpr int AT_KP = 72, AT_VP = 388;
__device__ __forceinline__ void attention_mfma(Frame& F, const InTab& A, int l) {
    LAS bf16* Ks = (LAS bf16*)(F.lds + RING_OFF);
    LAS bf16* Vt = (LAS bf16*)(F.lds + RING_OFF + 384 * AT_KP * 2);
    const bf16* P = (const bf16*)(F.ws + WS_PROJ); bf16* AT = (bf16*)(F.ws + WS_Z2AT) + HYW; const f32x2* RT = (const f32x2*)(F.ws + WS_ROPE);
    const float* gqp = A.in[I_QNG] + l * HD; const float* gkp = A.in[I_KNG] + l * HD;
    const int tid = F.tid, lane = F.lane, wave = F.wave, lr = lane & 31, hl = lane >> 5;
    for (int u = F.vcu; u < (T / 128) * NKV; u += F.G) {
        const int kv = u & 1, r0 = (u >> 1) * 128;
        int s0, len; seq_bounds(r0, s0, len);
        for (int i = tid; i < 384 * 8; i += NWAVES * 64) { const int kl = i >> 3, c8 = (i & 7) * 8, row = r0 - 128 + kl;
            const bool ok = row >= s0 && row < s0 + len; const int rc = ok ? row : r0;
            const v4u kraw = *(const v4u*)(P + (size_t)rc * INW + COL_K + kv * HD + c8), vraw = *(const v4u*)(P + (size_t)rc * INW + COL_V + kv * HD + c8);
            float x[8]; float ss = 0.f;
#pragma unroll
            for (int e = 0; e < 4; ++e) { x[2 * e] = bflo(kraw[e]); x[2 * e + 1] = bfhi(kraw[e]); ss += x[2 * e] * x[2 * e] + x[2 * e + 1] * x[2 * e + 1]; }
            ss += __shfl_xor(ss, 1); ss += __shfl_xor(ss, 2); ss += __shfl_xor(ss, 4);
            const float rstd = 1.0f / sqrtf(ss * (1.f / HD) + EPS);
            const f32x2* rt = RT + (size_t)(rc - s0) * 32 + (c8 & 31);
            float o[8];
#pragma unroll
            for (int e = 0; e < 8; ++e) { const float y = x[e] * rstd * gkp[c8 + e]; const float p = __shfl_xor(y, 4); const f32x2 cs = rt[e]; o[e] = c8 < 32 ? y * cs.x - p * cs.y : y * cs.x + p * cs.y; }
            v4u kw = {pk2(o[0], o[1]), pk2(o[2], o[3]), pk2(o[4], o[5]), pk2(o[6], o[7])}; v4u vw = vraw;
            if (!ok) { kw = (v4u){0u, 0u, 0u, 0u}; vw = (v4u){0u, 0u, 0u, 0u}; }
            *(LAS v4u*)(Ks + kl * AT_KP + c8) = kw;
#pragma unroll
            for (int e = 0; e < 4; ++e) { Vt[(c8 + 2 * e) * AT_VP + kl] = (bf16)(vw[e] & 0xffffu); Vt[(c8 + 2 * e + 1) * AT_VP + kl] = (bf16)(vw[e] >> 16); } }
        __syncthreads();
        const int h = kv * 4 + (wave >> 1);
        const float sink = A.in[I_SINK][l * NH + h];
        for (int qt = 0; qt < 2; ++qt) {
            const int qa = 64 * (wave & 1) + 32 * qt;
            bf16x8 Qf[4];
            {
                const int row = r0 + qa + lr; const bf16* qp = P + (size_t)row * INW + COL_Q + h * HD + 8 * hl;
                float x[4][8]; float ss = 0.f;
#pragma unroll
                for (int s = 0; s < 4; ++s) { const v4u w = *(const v4u*)(qp + 16 * s);
#pragma unroll
                    for (int e = 0; e < 4; ++e) { x[s][2 * e] = bflo(w[e]); x[s][2 * e + 1] = bfhi(w[e]); ss += x[s][2 * e] * x[s][2 * e] + x[s][2 * e + 1] * x[s][2 * e + 1]; } }
                ss += __shfl_xor(ss, 32);
                const float rstd = 0.125f / sqrtf(ss * (1.f / HD) + EPS);
                const f32x2* rt = RT + (size_t)(row - s0) * 32 + 8 * hl;
#pragma unroll
                for (int s = 0; s < 2; ++s) { float o1[8], o2[8];
#pragma unroll
                    for (int j = 0; j < 8; ++j) { const int d = 16 * s + 8 * hl + j; const float y1 = x[s][j] * rstd * gqp[d], y2 = x[s + 2][j] * rstd * gqp[d + 32]; const f32x2 cs = rt[16 * s + j];
                        o1[j] = y1 * cs.x - y2 * cs.y; o2[j] = y2 * cs.x + y1 * cs.y; }
                    const v4u a = {pk2(o1[0], o1[1]), pk2(o1[2], o1[3]), pk2(o1[4], o1[5]), pk2(o1[6], o1[7])}, b = {pk2(o2[0], o2[1]), pk2(o2[2], o2[3]), pk2(o2[4], o2[5]), pk2(o2[6], o2[7])};
                    Qf[s] = __builtin_bit_cast(bf16x8, a); Qf[s + 2] = __builtin_bit_cast(bf16x8, b); }
            }
            float m_run = sink, l_run = 0.f;
            f32x16 O0, O1;
#pragma unroll
            for (int r = 0; r < 16; ++r) { O0[r] = 0.f; O1[r] = 0.f; }
            for (int kt = qa >> 5; kt <= (qa >> 5) + 8; ++kt) {
                f32x16 S;
#pragma unroll
                for (int r = 0; r < 16; ++r) S[r] = 0.f;
#pragma unroll
                for (int s = 0; s < 4; ++s) { const bf16x8 Kf = *(const LAS bf16x8*)(Ks + (32 * kt + lr) * AT_KP + 16 * s + 8 * hl); S = __builtin_amdgcn_mfma_f32_32x32x16_bf16(Kf, Qf[s], S, 0, 0, 0); }
                float mt = -1e30f;
#pragma unroll
                for (int r = 0; r < 16; ++r) { const int kl = 32 * kt + (r & 3) + 8 * (r >> 2) + 4 * hl, dlt = qa + lr + 128 - kl, row = r0 - 128 + kl;
                    const bool ok = dlt <= WIN && dlt >= -WIN && row >= s0 && row < s0 + len;
                    S[r] = ok ? S[r] : -1e30f; mt = fmaxf(mt, S[r]); }
                mt = fmaxf(mt, __shfl_xor(mt, 32));
                const float m_new = fmaxf(m_run, mt), sc = fast_exp(m_run - m_new);
                float ps = 0.f;
#pragma unroll
                for (int r = 0; r < 16; ++r) { S[r] = fast_exp(S[r] - m_new); ps += S[r]; }
                l_run = l_run * sc + ps; m_run = m_new;
#pragma unroll
                for (int r = 0; r < 16; ++r) { O0[r] *= sc; O1[r] *= sc; }
#pragma unroll
                for (int sp = 0; sp < 2; ++sp) {
                    v4u pw; pw.x = pk2(S[8 * sp + 0], S[8 * sp + 1]); pw.y = pk2(S[8 * sp + 2], S[8 * sp + 3]); pw.z = pk2(S[8 * sp + 4], S[8 * sp + 5]); pw.w = pk2(S[8 * sp + 6], S[8 * sp + 7]);
                    const bf16x8 Pf = __builtin_bit_cast(bf16x8, pw);
                    const int kb = 32 * kt + 16 * sp + 4 * hl;
                    { const v2u a = *(const LAS v2u*)(Vt + lr * AT_VP + kb), b = *(const LAS v2u*)(Vt + lr * AT_VP + kb + 8); const v4u vv = {a.x, a.y, b.x, b.y};
                      O0 = __builtin_amdgcn_mfma_f32_32x32x16_bf16(__builtin_bit_cast(bf16x8, vv), Pf, O0, 0, 0, 0); }
                    { const v2u a = *(const LAS v2u*)(Vt + (32 + lr) * AT_VP + kb), b = *(const LAS v2u*)(Vt + (32 + lr) * AT_VP + kb + 8); const v4u vv = {a.x, a.y, b.x, b.y};
                      O1 = __builtin_amdgcn_mfma_f32_32x32x16_bf16(__builtin_bit_cast(bf16x8, vv), Pf, O1, 0, 0, 0); }
                }
            }
            const float l_tot = l_run + __shfl_xor(l_run, 32), inv = 1.0f / (l_tot + fast_exp(sink - m_run));
            bf16* orow = AT + (size_t)(r0 + qa + lr) * ZAP + h * HD + 4 * hl;
#pragma unroll
            for (int g = 0; g < 4; ++g) {
                v2u w0; w0.x = pk2(O0[4 * g + 0] * inv, O0[4 * g + 1] * inv); w0.y = pk2(O0[4 * g + 2] * inv, O0[4 * g + 3] * inv); *(v2u*)(orow + 8 * g) = w0;
                v2u w1; w1.x = pk2(O1[4 * g + 0] * inv, O1[4 * g + 1] * inv); w1.y = pk2(O1[4 * g + 2] * inv, O1[4 * g + 3] * inv); *(v2u*)(orow + 32 + 8 * g) = w1; }
        }
        __syncthreads();
    }
}

__device__ __forceinline__ void resid_norm_router2(Frame& F, const InTab& A, int l) {
    LAS float* rwT = (LAS float*)(F.lds + RING_OFF);
    const int gw = F.vcu * NWAVES + F.wave, NGW = F.G * NWAVES, lane = F.lane;
    const float* __restrict__ mod = (const float*)(F.ws + WS_MOD) + (size_t)l * NMOD * 6 * D;
    const float* __restrict__ MIX = (const float*)(F.ws + WS_MIX); bf16* __restrict__ H = (bf16*)(F.ws + WS_H); float* __restrict__ AFFT = (float*)(F.ws + WS_AFFT); float* __restrict__ AFFTOK = (float*)(F.ws + WS_AFFTOK);
    const float* __restrict__ g2 = A.in[I_N2G] + (size_t)l * D; const float* __restrict__ rw = A.in[I_RW] + (size_t)l * D * NE;
    for (int i = F.tid; i < D * NE / 4; i += NWAVES * 64) { const f32x4 w = ((const f32x4*)rw)[i]; const int k = i >> 2, e0 = (i & 3) * 4;
        rwT[(e0 + 0) * D + k] = w.x; rwT[(e0 + 1) * D + k] = w.y; rwT[(e0 + 2) * D + k] = w.z; rwT[(e0 + 3) * D + k] = w.w; }
    __syncthreads();
    f32x4 gg[4];
#pragma unroll
    for (int j = 0; j < 4; ++j) gg[j] = *(const f32x4*)(g2 + 4 * lane + 256 * j);
    f32x4 xn[4], scn[4], shn[4];
#define RR_ISSUE(mm) do { const f32x4* xr_ = (const f32x4*)(F.out + (size_t)(mm) * D) + lane; const float* mr_ = mod + (size_t)mod_row(mm) * 6 * D + 4 * lane; \
        _Pragma("unroll") for (int j = 0; j < 4; ++j) { xn[j] = xr_[64 * j]; scn[j] = *(const f32x4*)(mr_ + 4 * D + 256 * j); shn[j] = *(const f32x4*)(mr_ + 3 * D + 256 * j); } } while (0)
    if (gw < T) RR_ISSUE(gw);
    for (int m = gw; m < T; m += NGW) {
        f32x4 v[4], sc[4], sh[4]; float ss = 0.f;
#pragma unroll
        for (int j = 0; j < 4; ++j) { v[j] = xn[j]; sc[j] = scn[j]; sh[j] = shn[j]; }
        if (m + NGW < T) RR_ISSUE(m + NGW);
#pragma unroll
        for (int j = 0; j < 4; ++j) ss += (v[j].x * v[j].x + v[j].y * v[j].y) + (v[j].z * v[j].z + v[j].w * v[j].w);
        const float rstd = 1.0f / sqrtf(wave_sum(ss) * (1.f / D) + EPS);
        float lg[NE];
#pragma unroll
        for (int e = 0; e < NE; ++e) lg[e] = 0.f;
        unsigned long long* o8 = (unsigned long long*)(H + (size_t)m * D) + lane;
#pragma unroll
        for (int j = 0; j < 4; ++j) { const f32x4 o = v[j] * rstd * gg[j] * (sc[j] + 1.0f) + sh[j];
            o8[64 * j] = (unsigned long long)pk2(o.x, o.y) | ((unsigned long long)pk2(o.z, o.w) << 32);
#pragma unroll
            for (int eh = 0; eh < NE; eh += 8) {
#pragma unroll
                for (int e = eh; e < eh + 8; ++e) { const f32x4 w = *(const LAS f32x4*)(rwT + e * D + 4 * lane + 256 * j); lg[e] += (o.x * w.x + o.y * w.y) + (o.z * w.z + o.w * w.w); }
                asm volatile("" ::: "memory"); } }
        float k8[8], k4[4], k2[2], k1;
#pragma unroll
        for (int i = 0; i < 8; ++i) { const bool hi = lane & 32; const float send = hi ? lg[i] : lg[i + 8], keep = hi ? lg[i + 8] : lg[i]; k8[i] = keep + __shfl_xor(send, 32); }
#pragma unroll
        for (int i = 0; i < 4; ++i) { const bool hi = lane & 16; const float send = hi ? k8[i] : k8[i + 4], keep = hi ? k8[i + 4] : k8[i]; k4[i] = keep + __shfl_xor(send, 16); }
#pragma unroll
        for (int i = 0; i < 2; ++i) { const bool hi = lane & 8; const float send = hi ? k4[i] : k4[i + 2], keep = hi ? k4[i + 2] : k4[i]; k2[i] = keep + __shfl_xor(send, 8); }
        { const bool hi = lane & 4; const float send = hi ? k2[0] : k2[1], keep = hi ? k2[1] : k2[0]; k1 = keep + __shfl_xor(send, 4); }
        k1 += __shfl_xor(k1, 2); k1 += __shfl_xor(k1, 1);
        const int e = ((lane >> 5) & 1) * 8 + ((lane >> 4) & 1) * 4 + ((lane >> 3) & 1) * 2 + ((lane >> 2) & 1);
        const float mxl = wave_max(k1), ex = expf(k1 - mxl), den = wave_sum(ex) * 0.25f;
        const float aff = ex / den;
        const int grp = m >= TG, tg = m - grp * TG;
        if ((lane & 3) == 0) { AFFT[((size_t)grp * NE + e) * TG + tg] = aff; AFFTOK[(size_t)m * NE + e] = aff; }
    }
}
__device__ __forceinline__ void moe_combine2(Frame& F, int l, float zmul, int nl, const float* __restrict__ g1n) {
    const int gw = F.vcu * NWAVES + F.wave, NGW = F.G * NWAVES, lane = F.lane;
    const float* __restrict__ mod = (const float*)(F.ws + WS_MOD) + (size_t)l * NMOD * 6 * D;
    const int* __restrict__ SLOT = (const int*)(F.ws + WS_SLOT); const float* __restrict__ AFFTOK = (const float*)(F.ws + WS_AFFTOK); const bf16* __restrict__ YE = (const bf16*)(F.ws + WS_YE);
    for (int m = gw; m < T; m += NGW) {
        const int grp = m >= TG;
        const int sl = SLOT[(size_t)m * NE + (lane & 15)]; const float gtv = AFFTOK[(size_t)m * NE + (lane & 15)];
        f32x4* xo = (f32x4*)(F.out + (size_t)m * D) + lane;
        const float* __restrict__ mr = mod + (size_t)mod_row(m) * 6 * D;
        f32x4 xv[4], g2[4], acc[4];
#pragma unroll
        for (int j = 0; j < 4; ++j) { xv[j] = xo[64 * j]; g2[j] = *(const f32x4*)(mr + 5 * D + 4 * lane + 256 * j); acc[j] = (f32x4){0.f, 0.f, 0.f, 0.f}; }
        unsigned mask = (unsigned)(__ballot(sl >= 0) & 0xffffull);
        while (mask) {
            const int e0 = __builtin_ctz(mask); mask &= mask - 1u;
            const bool two = mask != 0u; const int e1 = two ? __builtin_ctz(mask) : e0; if (two) mask &= mask - 1u;
            const int s0 = __builtin_amdgcn_readlane(sl, e0), s1 = __builtin_amdgcn_readlane(sl, e1);
            const float t0 = rdlane(gtv, e0), t1 = two ? rdlane(gtv, e1) : 0.f;
            const v2u* __restrict__ y0 = (const v2u*)(YE + (((size_t)grp * NE + e0) * CAP + s0) * D) + lane; const v2u* __restrict__ y1 = (const v2u*)(YE + (((size_t)grp * NE + e1) * CAP + s1) * D) + lane;
            v2u a[4], b[4];
#pragma unroll
            for (int j = 0; j < 4; ++j) { a[j] = y0[64 * j]; b[j] = y1[64 * j]; }
#pragma unroll
            for (int j = 0; j < 4; ++j) { acc[j] += (f32x4){bflo(a[j].x), bfhi(a[j].x), bflo(a[j].y), bfhi(a[j].y)} * t0; acc[j] += (f32x4){bflo(b[j].x), bfhi(b[j].x), bflo(b[j].y), bfhi(b[j].y)} * t1; }
        }
#pragma unroll
        for (int j = 0; j < 4; ++j) { xv[j] = xv[j] + g2[j] * acc[j] * zmul; xo[64 * j] = xv[j]; }
        if (nl >= 0) {
            float ss = 0.f;
#pragma unroll
            for (int j = 0; j < 4; ++j) ss += (xv[j].x * xv[j].x + xv[j].y * xv[j].y) + (xv[j].z * xv[j].z + xv[j].w * xv[j].w);
            const float rstd = 1.0f / sqrtf(wave_sum(ss) * (1.f / D) + EPS);
            const float* __restrict__ mrn = (const float*)(F.ws + WS_MOD) + ((size_t)nl * NMOD + mod_row(m)) * 6 * D;
            unsigned long long* o8 = (unsigned long long*)((bf16*)(F.ws + WS_H) + (size_t)m * D) + lane;
#pragma unroll
            for (int j = 0; j < 4; ++j) { const int cc = 4 * lane + 256 * j;
                const f32x4 gg = *(const f32x4*)(g1n + cc), sc = *(const f32x4*)(mrn + D + cc), sh = *(const f32x4*)(mrn + cc);
                const f32x4 o = xv[j] * rstd * gg * (sc + 1.0f) + sh;
                o8[64 * j] = (unsigned long long)pk2(o.x, o.y) | ((unsigned long long)pk2(o.z, o.w) << 32); }
        }
    }
}

#ifdef PROBE_FP8
typedef int v8i_t __attribute__((ext_vector_type(8)));
__device__ __forceinline__ float fp8p_a(int i, int k) { return (float)(((i * 7 + k * 3) % 5) - 2); }
__device__ __forceinline__ float fp8p_b(int k, int j) { return (float)(((k * 5 + j * 11) % 7) - 3); }
__device__ __forceinline__ int fp8p_k(int lane, int b, int hyp) {
    const int g = lane >> 4;
    if (hyp == 1) return 32 * g + b;
    if (hyp == 2) return 16 * g + (b & 15) + 64 * (b >> 4);
    return 8 * g + (b & 7) + 32 * (b >> 3);
}
__device__ __forceinline__ bool fp8_probe(int lane) {
    v8i_t A, B;
#pragma unroll
    for (int v = 0; v < 8; ++v) { int wa = 0, wb = 0;
        { const int k0 = fp8p_k(lane, 4 * v + 0, PROBE_FP8_HA), k1 = fp8p_k(lane, 4 * v + 1, PROBE_FP8_HA), k2 = fp8p_k(lane, 4 * v + 2, PROBE_FP8_HA), k3 = fp8p_k(lane, 4 * v + 3, PROBE_FP8_HA);
          wa = __builtin_amdgcn_cvt_pk_fp8_f32(fp8p_a(lane & 15, k0), fp8p_a(lane & 15, k1), wa, false); wa = __builtin_amdgcn_cvt_pk_fp8_f32(fp8p_a(lane & 15, k2), fp8p_a(lane & 15, k3), wa, true); }
        { const int k0 = fp8p_k(lane, 4 * v + 0, PROBE_FP8_HB), k1 = fp8p_k(lane, 4 * v + 1, PROBE_FP8_HB), k2 = fp8p_k(lane, 4 * v + 2, PROBE_FP8_HB), k3 = fp8p_k(lane, 4 * v + 3, PROBE_FP8_HB);
          wb = __builtin_amdgcn_cvt_pk_fp8_f32(fp8p_b(k0, lane & 15), fp8p_b(k1, lane & 15), wb, false); wb = __builtin_amdgcn_cvt_pk_fp8_f32(fp8p_b(k2, lane & 15), fp8p_b(k3, lane & 15), wb, true); }
        A[v] = wa; B[v] = wb; }
    f32x4 acc = {0.f, 0.f, 0.f, 0.f};
    acc = __builtin_amdgcn_mfma_scale_f32_16x16x128_f8f6f4(A, B, acc, 0, 0, 0, 0x7F7F7F7F, 0, 0x7F7F7F7F);
    bool bad = false;
#pragma unroll
    for (int r = 0; r < 4; ++r) { const int row = 4 * (lane >> 4) + r, col = lane & 15; float s = 0.f;
        for (int k = 0; k < 128; ++k) s += fp8p_a(row, k) * fp8p_b(k, col);
        bad |= (acc[r] != s); }
    return bad;
}
#endif

#ifdef PROBE_FP4
typedef int v8i_p4 __attribute__((ext_vector_type(8)));
__device__ __forceinline__ float fp4p_a(int i, int k) { return (float)(((i * 7 + k * 3) % 5) - 2); }
__device__ __forceinline__ float fp4p_b(int k, int j) { return (float)(((k * 5 + j * 11) % 7) - 3); }
__device__ __forceinline__ bool fp4_probe(int lane) {
    v8i_p4 A, B;
#pragma unroll
    for (int v = 0; v < 8; ++v) { A[v] = 0; B[v] = 0; }
    const int g = lane >> 4;
#pragma unroll
    for (int v = 0; v < 4; ++v) { unsigned wa = 0u, wb = 0u;
#if PROBE_FP4 == 1
#define FP4P_K(by) const int k0 = 32 * g + 8 * v + 2 * (by), k1 = k0 + 1
#else
#define FP4P_K(by) const int k1 = 32 * g + 8 * v + 2 * (by), k0 = k1 + 1
#endif
#define FP4P_BYTE(by) { FP4P_K(by); wa = __builtin_amdgcn_cvt_scalef32_pk_fp4_f32(wa, fp4p_a(lane & 15, k0), fp4p_a(lane & 15, k1), 1.0f, by); wb = __builtin_amdgcn_cvt_scalef32_pk_fp4_f32(wb, fp4p_b(k0, lane & 15), fp4p_b(k1, lane & 15), 1.0f, by); }
        FP4P_BYTE(0) FP4P_BYTE(1) FP4P_BYTE(2) FP4P_BYTE(3)
#undef FP4P_BYTE
#undef FP4P_K
        A[v] = (int)wa; B[v] = (int)wb; }
    f32x4 acc = {0.f, 0.f, 0.f, 0.f};
    acc = __builtin_amdgcn_mfma_scale_f32_16x16x128_f8f6f4(A, B, acc, 4, 4, 0, 0x7F7F7F7F, 0, 0x7F7F7F7F);
    bool bad = false;
#pragma unroll
    for (int r = 0; r < 4; ++r) { const int row = 4 * (lane >> 4) + r, col = lane & 15; float s = 0.f;
        for (int k = 0; k < 128; ++k) s += fp4p_a(row, k) * fp4p_b(k, col);
        bad |= (acc[r] != s); }
    return bad;
}
#endif

constexpr int PH_PER_LAYER = 14, N_PHASES = 1 + DEPTH * PH_PER_LAYER;
__global__ void __launch_bounds__(NWAVES * 64, 2) mk_fwd(Args args) {
    extern __shared__ __attribute__((aligned(16))) unsigned char lds[];
    Frame F;
    F.lds = (LAS unsigned char*)lds;
    F.MISC = (volatile LAS unsigned*)(F.lds + MISC_OFF);
    F.tid = threadIdx.x; F.lane = F.tid & 63; F.wave = __builtin_amdgcn_readfirstlane(F.tid >> 6);
    F.G = gridDim.x; F.bid = blockIdx.x; { const int bx = blockIdx.x; F.vcu = (F.G % 8 == 0) ? (bx % 8) * (F.G / 8) + bx / 8 : bx; }
    F.ws = args.ws; F.out = args.out; F.ctl = (gu32*)(args.ws + WS_CTL);
    for (int u = F.tid; u < (SCR_OFF - LDSCTL_OFF) / 4; u += NWAVES * 64) ((LAS unsigned*)(F.lds + LDSCTL_OFF))[u] = 0u;
    __syncthreads();
    XcdBarrier bar; bar.bar = (unsigned*)(F.ctl + CW_BAR); bar.x = 0; bar.st = nullptr;
    if (!MK_PER_PHASE) bar = xcd_barrier_post((unsigned*)(F.ctl + CW_BAR), F.MISC + 8);
    const int lo = args.ph_lo, hi = args.ph_hi;
#ifndef PH_MASK
#define PH_MASK 0xFFFFu
#endif
#define PHON(j) (((PH_MASK) >> (j)) & 1u)
#define IN(k) (lo <= (k) && (k) < hi)
#define PH_ENTER() Frame P = F; InTab A; { KargTab t_ = (KargTab)__builtin_amdgcn_kernarg_segment_ptr(); asm volatile("" : "+s"(t_)); A.in.t = t_; { size_t z_ = 0; asm volatile("" : "+s"(z_)); P.ws = args.ws + z_; P.out = args.out + z_; } asm volatile("" : "+v"(P.tid)); asm volatile("" : "+s"(P.vcu)); asm volatile("" : "+s"(P.G)); asm volatile("" : "+s"(P.bid)); P.lane = P.tid & 63; P.wave = __builtin_amdgcn_readfirstlane(P.tid >> 6); }
#ifdef PROBE_SEAM2
#define SEAM(k) do { if (IN(k) && IN((k) + 1)) { xcd_barrier(bar); xcd_barrier(bar); } } while (0)
#else
#define SEAM(k) do { if (IN(k) && IN((k) + 1)) xcd_barrier(bar); } while (0)
#endif

    if (PHON(14) && IN(0)) { PH_ENTER(); adaln_mod(P, A); rope_table(P); convert_small_weights(P, A); convert_moe_weights(P, A, 0); }
    SEAM(0);

    for (int l = 0; l < DEPTH; ++l) {
        const int k0 = 1 + PH_PER_LAYER * l;
        if (PHON(0) && IN(k0 + 0)) { PH_ENTER(); filter_time_tiles(P, A, l); if (l == 0) norm_mod_rows(P, A, l, A.in[I_N1G] + (size_t)l * D, 0, D);
#ifdef PROBE_NORMROWS_TWICE
            norm_mod_rows(P, A, l, A.in[I_N1G] + (size_t)l * D, 0, D);
#endif
#ifdef PROBE_FTILES_TWICE
            filter_time_tiles(P, A, l);
#endif
        }
        SEAM(k0 + 0);
        if (PHON(1) && IN(k0 + 1)) { PH_ENTER();
            { pg8::Gemm g{(const bf16*)(P.ws + WS_H), (const bf16*)(P.ws + WS_WIN) + (size_t)l * INW * D, T, NHY, D, 1 << 30, 1, 0}; pg8::StaticOrder S; S.init(T, NHY, P.G, P.bid);
              pg8::EpiColMajor E{(float*)(P.ws + WS_HYT), TPAD}; pg8::gemm_phase<pg8::EpiColMajor, pg8::StaticOrder, true, true, true>(P.lds + RING_OFF, g, S, E);
#ifdef PROBE_PROJHY_TWICE
              pg8::gemm_phase<pg8::EpiColMajor, pg8::StaticOrder, true, true, true>(P.lds + RING_OFF, g, S, E);
#endif
            }
            { pg8::Gemm g{(const bf16*)(P.ws + WS_H), (const bf16*)(P.ws + WS_WIN) + (size_t)l * INW * D + (size_t)NHY * D, T, INW - NHY, D, 1 << 30, 1, 0}; pg8::StaticOrder S; S.init(T, INW - NHY, P.G, P.bid);
              pg8::EpiBf16<0> E{(bf16*)(P.ws + WS_PROJ) + NHY, INW, nullptr, 0, 0, 1.f}; pg8::gemm_phase<pg8::EpiBf16<0>, pg8::StaticOrder, true, true>(P.lds + RING_OFF, g, S, E);
#ifdef PROBE_PROJREST_TWICE
              pg8::gemm_phase<pg8::EpiBf16<0>, pg8::StaticOrder, true, true>(P.lds + RING_OFF, g, S, E);
#endif
            }
        }
        if (PHON(2) && IN(k0 + 2)) { PH_ENTER(); filter_fft_units(P); }
        SEAM(k0 + 2);
        if (PHON(3) && IN(k0 + 3)) { PH_ENTER(); hyena_units(P, A, l);
#if MK_ATTN_SIMPLE
            attention_simple(P, A, l);
#else
            attention_mfma(P, A, l);
#ifdef PROBE_ATTN_TWICE
            attention_mfma(P, A, l);
#endif
#ifdef PROBE_HYENA_TWICE
            hyena_units(P, A, l);
#endif
#endif
 }
        SEAM(k0 + 3);
        if (PHON(4) && IN(k0 + 4)) { PH_ENTER(); z2_transpose(P); }
        SEAM(k0 + 4);
        if (PHON(5) && IN(k0 + 5)) { PH_ENTER();
            pg8::Gemm g{(const bf16*)(P.ws + WS_Z2AT), (const bf16*)(P.ws + WS_WHY) + (size_t)l * D * ZAP, T, D, ZAP, 1 << 30, 1, 0}; pg8::StaticOrder S; S.init(T, D, P.G, P.bid);
            pg8::EpiGate2 E{(bf16*)(P.ws + WS_MERGED), D, (const bf16*)(P.ws + WS_PROJ) + COL_G, (const bf16*)(P.ws + WS_PROJ) + COL_G + D, INW};
            pg8::gemm_phase<pg8::EpiGate2, pg8::StaticOrder, true, true>(P.lds + RING_OFF, g, S, E); }
        SEAM(k0 + 5);
        if (PHON(7) && IN(k0 + 7)) { PH_ENTER(); pg8::Gemm g{(const bf16*)(P.ws + WS_MERGED), (const bf16*)(P.ws + WS_WO) + (size_t)l * D * D, T, D, D, 1 << 30, 1, 0}; pg8::StaticOrder S; S.init(T, D, P.G, P.bid);
            pg8::EpiResid E{l == 0 ? A.in[I_XP] : (const float*)P.out, l == 0 ? A.in[I_XS] : (const float*)P.out + (size_t)TP * D, P.out, (const float*)(P.ws + WS_MOD) + (size_t)l * NMOD * 6 * D + 2 * D, TP, TS, 6 * D, D};
            pg8::gemm_phase<pg8::EpiResid, pg8::StaticOrder, true, true>(P.lds + RING_OFF, g, S, E); }
        SEAM(k0 + 7);
        if (PHON(8) && IN(k0 + 8)) { PH_ENTER(); resid_norm_router2(P, A, l);
#ifdef PROBE_RESID_TWICE
            if (l == 0) resid_norm_router2(P, A, l);
#endif
        }
        SEAM(k0 + 8);
        if (PHON(9) && IN(k0 + 9)) { PH_ENTER();
#if MK_TOPK_RANK
            topk_rank(P);
#else
            topk_select(P);
#endif
        }
        SEAM(k0 + 9);
        if (PHON(10) && IN(k0 + 10)) { PH_ENTER(); gather_rows(P); }
        SEAM(k0 + 10);
        if (PHON(11) && IN(k0 + 11)) { PH_ENTER(); pg8::Gemm g{(const bf16*)(P.ws + WS_XE), (const bf16*)(P.ws + WS_WGU), NSLOT, 2 * FF, KB_UP / 2, CAP / 256, NE, (size_t)2 * FF * KB_UP}; pg8::StaticOrder S; S.init(NSLOT, 2 * FF, P.G, P.bid);
            pg8::EpiSwiGLU4 E{(unsigned char*)(P.ws + WS_HID), KB_DN, 1.0f / 64.0f, 2.0f}; pg8::gemm_phase4<pg8::EpiSwiGLU4, pg8::StaticOrder, true, true>(P.lds + RING_OFF, g, S, E);
#ifdef PROBE_UPVAR
            __syncthreads(); { pg8::EpiSwiGLU4 E2{(unsigned char*)(P.ws + WS_YE), KB_DN, 1.0f / 64.0f, 2.0f}; pg8::gemm_phase4<pg8::EpiSwiGLU4, pg8::StaticOrder, true, true, PROBE_UPVAR>(P.lds + RING_OFF, g, S, E2); }
#endif
        }
        SEAM(k0 + 11);
        if (PHON(12) && IN(k0 + 12)) { PH_ENTER(); pg8::Gemm g{(const bf16*)(P.ws + WS_HID), (const bf16*)(P.ws + WS_WD), NSLOT, D, KB_DN / 2, CAP / 256, NE, (size_t)D * KB_DN}; pg8::StaticOrder S; S.init(NSLOT, D, P.G, P.bid);
            pg8::EpiBf16S E{(bf16*)(P.ws + WS_YE), D, 1.0f / 256.0f}; pg8::gemm_phase4<pg8::EpiBf16S, pg8::StaticOrder, true, true>(P.lds + RING_OFF, g, S, E); }
        SEAM(k0 + 12);
        if (PHON(13) && IN(k0 + 13)) { PH_ENTER(); moe_combine2(P, l, 1.0f, l + 1 < DEPTH ? l + 1 : -1, A.in[I_N1G] + (size_t)(l + 1 < DEPTH ? l + 1 : 0) * D);
#ifdef PROBE_COMBINE_TWICE
            moe_combine2(P, l, (float)__hip_atomic_load(P.ctl + 8, __ATOMIC_RELAXED, __HIP_MEMORY_SCOPE_AGENT), -1, nullptr);
#endif
            if (l + 1 < DEPTH) convert_moe_weights(P, A, l + 1);
#ifdef PROBE_CONVERT_TWICE
            if (l + 1 < DEPTH) convert_moe_weights<PROBE_CONVERT_TWICE>(P, A, l + 1);
#endif
        }
        SEAM(k0 + 13);
    }
#ifdef PROBE_MFMA
    if (hi == N_PHASES) {
        typedef int pv4 __attribute__((ext_vector_type(4))); typedef int pv8 __attribute__((ext_vector_type(8)));
        f32x4 c0 = {0.f, 0.f, 0.f, 0.f}, c1 = c0, c2 = c0, c3 = c0, c4 = c0, c5 = c0, c6 = c0, c7 = c0; f32x16 d0 = {}, d1 = {}, d2 = {}, d3 = {};
        pv4 a = {0, 0, 0, 0}, b = {0, 0, 0, 0}; pv8 a8 = {}, b8 = {}; int sc = 0x7F7F7F7F; asm volatile("" : "+v"(a), "+v"(b), "+v"(sc), "+v"(a8), "+v"(b8));
#pragma unroll 1
        for (int it = 0; it < PROBE_MFMA_N; ++it) {
#if PROBE_MFMA == 1
#define PM(c) asm volatile("v_mfma_scale_f32_16x16x128_f8f6f4 %0, %1, %2, %0, %3, %3 op_sel_hi:[0,0,0] cbsz:4 blgp:4" : "+v"(c) : "v"(a), "v"(b), "v"(sc))
            PM(c0); PM(c1); PM(c2); PM(c3); PM(c4); PM(c5); PM(c6); PM(c7);
#elif PROBE_MFMA == 2
#define PM(c) asm volatile("v_mfma_f32_16x16x128_f8f6f4 %0, %1, %2, %0 cbsz:4 blgp:4" : "+v"(c) : "v"(a), "v"(b))
            PM(c0); PM(c1); PM(c2); PM(c3); PM(c4); PM(c5); PM(c6); PM(c7);
#elif PROBE_MFMA == 3
#define PM(c) asm volatile("v_mfma_scale_f32_32x32x64_f8f6f4 %0, %1, %2, %0, %3, %3 op_sel_hi:[0,0,0] cbsz:4 blgp:4" : "+v"(c) : "v"(a), "v"(b), "v"(sc))
            PM(d0); PM(d1); PM(d2); PM(d3);
#elif PROBE_MFMA == 4
#define PM(c) asm volatile("v_mfma_scale_f32_16x16x128_f8f6f4 %0, %1, %2, %0, %3, %3 op_sel_hi:[0,0,0]" : "+v"(c) : "v"(a8), "v"(b8), "v"(sc))
            PM(c0); PM(c1); PM(c2); PM(c3); PM(c4); PM(c5); PM(c6); PM(c7);
#elif PROBE_MFMA == 5
#define PM(c) asm volatile("v_mfma_f32_16x16x32_bf16 %0, %1, %2, %0" : "+v"(c) : "v"(a), "v"(b))
            PM(c0); PM(c1); PM(c2); PM(c3); PM(c4); PM(c5); PM(c6); PM(c7);
#endif
        }
        asm volatile("s_nop 15\n\ts_nop 15" ::: "memory");
        const float sum = c0[0] + c1[1] + c2[2] + c3[3] + c4[0] + c5[1] + c6[2] + c7[3] + d0[0] + d1[5] + d2[9] + d3[15];
        if (sum != 0.f) F.out[1] = __builtin_nanf("");
    }
#endif
#ifdef PROBE_FP4
    if (blockIdx.x == 0 && threadIdx.x < 64 && hi == N_PHASES) { const bool bad = fp4_probe((int)threadIdx.x); if (__any(bad) && threadIdx.x == 0) F.out[0] = __builtin_nanf(""); }
#endif
#ifdef PROBE_FP8
    if (blockIdx.x == 0 && threadIdx.x < 64 && hi == N_PHASES) { const bool bad = fp8_probe((int)threadIdx.x); if (__any(bad) && threadIdx.x == 0) F.out[0] = __builtin_nanf(""); }
#endif
#undef IN
#undef SEAM
}

#if defined(__HIP_DEVICE_COMPILE__) && MK_NOPK
#pragma clang attribute pop
#endif
extern "C" void kernel_launch(void* const* d_in, const int* in_sizes, int n_in, void* d_out, int out_size, void* d_ws, size_t ws_size, hipStream_t stream) {
    static int grid = 0;
    if (grid == 0) {
        if (n_in != 30 || in_sizes[0] != TP * D || out_size != T * D || ws_size < WS_END) { fprintf(stderr, "kernel_launch: shape/workspace mismatch: n_in %d in0 %d out %d ws %zu (need %zu); nothing launched\n", n_in, n_in > 0 ? in_sizes[0] : -1, out_size, ws_size, (size_t)WS_END); grid = -1; return; }
        int dev = 0, cus = 0, per_cu = 0;
        if (hipGetDevice(&dev) != hipSuccess || hipDeviceGetAttribute(&cus, hipDeviceAttributeMultiprocessorCount, dev) != hipSuccess) { fprintf(stderr, "kernel_launch: device query failed\n"); grid = -1; return; }
        if (hipFuncSetAttribute((const void*)mk_fwd, hipFuncAttributeMaxDynamicSharedMemorySize, LDS_BYTES) != hipSuccess) { fprintf(stderr, "kernel_launch: hipFuncSetAttribute failed\n"); grid = -1; return; }
        if (hipOccupancyMaxActiveBlocksPerMultiprocessor(&per_cu, (const void*)mk_fwd, NWAVES * 64, LDS_BYTES) != hipSuccess || per_cu < 1) fprintf(stderr, "kernel_launch: note: occupancy query reports %d\n", per_cu);
        (void)hipGetLastError();
        grid = cus;
    }
    if (grid < 0) return;
    if (hipMemsetAsync((char*)d_ws + WS_CTL, 0, CTL_ZERO_BYTES, stream) != hipSuccess) { fprintf(stderr, "kernel_launch: memset failed\n"); return; }
    Args a{};
    for (int i = 0; i < 30; ++i) a.in[i] = (const float*)d_in[i];
    a.out = (float*)d_out; a.ws = (unsigned char*)d_ws;
#if MK_PER_PHASE
    for (int k = 0; k < N_PHASES; ++k) { a.ph_lo = k; a.ph_hi = k + 1; hipLaunchKernelGGL(mk_fwd, dim3(grid), dim3(NWAVES * 64), LDS_BYTES, stream, a); }
#else
    a.ph_lo = 0; a.ph_hi = N_PHASES; hipLaunchKernelGGL(mk_fwd, dim3(grid), dim3(NWAVES * 64), LDS_BYTES, stream, a);
#endif
    const hipError_t le = hipPeekAtLastError();
    if (le != hipSuccess) fprintf(stderr, "kernel_launch: launch failed: %s\n", hipGetErrorName(le));
}
```

```cpp
#include <hip/hip_runtime.h>
#include <cstdio>
#include <cstdint>
#define MK_PER_PHASE 0
#ifndef MK_NOPK
#define MK_NOPK 0
#endif
#if defined(__HIP_DEVICE_COMPILE__) && MK_NOPK
#pragma clang attribute push(__attribute__((target("no-packed-fp32-ops"))), apply_to = function)
#endif
namespace pg8 {
#define PG8_LAS __attribute__((address_space(3)))
typedef unsigned short bf16_t;
typedef short bf16x8 __attribute__((ext_vector_type(8)));
typedef float f32x4 __attribute__((ext_vector_type(4)));
typedef unsigned u32x4 __attribute__((ext_vector_type(4)));
constexpr int BM = 256, BK = 64, HALF = 128, HTB = HALF * BK * 2  , STAGE_BYTES = 8 * HTB, NXCD = 8, WGM = 8;

__host__ __device__ __forceinline__ int lds_byte(int r, int c) { const int st = (r >> 4) * 2 + (c >> 5), rr = r & 15, cc = c & 31, ob = rr * 64 + cc * 2; return st * 1024 + (ob ^ (((ob >> 9) & 1) << 5)); }
__host__ __device__ __forceinline__ void stage_rc(int b, int& R, int& C) { const int st = b / 1024, sb = b % 1024, swz = sb ^ (((sb >> 9) & 1) << 5); R = (st >> 1) * 16 + swz / 64; C = (st & 1) * 32 + (swz % 64) / 2; }
__host__ __device__ __forceinline__ int perm32(int rho) { const int n = rho >> 4, i = rho & 15; return 8 * (i >> 2) + 4 * n + (i & 3); }

struct Unit { int pm, pn; };
struct Gemm { const bf16_t* A; const bf16_t* Bt; int M, N, K; int tpg, ng; size_t gstride; };

struct StaticOrder {
    int nM, nN, nwg, G, c;
    __host__ __device__ void init(int M, int N, int G_, int c_) { nM = M / BM; nN = N / BM; nwg = nM * nN; G = G_; c = c_; }
    __host__ __device__ bool next(int i, Unit& u) const {
        const long L = (long)i * G + c; if (L >= nwg) return false;
        int wgid = (int)L; { const int q = nwg / NXCD, r = nwg % NXCD, xcd = wgid % NXCD, off = wgid / NXCD; wgid = (xcd < r ? xcd * (q + 1) : r * (q + 1) + (xcd - r) * q) + off; }
        const int nig = WGM * nN, gid = wgid / nig, fm = gid * WGM, gsz = (nM - fm) < WGM ? (nM - fm) : WGM;
        u.pm = fm + ((wgid % nig) % gsz); u.pn = (wgid % nig) / gsz; return true;
    }
    __device__ __forceinline__ void a_ready(const Unit&) const {}
    __device__ __forceinline__ void done(const Unit&) const {}
};

__device__ __forceinline__ unsigned cvt_pk_bf16(float lo, float hi) { unsigned r; asm volatile("v_cvt_pk_bf16_f32 %0, %1, %2" : "=v"(r) : "v"(lo), "v"(hi)); return r; }
typedef float f32x2 __attribute__((ext_vector_type(2)));
__device__ __forceinline__ f32x2 gelu_pk(f32x2 v) {
    const f32x2 av = __builtin_elementwise_abs(v), d = av * 0.2316418882f + 1.0f;
    f32x2 t; t.x = __builtin_amdgcn_rcpf(d.x); t.y = __builtin_amdgcn_rcpf(d.y);
    f32x2 q = t * 0.5307027145f + (-0.7265760135f); q = q * t + 0.7107068705f; q = q * t + (-0.142248368f); q = q * t + 0.127414796f; q = q * t;
    const f32x2 s = (v * v) * (-0.72134752044f);
    f32x2 e; e.x = __builtin_amdgcn_exp2f(s.x); e.y = __builtin_amdgcn_exp2f(s.y);
    const f32x2 m = v * (q * e), r = v - m;
    f32x2 o; o.x = v.x < 0.f ? m.x : r.x; o.y = v.y < 0.f ? m.y : r.y; return o;
}

template <int ACT  > struct EpiBf16 {
    static constexpr bool PERM = true, AFTER_DRAIN = false; static constexpr int MID_T = 0; static_assert(ACT == 0 || ACT == 1, "EpiBf16: ACT is 0 (none) or 1 (gelu_pk)");
    bf16_t* O; int ldc; const float* bias; int split_cols; size_t split_stride; float scale0;
    __device__ __forceinline__ void operator()(const f32x4 (&acc)[2][2][4][2], const Unit& u, int wr, int wc, int fr, int fq) const {
        const int row0 = u.pm * BM + wr * 64 + fr; int colt = u.pn * BM; bf16_t* base = O;
        float sc = 1.f; if (split_cols) { const int t = colt / split_cols; base += (size_t)t * split_stride; colt -= t * split_cols; if (t == 0) sc = scale0; }
        const int col0 = colt + wc * 32 + 8 * fq, bcol0 = u.pn * BM + wc * 32 + 8 * fq;
        f32x4 bv[2][2];
#pragma unroll
        for (int bj = 0; bj < 2; ++bj)
#pragma unroll
            for (int n = 0; n < 2; ++n) bv[bj][n] = bias ? *(const f32x4*)(bias + bcol0 + bj * HALF + 4 * n) : (f32x4){0.f, 0.f, 0.f, 0.f};
#pragma unroll
        for (int ai = 0; ai < 2; ++ai)
#pragma unroll
            for (int m = 0; m < 4; ++m) { bf16_t* rowp = base + (size_t)(row0 + ai * HALF + m * 16) * ldc + col0;
#pragma unroll
                for (int bj = 0; bj < 2; ++bj) { f32x4 v0 = acc[ai][bj][m][0] + bv[bj][0], v1 = acc[ai][bj][m][1] + bv[bj][1];
                    if (ACT == 1) { f32x2 a = gelu_pk((f32x2){v0[0], v0[1]}), b = gelu_pk((f32x2){v0[2], v0[3]}), c = gelu_pk((f32x2){v1[0], v1[1]}), d = gelu_pk((f32x2){v1[2], v1[3]});
                        v0 = (f32x4){a.x, a.y, b.x, b.y}; v1 = (f32x4){c.x, c.y, d.x, d.y}; }
                    v0 = v0 * sc; v1 = v1 * sc; u32x4 w; w.x = cvt_pk_bf16(v0[0], v0[1]); w.y = cvt_pk_bf16(v0[2], v0[3]); w.z = cvt_pk_bf16(v1[0], v1[1]); w.w = cvt_pk_bf16(v1[2], v1[3]);
                    *(u32x4*)(rowp + bj * HALF) = w; } }
    }
};

struct EpiF32 {
    static constexpr bool PERM = false, AFTER_DRAIN = false; static constexpr int MID_T = 0;
    float* C; int ldc;
    __device__ __forceinline__ void operator()(const f32x4 (&acc)[2][2][4][2], const Unit& u, int wr, int wc, int fr, int fq) const {
        const int row0 = u.pm * BM + wr * 64 + fr, col0 = u.pn * BM + wc * 32 + 4 * fq;
#pragma unroll
        for (int ai = 0; ai < 2; ++ai)
#pragma unroll
            for (int m = 0; m < 4; ++m) { float* rowp = C + (size_t)(row0 + ai * HALF + m * 16) * ldc + col0;
#pragma unroll
                for (int bj = 0; bj < 2; ++bj)
#pragma unroll
                    for (int n = 0; n < 2; ++n) *(f32x4*)(rowp + bj * HALF + n * 16) = acc[ai][bj][m][n]; }
    }
};
struct EpiSwiGLU {
    static constexpr bool PERM = true, AFTER_DRAIN = false; static constexpr int MID_T = 0;
    bf16_t* O; int ldc;
    __device__ __forceinline__ static float silu(float x) { return x * __builtin_amdgcn_rcpf(1.0f + __builtin_amdgcn_exp2f(-1.4426950408889634f * x)); }
    __device__ __forceinline__ void operator()(const f32x4 (&acc)[2][2][4][2], const Unit& u, int wr, int wc, int fr, int fq) const {
        const int row0 = u.pm * BM + wr * 64 + fr, col0 = u.pn * HALF + wc * 32 + 8 * fq;
#pragma unroll
        for (int ai = 0; ai < 2; ++ai)
#pragma unroll
            for (int m = 0; m < 4; ++m) { bf16_t* rowp = O + (size_t)(row0 + ai * HALF + m * 16) * ldc + col0;
                const f32x4 g0 = acc[ai][0][m][0], g1 = acc[ai][0][m][1], u0 = acc[ai][1][m][0], u1 = acc[ai][1][m][1];
                u32x4 w; w.x = cvt_pk_bf16(silu(g0[0]) * u0[0], silu(g0[1]) * u0[1]); w.y = cvt_pk_bf16(silu(g0[2]) * u0[2], silu(g0[3]) * u0[3]);
                w.z = cvt_pk_bf16(silu(g1[0]) * u1[0], silu(g1[1]) * u1[1]); w.w = cvt_pk_bf16(silu(g1[2]) * u1[2], silu(g1[3]) * u1[3]);
                *(u32x4*)rowp = w; }
    }
};
struct EpiProj {
    static constexpr bool PERM = true, AFTER_DRAIN = false; static constexpr int MID_T = 0;
    bf16_t* O; int ldc; float* HT; int ldt; int NT;
    __device__ __forceinline__ void operator()(const f32x4 (&acc)[2][2][4][2], const Unit& u, int wr, int wc, int fr, int fq) const {
        const int row0 = u.pm * BM + wr * 64 + fr, col0 = u.pn * BM + wc * 32 + 8 * fq;
        if (u.pn < NT) {
#pragma unroll
            for (int ai = 0; ai < 2; ++ai)
#pragma unroll
                for (int m = 0; m < 4; ++m) { float* cp = HT + (size_t)col0 * ldt + (row0 + ai * HALF + m * 16);
#pragma unroll
                    for (int bj = 0; bj < 2; ++bj)
#pragma unroll
                        for (int n = 0; n < 2; ++n)
#pragma unroll
                            for (int e = 0; e < 4; ++e) cp[(size_t)(bj * HALF + 4 * n + e) * ldt] = acc[ai][bj][m][n][e]; }
        } else {
#pragma unroll
            for (int ai = 0; ai < 2; ++ai)
#pragma unroll
                for (int m = 0; m < 4; ++m) { bf16_t* rowp = O + (size_t)(row0 + ai * HALF + m * 16) * ldc + col0;
#pragma unroll
                    for (int bj = 0; bj < 2; ++bj) { const f32x4 v0 = acc[ai][bj][m][0], v1 = acc[ai][bj][m][1];
                        u32x4 w; w.x = cvt_pk_bf16(v0[0], v0[1]); w.y = cvt_pk_bf16(v0[2], v0[3]); w.z = cvt_pk_bf16(v1[0], v1[1]); w.w = cvt_pk_bf16(v1[2], v1[3]);
                        *(u32x4*)(rowp + bj * HALF) = w; } }
        }
    }
};
struct EpiGate {
    static constexpr bool PERM = true, AFTER_DRAIN = false; static constexpr int MID_T = 0;
    bf16_t* O; int ldc; const bf16_t* G; int ldg; int first;
    __device__ __forceinline__ static float sig(float x) { return __builtin_amdgcn_rcpf(1.0f + __builtin_amdgcn_exp2f(-1.4426950408889634f * x)); }
    __device__ __forceinline__ static float lo(unsigned w) { return __builtin_bit_cast(float, w << 16); }
    __device__ __forceinline__ static float hi(unsigned w) { return __builtin_bit_cast(float, w & 0xffff0000u); }
    __device__ __forceinline__ void operator()(const f32x4 (&acc)[2][2][4][2], const Unit& u, int wr, int wc, int fr, int fq) const {
        const int row0 = u.pm * BM + wr * 64 + fr, col0 = u.pn * BM + wc * 32 + 8 * fq;
#pragma unroll
        for (int ai = 0; ai < 2; ++ai)
#pragma unroll
            for (int m = 0; m < 4; ++m) { const size_t row = (size_t)(row0 + ai * HALF + m * 16);
#pragma unroll
                for (int bj = 0; bj < 2; ++bj) { const f32x4 v0 = acc[ai][bj][m][0], v1 = acc[ai][bj][m][1];
                    const u32x4 g = *(const u32x4*)(G + row * ldg + col0 + bj * HALF);
                    float o[8] = {sig(lo(g.x)) * v0[0], sig(hi(g.x)) * v0[1], sig(lo(g.y)) * v0[2], sig(hi(g.y)) * v0[3], sig(lo(g.z)) * v1[0], sig(hi(g.z)) * v1[1], sig(lo(g.w)) * v1[2], sig(hi(g.w)) * v1[3]};
                    u32x4* op = (u32x4*)(O + row * ldc + col0 + bj * HALF);
                    if (!first) { const u32x4 p = *op; o[0] += lo(p.x); o[1] += hi(p.x); o[2] += lo(p.y); o[3] += hi(p.y); o[4] += lo(p.z); o[5] += hi(p.z); o[6] += lo(p.w); o[7] += hi(p.w); }
                    u32x4 w; w.x = cvt_pk_bf16(o[0], o[1]); w.y = cvt_pk_bf16(o[2], o[3]); w.z = cvt_pk_bf16(o[4], o[5]); w.w = cvt_pk_bf16(o[6], o[7]);
                    *op = w; } }
    }
};
struct EpiResid {
    static constexpr bool PERM = false, AFTER_DRAIN = false; static constexpr int MID_T = 0;
    const float* xa; const float* xb; float* out; const float* gbase; int row_split, sub_rows, gstride, ldc;
    __device__ __forceinline__ void operator()(const f32x4 (&acc)[2][2][4][2], const Unit& u, int wr, int wc, int fr, int fq) const {
        const int row0 = u.pm * BM + wr * 64 + fr, col0 = u.pn * BM + wc * 32 + 4 * fq;
#pragma unroll
        for (int ai = 0; ai < 2; ++ai)
#pragma unroll
            for (int m = 0; m < 4; ++m) { const int row = row0 + ai * HALF + m * 16;
                const float* xr = (row < row_split ? xa + (size_t)row * ldc : xb + (size_t)(row - row_split) * ldc) + col0;
                const float* gr = gbase + (size_t)(row < row_split ? 0 : 1 + (row - row_split) / sub_rows) * gstride + col0;
                float* orow = out + (size_t)row * ldc + col0;
                f32x4 xv[2][2], gv[2][2];
#pragma unroll
                for (int bj = 0; bj < 2; ++bj)
#pragma unroll
                    for (int n = 0; n < 2; ++n) { xv[bj][n] = *(const f32x4*)(xr + bj * HALF + n * 16); gv[bj][n] = *(const f32x4*)(gr + bj * HALF + n * 16); }
#pragma unroll
                for (int bj = 0; bj < 2; ++bj)
#pragma unroll
                    for (int n = 0; n < 2; ++n) *(f32x4*)(orow + bj * HALF + n * 16) = xv[bj][n] + gv[bj][n] * acc[ai][bj][m][n]; }
    }
};
struct EpiGate2 {
    static constexpr bool PERM = true, AFTER_DRAIN = false; static constexpr int MID_T = 8;
    bf16_t* O; int ldc; const bf16_t* G1; const bf16_t* G2; int ldg;
    __device__ __forceinline__ static float en(float x) { return __builtin_amdgcn_exp2f(-1.4426950408889634f * x); }
    __device__ __forceinline__ static float lo(unsigned w) { return __builtin_bit_cast(float, w << 16); }
    __device__ __forceinline__ static float hi(unsigned w) { return __builtin_bit_cast(float, w & 0xffff0000u); }
    __device__ __forceinline__ static f32x4 rho4(unsigned a0, unsigned a1, unsigned b0, unsigned b1) {
        f32x4 r; r[0] = (1.f + en(lo(b0))) * __builtin_amdgcn_rcpf(1.f + en(lo(a0))); r[1] = (1.f + en(hi(b0))) * __builtin_amdgcn_rcpf(1.f + en(hi(a0)));
        r[2] = (1.f + en(lo(b1))) * __builtin_amdgcn_rcpf(1.f + en(lo(a1))); r[3] = (1.f + en(hi(b1))) * __builtin_amdgcn_rcpf(1.f + en(hi(a1))); return r; }
    __device__ __forceinline__ void mid(f32x4 (&acc)[2][2][4][2], const Unit& u, int wr, int wc, int fr_, int fq_) const {
        int fr = fr_, fq = fq_; asm volatile("" : "+v"(fr), "+v"(fq));
        const int row0 = u.pm * BM + wr * 64 + fr, col0 = u.pn * BM + wc * 32 + 8 * fq;
#pragma unroll
        for (int ai = 0; ai < 2; ++ai)
#pragma unroll
            for (int mh = 0; mh < 4; mh += 2) {
                u32x4 a[2][2], b[2][2];
#pragma unroll
                for (int mm = 0; mm < 2; ++mm) { const size_t row = (size_t)(row0 + ai * HALF + (mh + mm) * 16);
#pragma unroll
                    for (int bj = 0; bj < 2; ++bj) { a[mm][bj] = *(const u32x4*)(G1 + row * ldg + col0 + bj * HALF); b[mm][bj] = *(const u32x4*)(G2 + row * ldg + col0 + bj * HALF); } }
                asm volatile("" ::: "memory");
#pragma unroll
                for (int mm = 0; mm < 2; ++mm)
#pragma unroll
                    for (int bj = 0; bj < 2; ++bj) { const int m = mh + mm;
                        acc[ai][bj][m][0] = acc[ai][bj][m][0] * rho4(a[mm][bj].x, a[mm][bj].y, b[mm][bj].x, b[mm][bj].y);
                        acc[ai][bj][m][1] = acc[ai][bj][m][1] * rho4(a[mm][bj].z, a[mm][bj].w, b[mm][bj].z, b[mm][bj].w); }
                asm volatile("" ::: "memory");
            }
    }
    __device__ __forceinline__ void operator()(const f32x4 (&acc)[2][2][4][2], const Unit& u, int wr, int wc, int fr, int fq) const {
        const int row0 = u.pm * BM + wr * 64 + fr, col0 = u.pn * BM + wc * 32 + 8 * fq;
#pragma unroll
        for (int ai = 0; ai < 2; ++ai)
#pragma unroll
            for (int m = 0; m < 4; ++m) { const size_t row = (size_t)(row0 + ai * HALF + m * 16);
#pragma unroll
                for (int bj = 0; bj < 2; ++bj) { const f32x4 v0 = acc[ai][bj][m][0], v1 = acc[ai][bj][m][1];
                    const u32x4 b = *(const u32x4*)(G2 + row * ldg + col0 + bj * HALF);
                    u32x4 w;
                    w.x = cvt_pk_bf16(v0[0] * __builtin_amdgcn_rcpf(1.f + en(lo(b.x))), v0[1] * __builtin_amdgcn_rcpf(1.f + en(hi(b.x))));
                    w.y = cvt_pk_bf16(v0[2] * __builtin_amdgcn_rcpf(1.f + en(lo(b.y))), v0[3] * __builtin_amdgcn_rcpf(1.f + en(hi(b.y))));
                    w.z = cvt_pk_bf16(v1[0] * __builtin_amdgcn_rcpf(1.f + en(lo(b.z))), v1[1] * __builtin_amdgcn_rcpf(1.f + en(hi(b.z))));
                    w.w = cvt_pk_bf16(v1[2] * __builtin_amdgcn_rcpf(1.f + en(lo(b.w))), v1[3] * __builtin_amdgcn_rcpf(1.f + en(hi(b.w))));
                    *(u32x4*)(O + row * ldc + col0 + bj * HALF) = w; } }
    }
};
struct EpiColMajor {
    static constexpr bool PERM = false, AFTER_DRAIN = false; static constexpr int MID_T = 0;
    float* HT; int ldt;
    __device__ __forceinline__ void operator()(const f32x4 (&acc)[2][2][4][2], const Unit& u, int wr, int wc, int fr, int fq) const {
        const int row0 = u.pm * BM + wr * 64 + 4 * fq, col0 = u.pn * BM + wc * 32 + fr;
#pragma unroll
        for (int bj = 0; bj < 2; ++bj)
#pragma unroll
            for (int n = 0; n < 2; ++n) { float* cp = HT + (size_t)(col0 + bj * HALF + 16 * n) * ldt + row0;
#pragma unroll
                for (int ai = 0; ai < 2; ++ai)
#pragma unroll
                    for (int m = 0; m < 4; ++m) *(f32x4*)(cp + ai * HALF + 16 * m) = acc[ai][bj][m][n]; }
    }
};
__device__ __forceinline__ float clamp448(float x) { return __builtin_fminf(__builtin_fmaxf(x, -448.f), 448.f); }
__device__ __forceinline__ unsigned pack4_fp8(float a, float b, float c, float d) { int w = __builtin_amdgcn_cvt_pk_fp8_f32(clamp448(a), clamp448(b), 0, false); w = __builtin_amdgcn_cvt_pk_fp8_f32(clamp448(c), clamp448(d), w, true); return (unsigned)w; }
struct EpiSwiGLU8 {
    static constexpr bool PERM = true, AFTER_DRAIN = false; static constexpr int MID_T = 0;
    unsigned char* O; int ldc; float sin, sout;
    __device__ __forceinline__ static float silu(float x) { return x * __builtin_amdgcn_rcpf(1.0f + __builtin_amdgcn_exp2f(-1.4426950408889634f * x)); }
    __device__ __forceinline__ void operator()(const f32x4 (&acc)[2][2][4][2], const Unit& u, int wr, int wc, int fr, int fq) const {
        const int row0 = u.pm * BM + wr * 64 + fr, col0 = u.pn * HALF + wc * 32 + 8 * fq;
#pragma unroll
        for (int ai = 0; ai < 2; ++ai)
#pragma unroll
            for (int m = 0; m < 4; ++m) { unsigned char* rowp = O + (size_t)(row0 + ai * HALF + m * 16) * ldc + col0;
                const f32x4 g0 = acc[ai][0][m][0] * sin, g1 = acc[ai][0][m][1] * sin, u0 = acc[ai][1][m][0] * (sin * sout), u1 = acc[ai][1][m][1] * (sin * sout);
                typedef unsigned u32x2 __attribute__((ext_vector_type(2)));
                u32x2 w; w.x = pack4_fp8(silu(g0[0]) * u0[0], silu(g0[1]) * u0[1], silu(g0[2]) * u0[2], silu(g0[3]) * u0[3]); w.y = pack4_fp8(silu(g1[0]) * u1[0], silu(g1[1]) * u1[1], silu(g1[2]) * u1[2], silu(g1[3]) * u1[3]);
                *(u32x2*)rowp = w; asm volatile("" ::: "memory"); }
    }
};
struct EpiBf16S {
    static constexpr bool PERM = true, AFTER_DRAIN = false; static constexpr int MID_T = 0;
    bf16_t* O; int ldc; float s;
    __device__ __forceinline__ void operator()(const f32x4 (&acc)[2][2][4][2], const Unit& u, int wr, int wc, int fr, int fq) const {
        const int row0 = u.pm * BM + wr * 64 + fr, col0 = u.pn * BM + wc * 32 + 8 * fq;
#pragma unroll
        for (int ai = 0; ai < 2; ++ai)
#pragma unroll
            for (int m = 0; m < 4; ++m) { bf16_t* rowp = O + (size_t)(row0 + ai * HALF + m * 16) * ldc + col0;
#pragma unroll
                for (int bj = 0; bj < 2; ++bj) { const f32x4 v0 = acc[ai][bj][m][0] * s, v1 = acc[ai][bj][m][1] * s;
                    u32x4 w; w.x = cvt_pk_bf16(v0[0], v0[1]); w.y = cvt_pk_bf16(v0[2], v0[3]); w.z = cvt_pk_bf16(v1[0], v1[1]); w.w = cvt_pk_bf16(v1[2], v1[3]);
                    *(u32x4*)(rowp + bj * HALF) = w; } }
    }
};
#define PG8_FP4_PACK8(w, x0, x1, x2, x3, x4, x5, x6, x7) do { (w) = 0u; (w) = __builtin_amdgcn_cvt_scalef32_pk_fp4_f32((w), (x0), (x1), 1.0f, 0); (w) = __builtin_amdgcn_cvt_scalef32_pk_fp4_f32((w), (x2), (x3), 1.0f, 1); \
        (w) = __builtin_amdgcn_cvt_scalef32_pk_fp4_f32((w), (x4), (x5), 1.0f, 2); (w) = __builtin_amdgcn_cvt_scalef32_pk_fp4_f32((w), (x6), (x7), 1.0f, 3); } while (0)
__device__ __forceinline__ float clamp6(float x) { return x; }
struct EpiSwiGLU4 {
    static constexpr bool PERM = true, AFTER_DRAIN = false; static constexpr int MID_T = 0;
    unsigned char* O; int ldc; float sin, sout;
    __device__ __forceinline__ static float silu(float x) { return x * __builtin_amdgcn_rcpf(1.0f + __builtin_amdgcn_exp2f(-1.4426950408889634f * x)); }
    __device__ __forceinline__ void operator()(const f32x4 (&acc)[2][2][4][2], const Unit& u, int wr, int wc, int fr, int fq) const {
        const int row0 = u.pm * BM + wr * 64 + fr, col0 = u.pn * HALF + wc * 32 + 8 * fq;
        const float kexp = -1.4426950408889634f * sin, cden = 1.0f / (sin * sin * sout);
#pragma unroll
        for (int ai = 0; ai < 2; ++ai)
#pragma unroll
            for (int m = 0; m < 4; ++m) { unsigned char* rowp = O + (size_t)(row0 + ai * HALF + m * 16) * ldc + (col0 >> 1);
                const f32x4 ag0 = acc[ai][0][m][0], ag1 = acc[ai][0][m][1], au0 = acc[ai][1][m][0], au1 = acc[ai][1][m][1];
                const f32x4 y0 = ag0 * kexp, y1 = ag1 * kexp; f32x4 e0, e1;
#pragma unroll
                for (int i = 0; i < 4; ++i) { e0[i] = __builtin_amdgcn_exp2f(y0[i]); e1[i] = __builtin_amdgcn_exp2f(y1[i]); }
                const f32x4 d0 = e0 * cden + cden, d1 = e1 * cden + cden; f32x4 r0, r1;
#pragma unroll
                for (int i = 0; i < 4; ++i) { r0[i] = __builtin_amdgcn_rcpf(d0[i]); r1[i] = __builtin_amdgcn_rcpf(d1[i]); }
                const f32x4 o0 = (ag0 * au0) * r0, o1 = (ag1 * au1) * r1;
                unsigned w; PG8_FP4_PACK8(w, o0[0], o0[1], o0[2], o0[3], o1[0], o1[1], o1[2], o1[3]);
                *(unsigned*)rowp = w; asm volatile("" ::: "memory"); }
    }
};

template <class Epi, class Sched, bool ALIGN_EPI = false, bool SP2 = false, bool SWAP = false>
__device__ __forceinline__ void gemm_phase(PG8_LAS unsigned char* lds, const Gemm g, const Sched& S, const Epi& E) {
    int tid_ = threadIdx.x; asm volatile("" : "+v"(tid_));
    const int tid = tid_, wid = __builtin_amdgcn_readfirstlane(tid >> 6), lane = tid & 63, wr = wid >> 2, wc = wid & 3, fr = lane & 15, fq = lane >> 4;
    const int K = g.K, nt = K / BK;
    unsigned voffA[2], voffB[2];
#pragma unroll
    for (int i = 0; i < 2; ++i) { int R, C; stage_rc(tid * 16 + i * 8192, R, C); const int Rb = Epi::PERM ? ((R & ~31) + perm32(R & 31)) : R;
        voffA[i] = (unsigned)(R * K + C) * 2u; voffB[i] = (unsigned)(Rb * K + C) * 2u; }
    const size_t kstep = (size_t)(BK * 2);
    const size_t hstep = (size_t)HALF * K * 2;
    const size_t tstep = 2 * hstep;
    const unsigned ldsw = (unsigned)wid * 1024u;
    const int aoff = lds_byte(wr * 64 + fr, fq * 8), boff = lds_byte(wc * 32 + fr, fq * 8);
#define PG8_SA(b, h) (((b) * 2 + (h)) * HTB)
#define PG8_SB(b, h) ((4 + (b) * 2 + (h)) * HTB)
#define PG8_STAGE(bufoff, gbase, voff) do { _Pragma("unroll") for (int _i = 0; _i < 2; ++_i) \
        __builtin_amdgcn_global_load_lds((const unsigned*)((const char*)(gbase) + (voff)[_i]), (PG8_LAS unsigned*)(lds + (bufoff) + ldsw + _i * 8192), 16, 0, 0); } while (0)
#define PG8_LDA(dst, b, h) do { _Pragma("unroll") for (int m = 0; m < 4; ++m) _Pragma("unroll") for (int k = 0; k < 2; ++k) dst[m][k] = *(const PG8_LAS bf16x8*)(lds + PG8_SA(b, h) + aoff + m * 2048 + k * 1024); } while (0)
#define PG8_LDB(dst, b, h) do { _Pragma("unroll") for (int n = 0; n < 2; ++n) _Pragma("unroll") for (int k = 0; k < 2; ++k) dst[n][k] = *(const PG8_LAS bf16x8*)(lds + PG8_SB(b, h) + boff + n * 2048 + k * 1024); } while (0)
#define PG8_MMA(ai, bj, At, Bt) do { __builtin_amdgcn_s_setprio(1); _Pragma("unroll") for (int m = 0; m < 4; ++m) _Pragma("unroll") for (int n = 0; n < 2; ++n) _Pragma("unroll") for (int k = 0; k < 2; ++k) \
        acc[ai][bj][m][n] = SWAP ? __builtin_amdgcn_mfma_f32_16x16x32_bf16(At[m][k], Bt[n][k], acc[ai][bj][m][n], 0, 0, 0) : __builtin_amdgcn_mfma_f32_16x16x32_bf16(Bt[n][k], At[m][k], acc[ai][bj][m][n], 0, 0, 0); __builtin_amdgcn_s_setprio(0); } while (0)
#define PG8_WAIT_V(n) asm volatile("s_waitcnt vmcnt(" #n ")" ::: "memory")
#define PG8_WAIT_L(n) asm volatile("s_waitcnt lgkmcnt(" #n ")" ::: "memory")
#define PG8_BAR __builtin_amdgcn_s_barrier()
#define PG8_SCHED __builtin_amdgcn_sched_barrier(0)
    Unit cur, nxt; int ui = 0;
    if (!S.next(0, cur)) return;
    f32x4 acc[2][2][4][2];
#pragma unroll
    for (int a = 0; a < 2; ++a)
#pragma unroll
        for (int b = 0; b < 2; ++b)
#pragma unroll
            for (int m = 0; m < 4; ++m)
#pragma unroll
                for (int n = 0; n < 2; ++n) acc[a][b][m][n] = (f32x4){0.f, 0.f, 0.f, 0.f};
    bf16x8 At[4][2], B0[2][2], B1[2][2];
    const char* cA = (const char*)g.A + (size_t)cur.pm * tstep; const char* cB = (const char*)g.Bt + (size_t)((cur.pm / g.tpg) % g.ng) * g.gstride + (size_t)cur.pn * tstep;
    S.a_ready(cur);
    if constexpr (SP2) {
        PG8_STAGE(PG8_SB(0, 0), cB, voffB); PG8_STAGE(PG8_SB(0, 1), cB + hstep, voffB); PG8_STAGE(PG8_SA(0, 0), cA, voffA); PG8_STAGE(PG8_SA(0, 1), cA + hstep, voffA);
        if (wr == 1) PG8_BAR;
        PG8_WAIT_V(2); PG8_BAR;
        PG8_STAGE(PG8_SB(1, 0), cB + kstep, voffB); PG8_STAGE(PG8_SA(1, 0), cA + kstep, voffA); PG8_STAGE(PG8_SB(1, 1), cB + hstep + kstep, voffB);
        PG8_WAIT_V(6); PG8_BAR;
    } else {
        PG8_STAGE(PG8_SB(0, 0), cB, voffB); PG8_STAGE(PG8_SA(0, 0), cA, voffA); PG8_STAGE(PG8_SB(0, 1), cB + hstep, voffB); PG8_STAGE(PG8_SA(0, 1), cA + hstep, voffA);
        if (wr == 1) PG8_BAR;
        PG8_WAIT_V(4); PG8_BAR;
        PG8_STAGE(PG8_SB(1, 0), cB + kstep, voffB); PG8_STAGE(PG8_SA(1, 0), cA + kstep, voffA); PG8_STAGE(PG8_SB(1, 1), cB + hstep + kstep, voffB);
        PG8_WAIT_V(6); PG8_BAR;
    }
    for (;;) {
        const bool has_next = S.next(ui + 1, nxt);
        const char* nA = has_next ? (const char*)g.A + (size_t)nxt.pm * tstep : cA; const char* nB = has_next ? (const char*)g.Bt + (size_t)((nxt.pm / g.tpg) % g.ng) * g.gstride + (size_t)nxt.pn * tstep : cB;
        for (int t = 0; t < nt; t += 2) {
            if constexpr (Epi::MID_T > 0) { if (t == Epi::MID_T) E.mid(acc, cur, wr, wc, fr, fq); }
            const bool last = (t == nt - 2);
            const char* a1 = cA + (size_t)(t + 1) * kstep;
            const char* a2 = last ? nA : cA + (size_t)(t + 2) * kstep; const char* b2 = last ? nB : cB + (size_t)(t + 2) * kstep;
            const char* a3 = a2 + kstep; const char* b3 = b2 + kstep;
            if (last && has_next) S.a_ready(nxt);
            if constexpr (SP2) {
            PG8_LDB(B0, 0, 0); PG8_LDB(B1, 0, 1); PG8_SCHED; PG8_LDA(At, 0, 0); PG8_STAGE(PG8_SA(1, 1), a1 + hstep, voffA);
            PG8_WAIT_V(8); PG8_WAIT_L(0); PG8_BAR; PG8_MMA(0, 0, At, B0); PG8_MMA(0, 1, At, B1); PG8_BAR; PG8_SCHED;
            PG8_LDA(At, 0, 1); PG8_STAGE(PG8_SB(0, 0), b2, voffB); PG8_STAGE(PG8_SB(0, 1), b2 + hstep, voffB); PG8_STAGE(PG8_SA(0, 0), a2, voffA);
            PG8_WAIT_V(8); PG8_WAIT_L(0); PG8_BAR; PG8_MMA(1, 0, At, B0); PG8_MMA(1, 1, At, B1); PG8_BAR; PG8_SCHED;
            PG8_LDB(B0, 1, 0); PG8_LDB(B1, 1, 1); PG8_SCHED; PG8_LDA(At, 1, 0); PG8_STAGE(PG8_SA(0, 1), a2 + hstep, voffA);
            PG8_WAIT_V(8); PG8_WAIT_L(0); PG8_BAR; PG8_MMA(0, 0, At, B0); PG8_MMA(0, 1, At, B1); PG8_BAR; PG8_SCHED;
            PG8_LDA(At, 1, 1); PG8_STAGE(PG8_SB(1, 0), b3, voffB); PG8_STAGE(PG8_SB(1, 1), b3 + hstep, voffB); PG8_STAGE(PG8_SA(1, 0), a3, voffA);
            PG8_WAIT_V(8); PG8_WAIT_L(0); PG8_BAR; PG8_MMA(1, 0, At, B0); PG8_MMA(1, 1, At, B1); PG8_BAR; PG8_SCHED;
            } else {
            PG8_LDB(B0, 0, 0); PG8_SCHED; PG8_LDA(At, 0, 0); PG8_STAGE(PG8_SA(1, 1), a1 + hstep, voffA);
            PG8_WAIT_L(8); PG8_BAR; PG8_WAIT_L(0); PG8_MMA(0, 0, At, B0); PG8_BAR; PG8_SCHED;
            PG8_LDB(B1, 0, 1); PG8_STAGE(PG8_SB(0, 0), b2, voffB);
            PG8_BAR; PG8_WAIT_L(0); PG8_MMA(0, 1, At, B1); PG8_BAR;
            PG8_LDA(At, 0, 1); PG8_STAGE(PG8_SA(0, 0), a2, voffA);
            PG8_BAR; PG8_WAIT_L(0); PG8_MMA(1, 0, At, B0); PG8_BAR; PG8_SCHED;
            PG8_STAGE(PG8_SB(0, 1), b2 + hstep, voffB);
            PG8_WAIT_V(6); PG8_BAR; PG8_MMA(1, 1, At, B1); PG8_BAR;
            PG8_LDB(B0, 1, 0); PG8_SCHED; PG8_LDA(At, 1, 0); PG8_STAGE(PG8_SA(0, 1), a2 + hstep, voffA);
            PG8_WAIT_L(8); PG8_BAR; PG8_WAIT_L(0); PG8_MMA(0, 0, At, B0); PG8_BAR; PG8_SCHED;
            PG8_LDB(B1, 1, 1); PG8_STAGE(PG8_SB(1, 0), b3, voffB);
            PG8_BAR; PG8_WAIT_L(0); PG8_MMA(0, 1, At, B1); PG8_BAR;
            PG8_LDA(At, 1, 1); PG8_STAGE(PG8_SA(1, 0), a3, voffA);
            PG8_BAR; PG8_WAIT_L(0); PG8_MMA(1, 0, At, B0); PG8_BAR; PG8_SCHED;
            PG8_STAGE(PG8_SB(1, 1), b3 + hstep, voffB);
            PG8_WAIT_V(6); PG8_BAR; PG8_MMA(1, 1, At, B1); PG8_BAR;
            }
        }
        if constexpr (ALIGN_EPI) { if (wr == 0) PG8_BAR; }
        if constexpr (!Epi::AFTER_DRAIN) { E(acc, cur, wr, wc, fr, fq); S.done(cur); }
        if (!has_next) break;
#pragma unroll
        for (int a = 0; a < 2; ++a)
#pragma unroll
            for (int b = 0; b < 2; ++b)
#pragma unroll
                for (int m = 0; m < 4; ++m)
#pragma unroll
                    for (int n = 0; n < 2; ++n) acc[a][b][m][n] = (f32x4){0.f, 0.f, 0.f, 0.f};
        cur = nxt; cA = nA; cB = nB; ++ui;
        if constexpr (ALIGN_EPI) { if (wr == 1) PG8_BAR; }
    }
    PG8_WAIT_V(0);
    if constexpr (!ALIGN_EPI) { if (wr == 0) PG8_BAR; }
    PG8_BAR;
    if constexpr (Epi::AFTER_DRAIN) { E.fused(acc, cur, wr, wc, fr, fq, lds, wid, lane); S.done(cur); }
#undef PG8_SA
#undef PG8_SB
#undef PG8_STAGE
#undef PG8_LDA
#undef PG8_LDB
#undef PG8_MMA
#undef PG8_WAIT_V
#undef PG8_WAIT_L
#undef PG8_BAR
#undef PG8_SCHED
}
typedef int v8i_t __attribute__((ext_vector_type(8)));
__host__ __device__ __forceinline__ int lds_byte8(int r, int c16) { return (r >> 4) * 2048 + c16 * 256 + (r & 15) * 16; }
__host__ __device__ __forceinline__ void stage_rc8(int b, int& R, int& C) { R = (b / 2048) * 16 + (b % 256) / 16; C = ((b % 2048) / 256) * 8; }
__device__ __forceinline__ v8i_t ld_frag8(const PG8_LAS unsigned char* p) { const u32x4 a = *(const PG8_LAS u32x4*)p, b = *(const PG8_LAS u32x4*)(p + 256);
    v8i_t r; r[0] = (int)a.x; r[1] = (int)a.y; r[2] = (int)a.z; r[3] = (int)a.w; r[4] = (int)b.x; r[5] = (int)b.y; r[6] = (int)b.z; r[7] = (int)b.w; return r; }
template <class Epi, class Sched, bool ALIGN_EPI = false, bool SP2 = false>
__device__ __forceinline__ void gemm_phase8(PG8_LAS unsigned char* lds, const Gemm g, const Sched& S, const Epi& E) {
    int tid_ = threadIdx.x; asm volatile("" : "+v"(tid_));
    const int tid = tid_, wid = __builtin_amdgcn_readfirstlane(tid >> 6), lane = tid & 63, wr = wid >> 2, wc = wid & 3, fr = lane & 15, fq = lane >> 4;
    const int K = g.K, nt = K / BK;
    unsigned voffA[2], voffB[2];
#pragma unroll
    for (int i = 0; i < 2; ++i) { int R, C; stage_rc8(tid * 16 + i * 8192, R, C); const int Rb = Epi::PERM ? ((R & ~31) + perm32(R & 31)) : R;
        voffA[i] = (unsigned)(R * K + C) * 2u; voffB[i] = (unsigned)(Rb * K + C) * 2u; }
    const size_t kstep = (size_t)(BK * 2);
    const size_t hstep = (size_t)HALF * K * 2;
    const size_t tstep = 2 * hstep;
    const unsigned ldsw = (unsigned)wid * 1024u;
    const int aoff = lds_byte8(wr * 64 + fr, 2 * fq), boff = lds_byte8(wc * 32 + fr, 2 * fq);
#define PG8_SA(b, h) (((b) * 2 + (h)) * HTB)
#define PG8_SB(b, h) ((4 + (b) * 2 + (h)) * HTB)
#define PG8_STAGE(bufoff, gbase, voff) do { _Pragma("unroll") for (int _i = 0; _i < 2; ++_i) \
        __builtin_amdgcn_global_load_lds((const unsigned*)((const char*)(gbase) + (voff)[_i]), (PG8_LAS unsigned*)(lds + (bufoff) + ldsw + _i * 8192), 16, 0, 0); } while (0)
#define PG8_LDA(dst, b, h) do { _Pragma("unroll") for (int m = 0; m < 4; ++m) dst[m] = ld_frag8(lds + PG8_SA(b, h) + aoff + m * 2048); } while (0)
#define PG8_LDB(dst, b, h) do { _Pragma("unroll") for (int n = 0; n < 2; ++n) dst[n] = ld_frag8(lds + PG8_SB(b, h) + boff + n * 2048); } while (0)
#define PG8_MMA(ai, bj, At, Bt) do { __builtin_amdgcn_s_setprio(1); _Pragma("unroll") for (int m = 0; m < 4; ++m) _Pragma("unroll") for (int n = 0; n < 2; ++n) \
        asm volatile("v_mfma_scale_f32_16x16x128_f8f6f4 %0, %1, %2, %0, %3, %3 op_sel_hi:[0,0,0]" : "+v"(acc[ai][bj][m][n]) : "v"(Bt[n]), "v"(At[m]), "v"(one_scale)); __builtin_amdgcn_s_setprio(0); } while (0)
#define PG8_WAIT_V(n) asm volatile("s_waitcnt vmcnt(" #n ")" ::: "memory")
#define PG8_WAIT_L(n) asm volatile("s_waitcnt lgkmcnt(" #n ")" ::: "memory")
#define PG8_BAR __builtin_amdgcn_s_barrier()
#define PG8_SCHED __builtin_amdgcn_sched_barrier(0)
    Unit cur, nxt; int ui = 0;
    if (!S.next(0, cur)) return;
    f32x4 acc[2][2][4][2];
#pragma unroll
    for (int a = 0; a < 2; ++a)
#pragma unroll
        for (int b = 0; b < 2; ++b)
#pragma unroll
            for (int m = 0; m < 4; ++m)
#pragma unroll
                for (int n = 0; n < 2; ++n) acc[a][b][m][n] = (f32x4){0.f, 0.f, 0.f, 0.f};
    v8i_t At[4], B0[2], B1[2]; int one_scale = 0x7F7F7F7F; asm volatile("" : "+v"(one_scale));

    const char* cA = (const char*)g.A + (size_t)cur.pm * tstep; const char* cB = (const char*)g.Bt + (size_t)((cur.pm / g.tpg) % g.ng) * g.gstride + (size_t)cur.pn * tstep;
    S.a_ready(cur);
    if constexpr (SP2) {
        PG8_STAGE(PG8_SB(0, 0), cB, voffB); PG8_STAGE(PG8_SB(0, 1), cB + hstep, voffB); PG8_STAGE(PG8_SA(0, 0), cA, voffA); PG8_STAGE(PG8_SA(0, 1), cA + hstep, voffA);
        if (wr == 1) PG8_BAR;
        PG8_WAIT_V(2); PG8_BAR;
        PG8_STAGE(PG8_SB(1, 0), cB + kstep, voffB); PG8_STAGE(PG8_SA(1, 0), cA + kstep, voffA); PG8_STAGE(PG8_SB(1, 1), cB + hstep + kstep, voffB);
        PG8_WAIT_V(6); PG8_BAR;
    } else {
        PG8_STAGE(PG8_SB(0, 0), cB, voffB); PG8_STAGE(PG8_SA(0, 0), cA, voffA); PG8_STAGE(PG8_SB(0, 1), cB + hstep, voffB); PG8_STAGE(PG8_SA(0, 1), cA + hstep, voffA);
        if (wr == 1) PG8_BAR;
        PG8_WAIT_V(4); PG8_BAR;
        PG8_STAGE(PG8_SB(1, 0), cB + kstep, voffB); PG8_STAGE(PG8_SA(1, 0), cA + kstep, voffA); PG8_STAGE(PG8_SB(1, 1), cB + hstep + kstep, voffB);
        PG8_WAIT_V(6); PG8_BAR;
    }
    for (;;) {
        const bool has_next = S.next(ui + 1, nxt);
        const char* nA = has_next ? (const char*)g.A + (size_t)nxt.pm * tstep : cA; const char* nB = has_next ? (const char*)g.Bt + (size_t)((nxt.pm / g.tpg) % g.ng) * g.gstride + (size_t)nxt.pn * tstep : cB;
#pragma unroll 1
        for (int t = 0; t < nt; t += 2) {
            if constexpr (Epi::MID_T > 0) { if (t == Epi::MID_T) E.mid(acc, cur, wr, wc, fr, fq); }
            const bool last = (t == nt - 2);
            const char* a1 = cA + (size_t)(t + 1) * kstep;
            const char* a2 = last ? nA : cA + (size_t)(t + 2) * kstep; const char* b2 = last ? nB : cB + (size_t)(t + 2) * kstep;
            const char* a3 = a2 + kstep; const char* b3 = b2 + kstep;
            if (last && has_next) S.a_ready(nxt);
            if constexpr (SP2) {
            PG8_LDB(B0, 0, 0); PG8_LDB(B1, 0, 1); PG8_SCHED; PG8_LDA(At, 0, 0); PG8_STAGE(PG8_SA(1, 1), a1 + hstep, voffA);
            PG8_WAIT_V(8); PG8_WAIT_L(0); PG8_BAR; PG8_MMA(0, 0, At, B0); PG8_MMA(0, 1, At, B1); PG8_BAR; PG8_SCHED;
            PG8_LDA(At, 0, 1); PG8_STAGE(PG8_SB(0, 0), b2, voffB); PG8_STAGE(PG8_SB(0, 1), b2 + hstep, voffB); PG8_STAGE(PG8_SA(0, 0), a2, voffA);
            PG8_WAIT_V(8); PG8_WAIT_L(0); PG8_BAR; PG8_MMA(1, 0, At, B0); PG8_MMA(1, 1, At, B1); PG8_BAR; PG8_SCHED;
            PG8_LDB(B0, 1, 0); PG8_LDB(B1, 1, 1); PG8_SCHED; PG8_LDA(At, 1, 0); PG8_STAGE(PG8_SA(0, 1), a2 + hstep, voffA);
            PG8_WAIT_V(8); PG8_WAIT_L(0); PG8_BAR; PG8_MMA(0, 0, At, B0); PG8_MMA(0, 1, At, B1); PG8_BAR; PG8_SCHED;
            PG8_LDA(At, 1, 1); PG8_STAGE(PG8_SB(1, 0), b3, voffB); PG8_STAGE(PG8_SB(1, 1), b3 + hstep, voffB); PG8_STAGE(PG8_SA(1, 0), a3, voffA);
            PG8_WAIT_V(8); PG8_WAIT_L(0); PG8_BAR; PG8_MMA(1, 0, At, B0); PG8_MMA(1, 1, At, B1); PG8_BAR; PG8_SCHED;
            } else {
            PG8_LDB(B0, 0, 0); PG8_SCHED; PG8_LDA(At, 0, 0); PG8_STAGE(PG8_SA(1, 1), a1 + hstep, voffA);
            PG8_WAIT_L(8); PG8_BAR; PG8_WAIT_L(0); PG8_MMA(0, 0, At, B0); PG8_BAR; PG8_SCHED;
            PG8_LDB(B1, 0, 1); PG8_STAGE(PG8_SB(0, 0), b2, voffB);
            PG8_BAR; PG8_WAIT_L(0); PG8_MMA(0, 1, At, B1); PG8_BAR;
            PG8_LDA(At, 0, 1); PG8_STAGE(PG8_SA(0, 0), a2, voffA);
            PG8_BAR; PG8_WAIT_L(0); PG8_MMA(1, 0, At, B0); PG8_BAR; PG8_SCHED;
            PG8_STAGE(PG8_SB(0, 1), b2 + hstep, voffB);
            PG8_WAIT_V(6); PG8_BAR; PG8_MMA(1, 1, At, B1); PG8_BAR;
            PG8_LDB(B0, 1, 0); PG8_SCHED; PG8_LDA(At, 1, 0); PG8_STAGE(PG8_SA(0, 1), a2 + hstep, voffA);
            PG8_WAIT_L(8); PG8_BAR; PG8_WAIT_L(0); PG8_MMA(0, 0, At, B0); PG8_BAR; PG8_SCHED;
            PG8_LDB(B1, 1, 1); PG8_STAGE(PG8_SB(1, 0), b3, voffB);
            PG8_BAR; PG8_WAIT_L(0); PG8_MMA(0, 1, At, B1); PG8_BAR;
            PG8_LDA(At, 1, 1); PG8_STAGE(PG8_SA(1, 0), a3, voffA);
            PG8_BAR; PG8_WAIT_L(0); PG8_MMA(1, 0, At, B0); PG8_BAR; PG8_SCHED;
            PG8_STAGE(PG8_SB(1, 1), b3 + hstep, voffB);
            PG8_WAIT_V(6); PG8_BAR; PG8_MMA(1, 1, At, B1); PG8_BAR;
            }
        }
        if constexpr (ALIGN_EPI) { if (wr == 0) PG8_BAR; }
        asm volatile("s_nop 15\n\ts_nop 15" ::: "memory");
        if constexpr (!Epi::AFTER_DRAIN) { E(acc, cur, wr, wc, fr, fq); S.done(cur); }
        if (!has_next) break;
#pragma unroll
        for (int a = 0; a < 2; ++a)
#pragma unroll
            for (int b = 0; b < 2; ++b)
#pragma unroll
                for (int m = 0; m < 4; ++m)
#pragma unroll
                    for (int n = 0; n < 2; ++n) acc[a][b][m][n] = (f32x4){0.f, 0.f, 0.f, 0.f};
        cur = nxt; cA = nA; cB = nB; ++ui;
        if constexpr (ALIGN_EPI) { if (wr == 1) PG8_BAR; }
    }
    PG8_WAIT_V(0);
    if constexpr (!ALIGN_EPI) { if (wr == 0) PG8_BAR; }
    PG8_BAR;
    if constexpr (Epi::AFTER_DRAIN) { E.fused(acc, cur, wr, wc, fr, fq, lds, wid, lane); S.done(cur); }
#undef PG8_SA
#undef PG8_SB
#undef PG8_STAGE
#undef PG8_LDA
#undef PG8_LDB
#undef PG8_MMA
#undef PG8_WAIT_V
#undef PG8_WAIT_L
#undef PG8_BAR
#undef PG8_SCHED
}
#ifndef PG8_PRIO_MMA
#define PG8_PRIO_MMA 1
#endif
typedef int v4i_t __attribute__((ext_vector_type(4)));
__host__ __device__ __forceinline__ int lds_byte4(int r, int c16) { return r * 128 + ((c16 ^ ((r >> 1) & 7)) << 4); }
__host__ __device__ __forceinline__ void stage_rc4(int b, int& R, int& C) { R = b / 128; C = ((((b % 128) / 16) ^ ((R >> 1) & 7))) * 8; }
template <class Epi, class Sched, bool ALIGN_EPI = false, bool SP2 = false, int VAR = 0  >
__device__ __forceinline__ void gemm_phase4(PG8_LAS unsigned char* lds, const Gemm g, const Sched& S, const Epi& E) {
    int tid_ = threadIdx.x; asm volatile("" : "+v"(tid_));
    const int tid = tid_, wid = __builtin_amdgcn_readfirstlane(tid >> 6), lane = tid & 63, wr = wid >> 2, wc = wid & 3, fr = lane & 15, fq = lane >> 4;
    const int K = g.K, nt = K / BK;
    unsigned voffA[2], voffB[2];
#pragma unroll
    for (int i = 0; i < 2; ++i) { int R, C; stage_rc4(tid * 16 + i * 8192, R, C); const int Rb = Epi::PERM ? ((R & ~31) + perm32(R & 31)) : R;
        voffA[i] = (unsigned)(R * K + C) * 2u; voffB[i] = (unsigned)(Rb * K + C) * 2u; }
    const size_t kstep = (size_t)(BK * 2);
    const size_t hstep = (size_t)HALF * K * 2;
    const size_t tstep = 2 * hstep;
    const unsigned ldsw = (unsigned)wid * 1024u;
    const int aoff[2] = {lds_byte4(wr * 64 + fr, fq), lds_byte4(wr * 64 + fr, 4 + fq)}, boff[2] = {lds_byte4(wc * 32 + fr, fq), lds_byte4(wc * 32 + fr, 4 + fq)};
#define PG8_SA(b, h) (((b) * 2 + (h)) * HTB)
#define PG8_SB(b, h) ((4 + (b) * 2 + (h)) * HTB)
#define PG8_STAGE(bufoff, gbase, voff) do { if constexpr ((VAR & 4) == 0) _Pragma("unroll") for (int _i = 0; _i < 2; ++_i) \
        __builtin_amdgcn_global_load_lds((const unsigned*)((const char*)(gbase) + (voff)[_i]), (PG8_LAS unsigned*)(lds + (bufoff) + ldsw + _i * 8192), 16, 0, 0); } while (0)
#define PG8_LDA(dst, b, h) do { if constexpr ((VAR & 2) == 0) _Pragma("unroll") for (int m = 0; m < 4; ++m) _Pragma("unroll") for (int k = 0; k < 2; ++k) dst[m][k] = *(const PG8_LAS v4i_t*)(lds + PG8_SA(b, h) + aoff[k] + m * 2048); } while (0)
#define PG8_LDB(dst, b, h) do { if constexpr ((VAR & 2) == 0) _Pragma("unroll") for (int n = 0; n < 2; ++n) _Pragma("unroll") for (int k = 0; k < 2; ++k) dst[n][k] = *(const PG8_LAS v4i_t*)(lds + PG8_SB(b, h) + boff[k] + n * 2048); } while (0)
#define PG8_MMA(ai, bj, At, Bt) do { __builtin_amdgcn_s_setprio(PG8_PRIO_MMA); if constexpr ((VAR & 1) == 0) _Pragma("unroll") for (int k = 0; k < 2; ++k) _Pragma("unroll") for (int m = 0; m < 4; ++m) _Pragma("unroll") for (int n = 0; n < 2; ++n)   \
        asm volatile("v_mfma_scale_f32_16x16x128_f8f6f4 %0, %1, %2, %0, %3, %3 op_sel_hi:[0,0,0] cbsz:4 blgp:4" : "+v"(acc[ai][bj][m][n]) : "v"(Bt[n][k]), "v"(At[m][k]), "v"(one_scale)); __builtin_amdgcn_s_setprio(1 - PG8_PRIO_MMA); } while (0)
#define PG8_WAIT_V(n) asm volatile("s_waitcnt vmcnt(" #n ")" ::: "memory")
#define PG8_WAIT_L(n) asm volatile("s_waitcnt lgkmcnt(" #n ")" ::: "memory")
#define PG8_BAR __builtin_amdgcn_s_barrier()
#define PG8_SCHED __builtin_amdgcn_sched_barrier(0)
    Unit cur, nxt; int ui = 0;
    if (!S.next(0, cur)) return;
    f32x4 acc[2][2][4][2];
#pragma unroll
    for (int a = 0; a < 2; ++a)
#pragma unroll
        for (int b = 0; b < 2; ++b)
#pragma unroll
            for (int m = 0; m < 4; ++m)
#pragma unroll
                for (int n = 0; n < 2; ++n) acc[a][b][m][n] = (f32x4){0.f, 0.f, 0.f, 0.f};
    v4i_t At[4][2] = {}, B0[2][2] = {}, B1[2][2] = {}; if constexpr (VAR != 0) { _Pragma("unroll") for (int m = 0; m < 4; ++m) _Pragma("unroll") for (int k = 0; k < 2; ++k) asm volatile("" : "+v"(At[m][k])); _Pragma("unroll") for (int n = 0; n < 2; ++n) _Pragma("unroll") for (int k = 0; k < 2; ++k) asm volatile("" : "+v"(B0[n][k]), "+v"(B1[n][k])); }
    int one_scale = 0x7F7F7F7F; asm volatile("" : "+v"(one_scale));

    const char* cA = (const char*)g.A + (size_t)cur.pm * tstep; const char* cB = (const char*)g.Bt + (size_t)((cur.pm / g.tpg) % g.ng) * g.gstride + (size_t)cur.pn * tstep;
    S.a_ready(cur);
    if constexpr (SP2) {
        PG8_STAGE(PG8_SB(0, 0), cB, voffB); PG8_STAGE(PG8_SB(0, 1), cB + hstep, voffB); PG8_STAGE(PG8_SA(0, 0), cA, voffA); PG8_STAGE(PG8_SA(0, 1), cA + hstep, voffA);
        if (wr == 1) PG8_BAR;
        PG8_WAIT_V(2); PG8_BAR;
        PG8_STAGE(PG8_SB(1, 0), cB + kstep, voffB); PG8_STAGE(PG8_SA(1, 0), cA + kstep, voffA); PG8_STAGE(PG8_SB(1, 1), cB + hstep + kstep, voffB);
        PG8_WAIT_V(6); PG8_BAR;
    } else {
        PG8_STAGE(PG8_SB(0, 0), cB, voffB); PG8_STAGE(PG8_SA(0, 0), cA, voffA); PG8_STAGE(PG8_SB(0, 1), cB + hstep, voffB); PG8_STAGE(PG8_SA(0, 1), cA + hstep, voffA);
        if (wr == 1) PG8_BAR;
        PG8_WAIT_V(4); PG8_BAR;
        PG8_STAGE(PG8_SB(1, 0), cB + kstep, voffB); PG8_STAGE(PG8_SA(1, 0), cA + kstep, voffA); PG8_STAGE(PG8_SB(1, 1), cB + hstep + kstep, voffB);
        PG8_WAIT_V(6); PG8_BAR;
    }
    for (;;) {
        const bool has_next = S.next(ui + 1, nxt);
        const char* nA = has_next ? (const char*)g.A + (size_t)nxt.pm * tstep : cA; const char* nB = has_next ? (const char*)g.Bt + (size_t)((nxt.pm / g.tpg) % g.ng) * g.gstride + (size_t)nxt.pn * tstep : cB;
#pragma unroll 1
        for (int t = 0; t < nt; t += 2) {
            if constexpr (Epi::MID_T > 0) { if (t == Epi::MID_T) E.mid(acc, cur, wr, wc, fr, fq); }
            const bool last = (t == nt - 2);
            const char* a1 = cA + (size_t)(t + 1) * kstep;
            const char* a2 = last ? nA : cA + (size_t)(t + 2) * kstep; const char* b2 = last ? nB : cB + (size_t)(t + 2) * kstep;
            const char* a3 = a2 + kstep; const char* b3 = b2 + kstep;
            if (last && has_next) S.a_ready(nxt);
            if constexpr (SP2) {
            PG8_LDB(B0, 0, 0); PG8_LDB(B1, 0, 1); PG8_SCHED; PG8_LDA(At, 0, 0); PG8_STAGE(PG8_SA(1, 1), a1 + hstep, voffA);
            PG8_WAIT_V(8); PG8_WAIT_L(0); PG8_BAR; PG8_MMA(0, 0, At, B0); PG8_MMA(0, 1, At, B1); PG8_BAR; PG8_SCHED;
            PG8_LDA(At, 0, 1); PG8_STAGE(PG8_SB(0, 0), b2, voffB); PG8_STAGE(PG8_SB(0, 1), b2 + hstep, voffB); PG8_STAGE(PG8_SA(0, 0), a2, voffA);
            PG8_WAIT_V(8); PG8_WAIT_L(0); PG8_BAR; PG8_MMA(1, 0, At, B0); PG8_MMA(1, 1, At, B1); PG8_BAR; PG8_SCHED;
            PG8_LDB(B0, 1, 0); PG8_LDB(B1, 1, 1); PG8_SCHED; PG8_LDA(At, 1, 0); PG8_STAGE(PG8_SA(0, 1), a2 + hstep, voffA);
            PG8_WAIT_V(8); PG8_WAIT_L(0); PG8_BAR; PG8_MMA(0, 0, At, B0); PG8_MMA(0, 1, At, B1); PG8_BAR; PG8_SCHED;
            PG8_LDA(At, 1, 1); PG8_STAGE(PG8_SB(1, 0), b3, voffB); PG8_STAGE(PG8_SB(1, 1), b3 + hstep, voffB); PG8_STAGE(PG8_SA(1, 0), a3, voffA);
            PG8_WAIT_V(8); PG8_WAIT_L(0); PG8_BAR; PG8_MMA(1, 0, At, B0); PG8_MMA(1, 1, At, B1); PG8_BAR; PG8_SCHED;
            } else {
            PG8_LDB(B0, 0, 0); PG8_SCHED; PG8_LDA(At, 0, 0); PG8_STAGE(PG8_SA(1, 1), a1 + hstep, voffA);
            PG8_WAIT_L(8); PG8_BAR; PG8_WAIT_L(0); PG8_MMA(0, 0, At, B0); PG8_BAR; PG8_SCHED;
            PG8_LDB(B1, 0, 1); PG8_STAGE(PG8_SB(0, 0), b2, voffB);
            PG8_BAR; PG8_WAIT_L(0); PG8_MMA(0, 1, At, B1); PG8_BAR;
            PG8_LDA(At, 0, 1); PG8_STAGE(PG8_SA(0, 0), a2, voffA);
            PG8_BAR; PG8_WAIT_L(0); PG8_MMA(1, 0, At, B0); PG8_BAR; PG8_SCHED;
            PG8_STAGE(PG8_SB(0, 1), b2 + hstep, voffB);
            PG8_WAIT_V(6); PG8_BAR; PG8_MMA(1, 1, At, B1); PG8_BAR;
            PG8_LDB(B0, 1, 0); PG8_SCHED; PG8_LDA(At, 1, 0); PG8_STAGE(PG8_SA(0, 1), a2 + hstep, voffA);
            PG8_WAIT_L(8); PG8_BAR; PG8_WAIT_L(0); PG8_MMA(0, 0, At, B0); PG8_BAR; PG8_SCHED;
            PG8_LDB(B1, 1, 1); PG8_STAGE(PG8_SB(1, 0), b3, voffB);
            PG8_BAR; PG8_WAIT_L(0); PG8_MMA(0, 1, At, B1); PG8_BAR;
            PG8_LDA(At, 1, 1); PG8_STAGE(PG8_SA(1, 0), a3, voffA);
            PG8_BAR; PG8_WAIT_L(0); PG8_MMA(1, 0, At, B0); PG8_BAR; PG8_SCHED;
            PG8_STAGE(PG8_SB(1, 1), b3 + hstep, voffB);
            PG8_WAIT_V(6); PG8_BAR; PG8_MMA(1, 1, At, B1); PG8_BAR;
            }
        }
        if constexpr (ALIGN_EPI) { if (wr == 0) PG8_BAR; }
        asm volatile("s_nop 15\n\ts_nop 15" ::: "memory");
        if constexpr (!Epi::AFTER_DRAIN && (VAR & 8) == 0) { E(acc, cur, wr, wc, fr, fq); S.done(cur); }
        if (!has_next) break;
#pragma unroll
        for (int a = 0; a < 2; ++a)
#pragma unroll
            for (int b = 0; b < 2; ++b)
#pragma unroll
                for (int m = 0; m < 4; ++m)
#pragma unroll
                    for (int n = 0; n < 2; ++n) acc[a][b][m][n] = (f32x4){0.f, 0.f, 0.f, 0.f};
        cur = nxt; cA = nA; cB = nB; ++ui;
        if constexpr (ALIGN_EPI) { if (wr == 1) PG8_BAR; }
    }
    PG8_WAIT_V(0);
    if constexpr (!ALIGN_EPI) { if (wr == 0) PG8_BAR; }
    PG8_BAR;
    if constexpr (Epi::AFTER_DRAIN) { E.fused(acc, cur, wr, wc, fr, fq, lds, wid, lane); S.done(cur); }
#undef PG8_SA
#undef PG8_SB
#undef PG8_STAGE
#undef PG8_LDA
#undef PG8_LDB
#undef PG8_MMA
#undef PG8_WAIT_V
#undef PG8_WAIT_L
#undef PG8_BAR
#undef PG8_SCHED
}
}
constexpr int NWAVES = 8;
#ifndef MK_ATTN_SIMPLE
#define MK_ATTN_SIMPLE 0
#endif
#ifndef MK_TOPK_RANK
#define MK_TOPK_RANK 0
#endif
#ifndef MK_PER_PHASE
#define MK_PER_PHASE 0
#endif

constexpr int D = 1024, TP = 16384, TS = 4096, NSB = 4, T = TP + NSB * TS;
constexpr int DEPTH = 2, NMOD = 5;
constexpr int HYW = 512, NHY = 3 * HYW, ATW = 512, KVW = 128, INW = 4352;
constexpr int COL_Q = 1536, COL_K = 2048, COL_V = 2176, COL_G = 2304;
constexpr int NH = 8, NKV = 2, HD = 64, WIN = 128;
constexpr int NE = 16, CAP = 2048, FF = 2816, NGRP = 2, TG = 16384;
constexpr int NSLOT = NGRP * NE * CAP;
constexpr float EPS = 1e-6f;
constexpr int FH = 64, FEMB = 33, FOUT = 2048;
constexpr int TPAD = T + 64;
constexpr int KB_UP = D / 2, KB_DN = 1536;
constexpr int KFS_P = 16392, KFS_S = 4104;

constexpr size_t MiB = 1u << 20;
constexpr size_t WS_CTL = 0, CTL_ZERO_BYTES = 1 * MiB;
constexpr size_t WS_MOD = 1 * MiB;
constexpr size_t WS_PSUM = 2 * MiB;
constexpr size_t WS_AFFT = 7 * MiB;
constexpr size_t WS_SLOT = 9 * MiB;
constexpr size_t WS_IDX = 11 * MiB;
constexpr size_t WS_GATEV = 11 * MiB + 512 * 1024;
constexpr size_t WS_ROPE = 12 * MiB;
constexpr size_t WS_WIN = 16 * MiB;
constexpr size_t WS_WHY = 33 * MiB;
constexpr size_t WS_WAT = 35 * MiB;
constexpr size_t WS_WO = 37 * MiB;
constexpr size_t WS_AFFTOK = 41 * MiB;
constexpr size_t WS_WOUT = 43 * MiB;
constexpr size_t WS_WGU = 48 * MiB;
constexpr size_t WS_WD = 224 * MiB;
constexpr size_t WS_H = 312 * MiB;
constexpr size_t WS_R1 = 376 * MiB;
constexpr size_t WS_HRAW_P = WS_R1, WS_HRAW_S = WS_R1 + 128 * MiB;
constexpr size_t WS_Z2T = WS_R1, WS_Z2AT = WS_R1 + 65 * MiB;
constexpr int ZAP = 2 * HYW;
constexpr size_t WS_KF_P = 536 * MiB, WS_KF_S = 665 * MiB;
constexpr size_t WS_YHY = 536 * MiB, WS_YAT = 600 * MiB;
constexpr size_t WS_HYT = 698 * MiB;
constexpr size_t WS_MERGED = 698 * MiB, WS_MIX = 762 * MiB;
constexpr size_t WS_PROJ = 891 * MiB;
constexpr size_t WS_QN = 1162 * MiB, WS_KN = 1194 * MiB;
constexpr size_t WS_XE = 376 * MiB, WS_HID = 504 * MiB, WS_YE = 856 * MiB;
constexpr size_t WS_END = 1202 * MiB;
static_assert(WS_KF_P + (size_t)1024 * KFS_P * 8 <= WS_KF_S && WS_KF_S + (size_t)1024 * KFS_S * 8 <= WS_HYT && WS_HYT + (size_t)NHY * TPAD * 4 <= WS_PROJ && WS_PROJ + (size_t)T * INW * 2 <= WS_END && WS_Z2T + (size_t)HYW * TPAD * 4 <= WS_Z2AT && WS_Z2AT + (size_t)T * ZAP * 2 <= WS_R1 + 160 * MiB, "ws map");
static_assert(WS_HID + (size_t)NSLOT * FF * 2 <= WS_YE && WS_YE + (size_t)NSLOT * D * 2 <= WS_END && WS_WGU + (size_t)NE * 2 * FF * D * 2 <= WS_WD && WS_WD + (size_t)NE * D * FF * 2 <= WS_H, "ws map 2");
constexpr int CW_BAR = 4096;

constexpr int RING_OFF = 0, RING_BYTES = 139264;
constexpr int LDSCTL_OFF = RING_BYTES, MISC_OFF = LDSCTL_OFF + 320;
constexpr int SCR_OFF = RING_BYTES + 1024;
constexpr int LDS_BYTES = 151552;
static_assert(MISC_OFF + 128 <= SCR_OFF && SCR_OFF + 8192 <= LDS_BYTES, "LDS map");

#define GAS __attribute__((address_space(1)))
#define LAS __attribute__((address_space(3)))
typedef unsigned short bf16;
typedef unsigned v4u __attribute__((ext_vector_type(4)));
typedef unsigned v2u __attribute__((ext_vector_type(2)));
typedef float f32x4 __attribute__((ext_vector_type(4)));
typedef float f32x2 __attribute__((ext_vector_type(2)));
typedef float f32x16 __attribute__((ext_vector_type(16)));
typedef short bf16x8 __attribute__((ext_vector_type(8)));
typedef GAS unsigned gu32;
#define RLX_AGENT __ATOMIC_RELAXED, __HIP_MEMORY_SCOPE_AGENT
#define LDS_WAIT() asm volatile("s_waitcnt lgkmcnt(0)" ::: "memory")
#define VM_WAIT() asm volatile("s_waitcnt vmcnt(0)" ::: "memory")
__device__ __forceinline__ unsigned f2bf(float f) { unsigned u = __builtin_bit_cast(unsigned, f); return (u + 0x7fffu + ((u >> 16) & 1u)) >> 16; }
__device__ __forceinline__ unsigned pk2(float lo, float hi) { return f2bf(lo) | (f2bf(hi) << 16); }
__device__ __forceinline__ float bf2f(unsigned b) { return __builtin_bit_cast(float, b << 16); }
__device__ __forceinline__ float bflo(unsigned w) { return __builtin_bit_cast(float, w << 16); }
__device__ __forceinline__ float bfhi(unsigned w) { return __builtin_bit_cast(float, w & 0xffff0000u); }
__device__ __forceinline__ float wave_sum(float v) {
#pragma unroll
    for (int o = 1; o < 64; o <<= 1) v += __shfl_xor(v, o);
    return v;
}
__device__ __forceinline__ float wave_max(float v) {
#pragma unroll
    for (int o = 1; o < 64; o <<= 1) v = fmaxf(v, __shfl_xor(v, o));
    return v;
}
__device__ __forceinline__ float rdlane(float v, int l) { return __builtin_bit_cast(float, __builtin_amdgcn_readlane(__builtin_bit_cast(int, v), l)); }
__device__ __forceinline__ float sin_rev(float x) { return __builtin_amdgcn_sinf(x); }
__device__ __forceinline__ float cos_rev(float x) { return __builtin_amdgcn_cosf(x); }
__device__ __forceinline__ float fast_exp(float x) { return __builtin_amdgcn_exp2f(1.4426950408889634f * x); }
__device__ __forceinline__ float sigmoidf(float x) { return __builtin_amdgcn_rcpf(1.0f + fast_exp(-x)); }
__device__ __forceinline__ float siluf(float x) { return x * sigmoidf(x); }
__device__ __forceinline__ float siluf_acc(float x) { return x / (1.0f + expf(-x)); }

#define XB_TMO      128
#define XB_XCNT(j)  (256  + 64 * (j))
#define XB_XSUB(j)  (1280 + 64 * (j))
#define XB_XGEN(j)  (2304 + 64 * (j))
#define XB_TOP      3328
#define XB_TOPGEN   3392
#define XCD_BAR_WORDS 3456
#define XB_SPIN_CAP (1u << 22)

__device__ __forceinline__ unsigned xb_ld(unsigned* p)              { return __hip_atomic_load(p, __ATOMIC_RELAXED, __HIP_MEMORY_SCOPE_AGENT); }
__device__ __forceinline__ unsigned xb_add(unsigned* p, unsigned v) { return __hip_atomic_fetch_add(p, v, __ATOMIC_RELAXED, __HIP_MEMORY_SCOPE_AGENT); }
__device__ __forceinline__ unsigned xb_xcc_id() { return (unsigned)__builtin_amdgcn_s_getreg((3 << 11) | 20) & 0xFu; }
#define XB_SPIN(cond, bar) do { unsigned _sp = 0; while (cond) { __builtin_amdgcn_s_sleep(1); \
    if ((++_sp & 255u) == 0u) { if (xb_ld(&(bar)[XB_TMO])) break; if (_sp > XB_SPIN_CAP) { atomicAdd(&(bar)[XB_TMO], 1u); break; } } } } while (0)

struct XcdBarrier {
    unsigned* bar; unsigned x;
    volatile LAS unsigned* st;
};

__device__ __forceinline__ XcdBarrier xcd_barrier_post(unsigned* bar, volatile LAS unsigned* st) {
    XcdBarrier b; b.bar = bar; b.x = xb_xcc_id(); b.st = st;
    if (threadIdx.x == 0) (void)xb_add(&bar[XB_XCNT(b.x)], 1u);
    return b;
}
__device__ __forceinline__ void xcd_barrier_complete(unsigned* bar, unsigned x, unsigned& nloc, unsigned& nx) {
    const unsigned G = gridDim.x * gridDim.y * gridDim.z;
    unsigned sum, cnt, mine, sp = 0u;
    for (;;) {
        sum = 0u; cnt = 0u; mine = 0u;
#pragma unroll
        for (unsigned j = 0; j < 16; ++j) { const unsigned c = xb_ld(&bar[XB_XCNT(j)]); sum += c; cnt += (c > 0u) ? 1u : 0u; mine = (j == x) ? c : mine; }
        if (sum == G) break;
        __builtin_amdgcn_s_sleep(1);
        if ((++sp & 255u) == 0u) { if (xb_ld(&bar[XB_TMO])) break; if (sp > XB_SPIN_CAP) { atomicAdd(&bar[XB_TMO], 1u); break; } }
    }
    nloc = mine > 0u ? mine : 1u; nx = cnt > 0u ? cnt : 1u;
}

__device__ __forceinline__ void xcd_barrier(const XcdBarrier& b) {
    asm volatile("s_waitcnt vmcnt(0)" ::: "memory");
    __syncthreads();
    if (threadIdx.x == 0) {
        unsigned* bar = b.bar;
        __builtin_amdgcn_s_waitcnt(0);
        unsigned nloc = b.st[0], nx = b.st[1];
        if (nloc == 0u) { xcd_barrier_complete(bar, b.x, nloc, nx); b.st[0] = nloc; b.st[1] = nx; }
        const unsigned old = xb_add(&bar[XB_XSUB(b.x)], 1u);
        const unsigned gen = old / nloc;
        if (old + 1u == (gen + 1u) * nloc) {
            __builtin_amdgcn_fence(__ATOMIC_RELEASE, "agent");
            asm volatile("s_waitcnt vmcnt(0)" ::: "memory");
            const unsigned og = xb_add(&bar[XB_TOP], 1u);
            const unsigned tg = og / nx;
            if (og + 1u == (tg + 1u) * nx) xb_add(&bar[XB_TOPGEN], 1u);
            else XB_SPIN(xb_ld(&bar[XB_TOPGEN]) == tg, bar);
            __builtin_amdgcn_fence(__ATOMIC_ACQUIRE, "agent");
            xb_add(&bar[XB_XGEN(b.x)], 1u);
            asm volatile("s_waitcnt vmcnt(0)" ::: "memory");
        } else {
            XB_SPIN(xb_ld(&bar[XB_XGEN(b.x)]) == gen, bar);
            __builtin_amdgcn_fence(__ATOMIC_ACQUIRE, "agent");
            asm volatile("s_waitcnt vmcnt(0)" ::: "memory");
        }
    }
    __syncthreads();
}


#define FFT_DEV __device__ __forceinline__
#define FFT_LDS LAS
__device__ __forceinline__ int fft_tid_() { int t = threadIdx.x; asm volatile("" : "+v"(t)); return t; }
#define FFT_TID fft_tid_()
#define FFT_NTHR (NWAVES * 64)
#define FFT_SYNC() __syncthreads()
__device__ __forceinline__ float fft_sin_rev(float x) { return __builtin_amdgcn_sinf(x); }
__device__ __forceinline__ float fft_cos_rev(float x) { return __builtin_amdgcn_cosf(x); }
__device__ __forceinline__ unsigned fft_brev(unsigned x) { return __builtin_bitreverse32(x); }
typedef float c32 __attribute__((ext_vector_type(2)));
#define FFT_PIDX(i) ((i) + (((i) >> 6) << 2))
typedef float fft_v4 __attribute__((ext_vector_type(4)));
FFT_DEV c32 c_mk(float a, float b) { c32 r; r.x = a; r.y = b; return r; }
FFT_DEV c32 c_add(c32 a, c32 b) { return a + b; }
FFT_DEV c32 c_sub(c32 a, c32 b) { return a - b; }
FFT_DEV c32 c_mul(c32 a, c32 b) { return b * a.x + c_mk(-b.y, b.x) * a.y; }
FFT_DEV c32 c_mulc(c32 a, c32 b) { return a * b.x + c_mk(a.y, -a.x) * b.y; }
FFT_DEV c32 c_conj(c32 a) { return c_mk(a.x, -a.y); }
FFT_DEV c32 c_scale(c32 a, float s) { return a * s; }
FFT_DEV c32 c_twid(float rev) { return c_mk(fft_cos_rev(rev), -fft_sin_rev(rev)); }
FFT_DEV c32 c_root32(int j) {
    switch (j) { case 0: return c_mk(1.f, 0.f); case 1: return c_mk(0.98078528040323043f, -0.19509032201612825f); case 2: return c_mk(0.92387953251128674f, -0.38268343236508977f);
                 case 3: return c_mk(0.83146961230254524f, -0.55557023301960218f); case 4: return c_mk(0.70710678118654752f, -0.70710678118654752f);
                 case 5: return c_mk(0.55557023301960218f, -0.83146961230254524f); case 6: return c_mk(0.38268343236508977f, -0.92387953251128674f); default: return c_mk(0.19509032201612825f, -0.98078528040323043f); }
}
template <int LOGM, int NST, bool INV, int NB, int PRUNE> FFT_DEV void fft_pass(FFT_LDS c32* buf0, int s) {
    constexpr int M = 1 << LOGM, R = 1 << NST, G = M / R, PADM = FFT_PIDX(M);
    const int lq = LOGM - s - NST, q = 1 << lq;
    for (int gi = FFT_TID; gi < NB * G; gi += FFT_NTHR) {
        const int g = gi & (G - 1); FFT_LDS c32* buf = buf0 + (gi / G) * PADM;
        const int r = g & (q - 1), i0 = ((g >> lq) << (lq + NST)) + r;
        const int pb = FFT_PIDX(i0);
        c32 x[R];
#pragma unroll
        for (int j = 0; j < R; ++j) x[j] = (PRUNE == 1 && j >= R / 2) ? c_mk(0.f, 0.f) : buf[pb + FFT_PIDX(j * q)];
        c32 Ts[NST];
        Ts[0] = c_twid((float)(r << s) * (1.0f / M));
#pragma unroll
        for (int t = 1; t < NST; ++t) Ts[t] = c_mul(Ts[t - 1], Ts[t - 1]);
#pragma unroll
        for (int tt = 0; tt < NST; ++tt) {
            const int t = INV ? NST - 1 - tt : tt, h = R >> (t + 1);
            c32 Pq[R / 2], Qq[R / 2];
#pragma unroll
            for (int jj = 0; jj < h; ++jj) {
                c32 tw;
                if (jj < (h + 1) / 2) tw = jj == 0 ? Ts[t] : c_mul(Ts[t], c_root32(jj * (16 / h)));
                else { const c32 b = INV ? c_mk(Pq[jj - h / 2].x, -Pq[jj - h / 2].y) : Pq[jj - h / 2]; tw = c_mk(b.y, -b.x); }
                if (!INV) { Pq[jj] = tw; Qq[jj] = c_mk(-tw.y, tw.x); } else { Pq[jj] = c_mk(tw.x, -tw.y); Qq[jj] = c_mk(tw.y, tw.x); }
            }
#pragma unroll
            for (int j = 0; j < R / 2; ++j) { const int jj = j % h, b = (j / h) * 2 * h + jj;
                if (!INV) {
                    if (PRUNE == 1 && t == 0) { const c32 a = x[b]; x[b + h] = Pq[jj] * a.x + Qq[jj] * a.y; }
                    else { const c32 a = x[b], c = x[b + h], d = a - c; x[b] = a + c; x[b + h] = Pq[jj] * d.x + Qq[jj] * d.y; }
                } else {
                    const c32 a = x[b], cr = x[b + h], c = Pq[jj] * cr.x + Qq[jj] * cr.y; x[b] = a + c;
                    if (!(PRUNE == 2 && t == 0)) x[b + h] = a - c;
                }
            }
        }
#pragma unroll
        for (int j = 0; j < R; ++j) if (!(PRUNE == 2 && j >= R / 2)) buf[pb + FFT_PIDX(j * q)] = x[j];
    }
}
template <int LOGM, int NB, bool ZP> FFT_DEV void fft_fwd(FFT_LDS c32* buf) {
    static_assert(LOGM % 4 == 0 || LOGM % 4 == 2, "radix-16 passes + one radix-4 pass");
    FFT_SYNC(); fft_pass<LOGM, 4, false, NB, ZP ? 1 : 0>(buf, 0);
    if constexpr (LOGM == 14) { FFT_SYNC(); fft_pass<LOGM, 5, false, NB, 0>(buf, 4); FFT_SYNC(); fft_pass<LOGM, 5, false, NB, 0>(buf, 9); }
    else {
        int s = 4;
#pragma unroll
        for (int p = 1; p < LOGM / 4; ++p) { FFT_SYNC(); fft_pass<LOGM, 4, false, NB, 0>(buf, s); s += 4; }
        if (LOGM % 4 == 2) { FFT_SYNC(); fft_pass<LOGM, 2, false, NB, 0>(buf, s); }
    }
    FFT_SYNC();
}
template <int LOGM, int NB, bool HO> FFT_DEV void fft_inv(FFT_LDS c32* buf) {
    if constexpr (LOGM == 14) { FFT_SYNC(); fft_pass<LOGM, 5, true, NB, 0>(buf, 9); FFT_SYNC(); fft_pass<LOGM, 5, true, NB, 0>(buf, 4); }
    else {
        int s = LOGM;
        if (LOGM % 4 == 2) { s -= 2; FFT_SYNC(); fft_pass<LOGM, 2, true, NB, 0>(buf, s); }
#pragma unroll
        for (int p = 1; p < LOGM / 4; ++p) { s -= 4; FFT_SYNC(); fft_pass<LOGM, 4, true, NB, 0>(buf, s); }
    }
    FFT_SYNC(); fft_pass<LOGM, 4, true, NB, HO ? 2 : 0>(buf, 0);
    FFT_SYNC();
}
template <int LOGM> FFT_DEV void filt_untangle(FFT_LDS const c32* buf, c32* KfP, float scale) {
    constexpr int M = 1 << LOGM;
    for (int t = FFT_TID; t <= M / 2; t += FFT_NTHR) {
        if (t == 0) { const c32 Z0 = buf[FFT_PIDX(0)]; KfP[0] = c_mk((Z0.x + Z0.y) * scale, 0.f); KfP[1] = c_mk((Z0.x - Z0.y) * scale, 0.f); }
        else {
            const int p1 = t == M / 2 ? 1 : 2 * t, kk = (int)(fft_brev((unsigned)p1) >> (32 - LOGM)), p2 = (int)(fft_brev((unsigned)(M - kk)) >> (32 - LOGM));
            const c32 A = buf[FFT_PIDX(p1)], B = buf[FFT_PIDX(p2)];
            const c32 E = c_mk(0.5f * (A.x + B.x), 0.5f * (A.y - B.y)), O = c_mk(0.5f * (A.y + B.y), -0.5f * (A.x - B.x));
            const c32 wk = c_twid((float)kk * (0.5f / M)), Tt = c_mul(wk, O);
            const c32 K1 = c_scale(c_add(E, Tt), scale), K2 = c_scale(c_conj(c_sub(E, Tt)), scale);
            if (t == M / 2) KfP[M] = K1;
            else { fft_v4 v; v.x = K1.x; v.y = K1.y; v.z = K2.x; v.w = K2.y; *(fft_v4*)(KfP + 2 * t) = v; }
        }
    }
}
template <int LOGM, int NB, int CH> FFT_DEV void pw_fetch(const c32* __restrict__ KfP, c32 (&K1)[CH], c32 (&K2)[CH], int i0) {
    constexpr int M = 1 << LOGM;
#pragma unroll
    for (int j = 0; j < CH; ++j) { const int t = (i0 + j * FFT_NTHR) & (M / 2 - 1); const fft_v4 v = *(const fft_v4*)(KfP + 2 * t); K1[j] = c_mk(v.x, v.y); K2[j] = c_mk(v.z, v.w); }
}
template <int LOGM, int NB, int CH> FFT_DEV void conv_pointwise(FFT_LDS c32* buf0, const c32* __restrict__ KfP, float invM, c32 (&K1)[CH], c32 (&K2)[CH]) {
    constexpr int M = 1 << LOGM, PADM = FFT_PIDX(M), NP = NB * (M / 2);
    for (int i0 = FFT_TID; i0 < NP; i0 += CH * FFT_NTHR) {
        c32 N1[CH], N2[CH];
        const bool more = i0 + CH * FFT_NTHR < NP;
        if (more) pw_fetch<LOGM, NB, CH>(KfP, N1, N2, i0 + CH * FFT_NTHR);
#pragma unroll
        for (int j = 0; j < CH; ++j) { const int i = i0 + j * FFT_NTHR, t = i & (M / 2 - 1), p1 = 2 * t, kk = (int)(fft_brev((unsigned)p1) >> (32 - LOGM)); FFT_LDS c32* buf = buf0 + (i / (M / 2)) * PADM;
            if (t == 0) { const c32 Z0 = buf[FFT_PIDX(0)]; const float Y0 = (Z0.x + Z0.y) * K1[j].x * invM, YM = (Z0.x - Z0.y) * K2[j].x * invM; buf[FFT_PIDX(0)] = c_mk(0.5f * (Y0 + YM), 0.5f * (Y0 - YM)); }
            else {
                const int p2 = (int)(fft_brev((unsigned)(M - kk)) >> (32 - LOGM));
                const c32 A = buf[FFT_PIDX(p1)], B = buf[FFT_PIDX(p2)];
                const c32 E = c_mk(0.5f * (A.x + B.x), 0.5f * (A.y - B.y)), O = c_mk(0.5f * (A.y + B.y), -0.5f * (A.x - B.x));
                const c32 wk = c_twid((float)kk * (0.5f / M)), Tt = c_mul(wk, O);
                const c32 Yk = c_scale(c_mul(c_add(E, Tt), K1[j]), invM), Ymk = c_scale(c_mul(c_conj(c_sub(E, Tt)), K2[j]), invM);
                const c32 Ep = c_scale(c_add(Yk, c_conj(Ymk)), 0.5f), Op = c_scale(c_mulc(c_sub(Yk, c_conj(Ymk)), wk), 0.5f);
                buf[FFT_PIDX(p1)] = c_mk(Ep.x - Op.y, Ep.y + Op.x); buf[FFT_PIDX(p2)] = c_mk(Ep.x + Op.y, Op.x - Ep.y);
            }
        }
        if (more) {
#pragma unroll
            for (int j = 0; j < CH; ++j) { K1[j] = N1[j]; K2[j] = N2[j]; } }
    }
    for (int sb = FFT_TID; sb < NB; sb += FFT_NTHR) {
        FFT_LDS c32* buf = buf0 + sb * PADM; const c32 Zh = buf[FFT_PIDX(1)], Y = c_scale(c_mul(c_conj(Zh), KfP[M]), invM); buf[FFT_PIDX(1)] = c_conj(Y); }
}
FFT_DEV c32 conv_pair(const float* __restrict__ p, int m, int L, float w0, float w1, float w2, float b) {
    const float a = m > 0 ? p[2 * m - 1] : 0.f, x0 = p[2 * m], x1 = p[2 * m + 1], c = 2 * m + 2 < L ? p[2 * m + 2] : 0.f;
    return c_mk(w0 * a + w1 * x0 + w2 * x1 + b, w0 * x0 + w1 * x1 + w2 * c + b);
}
template <int LOGM, int NB, int CH> FFT_DEV void hyena_unit(FFT_LDS c32* buf, const float* __restrict__ pz, const float* __restrict__ pg0, const float* __restrict__ pg1, const float* cw, const c32* __restrict__ Kf0, const c32* __restrict__ Kf1, float bias0, float bias1, float* __restrict__ zout) {
    constexpr int M = 1 << LOGM, H = M / 2, L = M, PADM = FFT_PIDX(M); const float invM = 1.0f / M;
    for (int i0 = FFT_TID; i0 < NB * H; i0 += CH * FFT_NTHR) {
        c32 z[CH];
#pragma unroll
        for (int j = 0; j < CH; ++j) { const int i = i0 + j * FFT_NTHR, sq = i / H, m = i & (H - 1); z[j] = conv_pair(pz + sq * L, m, L, cw[0], cw[1], cw[2], cw[3]); }
#pragma unroll
        for (int j = 0; j < CH; ++j) { const int i = i0 + j * FFT_NTHR, sq = i / H, m = i & (H - 1); *(c32*)(zout + sq * L + 2 * m) = z[j]; buf[sq * PADM + FFT_PIDX(m)] = z[j]; }
    }
#ifdef PROBE_FFT_EXTRA
    fft_fwd<LOGM, NB, false>(buf); fft_inv<LOGM, NB, false>(buf);
    for (int i = FFT_TID; i < NB * M; i += FFT_NTHR) { const int sq = i / M, m = i & (M - 1); buf[sq * PADM + FFT_PIDX(m)] = buf[sq * PADM + FFT_PIDX(m)] * invM; }
#endif
    c32 KA[CH], KB[CH];
    pw_fetch<LOGM, NB, CH>(Kf0, KA, KB, FFT_TID);
    fft_fwd<LOGM, NB, true>(buf); conv_pointwise<LOGM, NB, CH>(buf, Kf0, invM, KA, KB); fft_inv<LOGM, NB, true>(buf);
    for (int i0 = FFT_TID; i0 < NB * H; i0 += CH * FFT_NTHR) {
        c32 g[CH], u[CH];
#pragma unroll
        for (int j = 0; j < CH; ++j) { const int i = i0 + j * FFT_NTHR, sq = i / H, m = i & (H - 1); g[j] = conv_pair(pg0 + sq * L, m, L, cw[4], cw[5], cw[6], cw[7]); u[j] = *(const c32*)(zout + sq * L + 2 * m); }
#pragma unroll
        for (int j = 0; j < CH; ++j) { const int i = i0 + j * FFT_NTHR, sq = i / H, m = i & (H - 1); const c32 y = buf[sq * PADM + FFT_PIDX(m)]; const c32 v = g[j] * (y + u[j] * bias0);
            *(c32*)(zout + sq * L + 2 * m) = v; buf[sq * PADM + FFT_PIDX(m)] = v; }
    }
    pw_fetch<LOGM, NB, CH>(Kf1, KA, KB, FFT_TID);
    fft_fwd<LOGM, NB, true>(buf); conv_pointwise<LOGM, NB, CH>(buf, Kf1, invM, KA, KB); fft_inv<LOGM, NB, true>(buf);
    for (int i0 = FFT_TID; i0 < NB * H; i0 += CH * FFT_NTHR) {
        c32 g[CH], u[CH];
#pragma unroll
        for (int j = 0; j < CH; ++j) { const int i = i0 + j * FFT_NTHR, sq = i / H, m = i & (H - 1); g[j] = conv_pair(pg1 + sq * L, m, L, cw[8], cw[9], cw[10], cw[11]); u[j] = *(const c32*)(zout + sq * L + 2 * m); }
#pragma unroll
        for (int j = 0; j < CH; ++j) { const int i = i0 + j * FFT_NTHR, sq = i / H, m = i & (H - 1); const c32 y = buf[sq * PADM + FFT_PIDX(m)]; *(c32*)(zout + sq * L + 2 * m) = g[j] * (y + u[j] * bias1); }
    }
    FFT_SYNC();
}
template <int LOGM, int CH> FFT_DEV void filter_unit(FFT_LDS c32* buf, const float* __restrict__ fwd, const float* __restrict__ bwd, int tstride, c32* __restrict__ KfP, float scale) {
    constexpr int M = 1 << LOGM, L = M, H = M / 2;
#define FFT_TIX(t) ((size_t)((t) >> 5) * tstride + ((t) & 31))
    for (int m0 = FFT_TID; m0 < H; m0 += CH * FFT_NTHR) {
        c32 a[CH], b[CH];
#pragma unroll
        for (int j = 0; j < CH; ++j) { const int m = m0 + j * FFT_NTHR; a[j] = *(const c32*)(fwd + FFT_TIX(2 * m));
            b[j] = m == 0 ? c_mk(0.f, bwd[FFT_TIX(L - 1)]) : c_mk(bwd[FFT_TIX(L - 2 * m)], bwd[FFT_TIX(L - 2 * m - 1)]); }
#pragma unroll
        for (int j = 0; j < CH; ++j) { const int m = m0 + j * FFT_NTHR; buf[FFT_PIDX(m)] = a[j]; buf[FFT_PIDX(m + H)] = b[j]; }
    }
#undef FFT_TIX
    fft_fwd<LOGM, 1, false>(buf); filt_untangle<LOGM>(buf, KfP, scale);
    FFT_SYNC();
}

struct Frame {
    LAS unsigned char* lds;
    volatile LAS unsigned* MISC;
    gu32* ctl;
    int tid, lane, wave;
    int vcu, G, bid;
    float* out; unsigned char* ws;
};
struct Args { const float* in[30]; float* out; unsigned char* ws; int ph_lo, ph_hi; };
typedef GAS const float* cfp_t;
typedef __attribute__((address_space(4))) const cfp_t* KargTab;
struct InPtrs { KargTab t; __device__ __forceinline__ const float* operator[](int i) const { return (const float*)t[i]; } };
struct InTab { InPtrs in; };
enum { I_XP = 0, I_XS, I_CP, I_CS, I_ADAW, I_ADAB, I_N1G, I_N2G, I_WIN, I_HCW, I_HCB, I_FW1, I_FB1, I_FW2, I_FB2, I_FW3, I_FB3, I_FFREQ, I_FWOUT, I_HYB, I_QNG, I_KNG, I_SINK, I_WHY, I_WAT, I_WO, I_RW, I_EWG, I_EWU, I_EWD };

__device__ __forceinline__ int mod_row(int r) { return r < TP ? 0 : 1 + ((r - TP) >> 12); }
__device__ __forceinline__ void seq_bounds(int r, int& s0, int& len) { if (r < TP) { s0 = 0; len = TP; } else { s0 = TP + (((r - TP) >> 12) << 12); len = TS; } }
__device__ __forceinline__ const float* x_row(const Frame& F, const InTab& A, int l, int r) { return l == 0 ? (r < TP ? A.in[I_XP] + (size_t)r * D : A.in[I_XS] + (size_t)(r - TP) * D) : F.out + (size_t)r * D; }

__device__ __forceinline__ void transpose_item(const float* W, int N, int K, int k0, int n0, bf16* WT, int dst_row0, LAS float* scr, int lane) {
    float r_[32];
#pragma unroll
    for (int i = 0; i < 32; ++i) r_[i] = W[(size_t)(k0 + 2 * i + (lane >> 5)) * N + n0 + (lane & 31)];
#pragma unroll
    for (int i = 0; i < 32; ++i) scr[(2 * i + (lane >> 5)) * 33 + (lane & 31)] = r_[i];
    LDS_WAIT(); asm volatile("" ::: "memory");
    const int c = lane & 7;
#pragma unroll
    for (int j = 0; j < 4; ++j) { const int n = (lane >> 3) + 8 * j; const LAS float* s = scr + (8 * c) * 33 + n;
        v4u o; o.x = pk2(s[0 * 33], s[1 * 33]); o.y = pk2(s[2 * 33], s[3 * 33]); o.z = pk2(s[4 * 33], s[5 * 33]); o.w = pk2(s[6 * 33], s[7 * 33]);
        *(v4u*)(WT + (size_t)(dst_row0 + n) * K + k0 + 8 * c) = o; }
    LDS_WAIT(); asm volatile("" ::: "memory");
}
__device__ __forceinline__ void convert_small_weights(Frame& F, const InTab& A) {
    LAS float* scr = (LAS float*)(F.lds + RING_OFF + F.wave * 16384);
    const int gw = F.vcu * NWAVES + F.wave, NGW = F.G * NWAVES;
    constexpr int I_IN = (D / 64) * (INW / 32), I_P = (HYW / 64) * (D / 32), I_O = (D / 64) * (D / 32), I_F = FOUT / 32, PER_L = I_IN + 2 * I_P + I_O + I_F;
    for (int it = gw; it < DEPTH * PER_L; it += NGW) {
        const int l = it / PER_L; int r = it % PER_L;
        if (r < I_IN) { const int nb = INW / 32; transpose_item(A.in[I_WIN] + (size_t)l * D * INW, INW, D, 64 * (r / nb), 32 * (r % nb), (bf16*)(F.ws + WS_WIN) + (size_t)l * INW * D, 32 * (r % nb), scr, F.lane); continue; } r -= I_IN;
        if (r < I_P) { const int nb = D / 32; transpose_item(A.in[I_WHY] + (size_t)l * HYW * D, D, 2 * HYW, 64 * (r / nb), 32 * (r % nb), (bf16*)(F.ws + WS_WHY) + (size_t)l * D * 2 * HYW, 32 * (r % nb), scr, F.lane); continue; } r -= I_P;
        if (r < I_P) { const int nb = D / 32; transpose_item(A.in[I_WAT] + (size_t)l * ATW * D, D, 2 * HYW, 64 * (r / nb), 32 * (r % nb), (bf16*)(F.ws + WS_WHY) + (size_t)l * D * 2 * HYW + HYW, 32 * (r % nb), scr, F.lane); continue; } r -= I_P;
        if (r < I_O) { const int nb = D / 32; transpose_item(A.in[I_WO] + (size_t)l * D * D, D, D, 64 * (r / nb), 32 * (r % nb), (bf16*)(F.ws + WS_WO) + (size_t)l * D * D, 32 * (r % nb), scr, F.lane); continue; } r -= I_O;
        transpose_item(A.in[I_FWOUT] + (size_t)l * FH * FOUT, FOUT, FH, 0, 32 * r, (bf16*)(F.ws + WS_WOUT) + (size_t)l * FOUT * FH, 32 * r, scr, F.lane);
    }
}
struct CvItem { const float* src; unsigned char* dst; int N, K; float sc; };
__device__ __forceinline__ CvItem cv_moe_item(const Frame& F, const InTab& A, int l, int it) {
    constexpr int I_G = (D / 64) * (FF / 32), I_D = (FF / 64) * (D / 32), PER_E = 2 * I_G + I_D;
    const int e = it / PER_E; int r = it % PER_E; CvItem c;
    if (r < 2 * I_G) { const int up = r >= I_G; if (up) r -= I_G; const int nb = FF / 32, k0 = 64 * (r / nb), n0 = 32 * (r % nb);
        c.src = A.in[up ? I_EWU : I_EWG] + ((size_t)l * NE + e) * D * FF + (size_t)k0 * FF + n0; c.N = FF; c.K = KB_UP; c.sc = 64.f;
        c.dst = (unsigned char*)(F.ws + WS_WGU) + ((size_t)e * (2 * FF) + (256 * (n0 >> 7) + (up ? 128 : 0) + (n0 & 127))) * KB_UP + (k0 >> 1); }
    else { r -= 2 * I_G; const int nb = D / 32, k0 = 64 * (r / nb), n0 = 32 * (r % nb);
        c.src = A.in[I_EWD] + ((size_t)l * NE + e) * FF * D + (size_t)k0 * D + n0; c.N = D; c.K = KB_DN; c.sc = 128.f;
        c.dst = (unsigned char*)(F.ws + WS_WD) + ((size_t)e * D + n0) * KB_DN + (k0 >> 1); }
    return c;
}
template <int VAR = 0  >
__device__ __forceinline__ void convert_moe_weights(Frame& F, const InTab& A, int l) {
    const int gw = F.vcu * NWAVES + F.wave, NGW = F.G * NWAVES, lane = F.lane, g = lane >> 3, c = lane & 7;
    constexpr int TOTAL = NE * (2 * (D / 64) * (FF / 32) + (FF / 64) * (D / 32));
    for (int i = (F.vcu * NWAVES + F.wave) * 64 + lane; i < NE * D * ((KB_DN - FF / 2) / 16); i += NGW * 64) { const int row = i >> 3, ch = i & 7;
        *(v4u*)((unsigned char*)(F.ws + WS_WD) + (size_t)row * KB_DN + FF / 2 + 16 * ch) = (v4u){0u, 0u, 0u, 0u}; }
    if constexpr (VAR == 2) {
        f32x4 acc = {0.f, 0.f, 0.f, 0.f};
        for (int m = 0; m < 3; ++m) { const float* base = A.in[m == 0 ? I_EWG : m == 1 ? I_EWU : I_EWD] + (size_t)l * NE * D * FF; const int nch = NE * D * FF / 2048;
            for (int ch = gw; ch < nch; ch += NGW) { const float* p = base + (size_t)ch * 2048 + 4 * lane; f32x4 r[8];
#pragma unroll
                for (int i = 0; i < 8; ++i) r[i] = *(const f32x4*)(p + 256 * i);
#pragma unroll
                for (int i = 0; i < 8; ++i) acc += r[i]; } }
        if (acc[0] + acc[1] + acc[2] + acc[3] == 1.2345e-30f) *(float*)(F.ws + WS_WD) = 0.f;
        return;
    }
    f32x4 ra[8], rb[8]; CvItem cur, nxt;
    if (gw < TOTAL) { cur = cv_moe_item(F, A, l, gw); const float* p = cur.src + (size_t)(8 * g) * cur.N + 4 * c;
#pragma unroll
        for (int i = 0; i < 8; ++i) ra[i] = *(const f32x4*)(p + (size_t)i * cur.N); }
    for (int it = gw; it < TOTAL; it += NGW) {
        const bool more = it + NGW < TOTAL;
        if (more) { nxt = cv_moe_item(F, A, l, it + NGW); const float* p = nxt.src + (size_t)(8 * g) * nxt.N + 4 * c;
#pragma unroll
            for (int i = 0; i < 8; ++i) rb[i] = *(const f32x4*)(p + (size_t)i * nxt.N); }
        const float sc = cur.sc;
#pragma unroll
        for (int j = 0; j < 4; ++j) { unsigned w; PG8_FP4_PACK8(w, ra[0][j] * sc, ra[1][j] * sc, ra[2][j] * sc, ra[3][j] * sc, ra[4][j] * sc, ra[5][j] * sc, ra[6][j] * sc, ra[7][j] * sc);
            if (VAR == 0 || w == 0x12345678u) *(unsigned*)(cur.dst + (size_t)(4 * c + j) * cur.K + 4 * g) = w; }
        if (more) { cur = nxt;
#pragma unroll
            for (int i = 0; i < 8; ++i) ra[i] = rb[i]; }
    }
}
__device__ __forceinline__ void adaln_mod(Frame& F, const InTab& A) {
    LAS float* sc = (LAS float*)(F.lds + RING_OFF);
    LAS float* red = (LAS float*)(F.lds + RING_OFF + 32768);
    for (int i = F.tid; i < NMOD * D; i += NWAVES * 64) { const int b = i / D, k = i % D; const float c = b == 0 ? A.in[I_CP][k] : A.in[I_CS][(b - 1) * D + k]; sc[i] = siluf_acc(c); }
    __syncthreads();
    float* mod = (float*)(F.ws + WS_MOD);
    for (int u = F.vcu; u < DEPTH * 96; u += F.G) {
        const int l = u / 96, n = (u % 96) * 64 + F.lane;
        const float* W = A.in[I_ADAW] + (size_t)l * D * 6 * D + n;
        float a[NMOD] = {0.f, 0.f, 0.f, 0.f, 0.f};
#pragma unroll 4
        for (int k = 128 * F.wave; k < 128 * F.wave + 128; ++k) { const float w = W[(size_t)k * 6 * D];
#pragma unroll
            for (int b = 0; b < NMOD; ++b) a[b] += sc[b * D + k] * w; }
#pragma unroll
        for (int b = 0; b < NMOD; ++b) red[(F.wave * NMOD + b) * 64 + F.lane] = a[b];
        __syncthreads();
        if (F.tid < NMOD * 64) { const int b = F.tid >> 6, ln = F.tid & 63; float s = A.in[I_ADAB][l * 6 * D + (u % 96) * 64 + ln];
#pragma unroll
            for (int w = 0; w < NWAVES; ++w) s += red[(w * NMOD + b) * 64 + ln];
            mod[((size_t)l * NMOD + b) * 6 * D + (u % 96) * 64 + ln] = s; }
        __syncthreads();
    }
}
__device__ __forceinline__ void norm_mod_rows(Frame& F, const InTab& A, int l, const float* g, int sh_off, int sc_off) {
    const int gw = F.vcu * NWAVES + F.wave, NGW = F.G * NWAVES;
    const float* mod = (const float*)(F.ws + WS_MOD) + (size_t)l * NMOD * 6 * D;
    bf16* H = (bf16*)(F.ws + WS_H);
    for (int m = gw; m < T; m += NGW) {
        const f32x4* xr = (const f32x4*)x_row(F, A, l, m) + F.lane;
        f32x4 v[4]; float ss = 0.f;
#pragma unroll
        for (int j = 0; j < 4; ++j) { v[j] = xr[64 * j]; ss += (v[j].x * v[j].x + v[j].y * v[j].y) + (v[j].z * v[j].z + v[j].w * v[j].w); }
        const float rstd = 1.0f / sqrtf(wave_sum(ss) * (1.f / D) + EPS);
        const float* mr = mod + (size_t)mod_row(m) * 6 * D;
        unsigned long long* o8 = (unsigned long long*)(H + (size_t)m * D) + F.lane;
#pragma unroll
        for (int j = 0; j < 4; ++j) { const int c = 4 * F.lane + 256 * j;
            const f32x4 gg = *(const f32x4*)(g + c), sc = *(const f32x4*)(mr + sc_off + c), sh = *(const f32x4*)(mr + sh_off + c);
            const f32x4 o = v[j] * rstd * gg * (sc + 1.0f) + sh;
            o8[64 * j] = (unsigned long long)pk2(o.x, o.y) | ((unsigned long long)pk2(o.z, o.w) << 32); }
    }
}

__device__ __forceinline__ void filter_time_tiles(Frame& F, const InTab& A, int l) {
    LAS bf16* h3s = (LAS bf16*)(F.lds + RING_OFF);
    const float* w1 = A.in[I_FW1] + (size_t)l * FEMB * FH; const float* b1 = A.in[I_FB1] + l * FH;
    const float* w2 = A.in[I_FW2] + (size_t)l * FH * FH;   const float* b2 = A.in[I_FB2] + l * FH;
    const float* w3 = A.in[I_FW3] + (size_t)l * FH * FH;   const float* b3 = A.in[I_FB3] + l * FH;
    const bf16* woT = (const bf16*)(F.ws + WS_WOUT) + (size_t)l * FOUT * FH;
    const float fr = A.in[I_FFREQ][l * FH + F.lane] * 0.15915494309189535f;
    const float bb1 = b1[F.lane], bb2 = b2[F.lane], bb3 = b3[F.lane];
    const int lane = F.lane;
    LAS float* wl1 = (LAS float*)(F.lds + RING_OFF + 16384); LAS float* wl2 = wl1 + FEMB * FH; LAS float* wl3 = wl2 + FH * FH;
    for (int i = F.tid; i < FEMB * FH; i += NWAVES * 64) wl1[i] = w1[i];
    for (int i = F.tid; i < FH * FH; i += NWAVES * 64) { wl2[i] = w2[i]; wl3[i] = w3[i]; }
    __syncthreads();
    for (int tile = F.vcu; tile < 640; tile += F.G) {
        const int set = tile >= 512, tl0 = set ? tile - 512 : tile, L = set ? TS : TP, j0 = 32 * tl0;
        float* hraw = (float*)(F.ws + (set ? WS_HRAW_S : WS_HRAW_P));
        float* psum = (float*)(F.ws + WS_PSUM) + (set ? (size_t)512 * FOUT : 0) + (size_t)tl0 * FOUT;
        const float invL = 1.0f / (float)L, invLm1 = 1.0f / (float)(L - 1);
        {
            float zv[4], h[4], pre[4];
#pragma unroll
            for (int i = 0; i < 4; ++i) { const int j = j0 + F.wave + 8 * i; float z = 0.f;
                if (lane == 0) z = (float)j * invLm1;
                else if (lane <= 32) { const int b = (lane - 1) & 15; const float fb = 1e-4f + (float)b * ((15.0f - 1e-4f) / 15.0f); const float rev = fb * (float)j * invL; z = lane <= 16 ? cos_rev(rev) : -sin_rev(rev); }
                zv[i] = z; pre[i] = bb1; }
#define FT_LAYER(WL, NK, SRC) do { _Pragma("unroll 1") for (int k0 = 0; k0 < (NK); k0 += 16) { float w_[16]; \
                _Pragma("unroll") for (int j = 0; j < 16; ++j) w_[j] = (k0 + j < (NK)) ? (WL)[(k0 + j) * FH + lane] : 0.f; \
                _Pragma("unroll") for (int j = 0; j < 16; ++j) { _Pragma("unroll") for (int i = 0; i < 4; ++i) pre[i] += rdlane(SRC[i], (k0 + j) & 63) * w_[j]; } } } while (0)
            FT_LAYER(wl1, FEMB, zv);
#pragma unroll
            for (int i = 0; i < 4; ++i) { h[i] = sin_rev(fr * pre[i]); pre[i] = bb2; }
            FT_LAYER(wl2, FH, h);
#pragma unroll
            for (int i = 0; i < 4; ++i) { h[i] = sin_rev(fr * pre[i]); pre[i] = bb3; }
            FT_LAYER(wl3, FH, h);
#undef FT_LAYER
#pragma unroll
            for (int i = 0; i < 4; ++i) h3s[(F.wave + 8 * i) * 72 + lane] = (bf16)f2bf(sin_rev(fr * pre[i]));
        }
        __syncthreads();
        {
            const int hi = lane >> 5, lr = lane & 31;
            bf16x8 af[4], bcur[4], bnxt[4];
#pragma unroll
            for (int s = 0; s < 4; ++s) { af[s] = *(const LAS bf16x8*)(h3s + lr * 72 + 16 * s + 8 * hi); bcur[s] = *(const bf16x8*)(woT + (size_t)((F.wave * 8) * 32 + lr) * FH + 16 * s + 8 * hi); }
#pragma unroll 1
            for (int r = 0; r < 8; ++r) {
                const int n = (F.wave * 8 + r) * 32 + lr;
                if (r < 7) {
#pragma unroll
                    for (int s = 0; s < 4; ++s) bnxt[s] = *(const bf16x8*)(woT + (size_t)(n + 32) * FH + 16 * s + 8 * hi); }
                f32x16 acc = {0.f, 0.f, 0.f, 0.f, 0.f, 0.f, 0.f, 0.f, 0.f, 0.f, 0.f, 0.f, 0.f, 0.f, 0.f, 0.f};
#pragma unroll
                for (int s = 0; s < 4; ++s) acc = __builtin_amdgcn_mfma_f32_32x32x16_bf16(af[s], bcur[s], acc, 0, 0, 0);
                const int dir = n >> 10, c = n & 511;
                const float delta = 3.070113457325394f + (float)c * ((15.350567286626971f - 3.070113457325394f) / 511.0f);
                float ssq = 0.f;
#pragma unroll
                for (int g = 0; g < 4; ++g) { f32x4 v;
#pragma unroll
                    for (int e = 0; e < 4; ++e) { const int j = j0 + 8 * g + 4 * hi + e; const float val = acc[4 * g + e] * fast_exp(-(float)j * invLm1 * delta); v[e] = val; if (!(dir == 1 && j == 0)) ssq += val * val; }
                    *(f32x4*)(hraw + ((size_t)tl0 * FOUT + n) * 32 + 8 * g + 4 * hi) = v; }
                ssq += __shfl_xor(ssq, 32);
                if (lane < 32) psum[n] = ssq;
#pragma unroll
                for (int s = 0; s < 4; ++s) bcur[s] = bnxt[s];
            }
        }
        __syncthreads();
    }
}

__device__ __forceinline__ void filter_fft_units(Frame& F) {
    LAS c32* buf = (LAS c32*)(F.lds + RING_OFF);
    LAS float* red = (LAS float*)(F.lds + SCR_OFF);
    const bool deal = F.G == 256, heavy = F.bid < 128;
    for (int k = 0; k < (deal ? 9 : (2048 + F.G - 1) / F.G); ++k) {
        int u;
        if (!deal) { u = F.vcu + k * F.G; if (u >= 2048) break; }
        else if (k < 5) { if (heavy) { if (k >= 3) continue; u = F.bid + 128 * k; } else u = 384 + (F.bid - 128) + 128 * k; }
        else u = 1024 + F.bid + 256 * (k - 5);
        const int set = u >= 1024, oc = u & 1023, ntile = set ? 128 : 512;
        const float* psum = (const float*)(F.ws + WS_PSUM) + (set ? (size_t)512 * FOUT : 0);
        float s = 0.f;
        if (F.tid < ntile) s = psum[(size_t)F.tid * FOUT + oc] + psum[(size_t)F.tid * FOUT + 1024 + oc];
        s = wave_sum(s);
        if (F.lane == 0) red[F.wave] = s;
        __syncthreads();
        float tot = 0.f;
#pragma unroll
        for (int w = 0; w < NWAVES; ++w) tot += red[w];
        const float scale = 1.0f / sqrtf(tot + EPS);
        if (set == 0) { const float* hr = (const float*)(F.ws + WS_HRAW_P); filter_unit<14, 8>(buf, hr + (size_t)oc * 32, hr + (size_t)(1024 + oc) * 32, FOUT * 32, (c32*)(F.ws + WS_KF_P) + (size_t)oc * KFS_P, scale); }
        else          { const float* hr = (const float*)(F.ws + WS_HRAW_S); filter_unit<12, 4>(buf, hr + (size_t)oc * 32, hr + (size_t)(1024 + oc) * 32, FOUT * 32, (c32*)(F.ws + WS_KF_S) + (size_t)oc * KFS_S, scale); }
    }
}
__device__ __forceinline__ void shortconv_transpose(Frame& F, const InTab& A, int l) {
    LAS float* scr = (LAS float*)(F.lds + RING_OFF + F.wave * 16384);
    const int gw = F.vcu * NWAVES + F.wave, NGW = F.G * NWAVES, lane = F.lane;
    const bf16* P = (const bf16*)(F.ws + WS_PROJ); float* HYT = (float*)(F.ws + WS_HYT);
    const float* cw = A.in[I_HCW] + (size_t)l * 3 * NHY; const float* cb = A.in[I_HCB] + (size_t)l * NHY;
    for (int it = gw; it < (T / 64) * (NHY / 32); it += NGW) {
        const int rt = it / (NHY / 32), ct = it % (NHY / 32), r0 = 64 * rt, c0 = 32 * ct;
        int s0, len; seq_bounds(r0, s0, len);
        for (int i = 0; i < 33; ++i) { const int rr = 2 * i + (lane >> 5), r = r0 - 1 + rr;
            float v = 0.f; if (r >= s0 && r < s0 + len) v = bf2f(P[(size_t)r * INW + c0 + (lane & 31)]);
            scr[rr * 33 + (lane & 31)] = v; }
        LDS_WAIT(); asm volatile("" ::: "memory");
        for (int cc = 0; cc < 32; ++cc) { const int c = c0 + cc; const float w0 = cw[c], w1 = cw[NHY + c], w2 = cw[2 * NHY + c], b = cb[c];
            const float v = w0 * scr[lane * 33 + cc] + w1 * scr[(lane + 1) * 33 + cc] + w2 * scr[(lane + 2) * 33 + cc] + b;
            HYT[(size_t)c * T + r0 + lane] = v; }
        LDS_WAIT(); asm volatile("" ::: "memory");
    }
}
__device__ const double ROPE_INV_REV[32] = {0.15915494309189535, 0.11934937021124886, 0.08949940160889101, 0.06711508300522726, 0.050329212104487035, 0.03774158471741977, 0.0283021958306234, 0.02122365276477766,
    0.015915494309189534, 0.011934937021124886, 0.008949940160889102, 0.006711508300522725, 0.005032921210448704, 0.003774158471741977, 0.00283021958306234, 0.0021223652764777662,
    0.0015915494309189536, 0.0011934937021124885, 0.0008949940160889102, 0.0006711508300522726, 0.0005032921210448703, 0.00037741584717419774, 0.00028302195830623395, 0.0002122365276477766,
    0.00015915494309189535, 0.00011934937021124886, 8.949940160889102e-05, 6.711508300522725e-05, 5.0329212104487035e-05, 3.774158471741978e-05, 2.8302195830623396e-05, 2.122365276477766e-05};
__device__ __forceinline__ void qk_norm_rope(Frame& F, const InTab& A, int l) {
    const int gw = F.vcu * NWAVES + F.wave, NGW = F.G * NWAVES, lane = F.lane;
    const bf16* P = (const bf16*)(F.ws + WS_PROJ); bf16* QN = (bf16*)(F.ws + WS_QN); bf16* KN = (bf16*)(F.ws + WS_KN);
    const float gq = A.in[I_QNG][l * HD + lane], gk = A.in[I_KNG][l * HD + lane];
    const double invr = ROPE_INV_REV[lane & 31];
    for (int m = gw; m < T; m += NGW) {
        int s0, len; seq_bounds(m, s0, len);
        double rv = (double)(m - s0) * invr; rv -= floor(rv);
        const float rf = (float)rv, cs = cos_rev(rf), sn = sin_rev(rf);
        for (int h = 0; h < NH + NKV; ++h) {
            const float x = bf2f(P[(size_t)m * INW + COL_Q + h * HD + lane]);
            const float ss = wave_sum(x * x);
            float y = x * (1.0f / sqrtf(ss * (1.f / HD) + EPS)) * (h < NH ? gq : gk);
            const float p = __shfl_xor(y, 32);
            float o = lane < 32 ? y * cs - p * sn : y * cs + p * sn;
            if (h < NH) QN[(size_t)m * ATW + h * HD + lane] = (bf16)f2bf(o * 0.125f); else KN[(size_t)m * KVW + (h - NH) * HD + lane] = (bf16)f2bf(o);
        }
    }
}
__device__ __forceinline__ void hyena_units(Frame& F, const InTab& A, int l) {
    LAS c32* buf = (LAS c32*)(F.lds + RING_OFF);
    LAS float* cws = (LAS float*)(F.lds + SCR_OFF);
    const float* HYT = (const float*)(F.ws + WS_HYT); float* Z2T = (float*)(F.ws + WS_Z2T);
    const float* hb = A.in[I_HYB] + (size_t)l * 2 * HYW;
    const float* cw = A.in[I_HCW] + (size_t)l * 3 * NHY; const float* cb = A.in[I_HCB] + (size_t)l * NHY;
    for (int u = F.vcu; u < 2 * HYW; u += F.G) {
        const int c = u & 511;
        if (F.tid < 12) { const int j = F.tid >> 2, k = F.tid & 3; cws[F.tid] = k < 3 ? cw[k * NHY + j * HYW + c] : cb[j * HYW + c]; }
        __syncthreads();
        float w[12];
#pragma unroll
        for (int i = 0; i < 12; ++i) w[i] = cws[i];
        if (u < HYW) { const size_t o = (size_t)c * TPAD;
            hyena_unit<14, 1, 8>(buf, HYT + o, HYT + (size_t)HYW * TPAD + o, HYT + (size_t)2 * HYW * TPAD + o, w, (const c32*)(F.ws + WS_KF_P) + (size_t)c * KFS_P, (const c32*)(F.ws + WS_KF_P) + (size_t)(512 + c) * KFS_P, hb[c], hb[HYW + c], Z2T + o); }
        else { const size_t o = (size_t)c * TPAD + TP;
            hyena_unit<12, NSB, 8>(buf, HYT + o, HYT + (size_t)HYW * TPAD + o, HYT + (size_t)2 * HYW * TPAD + o, w, (const c32*)(F.ws + WS_KF_S) + (size_t)c * KFS_S, (const c32*)(F.ws + WS_KF_S) + (size_t)(512 + c) * KFS_S, hb[c], hb[HYW + c], Z2T + o); }
    }
}
__device__ __forceinline__ void z2_transpose(Frame& F) {
    LAS float* scr = (LAS float*)(F.lds + RING_OFF + F.wave * 16384);
    const int gw = F.vcu * NWAVES + F.wave, NGW = F.G * NWAVES, lane = F.lane;
    const float* Z2T = (const float*)(F.ws + WS_Z2T); bf16* Z2 = (bf16*)(F.ws + WS_Z2AT);
    for (int it = gw; it < (T / 64) * (HYW / 32); it += NGW) {
        const int rt = it / (HYW / 32), ct = it % (HYW / 32), r0 = 64 * rt, c0 = 32 * ct;
        float r_[32];
#pragma unroll
        for (int cc = 0; cc < 32; ++cc) r_[cc] = Z2T[(size_t)(c0 + cc) * TPAD + r0 + lane];
#pragma unroll
        for (int cc = 0; cc < 32; ++cc) scr[cc * 65 + lane] = r_[cc];
        LDS_WAIT(); asm volatile("" ::: "memory");
        for (int i = 0; i < 32; ++i) { const int rr = 2 * i + (lane >> 5); Z2[(size_t)(r0 + rr) * ZAP + c0 + (lane & 31)] = (bf16)f2bf(scr[(lane & 31) * 65 + rr]); }
        LDS_WAIT(); asm volatile("" ::: "memory");
    }
}
__device__ __forceinline__ void attention_simple(Frame& F, const InTab& A, int l) {
    LAS float* qs = (LAS float*)(F.lds + RING_OFF + F.wave * 4096);
    LAS float* ps = qs + 64;
    const int gw = F.vcu * NWAVES + F.wave, NGW = F.G * NWAVES, lane = F.lane;
    const bf16* P = (const bf16*)(F.ws + WS_PROJ); const bf16* QN = (const bf16*)(F.ws + WS_QN); const bf16* KN = (const bf16*)(F.ws + WS_KN); bf16* AT = (bf16*)(F.ws + WS_Z2AT) + HYW;
    for (int it = gw; it < T * NH; it += NGW) {
        const int m = it >> 3, h = it & 7, kv = h >> 2;
        int s0, len; seq_bounds(m, s0, len);
        const int jlo = max(m - WIN, s0), jhi = min(m + WIN, s0 + len - 1), nk = jhi - jlo + 1;
        qs[lane] = bf2f(QN[(size_t)m * ATW + h * HD + lane]);
        LDS_WAIT(); asm volatile("" ::: "memory");
        const float sink = A.in[I_SINK][l * NH + h];
        float sc[5]; float mx = sink;
#pragma unroll
        for (int r = 0; r < 5; ++r) { const int jj = lane + 64 * r; float s = -1e30f;
            if (jj < nk) { const v4u* kp = (const v4u*)(KN + (size_t)(jlo + jj) * KVW + kv * HD); float a = 0.f;
#pragma unroll
                for (int c = 0; c < 8; ++c) { const v4u w = kp[c]; const LAS float* q = qs + 8 * c;
                    a += q[0] * bflo(w.x) + q[1] * bfhi(w.x) + q[2] * bflo(w.y) + q[3] * bfhi(w.y) + q[4] * bflo(w.z) + q[5] * bfhi(w.z) + q[6] * bflo(w.w) + q[7] * bfhi(w.w); }
                s = a; }
            sc[r] = s; mx = fmaxf(mx, s); }
        mx = wave_max(mx);
        float den = 0.f;
#pragma unroll
        for (int r = 0; r < 5; ++r) { const int jj = lane + 64 * r; const float p = jj < nk ? fast_exp(sc[r] - mx) : 0.f; den += p; ps[jj] = p; }
        den = wave_sum(den) + fast_exp(sink - mx);
        LDS_WAIT(); asm volatile("" ::: "memory");
        float o = 0.f;
        const bf16* vp = P + (size_t)jlo * INW + COL_V + kv * HD + lane;
        for (int j = 0; j < nk; ++j) o += ps[j] * bf2f(vp[(size_t)j * INW]);
        AT[(size_t)m * ZAP + h * HD + lane] = (bf16)f2bf(o / den);
        LDS_WAIT(); asm volatile("" ::: "memory");
    }
}
__device__ __forceinline__ void merge_gates(Frame& F) {
    const bf16* P = (const bf16*)(F.ws + WS_PROJ); const bf16* YH = (const bf16*)(F.ws + WS_YHY); const bf16* YA = (const bf16*)(F.ws + WS_YAT); bf16* MG = (bf16*)(F.ws + WS_MERGED);
    const size_t nthr = (size_t)F.G * NWAVES * 64, t0 = (size_t)F.vcu * NWAVES * 64 + F.tid;
    for (size_t i = t0; i < (size_t)T * D / 8; i += nthr) {
        const size_t m = i >> 7; const int c = (int)(i & 127) * 8;
        const v4u gh = *(const v4u*)(P + m * INW + COL_G + c), ga = *(const v4u*)(P + m * INW + COL_G + D + c), yh = *(const v4u*)(YH + m * D + c), ya = *(const v4u*)(YA + m * D + c);
        v4u o;
#pragma unroll
        for (int k = 0; k < 4; ++k) { const float a = sigmoidf(bflo(gh[k])) * bflo(yh[k]) + sigmoidf(bflo(ga[k])) * bflo(ya[k]), b = sigmoidf(bfhi(gh[k])) * bfhi(yh[k]) + sigmoidf(bfhi(ga[k])) * bfhi(ya[k]); o[k] = pk2(a, b); }
        *(v4u*)(MG + m * D + c) = o;
    }
}
__device__ __forceinline__ void resid_norm_router(Frame& F, const InTab& A, int l) {
    const int gw = F.vcu * NWAVES + F.wave, NGW = F.G * NWAVES, lane = F.lane;
    const float* mod = (const float*)(F.ws + WS_MOD) + (size_t)l * NMOD * 6 * D;
    const float* MIX = (const float*)(F.ws + WS_MIX); bf16* H = (bf16*)(F.ws + WS_H); float* AFFT = (float*)(F.ws + WS_AFFT);
    const float* g2 = A.in[I_N2G] + (size_t)l * D; const float* rw = A.in[I_RW] + (size_t)l * D * NE;
    for (int m = gw; m < T; m += NGW) {
        const f32x4* xr = (const f32x4*)x_row(F, A, l, m) + lane; const f32x4* mx = (const f32x4*)(MIX + (size_t)m * D) + lane;
        const float* mr = mod + (size_t)mod_row(m) * 6 * D;
        f32x4 v[4]; float ss = 0.f;
#pragma unroll
        for (int j = 0; j < 4; ++j) { const int c = 4 * lane + 256 * j; const f32x4 g1 = *(const f32x4*)(mr + 2 * D + c);
            v[j] = xr[64 * j] + g1 * mx[64 * j]; ((f32x4*)(F.out + (size_t)m * D))[lane + 64 * j] = v[j];
            ss += (v[j].x * v[j].x + v[j].y * v[j].y) + (v[j].z * v[j].z + v[j].w * v[j].w); }
        const float rstd = 1.0f / sqrtf(wave_sum(ss) * (1.f / D) + EPS);
        float lg[NE];
#pragma unroll
        for (int e = 0; e < NE; ++e) lg[e] = 0.f;
        unsigned long long* o8 = (unsigned long long*)(H + (size_t)m * D) + lane;
#pragma unroll
        for (int j = 0; j < 4; ++j) { const int c = 4 * lane + 256 * j;
            const f32x4 gg = *(const f32x4*)(g2 + c), sc = *(const f32x4*)(mr + 4 * D + c), sh = *(const f32x4*)(mr + 3 * D + c);
            const f32x4 o = v[j] * rstd * gg * (sc + 1.0f) + sh;
            o8[64 * j] = (unsigned long long)pk2(o.x, o.y) | ((unsigned long long)pk2(o.z, o.w) << 32);
#pragma unroll
            for (int q = 0; q < 4; ++q) { const f32x4* wr = (const f32x4*)(rw + (size_t)(c + q) * NE);
#pragma unroll
                for (int e4 = 0; e4 < 4; ++e4) { const f32x4 w = wr[e4]; lg[4 * e4 + 0] += o[q] * w.x; lg[4 * e4 + 1] += o[q] * w.y; lg[4 * e4 + 2] += o[q] * w.z; lg[4 * e4 + 3] += o[q] * w.w; } } }
        float mxl = -1e30f;
#pragma unroll
        for (int e = 0; e < NE; ++e) { lg[e] = wave_sum(lg[e]); mxl = fmaxf(mxl, lg[e]); }
        float den = 0.f;
#pragma unroll
        for (int e = 0; e < NE; ++e) { lg[e] = expf(lg[e] - mxl); den += lg[e]; }
        const int grp = m >= TG, tg = m - grp * TG;
        float mine = 0.f;
#pragma unroll
        for (int e = 0; e < NE; ++e) mine = lane == e ? lg[e] / den : mine;
        if (lane < NE) AFFT[((size_t)grp * NE + lane) * TG + tg] = mine;
    }
}
__device__ __forceinline__ void topk_rank(Frame& F) {
    const float* AFFT = (const float*)(F.ws + WS_AFFT); int* SLOT = (int*)(F.ws + WS_SLOT); int* IDX = (int*)(F.ws + WS_IDX); float* GV = (float*)(F.ws + WS_GATEV);
    const size_t nthr = (size_t)F.G * NWAVES * 64, t0 = (size_t)F.vcu * NWAVES * 64 + F.tid;
    for (size_t i = t0; i < (size_t)NGRP * NE * TG; i += nthr) {
        const int ge = (int)(i >> 14), t = (int)(i & (TG - 1));
        const float* a = AFFT + (size_t)ge * TG; const float mine = a[t];
        int rank = 0;
        for (int j = 0; j < TG; j += 4) { const f32x4 v = *(const f32x4*)(a + j);
            rank += (v.x > mine || (v.x == mine && j + 0 < t)) ? 1 : 0; rank += (v.y > mine || (v.y == mine && j + 1 < t)) ? 1 : 0;
            rank += (v.z > mine || (v.z == mine && j + 2 < t)) ? 1 : 0; rank += (v.w > mine || (v.w == mine && j + 3 < t)) ? 1 : 0; }
        SLOT[i] = rank < CAP ? rank : -1;
        if (rank < CAP) { IDX[(size_t)ge * CAP + rank] = t; GV[(size_t)ge * CAP + rank] = mine; }
    }
}
__device__ __forceinline__ void gather_rows(Frame& F) {
    const int gw = F.vcu * NWAVES + F.wave, NGW = F.G * NWAVES, lane = F.lane;
    const bf16* __restrict__ H = (const bf16*)(F.ws + WS_H); unsigned char* __restrict__ XE = (unsigned char*)(F.ws + WS_XE); unsigned char* __restrict__ HID = (unsigned char*)(F.ws + WS_HID); const int* __restrict__ IDX = (const int*)(F.ws + WS_IDX);
    for (int sb = gw * 32; sb < NSLOT; sb += NGW * 32) {
        const int grp = sb >> 15, tix = IDX[sb + (lane & 31)];
#pragma unroll
        for (int j = 0; j < 4; ++j) { const int q = j * 64 + lane; *(v4u*)(HID + (size_t)(sb + (q >> 3)) * KB_DN + FF / 2 + 16 * (q & 7)) = (v4u){0u, 0u, 0u, 0u}; }
        for (int i = 0; i < 32; i += 8) {
            v4u a[8], b[8];
#pragma unroll
            for (int k = 0; k < 8; ++k) { const int t = __builtin_amdgcn_readlane(tix, i + k); const v4u* src = (const v4u*)(H + ((size_t)grp * TG + t) * D); a[k] = src[lane]; b[k] = src[64 + lane]; }
#pragma unroll
            for (int k = 0; k < 8; ++k) { unsigned char* dst = XE + (size_t)(sb + i + k) * KB_UP;
                unsigned wa, wb;
                PG8_FP4_PACK8(wa, bflo(a[k].x), bfhi(a[k].x), bflo(a[k].y), bfhi(a[k].y), bflo(a[k].z), bfhi(a[k].z), bflo(a[k].w), bfhi(a[k].w));
                PG8_FP4_PACK8(wb, bflo(b[k].x), bfhi(b[k].x), bflo(b[k].y), bfhi(b[k].y), bflo(b[k].z), bfhi(b[k].z), bflo(b[k].w), bfhi(b[k].w));
                *(unsigned*)(dst + 4 * lane) = wa; *(unsigned*)(dst + 256 + 4 * lane) = wb; }
        }
    }
}
__device__ __forceinline__ void moe_combine(Frame& F, int l) {
    const int gw = F.vcu * NWAVES + F.wave, NGW = F.G * NWAVES, lane = F.lane;
    const float* mod = (const float*)(F.ws + WS_MOD) + (size_t)l * NMOD * 6 * D;
    const int* SLOT = (const int*)(F.ws + WS_SLOT); const float* GV = (const float*)(F.ws + WS_GATEV); const bf16* YE = (const bf16*)(F.ws + WS_YE);
    for (int m = gw; m < T; m += NGW) {
        const int grp = m >= TG, tg = m - grp * TG;
        const float* mr = mod + (size_t)mod_row(m) * 6 * D;
        f32x4 acc[4];
#pragma unroll
        for (int j = 0; j < 4; ++j) acc[j] = (f32x4){0.f, 0.f, 0.f, 0.f};
        for (int e = 0; e < NE; ++e) {
            const int sl = SLOT[((size_t)grp * NE + e) * TG + tg];
            if (sl >= 0) { const size_t row = ((size_t)grp * NE + e) * CAP + sl; const float gt = GV[row]; const v2u* yr = (const v2u*)(YE + row * D) + lane;
#pragma unroll
                for (int j = 0; j < 4; ++j) { const v2u w = yr[64 * j]; acc[j] += (f32x4){bflo(w.x), bfhi(w.x), bflo(w.y), bfhi(w.y)} * gt; } }
        }
        f32x4* xo = (f32x4*)(F.out + (size_t)m * D) + lane;
#pragma unroll
        for (int j = 0; j < 4; ++j) { const f32x4 g2 = *(const f32x4*)(mr + 5 * D + 4 * lane + 256 * j); xo[64 * j] = xo[64 * j] + g2 * acc[j]; }
    }
}

__device__ __forceinline__ void topk_select(Frame& F) {
    LAS unsigned* keys = (LAS unsigned*)(F.lds + RING_OFF);
    LAS unsigned* hist = (LAS unsigned*)(F.lds + RING_OFF + 65536);
    LAS unsigned* misc = (LAS unsigned*)(F.lds + RING_OFF + 65536 + 8192);
    const float* AFFT = (const float*)(F.ws + WS_AFFT); int* SLOT = (int*)(F.ws + WS_SLOT); int* IDX = (int*)(F.ws + WS_IDX); float* GV = (float*)(F.ws + WS_GATEV);
    const int tid = F.tid, lane = F.lane, wave = F.wave;
    for (int u = F.vcu; u < NGRP * NE; u += F.G) {
        const float* a = AFFT + (size_t)u * TG;
        for (int i = tid; i < TG; i += NWAVES * 64) keys[i] = __builtin_bit_cast(unsigned, a[i]);
        unsigned prefix = 0u, mask = 0u, need = CAP;
        for (int pass = 0; pass < 4; ++pass) {
            const int shift = 24 - 8 * pass;
            for (int i = tid; i < NWAVES * 256; i += NWAVES * 64) hist[i] = 0u;
            __syncthreads();
            for (int i = tid; i < TG; i += NWAVES * 64) { const unsigned k = keys[i]; if ((k & mask) == prefix) __hip_atomic_fetch_add(&hist[wave * 256 + ((k >> shift) & 255u)], 1u, __ATOMIC_RELAXED, __HIP_MEMORY_SCOPE_WORKGROUP); }
            __syncthreads();
            if (wave == 0) {
                unsigned h[4];
#pragma unroll
                for (int b = 0; b < 4; ++b) { unsigned s = 0u;
#pragma unroll
                    for (int w = 0; w < NWAVES; ++w) s += hist[w * 256 + 4 * lane + b];
                    h[b] = s; }
                const unsigned mine = h[0] + h[1] + h[2] + h[3];
                unsigned inc = mine;
#pragma unroll
                for (int o = 1; o < 64; o <<= 1) { const unsigned t = __shfl_down(inc, o); if (lane + o < 64) inc += t; }
                unsigned c = inc - mine;
#pragma unroll
                for (int b = 3; b >= 0; --b) { if (c < need && c + h[b] >= need) { misc[0] = (unsigned)(4 * lane + b); misc[1] = need - c; } c += h[b]; }
            }
            __syncthreads();
            prefix |= misc[0] << shift; mask |= 255u << shift; need = misc[1];
            __syncthreads();
        }
        unsigned cg = 0u, ce = 0u;
        for (int r = 0; r < 32; ++r) { const unsigned k = keys[2048 * wave + 64 * r + lane];
            cg += (unsigned)__popcll(__ballot(k > prefix)); ce += (unsigned)__popcll(__ballot(k == prefix)); }
        if (lane == 0) { misc[16 + 2 * wave] = cg; misc[17 + 2 * wave] = ce; }
        __syncthreads();
        unsigned eq_base = 0u, slot_base = 0u;
        for (int w = 0; w < NWAVES; ++w) { const unsigned g = misc[16 + 2 * w], e = misc[17 + 2 * w];
            if (w < wave) { const unsigned take = eq_base >= need ? 0u : ((need - eq_base) < e ? (need - eq_base) : e); slot_base += g + take; eq_base += e; } }
        const unsigned long long below = (1ull << lane) - 1ull;
        for (int r = 0; r < 32; ++r) { const int t = 2048 * wave + 64 * r + lane; const unsigned k = keys[t];
            const unsigned long long beq = __ballot(k == prefix);
            const unsigned eq_rank = eq_base + (unsigned)__popcll(beq & below);
            const bool sel = (k > prefix) || (k == prefix && eq_rank < need);
            const unsigned long long bsel = __ballot(sel);
            const unsigned slot = slot_base + (unsigned)__popcll(bsel & below);
            SLOT[((size_t)(u >> 4) * TG + t) * NE + (u & 15)] = sel ? (int)slot : -1;
            if (sel) { IDX[(size_t)u * CAP + slot] = t; GV[(size_t)u * CAP + slot] = __builtin_bit_cast(float, k); }
            eq_base += (unsigned)__popcll(beq); slot_base += (unsigned)__popcll(bsel); }
        __syncthreads();
    }
}
__device__ __forceinline__ void rope_table(Frame& F) {
    f32x2* RT = (f32x2*)(F.ws + WS_ROPE);
    const int nthr = F.G * NWAVES * 64;
    for (int i = F.vcu * NWAVES * 64 + F.tid; i < TP * 32; i += nthr) { double rv = (double)(i >> 5) * ROPE_INV_REV[i & 31]; rv -= floor(rv); const float rf = (float)rv; RT[i] = (f32x2){cos_rev(rf), sin_rev(rf)}; }
}
constexpr int AT_KP = 72, AT_VP = 388;
__device__ __forceinline__ void attention_mfma(Frame& F, const InTab& A, int l) {
    LAS bf16* Ks = (LAS bf16*)(F.lds + RING_OFF);
    LAS bf16* Vt = (LAS bf16*)(F.lds + RING_OFF + 384 * AT_KP * 2);
    const bf16* P = (const bf16*)(F.ws + WS_PROJ); bf16* AT = (bf16*)(F.ws + WS_Z2AT) + HYW; const f32x2* RT = (const f32x2*)(F.ws + WS_ROPE);
    const float* gqp = A.in[I_QNG] + l * HD; const float* gkp = A.in[I_KNG] + l * HD;
    const int tid = F.tid, lane = F.lane, wave = F.wave, lr = lane & 31, hl = lane >> 5;
    for (int u = F.vcu; u < (T / 128) * NKV; u += F.G) {
        const int kv = u & 1, r0 = (u >> 1) * 128;
        int s0, len; seq_bounds(r0, s0, len);
        for (int i = tid; i < 384 * 8; i += NWAVES * 64) { const int kl = i >> 3, c8 = (i & 7) * 8, row = r0 - 128 + kl;
            const bool ok = row >= s0 && row < s0 + len; const int rc = ok ? row : r0;
            const v4u kraw = *(const v4u*)(P + (size_t)rc * INW + COL_K + kv * HD + c8), vraw = *(const v4u*)(P + (size_t)rc * INW + COL_V + kv * HD + c8);
            float x[8]; float ss = 0.f;
#pragma unroll
            for (int e = 0; e < 4; ++e) { x[2 * e] = bflo(kraw[e]); x[2 * e + 1] = bfhi(kraw[e]); ss += x[2 * e] * x[2 * e] + x[2 * e + 1] * x[2 * e + 1]; }
            ss += __shfl_xor(ss, 1); ss += __shfl_xor(ss, 2); ss += __shfl_xor(ss, 4);
            const float rstd = 1.0f / sqrtf(ss * (1.f / HD) + EPS);
            const f32x2* rt = RT + (size_t)(rc - s0) * 32 + (c8 & 31);
            float o[8];
#pragma unroll
            for (int e = 0; e < 8; ++e) { const float y = x[e] * rstd * gkp[c8 + e]; const float p = __shfl_xor(y, 4); const f32x2 cs = rt[e]; o[e] = c8 < 32 ? y * cs.x - p * cs.y : y * cs.x + p * cs.y; }
            v4u kw = {pk2(o[0], o[1]), pk2(o[2], o[3]), pk2(o[4], o[5]), pk2(o[6], o[7])}; v4u vw = vraw;
            if (!ok) { kw = (v4u){0u, 0u, 0u, 0u}; vw = (v4u){0u, 0u, 0u, 0u}; }
            *(LAS v4u*)(Ks + kl * AT_KP + c8) = kw;
#pragma unroll
            for (int e = 0; e < 4; ++e) { Vt[(c8 + 2 * e) * AT_VP + kl] = (bf16)(vw[e] & 0xffffu); Vt[(c8 + 2 * e + 1) * AT_VP + kl] = (bf16)(vw[e] >> 16); } }
        __syncthreads();
        const int h = kv * 4 + (wave >> 1);
        const float sink = A.in[I_SINK][l * NH + h];
        for (int qt = 0; qt < 2; ++qt) {
            const int qa = 64 * (wave & 1) + 32 * qt;
            bf16x8 Qf[4];
            {
                const int row = r0 + qa + lr; const bf16* qp = P + (size_t)row * INW + COL_Q + h * HD + 8 * hl;
                float x[4][8]; float ss = 0.f;
#pragma unroll
                for (int s = 0; s < 4; ++s) { const v4u w = *(const v4u*)(qp + 16 * s);
#pragma unroll
                    for (int e = 0; e < 4; ++e) { x[s][2 * e] = bflo(w[e]); x[s][2 * e + 1] = bfhi(w[e]); ss += x[s][2 * e] * x[s][2 * e] + x[s][2 * e + 1] * x[s][2 * e + 1]; } }
                ss += __shfl_xor(ss, 32);
                const float rstd = 0.125f / sqrtf(ss * (1.f / HD) + EPS);
                const f32x2* rt = RT + (size_t)(row - s0) * 32 + 8 * hl;
#pragma unroll
                for (int s = 0; s < 2; ++s) { float o1[8], o2[8];
#pragma unroll
                    for (int j = 0; j < 8; ++j) { const int d = 16 * s + 8 * hl + j; const float y1 = x[s][j] * rstd * gqp[d], y2 = x[s + 2][j] * rstd * gqp[d + 32]; const f32x2 cs = rt[16 * s + j];
                        o1[j] = y1 * cs.x - y2 * cs.y; o2[j] = y2 * cs.x + y1 * cs.y; }
                    const v4u a = {pk2(o1[0], o1[1]), pk2(o1[2], o1[3]), pk2(o1[4], o1[5]), pk2(o1[6], o1[7])}, b = {pk2(o2[0], o2[1]), pk2(o2[2], o2[3]), pk2(o2[4], o2[5]), pk2(o2[6], o2[7])};
                    Qf[s] = __builtin_bit_cast(bf16x8, a); Qf[s + 2] = __builtin_bit_cast(bf16x8, b); }
            }
            float m_run = sink, l_run = 0.f;
            f32x16 O0, O1;
#pragma unroll
            for (int r = 0; r < 16; ++r) { O0[r] = 0.f; O1[r] = 0.f; }
            for (int kt = qa >> 5; kt <= (qa >> 5) + 8; ++kt) {
                f32x16 S;
#pragma unroll
                for (int r = 0; r < 16; ++r) S[r] = 0.f;
#pragma unroll
                for (int s = 0; s < 4; ++s) { const bf16x8 Kf = *(const LAS bf16x8*)(Ks + (32 * kt + lr) * AT_KP + 16 * s + 8 * hl); S = __builtin_amdgcn_mfma_f32_32x32x16_bf16(Kf, Qf[s], S, 0, 0, 0); }
                float mt = -1e30f;
#pragma unroll
                for (int r = 0; r < 16; ++r) { const int kl = 32 * kt + (r & 3) + 8 * (r >> 2) + 4 * hl, dlt = qa + lr + 128 - kl, row = r0 - 128 + kl;
                    const bool ok = dlt <= WIN && dlt >= -WIN && row >= s0 && row < s0 + len;
                    S[r] = ok ? S[r] : -1e30f; mt = fmaxf(mt, S[r]); }
                mt = fmaxf(mt, __shfl_xor(mt, 32));
                const float m_new = fmaxf(m_run, mt), sc = fast_exp(m_run - m_new);
                float ps = 0.f;
#pragma unroll
                for (int r = 0; r < 16; ++r) { S[r] = fast_exp(S[r] - m_new); ps += S[r]; }
                l_run = l_run * sc + ps; m_run = m_new;
#pragma unroll
                for (int r = 0; r < 16; ++r) { O0[r] *= sc; O1[r] *= sc; }
#pragma unroll
                for (int sp = 0; sp < 2; ++sp) {
                    v4u pw; pw.x = pk2(S[8 * sp + 0], S[8 * sp + 1]); pw.y = pk2(S[8 * sp + 2], S[8 * sp + 3]); pw.z = pk2(S[8 * sp + 4], S[8 * sp + 5]); pw.w = pk2(S[8 * sp + 6], S[8 * sp + 7]);
                    const bf16x8 Pf = __builtin_bit_cast(bf16x8, pw);
                    const int kb = 32 * kt + 16 * sp + 4 * hl;
                    { const v2u a = *(const LAS v2u*)(Vt + lr * AT_VP + kb), b = *(const LAS v2u*)(Vt + lr * AT_VP + kb + 8); const v4u vv = {a.x, a.y, b.x, b.y};
                      O0 = __builtin_amdgcn_mfma_f32_32x32x16_bf16(__builtin_bit_cast(bf16x8, vv), Pf, O0, 0, 0, 0); }
                    { const v2u a = *(const LAS v2u*)(Vt + (32 + lr) * AT_VP + kb), b = *(const LAS v2u*)(Vt + (32 + lr) * AT_VP + kb + 8); const v4u vv = {a.x, a.y, b.x, b.y};
                      O1 = __builtin_amdgcn_mfma_f32_32x32x16_bf16(__builtin_bit_cast(bf16x8, vv), Pf, O1, 0, 0, 0); }
                }
            }
            const float l_tot = l_run + __shfl_xor(l_run, 32), inv = 1.0f / (l_tot + fast_exp(sink - m_run));
            bf16* orow = AT + (size_t)(r0 + qa + lr) * ZAP + h * HD + 4 * hl;
#pragma unroll
            for (int g = 0; g < 4; ++g) {
                v2u w0; w0.x = pk2(O0[4 * g + 0] * inv, O0[4 * g + 1] * inv); w0.y = pk2(O0[4 * g + 2] * inv, O0[4 * g + 3] * inv); *(v2u*)(orow + 8 * g) = w0;
                v2u w1; w1.x = pk2(O1[4 * g + 0] * inv, O1[4 * g + 1] * inv); w1.y = pk2(O1[4 * g + 2] * inv, O1[4 * g + 3] * inv); *(v2u*)(orow + 32 + 8 * g) = w1; }
        }
        __syncthreads();
    }
}

__device__ __forceinline__ void resid_norm_router2(Frame& F, const InTab& A, int l) {
    LAS float* rwT = (LAS float*)(F.lds + RING_OFF);
    const int gw = F.vcu * NWAVES + F.wave, NGW = F.G * NWAVES, lane = F.lane;
    const float* __restrict__ mod = (const float*)(F.ws + WS_MOD) + (size_t)l * NMOD * 6 * D;
    const float* __restrict__ MIX = (const float*)(F.ws + WS_MIX); bf16* __restrict__ H = (bf16*)(F.ws + WS_H); float* __restrict__ AFFT = (float*)(F.ws + WS_AFFT); float* __restrict__ AFFTOK = (float*)(F.ws + WS_AFFTOK);
    const float* __restrict__ g2 = A.in[I_N2G] + (size_t)l * D; const float* __restrict__ rw = A.in[I_RW] + (size_t)l * D * NE;
    for (int i = F.tid; i < D * NE / 4; i += NWAVES * 64) { const f32x4 w = ((const f32x4*)rw)[i]; const int k = i >> 2, e0 = (i & 3) * 4;
        rwT[(e0 + 0) * D + k] = w.x; rwT[(e0 + 1) * D + k] = w.y; rwT[(e0 + 2) * D + k] = w.z; rwT[(e0 + 3) * D + k] = w.w; }
    __syncthreads();
    f32x4 gg[4];
#pragma unroll
    for (int j = 0; j < 4; ++j) gg[j] = *(const f32x4*)(g2 + 4 * lane + 256 * j);
    f32x4 xn[4], scn[4], shn[4];
#define RR_ISSUE(mm) do { const f32x4* xr_ = (const f32x4*)(F.out + (size_t)(mm) * D) + lane; const float* mr_ = mod + (size_t)mod_row(mm) * 6 * D + 4 * lane; \
        _Pragma("unroll") for (int j = 0; j < 4; ++j) { xn[j] = xr_[64 * j]; scn[j] = *(const f32x4*)(mr_ + 4 * D + 256 * j); shn[j] = *(const f32x4*)(mr_ + 3 * D + 256 * j); } } while (0)
    if (gw < T) RR_ISSUE(gw);
    for (int m = gw; m < T; m += NGW) {
        f32x4 v[4], sc[4], sh[4]; float ss = 0.f;
#pragma unroll
        for (int j = 0; j < 4; ++j) { v[j] = xn[j]; sc[j] = scn[j]; sh[j] = shn[j]; }
        if (m + NGW < T) RR_ISSUE(m + NGW);
#pragma unroll
        for (int j = 0; j < 4; ++j) ss += (v[j].x * v[j].x + v[j].y * v[j].y) + (v[j].z * v[j].z + v[j].w * v[j].w);
        const float rstd = 1.0f / sqrtf(wave_sum(ss) * (1.f / D) + EPS);
        float lg[NE];
#pragma unroll
        for (int e = 0; e < NE; ++e) lg[e] = 0.f;
        unsigned long long* o8 = (unsigned long long*)(H + (size_t)m * D) + lane;
#pragma unroll
        for (int j = 0; j < 4; ++j) { const f32x4 o = v[j] * rstd * gg[j] * (sc[j] + 1.0f) + sh[j];
            o8[64 * j] = (unsigned long long)pk2(o.x, o.y) | ((unsigned long long)pk2(o.z, o.w) << 32);
#pragma unroll
            for (int eh = 0; eh < NE; eh += 8) {
#pragma unroll
                for (int e = eh; e < eh + 8; ++e) { const f32x4 w = *(const LAS f32x4*)(rwT + e * D + 4 * lane + 256 * j); lg[e] += (o.x * w.x + o.y * w.y) + (o.z * w.z + o.w * w.w); }
                asm volatile("" ::: "memory"); } }
        float k8[8], k4[4], k2[2], k1;
#pragma unroll
        for (int i = 0; i < 8; ++i) { const bool hi = lane & 32; const float send = hi ? lg[i] : lg[i + 8], keep = hi ? lg[i + 8] : lg[i]; k8[i] = keep + __shfl_xor(send, 32); }
#pragma unroll
        for (int i = 0; i < 4; ++i) { const bool hi = lane & 16; const float send = hi ? k8[i] : k8[i + 4], keep = hi ? k8[i + 4] : k8[i]; k4[i] = keep + __shfl_xor(send, 16); }
#pragma unroll
        for (int i = 0; i < 2; ++i) { const bool hi = lane & 8; const float send = hi ? k4[i] : k4[i + 2], keep = hi ? k4[i + 2] : k4[i]; k2[i] = keep + __shfl_xor(send, 8); }
        { const bool hi = lane & 4; const float send = hi ? k2[0] : k2[1], keep = hi ? k2[1] : k2[0]; k1 = keep + __shfl_xor(send, 4); }
        k1 += __shfl_xor(k1, 2); k1 += __shfl_xor(k1, 1);
        const int e = ((lane >> 5) & 1) * 8 + ((lane >> 4) & 1) * 4 + ((lane >> 3) & 1) * 2 + ((lane >> 2) & 1);
        const float mxl = wave_max(k1), ex = expf(k1 - mxl), den = wave_sum(ex) * 0.25f;
        const float aff = ex / den;
        const int grp = m >= TG, tg = m - grp * TG;
        if ((lane & 3) == 0) { AFFT[((size_t)grp * NE + e) * TG + tg] = aff; AFFTOK[(size_t)m * NE + e] = aff; }
    }
}
__device__ __forceinline__ void moe_combine2(Frame& F, int l, float zmul, int nl, const float* __restrict__ g1n) {
    const int gw = F.vcu * NWAVES + F.wave, NGW = F.G * NWAVES, lane = F.lane;
    const float* __restrict__ mod = (const float*)(F.ws + WS_MOD) + (size_t)l * NMOD * 6 * D;
    const int* __restrict__ SLOT = (const int*)(F.ws + WS_SLOT); const float* __restrict__ AFFTOK = (const float*)(F.ws + WS_AFFTOK); const bf16* __restrict__ YE = (const bf16*)(F.ws + WS_YE);
    for (int m = gw; m < T; m += NGW) {
        const int grp = m >= TG;
        const int sl = SLOT[(size_t)m * NE + (lane & 15)]; const float gtv = AFFTOK[(size_t)m * NE + (lane & 15)];
        f32x4* xo = (f32x4*)(F.out + (size_t)m * D) + lane;
        const float* __restrict__ mr = mod + (size_t)mod_row(m) * 6 * D;
        f32x4 xv[4], g2[4], acc[4];
#pragma unroll
        for (int j = 0; j < 4; ++j) { xv[j] = xo[64 * j]; g2[j] = *(const f32x4*)(mr + 5 * D + 4 * lane + 256 * j); acc[j] = (f32x4){0.f, 0.f, 0.f, 0.f}; }
        unsigned mask = (unsigned)(__ballot(sl >= 0) & 0xffffull);
        while (mask) {
            const int e0 = __builtin_ctz(mask); mask &= mask - 1u;
            const bool two = mask != 0u; const int e1 = two ? __builtin_ctz(mask) : e0; if (two) mask &= mask - 1u;
            const int s0 = __builtin_amdgcn_readlane(sl, e0), s1 = __builtin_amdgcn_readlane(sl, e1);
            const float t0 = rdlane(gtv, e0), t1 = two ? rdlane(gtv, e1) : 0.f;
            const v2u* __restrict__ y0 = (const v2u*)(YE + (((size_t)grp * NE + e0) * CAP + s0) * D) + lane; const v2u* __restrict__ y1 = (const v2u*)(YE + (((size_t)grp * NE + e1) * CAP + s1) * D) + lane;
            v2u a[4], b[4];
#pragma unroll
            for (int j = 0; j < 4; ++j) { a[j] = y0[64 * j]; b[j] = y1[64 * j]; }
#pragma unroll
            for (int j = 0; j < 4; ++j) { acc[j] += (f32x4){bflo(a[j].x), bfhi(a[j].x), bflo(a[j].y), bfhi(a[j].y)} * t0; acc[j] += (f32x4){bflo(b[j].x), bfhi(b[j].x), bflo(b[j].y), bfhi(b[j].y)} * t1; }
        }
#pragma unroll
        for (int j = 0; j < 4; ++j) { xv[j] = xv[j] + g2[j] * acc[j] * zmul; xo[64 * j] = xv[j]; }
        if (nl >= 0) {
            float ss = 0.f;
#pragma unroll
            for (int j = 0; j < 4; ++j) ss += (xv[j].x * xv[j].x + xv[j].y * xv[j].y) + (xv[j].z * xv[j].z + xv[j].w * xv[j].w);
            const float rstd = 1.0f / sqrtf(wave_sum(ss) * (1.f / D) + EPS);
            const float* __restrict__ mrn = (const float*)(F.ws + WS_MOD) + ((size_t)nl * NMOD + mod_row(m)) * 6 * D;
            unsigned long long* o8 = (unsigned long long*)((bf16*)(F.ws + WS_H) + (size_t)m * D) + lane;
#pragma unroll
            for (int j = 0; j < 4; ++j) { const int cc = 4 * lane + 256 * j;
                const f32x4 gg = *(const f32x4*)(g1n + cc), sc = *(const f32x4*)(mrn + D + cc), sh = *(const f32x4*)(mrn + cc);
                const f32x4 o = xv[j] * rstd * gg * (sc + 1.0f) + sh;
                o8[64 * j] = (unsigned long long)pk2(o.x, o.y) | ((unsigned long long)pk2(o.z, o.w) << 32); }
        }
    }
}

#ifdef PROBE_FP8
typedef int v8i_t __attribute__((ext_vector_type(8)));
__device__ __forceinline__ float fp8p_a(int i, int k) { return (float)(((i * 7 + k * 3) % 5) - 2); }
__device__ __forceinline__ float fp8p_b(int k, int j) { return (float)(((k * 5 + j * 11) % 7) - 3); }
__device__ __forceinline__ int fp8p_k(int lane, int b, int hyp) {
    const int g = lane >> 4;
    if (hyp == 1) return 32 * g + b;
    if (hyp == 2) return 16 * g + (b & 15) + 64 * (b >> 4);
    return 8 * g + (b & 7) + 32 * (b >> 3);
}
__device__ __forceinline__ bool fp8_probe(int lane) {
    v8i_t A, B;
#pragma unroll
    for (int v = 0; v < 8; ++v) { int wa = 0, wb = 0;
        { const int k0 = fp8p_k(lane, 4 * v + 0, PROBE_FP8_HA), k1 = fp8p_k(lane, 4 * v + 1, PROBE_FP8_HA), k2 = fp8p_k(lane, 4 * v + 2, PROBE_FP8_HA), k3 = fp8p_k(lane, 4 * v + 3, PROBE_FP8_HA);
          wa = __builtin_amdgcn_cvt_pk_fp8_f32(fp8p_a(lane & 15, k0), fp8p_a(lane & 15, k1), wa, false); wa = __builtin_amdgcn_cvt_pk_fp8_f32(fp8p_a(lane & 15, k2), fp8p_a(lane & 15, k3), wa, true); }
        { const int k0 = fp8p_k(lane, 4 * v + 0, PROBE_FP8_HB), k1 = fp8p_k(lane, 4 * v + 1, PROBE_FP8_HB), k2 = fp8p_k(lane, 4 * v + 2, PROBE_FP8_HB), k3 = fp8p_k(lane, 4 * v + 3, PROBE_FP8_HB);
          wb = __builtin_amdgcn_cvt_pk_fp8_f32(fp8p_b(k0, lane & 15), fp8p_b(k1, lane & 15), wb, false); wb = __builtin_amdgcn_cvt_pk_fp8_f32(fp8p_b(k2, lane & 15), fp8p_b(k3, lane & 15), wb, true); }
        A[v] = wa; B[v] = wb; }
    f32x4 acc = {0.f, 0.f, 0.f, 0.f};
    acc = __builtin_amdgcn_mfma_scale_f32_16x16x128_f8f6f4(A, B, acc, 0, 0, 0, 0x7F7F7F7F, 0, 0x7F7F7F7F);
    bool bad = false;
#pragma unroll
    for (int r = 0; r < 4; ++r) { const int row = 4 * (lane >> 4) + r, col = lane & 15; float s = 0.f;
        for (int k = 0; k < 128; ++k) s += fp8p_a(row, k) * fp8p_b(k, col);
        bad |= (acc[r] != s); }
    return bad;
}
#endif

#ifdef PROBE_FP4
typedef int v8i_p4 __attribute__((ext_vector_type(8)));
__device__ __forceinline__ float fp4p_a(int i, int k) { return (float)(((i * 7 + k * 3) % 5) - 2); }
__device__ __forceinline__ float fp4p_b(int k, int j) { return (float)(((k * 5 + j * 11) % 7) - 3); }
__device__ __forceinline__ bool fp4_probe(int lane) {
    v8i_p4 A, B;
#pragma unroll
    for (int v = 0; v < 8; ++v) { A[v] = 0; B[v] = 0; }
    const int g = lane >> 4;
#pragma unroll
    for (int v = 0; v < 4; ++v) { unsigned wa = 0u, wb = 0u;
#if PROBE_FP4 == 1
#define FP4P_K(by) const int k0 = 32 * g + 8 * v + 2 * (by), k1 = k0 + 1
#else
#define FP4P_K(by) const int k1 = 32 * g + 8 * v + 2 * (by), k0 = k1 + 1
#endif
#define FP4P_BYTE(by) { FP4P_K(by); wa = __builtin_amdgcn_cvt_scalef32_pk_fp4_f32(wa, fp4p_a(lane & 15, k0), fp4p_a(lane & 15, k1), 1.0f, by); wb = __builtin_amdgcn_cvt_scalef32_pk_fp4_f32(wb, fp4p_b(k0, lane & 15), fp4p_b(k1, lane & 15), 1.0f, by); }
        FP4P_BYTE(0) FP4P_BYTE(1) FP4P_BYTE(2) FP4P_BYTE(3)
#undef FP4P_BYTE
#undef FP4P_K
        A[v] = (int)wa; B[v] = (int)wb; }
    f32x4 acc = {0.f, 0.f, 0.f, 0.f};
    acc = __builtin_amdgcn_mfma_scale_f32_16x16x128_f8f6f4(A, B, acc, 4, 4, 0, 0x7F7F7F7F, 0, 0x7F7F7F7F);
    bool bad = false;
#pragma unroll
    for (int r = 0; r < 4; ++r) { const int row = 4 * (lane >> 4) + r, col = lane & 15; float s = 0.f;
        for (int k = 0; k < 128; ++k) s += fp4p_a(row, k) * fp4p_b(k, col);
        bad |= (acc[r] != s); }
    return bad;
}
#endif

constexpr int PH_PER_LAYER = 14, N_PHASES = 1 + DEPTH * PH_PER_LAYER;
__global__ void __launch_bounds__(NWAVES * 64, 2) mk_fwd(Args args) {
    extern __shared__ __attribute__((aligned(16))) unsigned char lds[];
    Frame F;
    F.lds = (LAS unsigned char*)lds;
    F.MISC = (volatile LAS unsigned*)(F.lds + MISC_OFF);
    F.tid = threadIdx.x; F.lane = F.tid & 63; F.wave = __builtin_amdgcn_readfirstlane(F.tid >> 6);
    F.G = gridDim.x; F.bid = blockIdx.x; { const int bx = blockIdx.x; F.vcu = (F.G % 8 == 0) ? (bx % 8) * (F.G / 8) + bx / 8 : bx; }
    F.ws = args.ws; F.out = args.out; F.ctl = (gu32*)(args.ws + WS_CTL);
    for (int u = F.tid; u < (SCR_OFF - LDSCTL_OFF) / 4; u += NWAVES * 64) ((LAS unsigned*)(F.lds + LDSCTL_OFF))[u] = 0u;
    __syncthreads();
    XcdBarrier bar; bar.bar = (unsigned*)(F.ctl + CW_BAR); bar.x = 0; bar.st = nullptr;
    if (!MK_PER_PHASE) bar = xcd_barrier_post((unsigned*)(F.ctl + CW_BAR), F.MISC + 8);
    const int lo = args.ph_lo, hi = args.ph_hi;
#ifndef PH_MASK
#define PH_MASK 0xFFFFu
#endif
#define PHON(j) (((PH_MASK) >> (j)) & 1u)
#define IN(k) (lo <= (k) && (k) < hi)
#define PH_ENTER() Frame P = F; InTab A; { KargTab t_ = (KargTab)__builtin_amdgcn_kernarg_segment_ptr(); asm volatile("" : "+s"(t_)); A.in.t = t_; { size_t z_ = 0; asm volatile("" : "+s"(z_)); P.ws = args.ws + z_; P.out = args.out + z_; } asm volatile("" : "+v"(P.tid)); asm volatile("" : "+s"(P.vcu)); asm volatile("" : "+s"(P.G)); asm volatile("" : "+s"(P.bid)); P.lane = P.tid & 63; P.wave = __builtin_amdgcn_readfirstlane(P.tid >> 6); }
#ifdef PROBE_SEAM2
#define SEAM(k) do { if (IN(k) && IN((k) + 1)) { xcd_barrier(bar); xcd_barrier(bar); } } while (0)
#else
#define SEAM(k) do { if (IN(k) && IN((k) + 1)) xcd_barrier(bar); } while (0)
#endif

    if (PHON(14) && IN(0)) { PH_ENTER(); adaln_mod(P, A); rope_table(P); convert_small_weights(P, A); convert_moe_weights(P, A, 0); }
    SEAM(0);

    for (int l = 0; l < DEPTH; ++l) {
        const int k0 = 1 + PH_PER_LAYER * l;
        if (PHON(0) && IN(k0 + 0)) { PH_ENTER(); filter_time_tiles(P, A, l); if (l == 0) norm_mod_rows(P, A, l, A.in[I_N1G] + (size_t)l * D, 0, D);
#ifdef PROBE_NORMROWS_TWICE
            norm_mod_rows(P, A, l, A.in[I_N1G] + (size_t)l * D, 0, D);
#endif
#ifdef PROBE_FTILES_TWICE
            filter_time_tiles(P, A, l);
#endif
        }
        SEAM(k0 + 0);
        if (PHON(1) && IN(k0 + 1)) { PH_ENTER();
            { pg8::Gemm g{(const bf16*)(P.ws + WS_H), (const bf16*)(P.ws + WS_WIN) + (size_t)l * INW * D, T, NHY, D, 1 << 30, 1, 0}; pg8::StaticOrder S; S.init(T, NHY, P.G, P.bid);
              pg8::EpiColMajor E{(float*)(P.ws + WS_HYT), TPAD}; pg8::gemm_phase<pg8::EpiColMajor, pg8::StaticOrder, true, true, true>(P.lds + RING_OFF, g, S, E);
#ifdef PROBE_PROJHY_TWICE
              pg8::gemm_phase<pg8::EpiColMajor, pg8::StaticOrder, true, true, true>(P.lds + RING_OFF, g, S, E);
#endif
            }
            { pg8::Gemm g{(const bf16*)(P.ws + WS_H), (const bf16*)(P.ws + WS_WIN) + (size_t)l * INW * D + (size_t)NHY * D, T, INW - NHY, D, 1 << 30, 1, 0}; pg8::StaticOrder S; S.init(T, INW - NHY, P.G, P.bid);
              pg8::EpiBf16<0> E{(bf16*)(P.ws + WS_PROJ) + NHY, INW, nullptr, 0, 0, 1.f}; pg8::gemm_phase<pg8::EpiBf16<0>, pg8::StaticOrder, true, true>(P.lds + RING_OFF, g, S, E);
#ifdef PROBE_PROJREST_TWICE
              pg8::gemm_phase<pg8::EpiBf16<0>, pg8::StaticOrder, true, true>(P.lds + RING_OFF, g, S, E);
#endif
            }
        }
        if (PHON(2) && IN(k0 + 2)) { PH_ENTER(); filter_fft_units(P); }
        SEAM(k0 + 2);
        if (PHON(3) && IN(k0 + 3)) { PH_ENTER(); hyena_units(P, A, l);
#if MK_ATTN_SIMPLE
            attention_simple(P, A, l);
#else
            attention_mfma(P, A, l);
#ifdef PROBE_ATTN_TWICE
            attention_mfma(P, A, l);
#endif
#ifdef PROBE_HYENA_TWICE
            hyena_units(P, A, l);
#endif
#endif
 }
        SEAM(k0 + 3);
        if (PHON(4) && IN(k0 + 4)) { PH_ENTER(); z2_transpose(P); }
        SEAM(k0 + 4);
        if (PHON(5) && IN(k0 + 5)) { PH_ENTER();
            pg8::Gemm g{(const bf16*)(P.ws + WS_Z2AT), (const bf16*)(P.ws + WS_WHY) + (size_t)l * D * ZAP, T, D, ZAP, 1 << 30, 1, 0}; pg8::StaticOrder S; S.init(T, D, P.G, P.bid);
            pg8::EpiGate2 E{(bf16*)(P.ws + WS_MERGED), D, (const bf16*)(P.ws + WS_PROJ) + COL_G, (const bf16*)(P.ws + WS_PROJ) + COL_G + D, INW};
            pg8::gemm_phase<pg8::EpiGate2, pg8::StaticOrder, true, true>(P.lds + RING_OFF, g, S, E); }
        SEAM(k0 + 5);
        if (PHON(7) && IN(k0 + 7)) { PH_ENTER(); pg8::Gemm g{(const bf16*)(P.ws + WS_MERGED), (const bf16*)(P.ws + WS_WO) + (size_t)l * D * D, T, D, D, 1 << 30, 1, 0}; pg8::StaticOrder S; S.init(T, D, P.G, P.bid);
            pg8::EpiResid E{l == 0 ? A.in[I_XP] : (const float*)P.out, l == 0 ? A.in[I_XS] : (const float*)P.out + (size_t)TP * D, P.out, (const float*)(P.ws + WS_MOD) + (size_t)l * NMOD * 6 * D + 2 * D, TP, TS, 6 * D, D};
            pg8::gemm_phase<pg8::EpiResid, pg8::StaticOrder, true, true>(P.lds + RING_OFF, g, S, E); }
        SEAM(k0 + 7);
        if (PHON(8) && IN(k0 + 8)) { PH_ENTER(); resid_norm_router2(P, A, l);
#ifdef PROBE_RESID_TWICE
            if (l == 0) resid_norm_router2(P, A, l);
#endif
        }
        SEAM(k0 + 8);
        if (PHON(9) && IN(k0 + 9)) { PH_ENTER();
#if MK_TOPK_RANK
            topk_rank(P);
#else
            topk_select(P);
#endif
        }
        SEAM(k0 + 9);
        if (PHON(10) && IN(k0 + 10)) { PH_ENTER(); gather_rows(P); }
        SEAM(k0 + 10);
        if (PHON(11) && IN(k0 + 11)) { PH_ENTER(); pg8::Gemm g{(const bf16*)(P.ws + WS_XE), (const bf16*)(P.ws + WS_WGU), NSLOT, 2 * FF, KB_UP / 2, CAP / 256, NE, (size_t)2 * FF * KB_UP}; pg8::StaticOrder S; S.init(NSLOT, 2 * FF, P.G, P.bid);
            pg8::EpiSwiGLU4 E{(unsigned char*)(P.ws + WS_HID), KB_DN, 1.0f / 64.0f, 2.0f}; pg8::gemm_phase4<pg8::EpiSwiGLU4, pg8::StaticOrder, true, true>(P.lds + RING_OFF, g, S, E);
#ifdef PROBE_UPVAR
            __syncthreads(); { pg8::EpiSwiGLU4 E2{(unsigned char*)(P.ws + WS_YE), KB_DN, 1.0f / 64.0f, 2.0f}; pg8::gemm_phase4<pg8::EpiSwiGLU4, pg8::StaticOrder, true, true, PROBE_UPVAR>(P.lds + RING_OFF, g, S, E2); }
#endif
        }
        SEAM(k0 + 11);
        if (PHON(12) && IN(k0 + 12)) { PH_ENTER(); pg8::Gemm g{(const bf16*)(P.ws + WS_HID), (const bf16*)(P.ws + WS_WD), NSLOT, D, KB_DN / 2, CAP / 256, NE, (size_t)D * KB_DN}; pg8::StaticOrder S; S.init(NSLOT, D, P.G, P.bid);
            pg8::EpiBf16S E{(bf16*)(P.ws + WS_YE), D, 1.0f / 256.0f}; pg8::gemm_phase4<pg8::EpiBf16S, pg8::StaticOrder, true, true>(P.lds + RING_OFF, g, S, E); }
        SEAM(k0 + 12);
        if (PHON(13) && IN(k0 + 13)) { PH_ENTER(); moe_combine2(P, l, 1.0f, l + 1 < DEPTH ? l + 1 : -1, A.in[I_N1G] + (size_t)(l + 1 < DEPTH ? l + 1 : 0) * D);
#ifdef PROBE_COMBINE_TWICE
            moe_combine2(P, l, (float)__hip_atomic_load(P.ctl + 8, __ATOMIC_RELAXED, __HIP_MEMORY_SCOPE_AGENT), -1, nullptr);
#endif
            if (l + 1 < DEPTH) convert_moe_weights(P, A, l + 1);
#ifdef PROBE_CONVERT_TWICE
            if (l + 1 < DEPTH) convert_moe_weights<PROBE_CONVERT_TWICE>(P, A, l + 1);
#endif
        }
        SEAM(k0 + 13);
    }
#ifdef PROBE_MFMA
    if (hi == N_PHASES) {
        typedef int pv4 __attribute__((ext_vector_type(4))); typedef int pv8 __attribute__((ext_vector_type(8)));
        f32x4 c0 = {0.f, 0.f, 0.f, 0.f}, c1 = c0, c2 = c0, c3 = c0, c4 = c0, c5 = c0, c6 = c0, c7 = c0; f32x16 d0 = {}, d1 = {}, d2 = {}, d3 = {};
        pv4 a = {0, 0, 0, 0}, b = {0, 0, 0, 0}; pv8 a8 = {}, b8 = {}; int sc = 0x7F7F7F7F; asm volatile("" : "+v"(a), "+v"(b), "+v"(sc), "+v"(a8), "+v"(b8));
#pragma unroll 1
        for (int it = 0; it < PROBE_MFMA_N; ++it) {
#if PROBE_MFMA == 1
#define PM(c) asm volatile("v_mfma_scale_f32_16x16x128_f8f6f4 %0, %1, %2, %0, %3, %3 op_sel_hi:[0,0,0] cbsz:4 blgp:4" : "+v"(c) : "v"(a), "v"(b), "v"(sc))
            PM(c0); PM(c1); PM(c2); PM(c3); PM(c4); PM(c5); PM(c6); PM(c7);
#elif PROBE_MFMA == 2
#define PM(c) asm volatile("v_mfma_f32_16x16x128_f8f6f4 %0, %1, %2, %0 cbsz:4 blgp:4" : "+v"(c) : "v"(a), "v"(b))
            PM(c0); PM(c1); PM(c2); PM(c3); PM(c4); PM(c5); PM(c6); PM(c7);
#elif PROBE_MFMA == 3
#define PM(c) asm volatile("v_mfma_scale_f32_32x32x64_f8f6f4 %0, %1, %2, %0, %3, %3 op_sel_hi:[0,0,0] cbsz:4 blgp:4" : "+v"(c) : "v"(a), "v"(b), "v"(sc))
            PM(d0); PM(d1); PM(d2); PM(d3);
#elif PROBE_MFMA == 4
#define PM(c) asm volatile("v_mfma_scale_f32_16x16x128_f8f6f4 %0, %1, %2, %0, %3, %3 op_sel_hi:[0,0,0]" : "+v"(c) : "v"(a8), "v"(b8), "v"(sc))
            PM(c0); PM(c1); PM(c2); PM(c3); PM(c4); PM(c5); PM(c6); PM(c7);
#elif PROBE_MFMA == 5
#define PM(c) asm volatile("v_mfma_f32_16x16x32_bf16 %0, %1, %2, %0" : "+v"(c) : "v"(a), "v"(b))
            PM(c0); PM(c1); PM(c2); PM(c3); PM(c4); PM(c5); PM(c6); PM(c7);
#endif
        }
        asm volatile("s_nop 15\n\ts_nop 15" ::: "memory");
        const float sum = c0[0] + c1[1] + c2[2] + c3[3] + c4[0] + c5[1] + c6[2] + c7[3] + d0[0] + d1[5] + d2[9] + d3[15];
        if (sum != 0.f) F.out[1] = __builtin_nanf("");
    }
#endif
#ifdef PROBE_FP4
    if (blockIdx.x == 0 && threadIdx.x < 64 && hi == N_PHASES) { const bool bad = fp4_probe((int)threadIdx.x); if (__any(bad) && threadIdx.x == 0) F.out[0] = __builtin_nanf(""); }
#endif
#ifdef PROBE_FP8
    if (blockIdx.x == 0 && threadIdx.x < 64 && hi == N_PHASES) { const bool bad = fp8_probe((int)threadIdx.x); if (__any(bad) && threadIdx.x == 0) F.out[0] = __builtin_nanf(""); }
#endif
#undef IN
#undef SEAM
}

#if defined(__HIP_DEVICE_COMPILE__) && MK_NOPK
#pragma clang attribute pop
#endif
extern "C" void kernel_launch(void* const* d_in, const int* in_sizes, int n_in, void* d_out, int out_size, void* d_ws, size_t ws_size, hipStream_t stream) {
    static int grid = 0;
    if (grid == 0) {
        if (n_in != 30 || in_sizes[0] != TP * D || out_size != T * D || ws_size < WS_END) { fprintf(stderr, "kernel_launch: shape/workspace mismatch: n_in %d in0 %d out %d ws %zu (need %zu); nothing launched\n", n_in, n_in > 0 ? in_sizes[0] : -1, out_size, ws_size, (size_t)WS_END); grid = -1; return; }
        int dev = 0, cus = 0, per_cu = 0;
        if (hipGetDevice(&dev) != hipSuccess || hipDeviceGetAttribute(&cus, hipDeviceAttributeMultiprocessorCount, dev) != hipSuccess) { fprintf(stderr, "kernel_launch: device query failed\n"); grid = -1; return; }
        if (hipFuncSetAttribute((const void*)mk_fwd, hipFuncAttributeMaxDynamicSharedMemorySize, LDS_BYTES) != hipSuccess) { fprintf(stderr, "kernel_launch: hipFuncSetAttribute failed\n"); grid = -1; return; }
        if (hipOccupancyMaxActiveBlocksPerMultiprocessor(&per_cu, (const void*)mk_fwd, NWAVES * 64, LDS_BYTES) != hipSuccess || per_cu < 1) fprintf(stderr, "kernel_launch: note: occupancy query reports %d\n", per_cu);
        (void)hipGetLastError();
        grid = cus;
    }
    if (grid < 0) return;
    if (hipMemsetAsync((char*)d_ws + WS_CTL, 0, CTL_ZERO_BYTES, stream) != hipSuccess) { fprintf(stderr, "kernel_launch: memset failed\n"); return; }
    Args a{};
    for (int i = 0; i < 30; ++i) a.in[i] = (const float*)d_in[i];
    a.out = (float*)d_out; a.ws = (unsigned char*)d_ws;
#if MK_PER_PHASE
    for (int k = 0; k < N_PHASES; ++k) { a.ph_lo = k; a.ph_hi = k + 1; hipLaunchKernelGGL(mk_fwd, dim3(grid), dim3(NWAVES * 64), LDS_BYTES, stream, a); }
#else
    a.ph_lo = 0; a.ph_hi = N_PHASES; hipLaunchKernelGGL(mk_fwd, dim3(grid), dim3(NWAVES * 64), LDS_BYTES, stream, a);
#endif
    const hipError_t le = hipPeekAtLastError();
    if (le != hipSuccess) fprintf(stderr, "kernel_launch: launch failed: %s\n", hipGetErrorName(le));
}
```

```cpp
#include <hip/hip_runtime.h>
#include <cstdio>
#include <cstdint>
#define MK_PER_PHASE 0
#ifndef MK_NOPK
#define MK_NOPK 0
#endif
#if defined(__HIP_DEVICE_COMPILE__) && MK_NOPK
#pragma clang attribute push(__attribute__((target("no-packed-fp32-ops"))), apply_to = function)
#endif
namespace pg8 {
#define PG8_LAS __attribute__((address_space(3)))
typedef unsigned short bf16_t;
typedef short bf16x8 __attribute__((ext_vector_type(8)));
typedef float f32x4 __attribute__((ext_vector_type(4)));
typedef unsigned u32x4 __attribute__((ext_vector_type(4)));
constexpr int BM = 256, BK = 64, HALF = 128, HTB = HALF * BK * 2  , STAGE_BYTES = 8 * HTB, NXCD = 8, WGM = 8;

__host__ __device__ __forceinline__ int lds_byte(int r, int c) { const int st = (r >> 4) * 2 + (c >> 5), rr = r & 15, cc = c & 31, ob = rr * 64 + cc * 2; return st * 1024 + (ob ^ (((ob >> 9) & 1) << 5)); }
__host__ __device__ __forceinline__ void stage_rc(int b, int& R, int& C) { const int st = b / 1024, sb = b % 1024, swz = sb ^ (((sb >> 9) & 1) << 5); R = (st >> 1) * 16 + swz / 64; C = (st & 1) * 32 + (swz % 64) / 2; }
__host__ __device__ __forceinline__ int perm32(int rho) { const int n = rho >> 4, i = rho & 15; return 8 * (i >> 2) + 4 * n + (i & 3); }

struct Unit { int pm, pn; };
struct Gemm { const bf16_t* A; const bf16_t* Bt; int M, N, K; int tpg, ng; size_t gstride; };

struct StaticOrder {
    int nM, nN, nwg, G, c;
    __host__ __device__ void init(int M, int N, int G_, int c_) { nM = M / BM; nN = N / BM; nwg = nM * nN; G = G_; c = c_; }
    __host__ __device__ bool next(int i, Unit& u) const {
        const long L = (long)i * G + c; if (L >= nwg) return false;
        int wgid = (int)L; { const int q = nwg / NXCD, r = nwg % NXCD, xcd = wgid % NXCD, off = wgid / NXCD; wgid = (xcd < r ? xcd * (q + 1) : r * (q + 1) + (xcd - r) * q) + off; }
        const int nig = WGM * nN, gid = wgid / nig, fm = gid * WGM, gsz = (nM - fm) < WGM ? (nM - fm) : WGM;
        u.pm = fm + ((wgid % nig) % gsz); u.pn = (wgid % nig) / gsz; return true;
    }
    __device__ __forceinline__ void a_ready(const Unit&) const {}
    __device__ __forceinline__ void done(const Unit&) const {}
};

__device__ __forceinline__ unsigned cvt_pk_bf16(float lo, float hi) { unsigned r; asm volatile("v_cvt_pk_bf16_f32 %0, %1, %2" : "=v"(r) : "v"(lo), "v"(hi)); return r; }
typedef float f32x2 __attribute__((ext_vector_type(2)));
__device__ __forceinline__ f32x2 gelu_pk(f32x2 v) {
    const f32x2 av = __builtin_elementwise_abs(v), d = av * 0.2316418882f + 1.0f;
    f32x2 t; t.x = __builtin_amdgcn_rcpf(d.x); t.y = __builtin_amdgcn_rcpf(d.y);
    f32x2 q = t * 0.5307027145f + (-0.7265760135f); q = q * t + 0.7107068705f; q = q * t + (-0.142248368f); q = q * t + 0.127414796f; q = q * t;
    const f32x2 s = (v * v) * (-0.72134752044f);
    f32x2 e; e.x = __builtin_amdgcn_exp2f(s.x); e.y = __builtin_amdgcn_exp2f(s.y);
    const f32x2 m = v * (q * e), r = v - m;
    f32x2 o; o.x = v.x < 0.f ? m.x : r.x; o.y = v.y < 0.f ? m.y : r.y; return o;
}

template <int ACT  > struct EpiBf16 {
    static constexpr bool PERM = true, AFTER_DRAIN = false; static constexpr int MID_T = 0; static_assert(ACT == 0 || ACT == 1, "EpiBf16: ACT is 0 (none) or 1 (gelu_pk)");
    bf16_t* O; int ldc; const float* bias; int split_cols; size_t split_stride; float scale0;
    __device__ __forceinline__ void operator()(const f32x4 (&acc)[2][2][4][2], const Unit& u, int wr, int wc, int fr, int fq) const {
        const int row0 = u.pm * BM + wr * 64 + fr; int colt = u.pn * BM; bf16_t* base = O;
        float sc = 1.f; if (split_cols) { const int t = colt / split_cols; base += (size_t)t * split_stride; colt -= t * split_cols; if (t == 0) sc = scale0; }
        const int col0 = colt + wc * 32 + 8 * fq, bcol0 = u.pn * BM + wc * 32 + 8 * fq;
        f32x4 bv[2][2];
#pragma unroll
        for (int bj = 0; bj < 2; ++bj)
#pragma unroll
            for (int n = 0; n < 2; ++n) bv[bj][n] = bias ? *(const f32x4*)(bias + bcol0 + bj * HALF + 4 * n) : (f32x4){0.f, 0.f, 0.f, 0.f};
#pragma unroll
        for (int ai = 0; ai < 2; ++ai)
#pragma unroll
            for (int m = 0; m < 4; ++m) { bf16_t* rowp = base + (size_t)(row0 + ai * HALF + m * 16) * ldc + col0;
#pragma unroll
                for (int bj = 0; bj < 2; ++bj) { f32x4 v0 = acc[ai][bj][m][0] + bv[bj][0], v1 = acc[ai][bj][m][1] + bv[bj][1];
                    if (ACT == 1) { f32x2 a = gelu_pk((f32x2){v0[0], v0[1]}), b = gelu_pk((f32x2){v0[2], v0[3]}), c = gelu_pk((f32x2){v1[0], v1[1]}), d = gelu_pk((f32x2){v1[2], v1[3]});
                        v0 = (f32x4){a.x, a.y, b.x, b.y}; v1 = (f32x4){c.x, c.y, d.x, d.y}; }
                    v0 = v0 * sc; v1 = v1 * sc; u32x4 w; w.x = cvt_pk_bf16(v0[0], v0[1]); w.y = cvt_pk_bf16(v0[2], v0[3]); w.z = cvt_pk_bf16(v1[0], v1[1]); w.w = cvt_pk_bf16(v1[2], v1[3]);
                    *(u32x4*)(rowp + bj * HALF) = w; } }
    }
};

struct EpiF32 {
    static constexpr bool PERM = false, AFTER_DRAIN = false; static constexpr int MID_T = 0;
    float* C; int ldc;
    __device__ __forceinline__ void operator()(const f32x4 (&acc)[2][2][4][2], const Unit& u, int wr, int wc, int fr, int fq) const {
        const int row0 = u.pm * BM + wr * 64 + fr, col0 = u.pn * BM + wc * 32 + 4 * fq;
#pragma unroll
        for (int ai = 0; ai < 2; ++ai)
#pragma unroll
            for (int m = 0; m < 4; ++m) { float* rowp = C + (size_t)(row0 + ai * HALF + m * 16) * ldc + col0;
#pragma unroll
                for (int bj = 0; bj < 2; ++bj)
#pragma unroll
                    for (int n = 0; n < 2; ++n) *(f32x4*)(rowp + bj * HALF + n * 16) = acc[ai][bj][m][n]; }
    }
};
struct EpiSwiGLU {
    static constexpr bool PERM = true, AFTER_DRAIN = false; static constexpr int MID_T = 0;
    bf16_t* O; int ldc;
    __device__ __forceinline__ static float silu(float x) { return x * __builtin_amdgcn_rcpf(1.0f + __builtin_amdgcn_exp2f(-1.4426950408889634f * x)); }
    __device__ __forceinline__ void operator()(const f32x4 (&acc)[2][2][4][2], const Unit& u, int wr, int wc, int fr, int fq) const {
        const int row0 = u.pm * BM + wr * 64 + fr, col0 = u.pn * HALF + wc * 32 + 8 * fq;
#pragma unroll
        for (int ai = 0; ai < 2; ++ai)
#pragma unroll
            for (int m = 0; m < 4; ++m) { bf16_t* rowp = O + (size_t)(row0 + ai * HALF + m * 16) * ldc + col0;
                const f32x4 g0 = acc[ai][0][m][0], g1 = acc[ai][0][m][1], u0 = acc[ai][1][m][0], u1 = acc[ai][1][m][1];
                u32x4 w; w.x = cvt_pk_bf16(silu(g0[0]) * u0[0], silu(g0[1]) * u0[1]); w.y = cvt_pk_bf16(silu(g0[2]) * u0[2], silu(g0[3]) * u0[3]);
                w.z = cvt_pk_bf16(silu(g1[0]) * u1[0], silu(g1[1]) * u1[1]); w.w = cvt_pk_bf16(silu(g1[2]) * u1[2], silu(g1[3]) * u1[3]);
                *(u32x4*)rowp = w; }
    }
};
struct EpiProj {
    static constexpr bool PERM = true, AFTER_DRAIN = false; static constexpr int MID_T = 0;
    bf16_t* O; int ldc; float* HT; int ldt; int NT;
    __device__ __forceinline__ void operator()(const f32x4 (&acc)[2][2][4][2], const Unit& u, int wr, int wc, int fr, int fq) const {
        const int row0 = u.pm * BM + wr * 64 + fr, col0 = u.pn * BM + wc * 32 + 8 * fq;
        if (u.pn < NT) {
#pragma unroll
            for (int ai = 0; ai < 2; ++ai)
#pragma unroll
                for (int m = 0; m < 4; ++m) { float* cp = HT + (size_t)col0 * ldt + (row0 + ai * HALF + m * 16);
#pragma unroll
                    for (int bj = 0; bj < 2; ++bj)
#pragma unroll
                        for (int n = 0; n < 2; ++n)
#pragma unroll
                            for (int e = 0; e < 4; ++e) cp[(size_t)(bj * HALF + 4 * n + e) * ldt] = acc[ai][bj][m][n][e]; }
        } else {
#pragma unroll
            for (int ai = 0; ai < 2; ++ai)
#pragma unroll
                for (int m = 0; m < 4; ++m) { bf16_t* rowp = O + (size_t)(row0 + ai * HALF + m * 16) * ldc + col0;
#pragma unroll
                    for (int bj = 0; bj < 2; ++bj) { const f32x4 v0 = acc[ai][bj][m][0], v1 = acc[ai][bj][m][1];
                        u32x4 w; w.x = cvt_pk_bf16(v0[0], v0[1]); w.y = cvt_pk_bf16(v0[2], v0[3]); w.z = cvt_pk_bf16(v1[0], v1[1]); w.w = cvt_pk_bf16(v1[2], v1[3]);
                        *(u32x4*)(rowp + bj * HALF) = w; } }
        }
    }
};
struct EpiGate {
    static constexpr bool PERM = true, AFTER_DRAIN = false; static constexpr int MID_T = 0;
    bf16_t* O; int ldc; const bf16_t* G; int ldg; int first;
    __device__ __forceinline__ static float sig(float x) { return __builtin_amdgcn_rcpf(1.0f + __builtin_amdgcn_exp2f(-1.4426950408889634f * x)); }
    __device__ __forceinline__ static float lo(unsigned w) { return __builtin_bit_cast(float, w << 16); }
    __device__ __forceinline__ static float hi(unsigned w) { return __builtin_bit_cast(float, w & 0xffff0000u); }
    __device__ __forceinline__ void operator()(const f32x4 (&acc)[2][2][4][2], const Unit& u, int wr, int wc, int fr, int fq) const {
        const int row0 = u.pm * BM + wr * 64 + fr, col0 = u.pn * BM + wc * 32 + 8 * fq;
#pragma unroll
        for (int ai = 0; ai < 2; ++ai)
#pragma unroll
            for (int m = 0; m < 4; ++m) { const size_t row = (size_t)(row0 + ai * HALF + m * 16);
#pragma unroll
                for (int bj = 0; bj < 2; ++bj) { const f32x4 v0 = acc[ai][bj][m][0], v1 = acc[ai][bj][m][1];
                    const u32x4 g = *(const u32x4*)(G + row * ldg + col0 + bj * HALF);
                    float o[8] = {sig(lo(g.x)) * v0[0], sig(hi(g.x)) * v0[1], sig(lo(g.y)) * v0[2], sig(hi(g.y)) * v0[3], sig(lo(g.z)) * v1[0], sig(hi(g.z)) * v1[1], sig(lo(g.w)) * v1[2], sig(hi(g.w)) * v1[3]};
                    u32x4* op = (u32x4*)(O + row * ldc + col0 + bj * HALF);
                    if (!first) { const u32x4 p = *op; o[0] += lo(p.x); o[1] += hi(p.x); o[2] += lo(p.y); o[3] += hi(p.y); o[4] += lo(p.z); o[5] += hi(p.z); o[6] += lo(p.w); o[7] += hi(p.w); }
                    u32x4 w; w.x = cvt_pk_bf16(o[0], o[1]); w.y = cvt_pk_bf16(o[2], o[3]); w.z = cvt_pk_bf16(o[4], o[5]); w.w = cvt_pk_bf16(o[6], o[7]);
                    *op = w; } }
    }
};
struct EpiResid {
    static constexpr bool PERM = false, AFTER_DRAIN = false; static constexpr int MID_T = 0;
    const float* xa; const float* xb; float* out; const float* gbase; int row_split, sub_rows, gstride, ldc;
    __device__ __forceinline__ void operator()(const f32x4 (&acc)[2][2][4][2], const Unit& u, int wr, int wc, int fr, int fq) const {
        const int row0 = u.pm * BM + wr * 64 + fr, col0 = u.pn * BM + wc * 32 + 4 * fq;
#pragma unroll
        for (int ai = 0; ai < 2; ++ai)
#pragma unroll
            for (int m = 0; m < 4; ++m) { const int row = row0 + ai * HALF + m * 16;
                const float* xr = (row < row_split ? xa + (size_t)row * ldc : xb + (size_t)(row - row_split) * ldc) + col0;
                const float* gr = gbase + (size_t)(row < row_split ? 0 : 1 + (row - row_split) / sub_rows) * gstride + col0;
                float* orow = out + (size_t)row * ldc + col0;
                f32x4 xv[2][2], gv[2][2];
#pragma unroll
                for (int bj = 0; bj < 2; ++bj)
#pragma unroll
                    for (int n = 0; n < 2; ++n) { xv[bj][n] = *(const f32x4*)(xr + bj * HALF + n * 16); gv[bj][n] = *(const f32x4*)(gr + bj * HALF + n * 16); }
#pragma unroll
                for (int bj = 0; bj < 2; ++bj)
#pragma unroll
                    for (int n = 0; n < 2; ++n) *(f32x4*)(orow + bj * HALF + n * 16) = xv[bj][n] + gv[bj][n] * acc[ai][bj][m][n]; }
    }
};
struct EpiGate2 {
    static constexpr bool PERM = true, AFTER_DRAIN = false; static constexpr int MID_T = 8;
    bf16_t* O; int ldc; const bf16_t* G1; const bf16_t* G2; int ldg;
    __device__ __forceinline__ static float en(float x) { return __builtin_amdgcn_exp2f(-1.4426950408889634f * x); }
    __device__ __forceinline__ static float lo(unsigned w) { return __builtin_bit_cast(float, w << 16); }
    __device__ __forceinline__ static float hi(unsigned w) { return __builtin_bit_cast(float, w & 0xffff0000u); }
    __device__ __forceinline__ static f32x4 rho4(unsigned a0, unsigned a1, unsigned b0, unsigned b1) {
        f32x4 r; r[0] = (1.f + en(lo(b0))) * __builtin_amdgcn_rcpf(1.f + en(lo(a0))); r[1] = (1.f + en(hi(b0))) * __builtin_amdgcn_rcpf(1.f + en(hi(a0)));
        r[2] = (1.f + en(lo(b1))) * __builtin_amdgcn_rcpf(1.f + en(lo(a1))); r[3] = (1.f + en(hi(b1))) * __builtin_amdgcn_rcpf(1.f + en(hi(a1))); return r; }
    __device__ __forceinline__ void mid(f32x4 (&acc)[2][2][4][2], const Unit& u, int wr, int wc, int fr_, int fq_) const {
        int fr = fr_, fq = fq_; asm volatile("" : "+v"(fr), "+v"(fq));
        const int row0 = u.pm * BM + wr * 64 + fr, col0 = u.pn * BM + wc * 32 + 8 * fq;
#pragma unroll
        for (int ai = 0; ai < 2; ++ai)
#pragma unroll
            for (int mh = 0; mh < 4; mh += 2) {
                u32x4 a[2][2], b[2][2];
#pragma unroll
                for (int mm = 0; mm < 2; ++mm) { const size_t row = (size_t)(row0 + ai * HALF + (mh + mm) * 16);
#pragma unroll
                    for (int bj = 0; bj < 2; ++bj) { a[mm][bj] = *(const u32x4*)(G1 + row * ldg + col0 + bj * HALF); b[mm][bj] = *(const u32x4*)(G2 + row * ldg + col0 + bj * HALF); } }
                asm volatile("" ::: "memory");
#pragma unroll
                for (int mm = 0; mm < 2; ++mm)
#pragma unroll
                    for (int bj = 0; bj < 2; ++bj) { const int m = mh + mm;
                        acc[ai][bj][m][0] = acc[ai][bj][m][0] * rho4(a[mm][bj].x, a[mm][bj].y, b[mm][bj].x, b[mm][bj].y);
                        acc[ai][bj][m][1] = acc[ai][bj][m][1] * rho4(a[mm][bj].z, a[mm][bj].w, b[mm][bj].z, b[mm][bj].w); }
                asm volatile("" ::: "memory");
            }
    }
    __device__ __forceinline__ void operator()(const f32x4 (&acc)[2][2][4][2], const Unit& u, int wr, int wc, int fr, int fq) const {
        const int row0 = u.pm * BM + wr * 64 + fr, col0 = u.pn * BM + wc * 32 + 8 * fq;
#pragma unroll
        for (int ai = 0; ai < 2; ++ai)
#pragma unroll
            for (int m = 0; m < 4; ++m) { const size_t row = (size_t)(row0 + ai * HALF + m * 16);
#pragma unroll
                for (int bj = 0; bj < 2; ++bj) { const f32x4 v0 = acc[ai][bj][m][0], v1 = acc[ai][bj][m][1];
                    const u32x4 b = *(const u32x4*)(G2 + row * ldg + col0 + bj * HALF);
                    u32x4 w;
                    w.x = cvt_pk_bf16(v0[0] * __builtin_amdgcn_rcpf(1.f + en(lo(b.x))), v0[1] * __builtin_amdgcn_rcpf(1.f + en(hi(b.x))));
                    w.y = cvt_pk_bf16(v0[2] * __builtin_amdgcn_rcpf(1.f + en(lo(b.y))), v0[3] * __builtin_amdgcn_rcpf(1.f + en(hi(b.y))));
                    w.z = cvt_pk_bf16(v1[0] * __builtin_amdgcn_rcpf(1.f + en(lo(b.z))), v1[1] * __builtin_amdgcn_rcpf(1.f + en(hi(b.z))));
                    w.w = cvt_pk_bf16(v1[2] * __builtin_amdgcn_rcpf(1.f + en(lo(b.w))), v1[3] * __builtin_amdgcn_rcpf(1.f + en(hi(b.w))));
                    *(u32x4*)(O + row * ldc + col0 + bj * HALF) = w; } }
    }
};
struct EpiColMajor {
    static constexpr bool PERM = false, AFTER_DRAIN = false; static constexpr int MID_T = 0;
    float* HT; int ldt;
    __device__ __forceinline__ void operator()(const f32x4 (&acc)[2][2][4][2], const Unit& u, int wr, int wc, int fr, int fq) const {
        const int row0 = u.pm * BM + wr * 64 + 4 * fq, col0 = u.pn * BM + wc * 32 + fr;
#pragma unroll
        for (int bj = 0; bj < 2; ++bj)
#pragma unroll
            for (int n = 0; n < 2; ++n) { float* cp = HT + (size_t)(col0 + bj * HALF + 16 * n) * ldt + row0;
#pragma unroll
                for (int ai = 0; ai < 2; ++ai)
#pragma unroll
                    for (int m = 0; m < 4; ++m) *(f32x4*)(cp + ai * HALF + 16 * m) = acc[ai][bj][m][n]; }
    }
};
__device__ __forceinline__ float clamp448(float x) { return __builtin_fminf(__builtin_fmaxf(x, -448.f), 448.f); }
__device__ __forceinline__ unsigned pack4_fp8(float a, float b, float c, float d) { int w = __builtin_amdgcn_cvt_pk_fp8_f32(clamp448(a), clamp448(b), 0, false); w = __builtin_amdgcn_cvt_pk_fp8_f32(clamp448(c), clamp448(d), w, true); return (unsigned)w; }
struct EpiSwiGLU8 {
    static constexpr bool PERM = true, AFTER_DRAIN = false; static constexpr int MID_T = 0;
    unsigned char* O; int ldc; float sin, sout;
    __device__ __forceinline__ static float silu(float x) { return x * __builtin_amdgcn_rcpf(1.0f + __builtin_amdgcn_exp2f(-1.4426950408889634f * x)); }
    __device__ __forceinline__ void operator()(const f32x4 (&acc)[2][2][4][2], const Unit& u, int wr, int wc, int fr, int fq) const {
        const int row0 = u.pm * BM + wr * 64 + fr, col0 = u.pn * HALF + wc * 32 + 8 * fq;
#pragma unroll
        for (int ai = 0; ai < 2; ++ai)
#pragma unroll
            for (int m = 0; m < 4; ++m) { unsigned char* rowp = O + (size_t)(row0 + ai * HALF + m * 16) * ldc + col0;
                const f32x4 g0 = acc[ai][0][m][0] * sin, g1 = acc[ai][0][m][1] * sin, u0 = acc[ai][1][m][0] * (sin * sout), u1 = acc[ai][1][m][1] * (sin * sout);
                typedef unsigned u32x2 __attribute__((ext_vector_type(2)));
                u32x2 w; w.x = pack4_fp8(silu(g0[0]) * u0[0], silu(g0[1]) * u0[1], silu(g0[2]) * u0[2], silu(g0[3]) * u0[3]); w.y = pack4_fp8(silu(g1[0]) * u1[0], silu(g1[1]) * u1[1], silu(g1[2]) * u1[2], silu(g1[3]) * u1[3]);
                *(u32x2*)rowp = w; asm volatile("" ::: "memory"); }
    }
};
struct EpiBf16S {
    static constexpr bool PERM = true, AFTER_DRAIN = false; static constexpr int MID_T = 0;
    bf16_t* O; int ldc; float s;
    __device__ __forceinline__ void operator()(const f32x4 (&acc)[2][2][4][2], const Unit& u, int wr, int wc, int fr, int fq) const {
        const int row0 = u.pm * BM + wr * 64 + fr, col0 = u.pn * BM + wc * 32 + 8 * fq;
#pragma unroll
        for (int ai = 0; ai < 2; ++ai)
#pragma unroll
            for (int m = 0; m < 4; ++m) { bf16_t* rowp = O + (size_t)(row0 + ai * HALF + m * 16) * ldc + col0;
#pragma unroll
                for (int bj = 0; bj < 2; ++bj) { const f32x4 v0 = acc[ai][bj][m][0] * s, v1 = acc[ai][bj][m][1] * s;
                    u32x4 w; w.x = cvt_pk_bf16(v0[0], v0[1]); w.y = cvt_pk_bf16(v0[2], v0[3]); w.z = cvt_pk_bf16(v1[0], v1[1]); w.w = cvt_pk_bf16(v1[2], v1[3]);
                    *(u32x4*)(rowp + bj * HALF) = w; } }
    }
};
#define PG8_FP4_PACK8(w, x0, x1, x2, x3, x4, x5, x6, x7) do { (w) = 0u; (w) = __builtin_amdgcn_cvt_scalef32_pk_fp4_f32((w), (x0), (x1), 1.0f, 0); (w) = __builtin_amdgcn_cvt_scalef32_pk_fp4_f32((w), (x2), (x3), 1.0f, 1); \
        (w) = __builtin_amdgcn_cvt_scalef32_pk_fp4_f32((w), (x4), (x5), 1.0f, 2); (w) = __builtin_amdgcn_cvt_scalef32_pk_fp4_f32((w), (x6), (x7), 1.0f, 3); } while (0)
__device__ __forceinline__ float clamp6(float x) { return x; }
struct EpiSwiGLU4 {
    static constexpr bool PERM = true, AFTER_DRAIN = false; static constexpr int MID_T = 0;
    unsigned char* O; int ldc; float sin, sout;
    __device__ __forceinline__ static float silu(float x) { return x * __builtin_amdgcn_rcpf(1.0f + __builtin_amdgcn_exp2f(-1.4426950408889634f * x)); }
    __device__ __forceinline__ void operator()(const f32x4 (&acc)[2][2][4][2], const Unit& u, int wr, int wc, int fr, int fq) const {
        const int row0 = u.pm * BM + wr * 64 + fr, col0 = u.pn * HALF + wc * 32 + 8 * fq;
        const float kexp = -1.4426950408889634f * sin, cden = 1.0f / (sin * sin * sout);
#pragma unroll
        for (int ai = 0; ai < 2; ++ai)
#pragma unroll
            for (int m = 0; m < 4; ++m) { unsigned char* rowp = O + (size_t)(row0 + ai * HALF + m * 16) * ldc + (col0 >> 1);
                const f32x4 ag0 = acc[ai][0][m][0], ag1 = acc[ai][0][m][1], au0 = acc[ai][1][m][0], au1 = acc[ai][1][m][1];
                const f32x4 y0 = ag0 * kexp, y1 = ag1 * kexp; f32x4 e0, e1;
#pragma unroll
                for (int i = 0; i < 4; ++i) { e0[i] = __builtin_amdgcn_exp2f(y0[i]); e1[i] = __builtin_amdgcn_exp2f(y1[i]); }
                const f32x4 d0 = e0 * cden + cden, d1 = e1 * cden + cden; f32x4 r0, r1;
#pragma unroll
                for (int i = 0; i < 4; ++i) { r0[i] = __builtin_amdgcn_rcpf(d0[i]); r1[i] = __builtin_amdgcn_rcpf(d1[i]); }
                const f32x4 o0 = (ag0 * au0) * r0, o1 = (ag1 * au1) * r1;
                unsigned w; PG8_FP4_PACK8(w, o0[0], o0[1], o0[2], o0[3], o1[0], o1[1], o1[2], o1[3]);
                *(unsigned*)rowp = w; asm volatile("" ::: "memory"); }
    }
};

template <class Epi, class Sched, bool ALIGN_EPI = false, bool SP2 = false, bool SWAP = false>
__device__ __forceinline__ void gemm_phase(PG8_LAS unsigned char* lds, const Gemm g, const Sched& S, const Epi& E) {
    int tid_ = threadIdx.x; asm volatile("" : "+v"(tid_));
    const int tid = tid_, wid = __builtin_amdgcn_readfirstlane(tid >> 6), lane = tid & 63, wr = wid >> 2, wc = wid & 3, fr = lane & 15, fq = lane >> 4;
    const int K = g.K, nt = K / BK;
    unsigned voffA[2], voffB[2];
#pragma unroll
    for (int i = 0; i < 2; ++i) { int R, C; stage_rc(tid * 16 + i * 8192, R, C); const int Rb = Epi::PERM ? ((R & ~31) + perm32(R & 31)) : R;
        voffA[i] = (unsigned)(R * K + C) * 2u; voffB[i] = (unsigned)(Rb * K + C) * 2u; }
    const size_t kstep = (size_t)(BK * 2);
    const size_t hstep = (size_t)HALF * K * 2;
    const size_t tstep = 2 * hstep;
    const unsigned ldsw = (unsigned)wid * 1024u;
    const int aoff = lds_byte(wr * 64 + fr, fq * 8), boff = lds_byte(wc * 32 + fr, fq * 8);
#define PG8_SA(b, h) (((b) * 2 + (h)) * HTB)
#define PG8_SB(b, h) ((4 + (b) * 2 + (h)) * HTB)
#define PG8_STAGE(bufoff, gbase, voff) do { _Pragma("unroll") for (int _i = 0; _i < 2; ++_i) \
        __builtin_amdgcn_global_load_lds((const unsigned*)((const char*)(gbase) + (voff)[_i]), (PG8_LAS unsigned*)(lds + (bufoff) + ldsw + _i * 8192), 16, 0, 0); } while (0)
#define PG8_LDA(dst, b, h) do { _Pragma("unroll") for (int m = 0; m < 4; ++m) _Pragma("unroll") for (int k = 0; k < 2; ++k) dst[m][k] = *(const PG8_LAS bf16x8*)(lds + PG8_SA(b, h) + aoff + m * 2048 + k * 1024); } while (0)
#define PG8_LDB(dst, b, h) do { _Pragma("unroll") for (int n = 0; n < 2; ++n) _Pragma("unroll") for (int k = 0; k < 2; ++k) dst[n][k] = *(const PG8_LAS bf16x8*)(lds + PG8_SB(b, h) + boff + n * 2048 + k * 1024); } while (0)
#define PG8_MMA(ai, bj, At, Bt) do { __builtin_amdgcn_s_setprio(1); _Pragma("unroll") for (int m = 0; m < 4; ++m) _Pragma("unroll") for (int n = 0; n < 2; ++n) _Pragma("unroll") for (int k = 0; k < 2; ++k) \
        acc[ai][bj][m][n] = SWAP ? __builtin_amdgcn_mfma_f32_16x16x32_bf16(At[m][k], Bt[n][k], acc[ai][bj][m][n], 0, 0, 0) : __builtin_amdgcn_mfma_f32_16x16x32_bf16(Bt[n][k], At[m][k], acc[ai][bj][m][n], 0, 0, 0); __builtin_amdgcn_s_setprio(0); } while (0)
#define PG8_WAIT_V(n) asm volatile("s_waitcnt vmcnt(" #n ")" ::: "memory")
#define PG8_WAIT_L(n) asm volatile("s_waitcnt lgkmcnt(" #n ")" ::: "memory")
#define PG8_BAR __builtin_amdgcn_s_barrier()
#define PG8_SCHED __builtin_amdgcn_sched_barrier(0)
    Unit cur, nxt; int ui = 0;
    if (!S.next(0, cur)) return;
    f32x4 acc[2][2][4][2];
#pragma unroll
    for (int a = 0; a < 2; ++a)
#pragma unroll
        for (int b = 0; b < 2; ++b)
#pragma unroll
            for (int m = 0; m < 4; ++m)
#pragma unroll
                for (int n = 0; n < 2; ++n) acc[a][b][m][n] = (f32x4){0.f, 0.f, 0.f, 0.f};
    bf16x8 At[4][2], B0[2][2], B1[2][2];
    const char* cA = (const char*)g.A + (size_t)cur.pm * tstep; const char* cB = (const char*)g.Bt + (size_t)((cur.pm / g.tpg) % g.ng) * g.gstride + (size_t)cur.pn * tstep;
    S.a_ready(cur);
    if constexpr (SP2) {
        PG8_STAGE(PG8_SB(0, 0), cB, voffB); PG8_STAGE(PG8_SB(0, 1), cB + hstep, voffB); PG8_STAGE(PG8_SA(0, 0), cA, voffA); PG8_STAGE(PG8_SA(0, 1), cA + hstep, voffA);
        if (wr == 1) PG8_BAR;
        PG8_WAIT_V(2); PG8_BAR;
        PG8_STAGE(PG8_SB(1, 0), cB + kstep, voffB); PG8_STAGE(PG8_SA(1, 0), cA + kstep, voffA); PG8_STAGE(PG8_SB(1, 1), cB + hstep + kstep, voffB);
        PG8_WAIT_V(6); PG8_BAR;
    } else {
        PG8_STAGE(PG8_SB(0, 0), cB, voffB); PG8_STAGE(PG8_SA(0, 0), cA, voffA); PG8_STAGE(PG8_SB(0, 1), cB + hstep, voffB); PG8_STAGE(PG8_SA(0, 1), cA + hstep, voffA);
        if (wr == 1) PG8_BAR;
        PG8_WAIT_V(4); PG8_BAR;
        PG8_STAGE(PG8_SB(1, 0), cB + kstep, voffB); PG8_STAGE(PG8_SA(1, 0), cA + kstep, voffA); PG8_STAGE(PG8_SB(1, 1), cB + hstep + kstep, voffB);
        PG8_WAIT_V(6); PG8_BAR;
    }
    for (;;) {
        const bool has_next = S.next(ui + 1, nxt);
        const char* nA = has_next ? (const char*)g.A + (size_t)nxt.pm * tstep : cA; const char* nB = has_next ? (const char*)g.Bt + (size_t)((nxt.pm / g.tpg) % g.ng) * g.gstride + (size_t)nxt.pn * tstep : cB;
        for (int t = 0; t < nt; t += 2) {
            if constexpr (Epi::MID_T > 0) { if (t == Epi::MID_T) E.mid(acc, cur, wr, wc, fr, fq); }
            const bool last = (t == nt - 2);
            const char* a1 = cA + (size_t)(t + 1) * kstep;
            const char* a2 = last ? nA : cA + (size_t)(t + 2) * kstep; const char* b2 = last ? nB : cB + (size_t)(t + 2) * kstep;
            const char* a3 = a2 + kstep; const char* b3 = b2 + kstep;
            if (last && has_next) S.a_ready(nxt);
            if constexpr (SP2) {
            PG8_LDB(B0, 0, 0); PG8_LDB(B1, 0, 1); PG8_SCHED; PG8_LDA(At, 0, 0); PG8_STAGE(PG8_SA(1, 1), a1 + hstep, voffA);
            PG8_WAIT_V(8); PG8_WAIT_L(0); PG8_BAR; PG8_MMA(0, 0, At, B0); PG8_MMA(0, 1, At, B1); PG8_BAR; PG8_SCHED;
            PG8_LDA(At, 0, 1); PG8_STAGE(PG8_SB(0, 0), b2, voffB); PG8_STAGE(PG8_SB(0, 1), b2 + hstep, voffB); PG8_STAGE(PG8_SA(0, 0), a2, voffA);
            PG8_WAIT_V(8); PG8_WAIT_L(0); PG8_BAR; PG8_MMA(1, 0, At, B0); PG8_MMA(1, 1, At, B1); PG8_BAR; PG8_SCHED;
            PG8_LDB(B0, 1, 0); PG8_LDB(B1, 1, 1); PG8_SCHED; PG8_LDA(At, 1, 0); PG8_STAGE(PG8_SA(0, 1), a2 + hstep, voffA);
            PG8_WAIT_V(8); PG8_WAIT_L(0); PG8_BAR; PG8_MMA(0, 0, At, B0); PG8_MMA(0, 1, At, B1); PG8_BAR; PG8_SCHED;
            PG8_LDA(At, 1, 1); PG8_STAGE(PG8_SB(1, 0), b3, voffB); PG8_STAGE(PG8_SB(1, 1), b3 + hstep, voffB); PG8_STAGE(PG8_SA(1, 0), a3, voffA);
            PG8_WAIT_V(8); PG8_WAIT_L(0); PG8_BAR; PG8_MMA(1, 0, At, B0); PG8_MMA(1, 1, At, B1); PG8_BAR; PG8_SCHED;
            } else {
            PG8_LDB(B0, 0, 0); PG8_SCHED; PG8_LDA(At, 0, 0); PG8_STAGE(PG8_SA(1, 1), a1 + hstep, voffA);
            PG8_WAIT_L(8); PG8_BAR; PG8_WAIT_L(0); PG8_MMA(0, 0, At, B0); PG8_BAR; PG8_SCHED;
            PG8_LDB(B1, 0, 1); PG8_STAGE(PG8_SB(0, 0), b2, voffB);
            PG8_BAR; PG8_WAIT_L(0); PG8_MMA(0, 1, At, B1); PG8_BAR;
            PG8_LDA(At, 0, 1); PG8_STAGE(PG8_SA(0, 0), a2, voffA);
            PG8_BAR; PG8_WAIT_L(0); PG8_MMA(1, 0, At, B0); PG8_BAR; PG8_SCHED;
            PG8_STAGE(PG8_SB(0, 1), b2 + hstep, voffB);
            PG8_WAIT_V(6); PG8_BAR; PG8_MMA(1, 1, At, B1); PG8_BAR;
            PG8_LDB(B0, 1, 0); PG8_SCHED; PG8_LDA(At, 1, 0); PG8_STAGE(PG8_SA(0, 1), a2 + hstep, voffA);
            PG8_WAIT_L(8); PG8_BAR; PG8_WAIT_L(0); PG8_MMA(0, 0, At, B0); PG8_BAR; PG8_SCHED;
            PG8_LDB(B1, 1, 1); PG8_STAGE(PG8_SB(1, 0), b3, voffB);
            PG8_BAR; PG8_WAIT_L(0); PG8_MMA(0, 1, At, B1); PG8_BAR;
            PG8_LDA(At, 1, 1); PG8_STAGE(PG8_SA(1, 0), a3, voffA);
            PG8_BAR; PG8_WAIT_L(0); PG8_MMA(1, 0, At, B0); PG8_BAR; PG8_SCHED;
            PG8_STAGE(PG8_SB(1, 1), b3 + hstep, voffB);
            PG8_WAIT_V(6); PG8_BAR; PG8_MMA(1, 1, At, B1); PG8_BAR;
            }
        }
        if constexpr (ALIGN_EPI) { if (wr == 0) PG8_BAR; }
        if constexpr (!Epi::AFTER_DRAIN) { E(acc, cur, wr, wc, fr, fq); S.done(cur); }
        if (!has_next) break;
#pragma unroll
        for (int a = 0; a < 2; ++a)
#pragma unroll
            for (int b = 0; b < 2; ++b)
#pragma unroll
                for (int m = 0; m < 4; ++m)
#pragma unroll
                    for (int n = 0; n < 2; ++n) acc[a][b][m][n] = (f32x4){0.f, 0.f, 0.f, 0.f};
        cur = nxt; cA = nA; cB = nB; ++ui;
        if constexpr (ALIGN_EPI) { if (wr == 1) PG8_BAR; }
    }
    PG8_WAIT_V(0);
    if constexpr (!ALIGN_EPI) { if (wr == 0) PG8_BAR; }
    PG8_BAR;
    if constexpr (Epi::AFTER_DRAIN) { E.fused(acc, cur, wr, wc, fr, fq, lds, wid, lane); S.done(cur); }
#undef PG8_SA
#undef PG8_SB
#undef PG8_STAGE
#undef PG8_LDA
#undef PG8_LDB
#undef PG8_MMA
#undef PG8_WAIT_V
#undef PG8_WAIT_L
#undef PG8_BAR
#undef PG8_SCHED
}
typedef int v8i_t __attribute__((ext_vector_type(8)));
__host__ __device__ __forceinline__ int lds_byte8(int r, int c16) { return (r >> 4) * 2048 + c16 * 256 + (r & 15) * 16; }
__host__ __device__ __forceinline__ void stage_rc8(int b, int& R, int& C) { R = (b / 2048) * 16 + (b % 256) / 16; C = ((b % 2048) / 256) * 8; }
__device__ __forceinline__ v8i_t ld_frag8(const PG8_LAS unsigned char* p) { const u32x4 a = *(const PG8_LAS u32x4*)p, b = *(const PG8_LAS u32x4*)(p + 256);
    v8i_t r; r[0] = (int)a.x; r[1] = (int)a.y; r[2] = (int)a.z; r[3] = (int)a.w; r[4] = (int)b.x; r[5] = (int)b.y; r[6] = (int)b.z; r[7] = (int)b.w; return r; }
template <class Epi, class Sched, bool ALIGN_EPI = false, bool SP2 = false>
__device__ __forceinline__ void gemm_phase8(PG8_LAS unsigned char* lds, const Gemm g, const Sched& S, const Epi& E) {
    int tid_ = threadIdx.x; asm volatile("" : "+v"(tid_));
    const int tid = tid_, wid = __builtin_amdgcn_readfirstlane(tid >> 6), lane = tid & 63, wr = wid >> 2, wc = wid & 3, fr = lane & 15, fq = lane >> 4;
    const int K = g.K, nt = K / BK;
    unsigned voffA[2], voffB[2];
#pragma unroll
    for (int i = 0; i < 2; ++i) { int R, C; stage_rc8(tid * 16 + i * 8192, R, C); const int Rb = Epi::PERM ? ((R & ~31) + perm32(R & 31)) : R;
        voffA[i] = (unsigned)(R * K + C) * 2u; voffB[i] = (unsigned)(Rb * K + C) * 2u; }
    const size_t kstep = (size_t)(BK * 2);
    const size_t hstep = (size_t)HALF * K * 2;
    const size_t tstep = 2 * hstep;
    const unsigned ldsw = (unsigned)wid * 1024u;
    const int aoff = lds_byte8(wr * 64 + fr, 2 * fq), boff = lds_byte8(wc * 32 + fr, 2 * fq);
#define PG8_SA(b, h) (((b) * 2 + (h)) * HTB)
#define PG8_SB(b, h) ((4 + (b) * 2 + (h)) * HTB)
#define PG8_STAGE(bufoff, gbase, voff) do { _Pragma("unroll") for (int _i = 0; _i < 2; ++_i) \
        __builtin_amdgcn_global_load_lds((const unsigned*)((const char*)(gbase) + (voff)[_i]), (PG8_LAS unsigned*)(lds + (bufoff) + ldsw + _i * 8192), 16, 0, 0); } while (0)
#define PG8_LDA(dst, b, h) do { _Pragma("unroll") for (int m = 0; m < 4; ++m) dst[m] = ld_frag8(lds + PG8_SA(b, h) + aoff + m * 2048); } while (0)
#define PG8_LDB(dst, b, h) do { _Pragma("unroll") for (int n = 0; n < 2; ++n) dst[n] = ld_frag8(lds + PG8_SB(b, h) + boff + n * 2048); } while (0)
#define PG8_MMA(ai, bj, At, Bt) do { __builtin_amdgcn_s_setprio(1); _Pragma("unroll") for (int m = 0; m < 4; ++m) _Pragma("unroll") for (int n = 0; n < 2; ++n) \
        asm volatile("v_mfma_scale_f32_16x16x128_f8f6f4 %0, %1, %2, %0, %3, %3 op_sel_hi:[0,0,0]" : "+v"(acc[ai][bj][m][n]) : "v"(Bt[n]), "v"(At[m]), "v"(one_scale)); __builtin_amdgcn_s_setprio(0); } while (0)
#define PG8_WAIT_V(n) asm volatile("s_waitcnt vmcnt(" #n ")" ::: "memory")
#define PG8_WAIT_L(n) asm volatile("s_waitcnt lgkmcnt(" #n ")" ::: "memory")
#define PG8_BAR __builtin_amdgcn_s_barrier()
#define PG8_SCHED __builtin_amdgcn_sched_barrier(0)
    Unit cur, nxt; int ui = 0;
    if (!S.next(0, cur)) return;
    f32x4 acc[2][2][4][2];
#pragma unroll
    for (int a = 0; a < 2; ++a)
#pragma unroll
        for (int b = 0; b < 2; ++b)
#pragma unroll
            for (int m = 0; m < 4; ++m)
#pragma unroll
                for (int n = 0; n < 2; ++n) acc[a][b][m][n] = (f32x4){0.f, 0.f, 0.f, 0.f};
    v8i_t At[4], B0[2], B1[2]; int one_scale = 0x7F7F7F7F; asm volatile("" : "+v"(one_scale));

    const char* cA = (const char*)g.A + (size_t)cur.pm * tstep; const char* cB = (const char*)g.Bt + (size_t)((cur.pm / g.tpg) % g.ng) * g.gstride + (size_t)cur.pn * tstep;
    S.a_ready(cur);
    if constexpr (SP2) {
        PG8_STAGE(PG8_SB(0, 0), cB, voffB); PG8_STAGE(PG8_SB(0, 1), cB + hstep, voffB); PG8_STAGE(PG8_SA(0, 0), cA, voffA); PG8_STAGE(PG8_SA(0, 1), cA + hstep, voffA);
        if (wr == 1) PG8_BAR;
        PG8_WAIT_V(2); PG8_BAR;
        PG8_STAGE(PG8_SB(1, 0), cB + kstep, voffB); PG8_STAGE(PG8_SA(1, 0), cA + kstep, voffA); PG8_STAGE(PG8_SB(1, 1), cB + hstep + kstep, voffB);
        PG8_WAIT_V(6); PG8_BAR;
    } else {
        PG8_STAGE(PG8_SB(0, 0), cB, voffB); PG8_STAGE(PG8_SA(0, 0), cA, voffA); PG8_STAGE(PG8_SB(0, 1), cB + hstep, voffB); PG8_STAGE(PG8_SA(0, 1), cA + hstep, voffA);
        if (wr == 1) PG8_BAR;
        PG8_WAIT_V(4); PG8_BAR;
        PG8_STAGE(PG8_SB(1, 0), cB + kstep, voffB); PG8_STAGE(PG8_SA(1, 0), cA + kstep, voffA); PG8_STAGE(PG8_SB(1, 1), cB + hstep + kstep, voffB);
        PG8_WAIT_V(6); PG8_BAR;
    }
    for (;;) {
        const bool has_next = S.next(ui + 1, nxt);
        const char* nA = has_next ? (const char*)g.A + (size_t)nxt.pm * tstep : cA; const char* nB = has_next ? (const char*)g.Bt + (size_t)((nxt.pm / g.tpg) % g.ng) * g.gstride + (size_t)nxt.pn * tstep : cB;
#pragma unroll 1
        for (int t = 0; t < nt; t += 2) {
            if constexpr (Epi::MID_T > 0) { if (t == Epi::MID_T) E.mid(acc, cur, wr, wc, fr, fq); }
            const bool last = (t == nt - 2);
            const char* a1 = cA + (size_t)(t + 1) * kstep;
            const char* a2 = last ? nA : cA + (size_t)(t + 2) * kstep; const char* b2 = last ? nB : cB + (size_t)(t + 2) * kstep;
            const char* a3 = a2 + kstep; const char* b3 = b2 + kstep;
            if (last && has_next) S.a_ready(nxt);
            if constexpr (SP2) {
            PG8_LDB(B0, 0, 0); PG8_LDB(B1, 0, 1); PG8_SCHED; PG8_LDA(At, 0, 0); PG8_STAGE(PG8_SA(1, 1), a1 + hstep, voffA);
            PG8_WAIT_V(8); PG8_WAIT_L(0); PG8_BAR; PG8_MMA(0, 0, At, B0); PG8_MMA(0, 1, At, B1); PG8_BAR; PG8_SCHED;
            PG8_LDA(At, 0, 1); PG8_STAGE(PG8_SB(0, 0), b2, voffB); PG8_STAGE(PG8_SB(0, 1), b2 + hstep, voffB); PG8_STAGE(PG8_SA(0, 0), a2, voffA);
            PG8_WAIT_V(8); PG8_WAIT_L(0); PG8_BAR; PG8_MMA(1, 0, At, B0); PG8_MMA(1, 1, At, B1); PG8_BAR; PG8_SCHED;
            PG8_LDB(B0, 1, 0); PG8_LDB(B1, 1, 1); PG8_SCHED; PG8_LDA(At, 1, 0); PG8_STAGE(PG8_SA(0, 1), a2 + hstep, voffA);
            PG8_WAIT_V(8); PG8_WAIT_L(0); PG8_BAR; PG8_MMA(0, 0, At, B0); PG8_MMA(0, 1, At, B1); PG8_BAR; PG8_SCHED;
            PG8_LDA(At, 1, 1); PG8_STAGE(PG8_SB(1, 0), b3, voffB); PG8_STAGE(PG8_SB(1, 1), b3 + hstep, voffB); PG8_STAGE(PG8_SA(1, 0), a3, voffA);
            PG8_WAIT_V(8); PG8_WAIT_L(0); PG8_BAR; PG8_MMA(1, 0, At, B0); PG8_MMA(1, 1, At, B1); PG8_BAR; PG8_SCHED;
            } else {
            PG8_LDB(B0, 0, 0); PG8_SCHED; PG8_LDA(At, 0, 0); PG8_STAGE(PG8_SA(1, 1), a1 + hstep, voffA);
            PG8_WAIT_L(8); PG8_BAR; PG8_WAIT_L(0); PG8_MMA(0, 0, At, B0); PG8_BAR; PG8_SCHED;
            PG8_LDB(B1, 0, 1); PG8_STAGE(PG8_SB(0, 0), b2, voffB);
            PG8_BAR; PG8_WAIT_L(0); PG8_MMA(0, 1, At, B1); PG8_BAR;
            PG8_LDA(At, 0, 1); PG8_STAGE(PG8_SA(0, 0), a2, voffA);
            PG8_BAR; PG8_WAIT_L(0); PG8_MMA(1, 0, At, B0); PG8_BAR; PG8_SCHED;
            PG8_STAGE(PG8_SB(0, 1), b2 + hstep, voffB);
            PG8_WAIT_V(6); PG8_BAR; PG8_MMA(1, 1, At, B1); PG8_BAR;
            PG8_LDB(B0, 1, 0); PG8_SCHED; PG8_LDA(At, 1, 0); PG8_STAGE(PG8_SA(0, 1), a2 + hstep, voffA);
            PG8_WAIT_L(8); PG8_BAR; PG8_WAIT_L(0); PG8_MMA(0, 0, At, B0); PG8_BAR; PG8_SCHED;
            PG8_LDB(B1, 1, 1); PG8_STAGE(PG8_SB(1, 0), b3, voffB);
            PG8_BAR; PG8_WAIT_L(0); PG8_MMA(0, 1, At, B1); PG8_BAR;
            PG8_LDA(At, 1, 1); PG8_STAGE(PG8_SA(1, 0), a3, voffA);
            PG8_BAR; PG8_WAIT_L(0); PG8_MMA(1, 0, At, B0); PG8_BAR; PG8_SCHED;
            PG8_STAGE(PG8_SB(1, 1), b3 + hstep, voffB);
            PG8_WAIT_V(6); PG8_BAR; PG8_MMA(1, 1, At, B1); PG8_BAR;
            }
        }
        if constexpr (ALIGN_EPI) { if (wr == 0) PG8_BAR; }
        asm volatile("s_nop 15\n\ts_nop 15" ::: "memory");
        if constexpr (!Epi::AFTER_DRAIN) { E(acc, cur, wr, wc, fr, fq); S.done(cur); }
        if (!has_next) break;
#pragma unroll
        for (int a = 0; a < 2; ++a)
#pragma unroll
            for (int b = 0; b < 2; ++b)
#pragma unroll
                for (int m = 0; m < 4; ++m)
#pragma unroll
                    for (int n = 0; n < 2; ++n) acc[a][b][m][n] = (f32x4){0.f, 0.f, 0.f, 0.f};
        cur = nxt; cA = nA; cB = nB; ++ui;
        if constexpr (ALIGN_EPI) { if (wr == 1) PG8_BAR; }
    }
    PG8_WAIT_V(0);
    if constexpr (!ALIGN_EPI) { if (wr == 0) PG8_BAR; }
    PG8_BAR;
    if constexpr (Epi::AFTER_DRAIN) { E.fused(acc, cur, wr, wc, fr, fq, lds, wid, lane); S.done(cur); }
#undef PG8_SA
#undef PG8_SB
#undef PG8_STAGE
#undef PG8_LDA
#undef PG8_LDB
#undef PG8_MMA
#undef PG8_WAIT_V
#undef PG8_WAIT_L
#undef PG8_BAR
#undef PG8_SCHED
}
#ifndef PG8_PRIO_MMA
#define PG8_PRIO_MMA 1
#endif
typedef int v4i_t __attribute__((ext_vector_type(4)));
__host__ __device__ __forceinline__ int lds_byte4(int r, int c16) { return r * 128 + ((c16 ^ ((r >> 1) & 7)) << 4); }
__host__ __device__ __forceinline__ void stage_rc4(int b, int& R, int& C) { R = b / 128; C = ((((b % 128) / 16) ^ ((R >> 1) & 7))) * 8; }
template <class Epi, class Sched, bool ALIGN_EPI = false, bool SP2 = false, int VAR = 0  >
__device__ __forceinline__ void gemm_phase4(PG8_LAS unsigned char* lds, const Gemm g, const Sched& S, const Epi& E) {
    int tid_ = threadIdx.x; asm volatile("" : "+v"(tid_));
    const int tid = tid_, wid = __builtin_amdgcn_readfirstlane(tid >> 6), lane = tid & 63, wr = wid >> 2, wc = wid & 3, fr = lane & 15, fq = lane >> 4;
    const int K = g.K, nt = K / BK;
    unsigned voffA[2], voffB[2];
#pragma unroll
    for (int i = 0; i < 2; ++i) { int R, C; stage_rc4(tid * 16 + i * 8192, R, C); const int Rb = Epi::PERM ? ((R & ~31) + perm32(R & 31)) : R;
        voffA[i] = (unsigned)(R * K + C) * 2u; voffB[i] = (unsigned)(Rb * K + C) * 2u; }
    const size_t kstep = (size_t)(BK * 2);
    const size_t hstep = (size_t)HALF * K * 2;
    const size_t tstep = 2 * hstep;
    const unsigned ldsw = (unsigned)wid * 1024u;
    const int aoff[2] = {lds_byte4(wr * 64 + fr, fq), lds_byte4(wr * 64 + fr, 4 + fq)}, boff[2] = {lds_byte4(wc * 32 + fr, fq), lds_byte4(wc * 32 + fr, 4 + fq)};
#define PG8_SA(b, h) (((b) * 2 + (h)) * HTB)
#define PG8_SB(b, h) ((4 + (b) * 2 + (h)) * HTB)
#define PG8_STAGE(bufoff, gbase, voff) do { if constexpr ((VAR & 4) == 0) _Pragma("unroll") for (int _i = 0; _i < 2; ++_i) \
        __builtin_amdgcn_global_load_lds((const unsigned*)((const char*)(gbase) + (voff)[_i]), (PG8_LAS unsigned*)(lds + (bufoff) + ldsw + _i * 8192), 16, 0, 0); } while (0)
#define PG8_LDA(dst, b, h) do { if constexpr ((VAR & 2) == 0) _Pragma("unroll") for (int m = 0; m < 4; ++m) _Pragma("unroll") for (int k = 0; k < 2; ++k) dst[m][k] = *(const PG8_LAS v4i_t*)(lds + PG8_SA(b, h) + aoff[k] + m * 2048); } while (0)
#define PG8_LDB(dst, b, h) do { if constexpr ((VAR & 2) == 0) _Pragma("unroll") for (int n = 0; n < 2; ++n) _Pragma("unroll") for (int k = 0; k < 2; ++k) dst[n][k] = *(const PG8_LAS v4i_t*)(lds + PG8_SB(b, h) + boff[k] + n * 2048); } while (0)
#define PG8_MMA(ai, bj, At, Bt) do { __builtin_amdgcn_s_setprio(PG8_PRIO_MMA); if constexpr ((VAR & 1) == 0) _Pragma("unroll") for (int k = 0; k < 2; ++k) _Pragma("unroll") for (int m = 0; m < 4; ++m) _Pragma("unroll") for (int n = 0; n < 2; ++n)   \
        asm volatile("v_mfma_scale_f32_16x16x128_f8f6f4 %0, %1, %2, %0, %3, %3 op_sel_hi:[0,0,0] cbsz:4 blgp:4" : "+v"(acc[ai][bj][m][n]) : "v"(Bt[n][k]), "v"(At[m][k]), "v"(one_scale)); __builtin_amdgcn_s_setprio(1 - PG8_PRIO_MMA); } while (0)
#define PG8_WAIT_V(n) asm volatile("s_waitcnt vmcnt(" #n ")" ::: "memory")
#define PG8_WAIT_L(n) asm volatile("s_waitcnt lgkmcnt(" #n ")" ::: "memory")
#define PG8_BAR __builtin_amdgcn_s_barrier()
#define PG8_SCHED __builtin_amdgcn_sched_barrier(0)
    Unit cur, nxt; int ui = 0;
    if (!S.next(0, cur)) return;
    f32x4 acc[2][2][4][2];
#pragma unroll
    for (int a = 0; a < 2; ++a)
#pragma unroll
        for (int b = 0; b < 2; ++b)
#pragma unroll
            for (int m = 0; m < 4; ++m)
#pragma unroll
                for (int n = 0; n < 2; ++n) acc[a][b][m][n] = (f32x4){0.f, 0.f, 0.f, 0.f};
    v4i_t At[4][2] = {}, B0[2][2] = {}, B1[2][2] = {}; if constexpr (VAR != 0) { _Pragma("unroll") for (int m = 0; m < 4; ++m) _Pragma("unroll") for (int k = 0; k < 2; ++k) asm volatile("" : "+v"(At[m][k])); _Pragma("unroll") for (int n = 0; n < 2; ++n) _Pragma("unroll") for (int k = 0; k < 2; ++k) asm volatile("" : "+v"(B0[n][k]), "+v"(B1[n][k])); }
    int one_scale = 0x7F7F7F7F; asm volatile("" : "+v"(one_scale));

    const char* cA = (const char*)g.A + (size_t)cur.pm * tstep; const char* cB = (const char*)g.Bt + (size_t)((cur.pm / g.tpg) % g.ng) * g.gstride + (size_t)cur.pn * tstep;
    S.a_ready(cur);
    if constexpr (SP2) {
        PG8_STAGE(PG8_SB(0, 0), cB, voffB); PG8_STAGE(PG8_SB(0, 1), cB + hstep, voffB); PG8_STAGE(PG8_SA(0, 0), cA, voffA); PG8_STAGE(PG8_SA(0, 1), cA + hstep, voffA);
        if (wr == 1) PG8_BAR;
        PG8_WAIT_V(2); PG8_BAR;
        PG8_STAGE(PG8_SB(1, 0), cB + kstep, voffB); PG8_STAGE(PG8_SA(1, 0), cA + kstep, voffA); PG8_STAGE(PG8_SB(1, 1), cB + hstep + kstep, voffB);
        PG8_WAIT_V(6); PG8_BAR;
    } else {
        PG8_STAGE(PG8_SB(0, 0), cB, voffB); PG8_STAGE(PG8_SA(0, 0), cA, voffA); PG8_STAGE(PG8_SB(0, 1), cB + hstep, voffB); PG8_STAGE(PG8_SA(0, 1), cA + hstep, voffA);
        if (wr == 1) PG8_BAR;
        PG8_WAIT_V(4); PG8_BAR;
        PG8_STAGE(PG8_SB(1, 0), cB + kstep, voffB); PG8_STAGE(PG8_SA(1, 0), cA + kstep, voffA); PG8_STAGE(PG8_SB(1, 1), cB + hstep + kstep, voffB);
        PG8_WAIT_V(6); PG8_BAR;
    }
    for (;;) {
        const bool has_next = S.next(ui + 1, nxt);
        const char* nA = has_next ? (const char*)g.A + (size_t)nxt.pm * tstep : cA; const char* nB = has_next ? (const char*)g.Bt + (size_t)((nxt.pm / g.tpg) % g.ng) * g.gstride + (size_t)nxt.pn * tstep : cB;
#pragma unroll 1
        for (int t = 0; t < nt; t += 2) {
            if constexpr (Epi::MID_T > 0) { if (t == Epi::MID_T) E.mid(acc, cur, wr, wc, fr, fq); }
            const bool last = (t == nt - 2);
            const char* a1 = cA + (size_t)(t + 1) * kstep;
            const char* a2 = last ? nA : cA + (size_t)(t + 2) * kstep; const char* b2 = last ? nB : cB + (size_t)(t + 2) * kstep;
            const char* a3 = a2 + kstep; const char* b3 = b2 + kstep;
            if (last && has_next) S.a_ready(nxt);
            if constexpr (SP2) {
            PG8_LDB(B0, 0, 0); PG8_LDB(B1, 0, 1); PG8_SCHED; PG8_LDA(At, 0, 0); PG8_STAGE(PG8_SA(1, 1), a1 + hstep, voffA);
            PG8_WAIT_V(8); PG8_WAIT_L(0); PG8_BAR; PG8_MMA(0, 0, At, B0); PG8_MMA(0, 1, At, B1); PG8_BAR; PG8_SCHED;
            PG8_LDA(At, 0, 1); PG8_STAGE(PG8_SB(0, 0), b2, voffB); PG8_STAGE(PG8_SB(0, 1), b2 + hstep, voffB); PG8_STAGE(PG8_SA(0, 0), a2, voffA);
            PG8_WAIT_V(8); PG8_WAIT_L(0); PG8_BAR; PG8_MMA(1, 0, At, B0); PG8_MMA(1, 1, At, B1); PG8_BAR; PG8_SCHED;
            PG8_LDB(B0, 1, 0); PG8_LDB(B1, 1, 1); PG8_SCHED; PG8_LDA(At, 1, 0); PG8_STAGE(PG8_SA(0, 1), a2 + hstep, voffA);
            PG8_WAIT_V(8); PG8_WAIT_L(0); PG8_BAR; PG8_MMA(0, 0, At, B0); PG8_MMA(0, 1, At, B1); PG8_BAR; PG8_SCHED;
            PG8_LDA(At, 1, 1); PG8_STAGE(PG8_SB(1, 0), b3, voffB); PG8_STAGE(PG8_SB(1, 1), b3 + hstep, voffB); PG8_STAGE(PG8_SA(1, 0), a3, voffA);
            PG8_WAIT_V(8); PG8_WAIT_L(0); PG8_BAR; PG8_MMA(1, 0, At, B0); PG8_MMA(1, 1, At, B1); PG8_BAR; PG8_SCHED;
            } else {
            PG8_LDB(B0, 0, 0); PG8_SCHED; PG8_LDA(At, 0, 0); PG8_STAGE(PG8_SA(1, 1), a1 + hstep, voffA);
            PG8_WAIT_L(8); PG8_BAR; PG8_WAIT_L(0); PG8_MMA(0, 0, At, B0); PG8_BAR; PG8_SCHED;
            PG8_LDB(B1, 0, 1); PG8_STAGE(PG8_SB(0, 0), b2, voffB);
            PG8_BAR; PG8_WAIT_L(0); PG8_MMA(0, 1, At, B1); PG8_BAR;
            PG8_LDA(At, 0, 1); PG8_STAGE(PG8_SA(0, 0), a2, voffA);
            PG8_BAR; PG8_WAIT_L(0); PG8_MMA(1, 0, At, B0); PG8_BAR; PG8_SCHED;
            PG8_STAGE(PG8_SB(0, 1), b2 + hstep, voffB);
            PG8_WAIT_V(6); PG8_BAR; PG8_MMA(1, 1, At, B1); PG8_BAR;
            PG8_LDB(B0, 1, 0); PG8_SCHED; PG8_LDA(At, 1, 0); PG8_STAGE(PG8_SA(0, 1), a2 + hstep, voffA);
            PG8_WAIT_L(8); PG8_BAR; PG8_WAIT_L(0); PG8_MMA(0, 0, At, B0); PG8_BAR; PG8_SCHED;
            PG8_LDB(B1, 1, 1); PG8_STAGE(PG8_SB(1, 0), b3, voffB);
            PG8_BAR; PG8_WAIT_L(0); PG8_MMA(0, 1, At, B1); PG8_BAR;
            PG8_LDA(At, 1, 1); PG8_STAGE(PG8_SA(1, 0), a3, voffA);
            PG8_BAR; PG8_WAIT_L(0); PG8_MMA(1, 0, At, B0); PG8_BAR; PG8_SCHED;
            PG8_STAGE(PG8_SB(1, 1), b3 + hstep, voffB);
            PG8_WAIT_V(6); PG8_BAR; PG8_MMA(1, 1, At, B1); PG8_BAR;
            }
        }
        if constexpr (ALIGN_EPI) { if (wr == 0) PG8_BAR; }
        asm volatile("s_nop 15\n\ts_nop 15" ::: "memory");
        if constexpr (!Epi::AFTER_DRAIN && (VAR & 8) == 0) { E(acc, cur, wr, wc, fr, fq); S.done(cur); }
        if (!has_next) break;
#pragma unroll
        for (int a = 0; a < 2; ++a)
#pragma unroll
            for (int b = 0; b < 2; ++b)
#pragma unroll
                for (int m = 0; m < 4; ++m)
#pragma unroll
                    for (int n = 0; n < 2; ++n) acc[a][b][m][n] = (f32x4){0.f, 0.f, 0.f, 0.f};
        cur = nxt; cA = nA; cB = nB; ++ui;
        if constexpr (ALIGN_EPI) { if (wr == 1) PG8_BAR; }
    }
    PG8_WAIT_V(0);
    if constexpr (!ALIGN_EPI) { if (wr == 0) PG8_BAR; }
    PG8_BAR;
    if constexpr (Epi::AFTER_DRAIN) { E.fused(acc, cur, wr, wc, fr, fq, lds, wid, lane); S.done(cur); }
#undef PG8_SA
#undef PG8_SB
#undef PG8_STAGE
#undef PG8_LDA
#undef PG8_LDB
#undef PG8_MMA
#undef PG8_WAIT_V
#undef PG8_WAIT_L
#undef PG8_BAR
#undef PG8_SCHED
}
}
constexpr int NWAVES = 8;
#ifndef MK_ATTN_SIMPLE
#define MK_ATTN_SIMPLE 0
#endif
#ifndef MK_TOPK_RANK
#define MK_TOPK_RANK 0
#endif
#ifndef MK_PER_PHASE
#define MK_PER_PHASE 0
#endif

constexpr int D = 1024, TP = 16384, TS = 4096, NSB = 4, T = TP + NSB * TS;
constexpr int DEPTH = 2, NMOD = 5;
constexpr int HYW = 512, NHY = 3 * HYW, ATW = 512, KVW = 128, INW = 4352;
constexpr int COL_Q = 1536, COL_K = 2048, COL_V = 2176, COL_G = 2304;
constexpr int NH = 8, NKV = 2, HD = 64, WIN = 128;
constexpr int NE = 16, CAP = 2048, FF = 2816, NGRP = 2, TG = 16384;
constexpr int NSLOT = NGRP * NE * CAP;
constexpr float EPS = 1e-6f;
constexpr int FH = 64, FEMB = 33, FOUT = 2048;
constexpr int TPAD = T + 64;
constexpr int KB_UP = D / 2, KB_DN = 1536;
constexpr int KFS_P = 16392, KFS_S = 4104;

constexpr size_t MiB = 1u << 20;
constexpr size_t WS_CTL = 0, CTL_ZERO_BYTES = 1 * MiB;
constexpr size_t WS_MOD = 1 * MiB;
constexpr size_t WS_PSUM = 2 * MiB;
constexpr size_t WS_AFFT = 7 * MiB;
constexpr size_t WS_SLOT = 9 * MiB;
constexpr size_t WS_IDX = 11 * MiB;
constexpr size_t WS_GATEV = 11 * MiB + 512 * 1024;
constexpr size_t WS_ROPE = 12 * MiB;
constexpr size_t WS_WIN = 16 * MiB;
constexpr size_t WS_WHY = 33 * MiB;
constexpr size_t WS_WAT = 35 * MiB;
constexpr size_t WS_WO = 37 * MiB;
constexpr size_t WS_AFFTOK = 41 * MiB;
constexpr size_t WS_WOUT = 43 * MiB;
constexpr size_t WS_WGU = 48 * MiB;
constexpr size_t WS_WD = 224 * MiB;
constexpr size_t WS_H = 312 * MiB;
constexpr size_t WS_R1 = 376 * MiB;
constexpr size_t WS_HRAW_P = WS_R1, WS_HRAW_S = WS_R1 + 128 * MiB;
constexpr size_t WS_Z2T = WS_R1, WS_Z2AT = WS_R1 + 65 * MiB;
constexpr int ZAP = 2 * HYW;
constexpr size_t WS_KF_P = 536 * MiB, WS_KF_S = 665 * MiB;
constexpr size_t WS_YHY = 536 * MiB, WS_YAT = 600 * MiB;
constexpr size_t WS_HYT = 698 * MiB;
constexpr size_t WS_MERGED = 698 * MiB, WS_MIX = 762 * MiB;
constexpr size_t WS_PROJ = 891 * MiB;
constexpr size_t WS_QN = 1162 * MiB, WS_KN = 1194 * MiB;
constexpr size_t WS_XE = 376 * MiB, WS_HID = 504 * MiB, WS_YE = 856 * MiB;
constexpr size_t WS_END = 1202 * MiB;
static_assert(WS_KF_P + (size_t)1024 * KFS_P * 8 <= WS_KF_S && WS_KF_S + (size_t)1024 * KFS_S * 8 <= WS_HYT && WS_HYT + (size_t)NHY * TPAD * 4 <= WS_PROJ && WS_PROJ + (size_t)T * INW * 2 <= WS_END && WS_Z2T + (size_t)HYW * TPAD * 4 <= WS_Z2AT && WS_Z2AT + (size_t)T * ZAP * 2 <= WS_R1 + 160 * MiB, "ws map");
static_assert(WS_HID + (size_t)NSLOT * FF * 2 <= WS_YE && WS_YE + (size_t)NSLOT * D * 2 <= WS_END && WS_WGU + (size_t)NE * 2 * FF * D * 2 <= WS_WD && WS_WD + (size_t)NE * D * FF * 2 <= WS_H, "ws map 2");
constexpr int CW_BAR = 4096;

constexpr int RING_OFF = 0, RING_BYTES = 139264;
constexpr int LDSCTL_OFF = RING_BYTES, MISC_OFF = LDSCTL_OFF + 320;
constexpr int SCR_OFF = RING_BYTES + 1024;
constexpr int LDS_BYTES = 151552;
static_assert(MISC_OFF + 128 <= SCR_OFF && SCR_OFF + 8192 <= LDS_BYTES, "LDS map");

#define GAS __attribute__((address_space(1)))
#define LAS __attribute__((address_space(3)))
typedef unsigned short bf16;
typedef unsigned v4u __attribute__((ext_vector_type(4)));
typedef unsigned v2u __attribute__((ext_vector_type(2)));
typedef float f32x4 __attribute__((ext_vector_type(4)));
typedef float f32x2 __attribute__((ext_vector_type(2)));
typedef float f32x16 __attribute__((ext_vector_type(16)));
typedef short bf16x8 __attribute__((ext_vector_type(8)));
typedef GAS unsigned gu32;
#define RLX_AGENT __ATOMIC_RELAXED, __HIP_MEMORY_SCOPE_AGENT
#define LDS_WAIT() asm volatile("s_waitcnt lgkmcnt(0)" ::: "memory")
#define VM_WAIT() asm volatile("s_waitcnt vmcnt(0)" ::: "memory")
__device__ __forceinline__ unsigned f2bf(float f) { unsigned u = __builtin_bit_cast(unsigned, f); return (u + 0x7fffu + ((u >> 16) & 1u)) >> 16; }
__device__ __forceinline__ unsigned pk2(float lo, float hi) { return f2bf(lo) | (f2bf(hi) << 16); }
__device__ __forceinline__ float bf2f(unsigned b) { return __builtin_bit_cast(float, b << 16); }
__device__ __forceinline__ float bflo(unsigned w) { return __builtin_bit_cast(float, w << 16); }
__device__ __forceinline__ float bfhi(unsigned w) { return __builtin_bit_cast(float, w & 0xffff0000u); }
__device__ __forceinline__ float wave_sum(float v) {
#pragma unroll
    for (int o = 1; o < 64; o <<= 1) v += __shfl_xor(v, o);
    return v;
}
__device__ __forceinline__ float wave_max(float v) {
#pragma unroll
    for (int o = 1; o < 64; o <<= 1) v = fmaxf(v, __shfl_xor(v, o));
    return v;
}
__device__ __forceinline__ float rdlane(float v, int l) { return __builtin_bit_cast(float, __builtin_amdgcn_readlane(__builtin_bit_cast(int, v), l)); }
__device__ __forceinline__ float sin_rev(float x) { return __builtin_amdgcn_sinf(x); }
__device__ __forceinline__ float cos_rev(float x) { return __builtin_amdgcn_cosf(x); }
__device__ __forceinline__ float fast_exp(float x) { return __builtin_amdgcn_exp2f(1.4426950408889634f * x); }
__device__ __forceinline__ float sigmoidf(float x) { return __builtin_amdgcn_rcpf(1.0f + fast_exp(-x)); }
__device__ __forceinline__ float siluf(float x) { return x * sigmoidf(x); }
__device__ __forceinline__ float siluf_acc(float x) { return x / (1.0f + expf(-x)); }

#define XB_TMO      128
#define XB_XCNT(j)  (256  + 64 * (j))
#define XB_XSUB(j)  (1280 + 64 * (j))
#define XB_XGEN(j)  (2304 + 64 * (j))
#define XB_TOP      3328
#define XB_TOPGEN   3392
#define XCD_BAR_WORDS 3456
#define XB_SPIN_CAP (1u << 22)

__device__ __forceinline__ unsigned xb_ld(unsigned* p)              { return __hip_atomic_load(p, __ATOMIC_RELAXED, __HIP_MEMORY_SCOPE_AGENT); }
__device__ __forceinline__ unsigned xb_add(unsigned* p, unsigned v) { return __hip_atomic_fetch_add(p, v, __ATOMIC_RELAXED, __HIP_MEMORY_SCOPE_AGENT); }
__device__ __forceinline__ unsigned xb_xcc_id() { return (unsigned)__builtin_amdgcn_s_getreg((3 << 11) | 20) & 0xFu; }
#define XB_SPIN(cond, bar) do { unsigned _sp = 0; while (cond) { __builtin_amdgcn_s_sleep(1); \
    if ((++_sp & 255u) == 0u) { if (xb_ld(&(bar)[XB_TMO])) break; if (_sp > XB_SPIN_CAP) { atomicAdd(&(bar)[XB_TMO], 1u); break; } } } } while (0)

struct XcdBarrier {
    unsigned* bar; unsigned x;
    volatile LAS unsigned* st;
};

__device__ __forceinline__ XcdBarrier xcd_barrier_post(unsigned* bar, volatile LAS unsigned* st) {
    XcdBarrier b; b.bar = bar; b.x = xb_xcc_id(); b.st = st;
    if (threadIdx.x == 0) (void)xb_add(&bar[XB_XCNT(b.x)], 1u);
    return b;
}
__device__ __forceinline__ void xcd_barrier_complete(unsigned* bar, unsigned x, unsigned& nloc, unsigned& nx) {
    const unsigned G = gridDim.x * gridDim.y * gridDim.z;
    unsigned sum, cnt, mine, sp = 0u;
    for (;;) {
        sum = 0u; cnt = 0u; mine = 0u;
#pragma unroll
        for (unsigned j = 0; j < 16; ++j) { const unsigned c = xb_ld(&bar[XB_XCNT(j)]); sum += c; cnt += (c > 0u) ? 1u : 0u; mine = (j == x) ? c : mine; }
        if (sum == G) break;
        __builtin_amdgcn_s_sleep(1);
        if ((++sp & 255u) == 0u) { if (xb_ld(&bar[XB_TMO])) break; if (sp > XB_SPIN_CAP) { atomicAdd(&bar[XB_TMO], 1u); break; } }
    }
    nloc = mine > 0u ? mine : 1u; nx = cnt > 0u ? cnt : 1u;
}

__device__ __forceinline__ void xcd_barrier(const XcdBarrier& b) {
    asm volatile("s_waitcnt vmcnt(0)" ::: "memory");
    __syncthreads();
    if (threadIdx.x == 0) {
        unsigned* bar = b.bar;
        __builtin_amdgcn_s_waitcnt(0);
        unsigned nloc = b.st[0], nx = b.st[1];
        if (nloc == 0u) { xcd_barrier_complete(bar, b.x, nloc, nx); b.st[0] = nloc; b.st[1] = nx; }
        const unsigned old = xb_add(&bar[XB_XSUB(b.x)], 1u);
        const unsigned gen = old / nloc;
        if (old + 1u == (gen + 1u) * nloc) {
            __builtin_amdgcn_fence(__ATOMIC_RELEASE, "agent");
            asm volatile("s_waitcnt vmcnt(0)" ::: "memory");
            const unsigned og = xb_add(&bar[XB_TOP], 1u);
            const unsigned tg = og / nx;
            if (og + 1u == (tg + 1u) * nx) xb_add(&bar[XB_TOPGEN], 1u);
            else XB_SPIN(xb_ld(&bar[XB_TOPGEN]) == tg, bar);
            __builtin_amdgcn_fence(__ATOMIC_ACQUIRE, "agent");
            xb_add(&bar[XB_XGEN(b.x)], 1u);
            asm volatile("s_waitcnt vmcnt(0)" ::: "memory");
        } else {
            XB_SPIN(xb_ld(&bar[XB_XGEN(b.x)]) == gen, bar);
            __builtin_amdgcn_fence(__ATOMIC_ACQUIRE, "agent");
            asm volatile("s_waitcnt vmcnt(0)" ::: "memory");
        }
    }
    __syncthreads();
}


#define FFT_DEV __device__ __forceinline__
#define FFT_LDS LAS
__device__ __forceinline__ int fft_tid_() { int t = threadIdx.x; asm volatile("" : "+v"(t)); return t; }
#define FFT_TID fft_tid_()
#define FFT_NTHR (NWAVES * 64)
#define FFT_SYNC() __syncthreads()
__device__ __forceinline__ float fft_sin_rev(float x) { return __builtin_amdgcn_sinf(x); }
__device__ __forceinline__ float fft_cos_rev(float x) { return __builtin_amdgcn_cosf(x); }
__device__ __forceinline__ unsigned fft_brev(unsigned x) { return __builtin_bitreverse32(x); }
typedef float c32 __attribute__((ext_vector_type(2)));
#define FFT_PIDX(i) ((i) + (((i) >> 6) << 2))
typedef float fft_v4 __attribute__((ext_vector_type(4)));
FFT_DEV c32 c_mk(float a, float b) { c32 r; r.x = a; r.y = b; return r; }
FFT_DEV c32 c_add(c32 a, c32 b) { return a + b; }
FFT_DEV c32 c_sub(c32 a, c32 b) { return a - b; }
FFT_DEV c32 c_mul(c32 a, c32 b) { return b * a.x + c_mk(-b.y, b.x) * a.y; }
FFT_DEV c32 c_mulc(c32 a, c32 b) { return a * b.x + c_mk(a.y, -a.x) * b.y; }
FFT_DEV c32 c_conj(c32 a) { return c_mk(a.x, -a.y); }
FFT_DEV c32 c_scale(c32 a, float s) { return a * s; }
FFT_DEV c32 c_twid(float rev) { return c_mk(fft_cos_rev(rev), -fft_sin_rev(rev)); }
FFT_DEV c32 c_root32(int j) {
    switch (j) { case 0: return c_mk(1.f, 0.f); case 1: return c_mk(0.98078528040323043f, -0.19509032201612825f); case 2: return c_mk(0.92387953251128674f, -0.38268343236508977f);
                 case 3: return c_mk(0.83146961230254524f, -0.55557023301960218f); case 4: return c_mk(0.70710678118654752f, -0.70710678118654752f);
                 case 5: return c_mk(0.55557023301960218f, -0.83146961230254524f); case 6: return c_mk(0.38268343236508977f, -0.92387953251128674f); default: return c_mk(0.19509032201612825f, -0.98078528040323043f); }
}
template <int LOGM, int NST, bool INV, int NB, int PRUNE> FFT_DEV void fft_pass(FFT_LDS c32* buf0, int s) {
    constexpr int M = 1 << LOGM, R = 1 << NST, G = M / R, PADM = FFT_PIDX(M);
    const int lq = LOGM - s - NST, q = 1 << lq;
    for (int gi = FFT_TID; gi < NB * G; gi += FFT_NTHR) {
        const int g = gi & (G - 1); FFT_LDS c32* buf = buf0 + (gi / G) * PADM;
        const int r = g & (q - 1), i0 = ((g >> lq) << (lq + NST)) + r;
        const int pb = FFT_PIDX(i0);
        c32 x[R];
#pragma unroll
        for (int j = 0; j < R; ++j) x[j] = (PRUNE == 1 && j >= R / 2) ? c_mk(0.f, 0.f) : buf[pb + FFT_PIDX(j * q)];
        c32 Ts[NST];
        Ts[0] = c_twid((float)(r << s) * (1.0f / M));
#pragma unroll
        for (int t = 1; t < NST; ++t) Ts[t] = c_mul(Ts[t - 1], Ts[t - 1]);
#pragma unroll
        for (int tt = 0; tt < NST; ++tt) {
            const int t = INV ? NST - 1 - tt : tt, h = R >> (t + 1);
            c32 Pq[R / 2], Qq[R / 2];
#pragma unroll
            for (int jj = 0; jj < h; ++jj) {
                c32 tw;
                if (jj < (h + 1) / 2) tw = jj == 0 ? Ts[t] : c_mul(Ts[t], c_root32(jj * (16 / h)));
                else { const c32 b = INV ? c_mk(Pq[jj - h / 2].x, -Pq[jj - h / 2].y) : Pq[jj - h / 2]; tw = c_mk(b.y, -b.x); }
                if (!INV) { Pq[jj] = tw; Qq[jj] = c_mk(-tw.y, tw.x); } else { Pq[jj] = c_mk(tw.x, -tw.y); Qq[jj] = c_mk(tw.y, tw.x); }
            }
#pragma unroll
            for (int j = 0; j < R / 2; ++j) { const int jj = j % h, b = (j / h) * 2 * h + jj;
                if (!INV) {
                    if (PRUNE == 1 && t == 0) { const c32 a = x[b]; x[b + h] = Pq[jj] * a.x + Qq[jj] * a.y; }
                    else { const c32 a = x[b], c = x[b + h], d = a - c; x[b] = a + c; x[b + h] = Pq[jj] * d.x + Qq[jj] * d.y; }
                } else {
                    const c32 a = x[b], cr = x[b + h], c = Pq[jj] * cr.x + Qq[jj] * cr.y; x[b] = a + c;
                    if (!(PRUNE == 2 && t == 0)) x[b + h] = a - c;
                }
            }
        }
#pragma unroll
        for (int j = 0; j < R; ++j) if (!(PRUNE == 2 && j >= R / 2)) buf[pb + FFT_PIDX(j * q)] = x[j];
    }
}
template <int LOGM, int NB, bool ZP> FFT_DEV void fft_fwd(FFT_LDS c32* buf) {
    static_assert(LOGM % 4 == 0 || LOGM % 4 == 2, "radix-16 passes + one radix-4 pass");
    FFT_SYNC(); fft_pass<LOGM, 4, false, NB, ZP ? 1 : 0>(buf, 0);
    if constexpr (LOGM == 14) { FFT_SYNC(); fft_pass<LOGM, 5, false, NB, 0>(buf, 4); FFT_SYNC(); fft_pass<LOGM, 5, false, NB, 0>(buf, 9); }
    else {
        int s = 4;
#pragma unroll
        for (int p = 1; p < LOGM / 4; ++p) { FFT_SYNC(); fft_pass<LOGM, 4, false, NB, 0>(buf, s); s += 4; }
        if (LOGM % 4 == 2) { FFT_SYNC(); fft_pass<LOGM, 2, false, NB, 0>(buf, s); }
    }
    FFT_SYNC();
}
template <int LOGM, int NB, bool HO> FFT_DEV void fft_inv(FFT_LDS c32* buf) {
    if constexpr (LOGM == 14) { FFT_SYNC(); fft_pass<LOGM, 5, true, NB, 0>(buf, 9); FFT_SYNC(); fft_pass<LOGM, 5, true, NB, 0>(buf, 4); }
    else {
        int s = LOGM;
        if (LOGM % 4 == 2) { s -= 2; FFT_SYNC(); fft_pass<LOGM, 2, true, NB, 0>(buf, s); }
#pragma unroll
        for (int p = 1; p < LOGM / 4; ++p) { s -= 4; FFT_SYNC(); fft_pass<LOGM, 4, true, NB, 0>(buf, s); }
    }
    FFT_SYNC(); fft_pass<LOGM, 4, true, NB, HO ? 2 : 0>(buf, 0);
    FFT_SYNC();
}
template <int LOGM> FFT_DEV void filt_untangle(FFT_LDS const c32* buf, c32* KfP, float scale) {
    constexpr int M = 1 << LOGM;
    for (int t = FFT_TID; t <= M / 2; t += FFT_NTHR) {
        if (t == 0) { const c32 Z0 = buf[FFT_PIDX(0)]; KfP[0] = c_mk((Z0.x + Z0.y) * scale, 0.f); KfP[1] = c_mk((Z0.x - Z0.y) * scale, 0.f); }
        else {
            const int p1 = t == M / 2 ? 1 : 2 * t, kk = (int)(fft_brev((unsigned)p1) >> (32 - LOGM)), p2 = (int)(fft_brev((unsigned)(M - kk)) >> (32 - LOGM));
            const c32 A = buf[FFT_PIDX(p1)], B = buf[FFT_PIDX(p2)];
            const c32 E = c_mk(0.5f * (A.x + B.x), 0.5f * (A.y - B.y)), O = c_mk(0.5f * (A.y + B.y), -0.5f * (A.x - B.x));
            const c32 wk = c_twid((float)kk * (0.5f / M)), Tt = c_mul(wk, O);
            const c32 K1 = c_scale(c_add(E, Tt), scale), K2 = c_scale(c_conj(c_sub(E, Tt)), scale);
            if (t == M / 2) KfP[M] = K1;
            else { fft_v4 v; v.x = K1.x; v.y = K1.y; v.z = K2.x; v.w = K2.y; *(fft_v4*)(KfP + 2 * t) = v; }
        }
    }
}
template <int LOGM, int NB, int CH> FFT_DEV void pw_fetch(const c32* __restrict__ KfP, c32 (&K1)[CH], c32 (&K2)[CH], int i0) {
    constexpr int M = 1 << LOGM;
#pragma unroll
    for (int j = 0; j < CH; ++j) { const int t = (i0 + j * FFT_NTHR) & (M / 2 - 1); const fft_v4 v = *(const fft_v4*)(KfP + 2 * t); K1[j] = c_mk(v.x, v.y); K2[j] = c_mk(v.z, v.w); }
}
template <int LOGM, int NB, int CH> FFT_DEV void conv_pointwise(FFT_LDS c32* buf0, const c32* __restrict__ KfP, float invM, c32 (&K1)[CH], c32 (&K2)[CH]) {
    constexpr int M = 1 << LOGM, PADM = FFT_PIDX(M), NP = NB * (M / 2);
    for (int i0 = FFT_TID; i0 < NP; i0 += CH * FFT_NTHR) {
        c32 N1[CH], N2[CH];
        const bool more = i0 + CH * FFT_NTHR < NP;
        if (more) pw_fetch<LOGM, NB, CH>(KfP, N1, N2, i0 + CH * FFT_NTHR);
#pragma unroll
        for (int j = 0; j < CH; ++j) { const int i = i0 + j * FFT_NTHR, t = i & (M / 2 - 1), p1 = 2 * t, kk = (int)(fft_brev((unsigned)p1) >> (32 - LOGM)); FFT_LDS c32* buf = buf0 + (i / (M / 2)) * PADM;
            if (t == 0) { const c32 Z0 = buf[FFT_PIDX(0)]; const float Y0 = (Z0.x + Z0.y) * K1[j].x * invM, YM = (Z0.x - Z0.y) * K2[j].x * invM; buf[FFT_PIDX(0)] = c_mk(0.5f * (Y0 + YM), 0.5f * (Y0 - YM)); }
            else {
                const int p2 = (int)(fft_brev((unsigned)(M - kk)) >> (32 - LOGM));
                const c32 A = buf[FFT_PIDX(p1)], B = buf[FFT_PIDX(p2)];
                const c32 E = c_mk(0.5f * (A.x + B.x), 0.5f * (A.y - B.y)), O = c_mk(0.5f * (A.y + B.y), -0.5f * (A.x - B.x));
                const c32 wk = c_twid((float)kk * (0.5f / M)), Tt = c_mul(wk, O);
                const c32 Yk = c_scale(c_mul(c_add(E, Tt), K1[j]), invM), Ymk = c_scale(c_mul(c_conj(c_sub(E, Tt)), K2[j]), invM);
                const c32 Ep = c_scale(c_add(Yk, c_conj(Ymk)), 0.5f), Op = c_scale(c_mulc(c_sub(Yk, c_conj(Ymk)), wk), 0.5f);
                buf[FFT_PIDX(p1)] = c_mk(Ep.x - Op.y, Ep.y + Op.x); buf[FFT_PIDX(p2)] = c_mk(Ep.x + Op.y, Op.x - Ep.y);
            }
        }
        if (more) {
#pragma unroll
            for (int j = 0; j < CH; ++j) { K1[j] = N1[j]; K2[j] = N2[j]; } }
    }
    for (int sb = FFT_TID; sb < NB; sb += FFT_NTHR) {
        FFT_LDS c32* buf = buf0 + sb * PADM; const c32 Zh = buf[FFT_PIDX(1)], Y = c_scale(c_mul(c_conj(Zh), KfP[M]), invM); buf[FFT_PIDX(1)] = c_conj(Y); }
}
FFT_DEV c32 conv_pair(const float* __restrict__ p, int m, int L, float w0, float w1, float w2, float b) {
    const float a = m > 0 ? p[2 * m - 1] : 0.f, x0 = p[2 * m], x1 = p[2 * m + 1], c = 2 * m + 2 < L ? p[2 * m + 2] : 0.f;
    return c_mk(w0 * a + w1 * x0 + w2 * x1 + b, w0 * x0 + w1 * x1 + w2 * c + b);
}
template <int LOGM, int NB, int CH> FFT_DEV void hyena_unit(FFT_LDS c32* buf, const float* __restrict__ pz, const float* __restrict__ pg0, const float* __restrict__ pg1, const float* cw, const c32* __restrict__ Kf0, const c32* __restrict__ Kf1, float bias0, float bias1, float* __restrict__ zout) {
    constexpr int M = 1 << LOGM, H = M / 2, L = M, PADM = FFT_PIDX(M); const float invM = 1.0f / M;
    constexpr int RD = NB * H / (CH * FFT_NTHR);
    static_assert(RD * CH * FFT_NTHR == NB * H, "whole rounds");
    c32 zk[RD][CH];
#pragma unroll
    for (int rd = 0; rd < RD; ++rd) { const int i0 = FFT_TID + rd * CH * FFT_NTHR;
#pragma unroll
        for (int j = 0; j < CH; ++j) { const int i = i0 + j * FFT_NTHR, sq = i / H, m = i & (H - 1); zk[rd][j] = conv_pair(pz + sq * L, m, L, cw[0], cw[1], cw[2], cw[3]); }
#pragma unroll
        for (int j = 0; j < CH; ++j) { const int i = i0 + j * FFT_NTHR, sq = i / H, m = i & (H - 1); buf[sq * PADM + FFT_PIDX(m)] = zk[rd][j]; }
    }
#ifdef PROBE_FFT_EXTRA
    fft_fwd<LOGM, NB, false>(buf); fft_inv<LOGM, NB, false>(buf);
    for (int i = FFT_TID; i < NB * M; i += FFT_NTHR) { const int sq = i / M, m = i & (M - 1); buf[sq * PADM + FFT_PIDX(m)] = buf[sq * PADM + FFT_PIDX(m)] * invM; }
#endif
    c32 KA[CH], KB[CH];
    if constexpr (LOGM == 14) { fft_fwd<LOGM, NB, true>(buf); pw_fetch<LOGM, NB, CH>(Kf0, KA, KB, FFT_TID); }
    else { pw_fetch<LOGM, NB, CH>(Kf0, KA, KB, FFT_TID); fft_fwd<LOGM, NB, true>(buf); }
    conv_pointwise<LOGM, NB, CH>(buf, Kf0, invM, KA, KB); fft_inv<LOGM, NB, true>(buf);
#pragma unroll
    for (int rd = 0; rd < RD; ++rd) { const int i0 = FFT_TID + rd * CH * FFT_NTHR;
        c32 g[CH];
#pragma unroll
        for (int j = 0; j < CH; ++j) { const int i = i0 + j * FFT_NTHR, sq = i / H, m = i & (H - 1); g[j] = conv_pair(pg0 + sq * L, m, L, cw[4], cw[5], cw[6], cw[7]); }
#pragma unroll
        for (int j = 0; j < CH; ++j) { const int i = i0 + j * FFT_NTHR, sq = i / H, m = i & (H - 1); const c32 y = buf[sq * PADM + FFT_PIDX(m)]; const c32 v = g[j] * (y + zk[rd][j] * bias0);
            zk[rd][j] = v; buf[sq * PADM + FFT_PIDX(m)] = v; }
    }
    if constexpr (LOGM == 14) { fft_fwd<LOGM, NB, true>(buf); pw_fetch<LOGM, NB, CH>(Kf1, KA, KB, FFT_TID); }
    else { pw_fetch<LOGM, NB, CH>(Kf1, KA, KB, FFT_TID); fft_fwd<LOGM, NB, true>(buf); }
    conv_pointwise<LOGM, NB, CH>(buf, Kf1, invM, KA, KB); fft_inv<LOGM, NB, true>(buf);
#pragma unroll
    for (int rd = 0; rd < RD; ++rd) { const int i0 = FFT_TID + rd * CH * FFT_NTHR;
        c32 g[CH];
#pragma unroll
        for (int j = 0; j < CH; ++j) { const int i = i0 + j * FFT_NTHR, sq = i / H, m = i & (H - 1); g[j] = conv_pair(pg1 + sq * L, m, L, cw[8], cw[9], cw[10], cw[11]); }
#pragma unroll
        for (int j = 0; j < CH; ++j) { const int i = i0 + j * FFT_NTHR, sq = i / H, m = i & (H - 1); const c32 y = buf[sq * PADM + FFT_PIDX(m)]; *(c32*)(zout + sq * L + 2 * m) = g[j] * (y + zk[rd][j] * bias1); }
    }
    FFT_SYNC();
}
template <int LOGM, int CH> FFT_DEV void filter_unit(FFT_LDS c32* buf, const float* __restrict__ fwd, const float* __restrict__ bwd, int tstride, c32* __restrict__ KfP, float scale) {
    constexpr int M = 1 << LOGM, L = M, H = M / 2;
#define FFT_TIX(t) ((size_t)((t) >> 5) * tstride + ((t) & 31))
    for (int m0 = FFT_TID; m0 < H; m0 += CH * FFT_NTHR) {
        c32 a[CH], b[CH];
#pragma unroll
        for (int j = 0; j < CH; ++j) { const int m = m0 + j * FFT_NTHR; a[j] = *(const c32*)(fwd + FFT_TIX(2 * m));
            b[j] = m == 0 ? c_mk(0.f, bwd[FFT_TIX(L - 1)]) : c_mk(bwd[FFT_TIX(L - 2 * m)], bwd[FFT_TIX(L - 2 * m - 1)]); }
#pragma unroll
        for (int j = 0; j < CH; ++j) { const int m = m0 + j * FFT_NTHR; buf[FFT_PIDX(m)] = a[j]; buf[FFT_PIDX(m + H)] = b[j]; }
    }
#undef FFT_TIX
    fft_fwd<LOGM, 1, false>(buf); filt_untangle<LOGM>(buf, KfP, scale);
    FFT_SYNC();
}
template <int LOGM, int CH> FFT_DEV void filter_unit_pair(FFT_LDS c32* buf, const float* __restrict__ fwd0, const float* __restrict__ bwd0, const float* __restrict__ fwd1, const float* __restrict__ bwd1, int tstride,
                                                          c32* __restrict__ Kf0, c32* __restrict__ Kf1, float scale0, float scale1) {
    constexpr int M = 1 << LOGM, L = M, H = M / 2, PADM = FFT_PIDX(M);
#define FFT_TIX(t) ((size_t)((t) >> 5) * tstride + ((t) & 31))
    for (int m0 = FFT_TID; m0 < H; m0 += CH * FFT_NTHR) {
        c32 a0[CH], b0[CH], a1[CH], b1[CH];
#pragma unroll
        for (int j = 0; j < CH; ++j) { const int m = m0 + j * FFT_NTHR; a0[j] = *(const c32*)(fwd0 + FFT_TIX(2 * m)); a1[j] = *(const c32*)(fwd1 + FFT_TIX(2 * m));
            b0[j] = m == 0 ? c_mk(0.f, bwd0[FFT_TIX(L - 1)]) : c_mk(bwd0[FFT_TIX(L - 2 * m)], bwd0[FFT_TIX(L - 2 * m - 1)]);
            b1[j] = m == 0 ? c_mk(0.f, bwd1[FFT_TIX(L - 1)]) : c_mk(bwd1[FFT_TIX(L - 2 * m)], bwd1[FFT_TIX(L - 2 * m - 1)]); }
#pragma unroll
        for (int j = 0; j < CH; ++j) { const int m = m0 + j * FFT_NTHR; buf[FFT_PIDX(m)] = a0[j]; buf[FFT_PIDX(m + H)] = b0[j]; buf[PADM + FFT_PIDX(m)] = a1[j]; buf[PADM + FFT_PIDX(m + H)] = b1[j]; }
    }
#undef FFT_TIX
    fft_fwd<LOGM, 2, false>(buf); filt_untangle<LOGM>(buf, Kf0, scale0); filt_untangle<LOGM>(buf + PADM, Kf1, scale1);
    FFT_SYNC();
}

struct Frame {
    LAS unsigned char* lds;
    volatile LAS unsigned* MISC;
    gu32* ctl;
    int tid, lane, wave;
    int vcu, G, bid;
    float* out; unsigned char* ws;
};
struct Args { const float* in[30]; float* out; unsigned char* ws; int ph_lo, ph_hi; };
typedef GAS const float* cfp_t;
typedef __attribute__((address_space(4))) const cfp_t* KargTab;
struct InPtrs { KargTab t; __device__ __forceinline__ const float* operator[](int i) const { return (const float*)t[i]; } };
struct InTab { InPtrs in; };
enum { I_XP = 0, I_XS, I_CP, I_CS, I_ADAW, I_ADAB, I_N1G, I_N2G, I_WIN, I_HCW, I_HCB, I_FW1, I_FB1, I_FW2, I_FB2, I_FW3, I_FB3, I_FFREQ, I_FWOUT, I_HYB, I_QNG, I_KNG, I_SINK, I_WHY, I_WAT, I_WO, I_RW, I_EWG, I_EWU, I_EWD };

__device__ __forceinline__ int mod_row(int r) { return r < TP ? 0 : 1 + ((r - TP) >> 12); }
__device__ __forceinline__ void seq_bounds(int r, int& s0, int& len) { if (r < TP) { s0 = 0; len = TP; } else { s0 = TP + (((r - TP) >> 12) << 12); len = TS; } }
__device__ __forceinline__ const float* x_row(const Frame& F, const InTab& A, int l, int r) { return l == 0 ? (r < TP ? A.in[I_XP] + (size_t)r * D : A.in[I_XS] + (size_t)(r - TP) * D) : F.out + (size_t)r * D; }

__device__ __forceinline__ void transpose_item(const float* W, int N, int K, int k0, int n0, bf16* WT, int dst_row0, LAS float* scr, int lane) {
    float r_[32];
#pragma unroll
    for (int i = 0; i < 32; ++i) r_[i] = W[(size_t)(k0 + 2 * i + (lane >> 5)) * N + n0 + (lane & 31)];
#pragma unroll
    for (int i = 0; i < 32; ++i) scr[(2 * i + (lane >> 5)) * 33 + (lane & 31)] = r_[i];
    LDS_WAIT(); asm volatile("" ::: "memory");
    const int c = lane & 7;
#pragma unroll
    for (int j = 0; j < 4; ++j) { const int n = (lane >> 3) + 8 * j; const LAS float* s = scr + (8 * c) * 33 + n;
        v4u o; o.x = pk2(s[0 * 33], s[1 * 33]); o.y = pk2(s[2 * 33], s[3 * 33]); o.z = pk2(s[4 * 33], s[5 * 33]); o.w = pk2(s[6 * 33], s[7 * 33]);
        *(v4u*)(WT + (size_t)(dst_row0 + n) * K + k0 + 8 * c) = o; }
    LDS_WAIT(); asm volatile("" ::: "memory");
}
__device__ __forceinline__ void convert_small_weights(Frame& F, const InTab& A) {
    LAS float* scr = (LAS float*)(F.lds + RING_OFF + F.wave * 16384);
    const int gw = F.vcu * NWAVES + F.wave, NGW = F.G * NWAVES;
    constexpr int I_IN = (D / 64) * (INW / 32), I_P = (HYW / 64) * (D / 32), I_O = (D / 64) * (D / 32), I_F = FOUT / 32, PER_L = I_IN + 2 * I_P + I_O + I_F;
    for (int it = gw; it < DEPTH * PER_L; it += NGW) {
        const int l = it / PER_L; int r = it % PER_L;
        if (r < I_IN) { const int nb = INW / 32; transpose_item(A.in[I_WIN] + (size_t)l * D * INW, INW, D, 64 * (r / nb), 32 * (r % nb), (bf16*)(F.ws + WS_WIN) + (size_t)l * INW * D, 32 * (r % nb), scr, F.lane); continue; } r -= I_IN;
        if (r < I_P) { const int nb = D / 32; transpose_item(A.in[I_WHY] + (size_t)l * HYW * D, D, 2 * HYW, 64 * (r / nb), 32 * (r % nb), (bf16*)(F.ws + WS_WHY) + (size_t)l * D * 2 * HYW, 32 * (r % nb), scr, F.lane); continue; } r -= I_P;
        if (r < I_P) { const int nb = D / 32; transpose_item(A.in[I_WAT] + (size_t)l * ATW * D, D, 2 * HYW, 64 * (r / nb), 32 * (r % nb), (bf16*)(F.ws + WS_WHY) + (size_t)l * D * 2 * HYW + HYW, 32 * (r % nb), scr, F.lane); continue; } r -= I_P;
        if (r < I_O) { const int nb = D / 32; transpose_item(A.in[I_WO] + (size_t)l * D * D, D, D, 64 * (r / nb), 32 * (r % nb), (bf16*)(F.ws + WS_WO) + (size_t)l * D * D, 32 * (r % nb), scr, F.lane); continue; } r -= I_O;
        transpose_item(A.in[I_FWOUT] + (size_t)l * FH * FOUT, FOUT, FH, 0, 32 * r, (bf16*)(F.ws + WS_WOUT) + (size_t)l * FOUT * FH, 32 * r, scr, F.lane);
    }
}
#ifndef CV_TAIL_STRIDE
#define CV_TAIL_STRIDE 2
#endif
#ifndef CV_HEAD_ITEMS
#define CV_HEAD_ITEMS 16
#endif
struct CvItem { const float* src; unsigned char* dst; int N, K; float sc; };
__device__ __forceinline__ CvItem cv_moe_item(const Frame& F, const InTab& A, int l, int it) {
    constexpr int I_G = (D / 64) * (FF / 32), I_D = (FF / 64) * (D / 32), PER_E = 2 * I_G + I_D;
    const int e = it / PER_E; int r = it % PER_E; CvItem c;
    if (r < 2 * I_G) { const int up = r >= I_G; if (up) r -= I_G; const int nb = FF / 32, k0 = 64 * (r / nb), n0 = 32 * (r % nb);
        c.src = A.in[up ? I_EWU : I_EWG] + ((size_t)l * NE + e) * D * FF + (size_t)k0 * FF + n0; c.N = FF; c.K = KB_UP; c.sc = 64.f;
        c.dst = (unsigned char*)(F.ws + WS_WGU) + ((size_t)e * (2 * FF) + (256 * (n0 >> 7) + (up ? 128 : 0) + (n0 & 127))) * KB_UP + (k0 >> 1); }
    else { r -= 2 * I_G; const int nb = D / 32, k0 = 64 * (r / nb), n0 = 32 * (r % nb);
        c.src = A.in[I_EWD] + ((size_t)l * NE + e) * FF * D + (size_t)k0 * D + n0; c.N = D; c.K = KB_DN; c.sc = 128.f;
        c.dst = (unsigned char*)(F.ws + WS_WD) + ((size_t)e * D + n0) * KB_DN + (k0 >> 1); }
    return c;
}
template <int VAR = 0  >
__device__ __forceinline__ void convert_moe_weights(Frame& F, const InTab& A, int l, int part = 0) {
    constexpr int TOTAL0 = NE * (2 * (D / 64) * (FF / 32) + (FF / 64) * (D / 32)), TOPK_WG = NGRP * NE;
    const int n1 = F.G > TOPK_WG ? (F.G - TOPK_WG) * NWAVES * CV_HEAD_ITEMS : 0;
    if (part == 1 && F.vcu < TOPK_WG) return;
    if (part == 2 && F.vcu % CV_TAIL_STRIDE != 0) return;
    const int lane = F.lane, g = lane >> 3, c = lane & 7, NGW = (part == 1 ? F.G - TOPK_WG : part == 2 ? (F.G + CV_TAIL_STRIDE - 1) / CV_TAIL_STRIDE : F.G) * NWAVES;
    const int gw = (part == 1 ? (F.vcu - TOPK_WG) * NWAVES + F.wave : part == 2 ? n1 + (F.vcu / CV_TAIL_STRIDE) * NWAVES + F.wave : F.vcu * NWAVES + F.wave), TOTAL = part == 1 ? n1 : TOTAL0;
    if (part != 1) for (int i = ((part == 2 ? F.vcu / CV_TAIL_STRIDE : F.vcu) * NWAVES + F.wave) * 64 + lane; i < NE * D * ((KB_DN - FF / 2) / 16); i += NGW * 64) { const int row = i >> 3, ch = i & 7;
        *(v4u*)((unsigned char*)(F.ws + WS_WD) + (size_t)row * KB_DN + FF / 2 + 16 * ch) = (v4u){0u, 0u, 0u, 0u}; }
    if constexpr (VAR == 2) {
        f32x4 acc = {0.f, 0.f, 0.f, 0.f};
        for (int m = 0; m < 3; ++m) { const float* base = A.in[m == 0 ? I_EWG : m == 1 ? I_EWU : I_EWD] + (size_t)l * NE * D * FF; const int nch = NE * D * FF / 2048;
            for (int ch = gw; ch < nch; ch += NGW) { const float* p = base + (size_t)ch * 2048 + 4 * lane; f32x4 r[8];
#pragma unroll
                for (int i = 0; i < 8; ++i) r[i] = *(const f32x4*)(p + 256 * i);
#pragma unroll
                for (int i = 0; i < 8; ++i) acc += r[i]; } }
        if (acc[0] + acc[1] + acc[2] + acc[3] == 1.2345e-30f) *(float*)(F.ws + WS_WD) = 0.f;
        return;
    }
    f32x4 ra[8], rb[8], rc[8]; CvItem cur, nx1, nx2;
#define CV_ISSUE(R, ITEM, IT) do { ITEM = cv_moe_item(F, A, l, (IT)); const float* p_ = ITEM.src + (size_t)(8 * g) * ITEM.N + 4 * c; \
        _Pragma("unroll") for (int i = 0; i < 8; ++i) R[i] = *(const f32x4*)(p_ + (size_t)i * ITEM.N); } while (0)
    if (gw < TOTAL) CV_ISSUE(ra, cur, gw);
    if (gw + NGW < TOTAL) CV_ISSUE(rb, nx1, gw + NGW);
    for (int it = gw; it < TOTAL; it += NGW) {
        const bool more1 = it + NGW < TOTAL, more2 = it + 2 * NGW < TOTAL;
        if (more2) CV_ISSUE(rc, nx2, it + 2 * NGW);
        const float sc = cur.sc;
#pragma unroll
        for (int j = 0; j < 4; ++j) { unsigned w; PG8_FP4_PACK8(w, ra[0][j] * sc, ra[1][j] * sc, ra[2][j] * sc, ra[3][j] * sc, ra[4][j] * sc, ra[5][j] * sc, ra[6][j] * sc, ra[7][j] * sc);
            if (VAR == 0 || w == 0x12345678u) *(unsigned*)(cur.dst + (size_t)(4 * c + j) * cur.K + 4 * g) = w; }
        if (more1) { cur = nx1; nx1 = nx2;
#pragma unroll
            for (int i = 0; i < 8; ++i) { ra[i] = rb[i]; rb[i] = rc[i]; } }
    }
#undef CV_ISSUE
}
__device__ __forceinline__ void adaln_mod(Frame& F, const InTab& A) {
    LAS float* sc = (LAS float*)(F.lds + RING_OFF);
    LAS float* red = (LAS float*)(F.lds + RING_OFF + 32768);
    for (int i = F.tid; i < NMOD * D; i += NWAVES * 64) { const int b = i / D, k = i % D; const float c = b == 0 ? A.in[I_CP][k] : A.in[I_CS][(b - 1) * D + k]; sc[i] = siluf_acc(c); }
    __syncthreads();
    float* mod = (float*)(F.ws + WS_MOD);
    for (int u = F.vcu; u < DEPTH * 96; u += F.G) {
        const int l = u / 96, n = (u % 96) * 64 + F.lane;
        const float* W = A.in[I_ADAW] + (size_t)l * D * 6 * D + n;
        float a[NMOD] = {0.f, 0.f, 0.f, 0.f, 0.f};
#pragma unroll 1
        for (int k0 = 128 * F.wave; k0 < 128 * F.wave + 128; k0 += 32) { float wv[32];
#pragma unroll
            for (int j = 0; j < 32; ++j) wv[j] = W[(size_t)(k0 + j) * 6 * D];
#pragma unroll
            for (int j = 0; j < 32; ++j) {
#pragma unroll
                for (int b = 0; b < NMOD; ++b) a[b] += sc[b * D + k0 + j] * wv[j]; } }
#pragma unroll
        for (int b = 0; b < NMOD; ++b) red[(F.wave * NMOD + b) * 64 + F.lane] = a[b];
        __syncthreads();
        if (F.tid < NMOD * 64) { const int b = F.tid >> 6, ln = F.tid & 63; float s = A.in[I_ADAB][l * 6 * D + (u % 96) * 64 + ln];
#pragma unroll
            for (int w = 0; w < NWAVES; ++w) s += red[(w * NMOD + b) * 64 + ln];
            mod[((size_t)l * NMOD + b) * 6 * D + (u % 96) * 64 + ln] = s; }
        __syncthreads();
    }
}
__device__ __forceinline__ void norm_mod_rows(Frame& F, const InTab& A, int l, const float* g, int sh_off, int sc_off) {
    const int gw = F.vcu * NWAVES + F.wave, NGW = F.G * NWAVES;
    const float* mod = (const float*)(F.ws + WS_MOD) + (size_t)l * NMOD * 6 * D;
    bf16* H = (bf16*)(F.ws + WS_H);
    for (int blkid = gw; blkid < T / 16; blkid += NGW) {
        const int mb = blkid * 16; const float* mr = mod + (size_t)mod_row(mb) * 6 * D;
        f32x4 gsc[4], shv[4], xn[4];
#pragma unroll
        for (int j = 0; j < 4; ++j) { const int c = 4 * F.lane + 256 * j; gsc[j] = *(const f32x4*)(g + c) * (*(const f32x4*)(mr + sc_off + c) + 1.0f); shv[j] = *(const f32x4*)(mr + sh_off + c); }
        { const f32x4* xr = (const f32x4*)x_row(F, A, l, mb) + F.lane;
#pragma unroll
          for (int j = 0; j < 4; ++j) xn[j] = xr[64 * j]; }
#pragma unroll 1
        for (int m = mb; m < mb + 16; ++m) {
            f32x4 v[4]; float ss = 0.f;
#pragma unroll
            for (int j = 0; j < 4; ++j) v[j] = xn[j];
            if (m + 1 < mb + 16) { const f32x4* xr = (const f32x4*)x_row(F, A, l, m + 1) + F.lane;
#pragma unroll
                for (int j = 0; j < 4; ++j) xn[j] = xr[64 * j]; }
#pragma unroll
            for (int j = 0; j < 4; ++j) ss += (v[j].x * v[j].x + v[j].y * v[j].y) + (v[j].z * v[j].z + v[j].w * v[j].w);
            const float rstd = 1.0f / sqrtf(wave_sum(ss) * (1.f / D) + EPS);
            unsigned long long* o8 = (unsigned long long*)(H + (size_t)m * D) + F.lane;
#pragma unroll
            for (int j = 0; j < 4; ++j) { const f32x4 o = v[j] * rstd * gsc[j] + shv[j];
                o8[64 * j] = (unsigned long long)pk2(o.x, o.y) | ((unsigned long long)pk2(o.z, o.w) << 32); }
        }
    }
}

__device__ __forceinline__ void filter_time_tiles(Frame& F, const InTab& A, int l) {
    LAS bf16* h3s = (LAS bf16*)(F.lds + RING_OFF);
    const float* w1 = A.in[I_FW1] + (size_t)l * FEMB * FH; const float* b1 = A.in[I_FB1] + l * FH;
    const float* w2 = A.in[I_FW2] + (size_t)l * FH * FH;   const float* b2 = A.in[I_FB2] + l * FH;
    const float* w3 = A.in[I_FW3] + (size_t)l * FH * FH;   const float* b3 = A.in[I_FB3] + l * FH;
    const bf16* woT = (const bf16*)(F.ws + WS_WOUT) + (size_t)l * FOUT * FH;
    const float fr = A.in[I_FFREQ][l * FH + F.lane] * 0.15915494309189535f;
    const float bb1 = b1[F.lane], bb2 = b2[F.lane], bb3 = b3[F.lane];
    const int lane = F.lane;
    LAS float* wl1 = (LAS float*)(F.lds + RING_OFF + 16384); LAS float* wl2 = wl1 + FEMB * FH; LAS float* wl3 = wl2 + FH * FH;
    {
        float t1[5], t2[8], t3[8];
#pragma unroll
        for (int q = 0; q < 5; ++q) { const int i = F.tid + q * NWAVES * 64; t1[q] = i < FEMB * FH ? w1[i] : 0.f; }
#pragma unroll
        for (int q = 0; q < 8; ++q) { const int i = F.tid + q * NWAVES * 64; t2[q] = w2[i]; t3[q] = w3[i]; }
#pragma unroll
        for (int q = 0; q < 5; ++q) { const int i = F.tid + q * NWAVES * 64; if (i < FEMB * FH) wl1[i] = t1[q]; }
#pragma unroll
        for (int q = 0; q < 8; ++q) { const int i = F.tid + q * NWAVES * 64; wl2[i] = t2[q]; wl3[i] = t3[q]; }
    }
    __syncthreads();
    LAS int* tsh = (LAS int*)(F.lds + SCR_OFF);
    if (F.tid == 0) *tsh = (int)__hip_atomic_fetch_add(F.ctl + 16 + l, 1u, __ATOMIC_RELAXED, __HIP_MEMORY_SCOPE_AGENT);
    __syncthreads();
    for (;;) {
        const int tile = __builtin_amdgcn_readfirstlane(*tsh);
        if (tile >= 640) break;
        int nxt_tile = 0;
        if (F.tid == 0) nxt_tile = (int)__hip_atomic_fetch_add(F.ctl + 16 + l, 1u, __ATOMIC_RELAXED, __HIP_MEMORY_SCOPE_AGENT);
        const int set = tile >= 512, tl0 = set ? tile - 512 : tile, L = set ? TS : TP, j0 = 32 * tl0;
        float* hraw = (float*)(F.ws + (set ? WS_HRAW_S : WS_HRAW_P));
        float* psum = (float*)(F.ws + WS_PSUM) + (set ? (size_t)512 * FOUT : 0) + (size_t)tl0 * FOUT;
        const float invL = 1.0f / (float)L, invLm1 = 1.0f / (float)(L - 1);
        {
            float zv[4], h[4], pre[4];
#pragma unroll
            for (int i = 0; i < 4; ++i) { const int j = j0 + F.wave + 8 * i; float z = 0.f;
                if (lane == 0) z = (float)j * invLm1;
                else if (lane <= 32) { const int b = (lane - 1) & 15; const float fb = 1e-4f + (float)b * ((15.0f - 1e-4f) / 15.0f); const float rev = fb * (float)j * invL; z = lane <= 16 ? cos_rev(rev) : -sin_rev(rev); }
                zv[i] = z; pre[i] = bb1; }
#define FT_LAYER(WL, NK, SRC) do { _Pragma("unroll 1") for (int k0 = 0; k0 < (NK); k0 += 16) { float w_[16]; \
                _Pragma("unroll") for (int j = 0; j < 16; ++j) w_[j] = (k0 + j < (NK)) ? (WL)[(k0 + j) * FH + lane] : 0.f; \
                _Pragma("unroll") for (int j = 0; j < 16; ++j) { _Pragma("unroll") for (int i = 0; i < 4; ++i) pre[i] += rdlane(SRC[i], (k0 + j) & 63) * w_[j]; } } } while (0)
            FT_LAYER(wl1, FEMB, zv);
#pragma unroll
            for (int i = 0; i < 4; ++i) { h[i] = sin_rev(fr * pre[i]); pre[i] = bb2; }
            FT_LAYER(wl2, FH, h);
#pragma unroll
            for (int i = 0; i < 4; ++i) { h[i] = sin_rev(fr * pre[i]); pre[i] = bb3; }
            FT_LAYER(wl3, FH, h);
#undef FT_LAYER
#pragma unroll
            for (int i = 0; i < 4; ++i) h3s[(F.wave + 8 * i) * 72 + lane] = (bf16)f2bf(sin_rev(fr * pre[i]));
        }
        __syncthreads();
        {
            const int hi = lane >> 5, lr = lane & 31;
            bf16x8 af[4], bcur[4], bnxt[4];
#pragma unroll
            for (int s = 0; s < 4; ++s) { af[s] = *(const LAS bf16x8*)(h3s + lr * 72 + 16 * s + 8 * hi); bcur[s] = *(const bf16x8*)(woT + (size_t)((F.wave * 8) * 32 + lr) * FH + 16 * s + 8 * hi); }
#pragma unroll 1
            for (int r = 0; r < 8; ++r) {
                const int n = (F.wave * 8 + r) * 32 + lr;
                if (r < 7) {
#pragma unroll
                    for (int s = 0; s < 4; ++s) bnxt[s] = *(const bf16x8*)(woT + (size_t)(n + 32) * FH + 16 * s + 8 * hi); }
                f32x16 acc = {0.f, 0.f, 0.f, 0.f, 0.f, 0.f, 0.f, 0.f, 0.f, 0.f, 0.f, 0.f, 0.f, 0.f, 0.f, 0.f};
#pragma unroll
                for (int s = 0; s < 4; ++s) acc = __builtin_amdgcn_mfma_f32_32x32x16_bf16(af[s], bcur[s], acc, 0, 0, 0);
                const int dir = n >> 10, c = n & 511;
                const float delta = 3.070113457325394f + (float)c * ((15.350567286626971f - 3.070113457325394f) / 511.0f);
                float ssq = 0.f;
                LAS float* tr = (LAS float*)(F.lds + RING_OFF + 65536 + F.wave * 4608);
#pragma unroll
                for (int g = 0; g < 4; ++g) { f32x4 v;
#pragma unroll
                    for (int e = 0; e < 4; ++e) { const int j = j0 + 8 * g + 4 * hi + e; const float val = acc[4 * g + e] * fast_exp(-(float)j * invLm1 * delta); v[e] = val; if (!(dir == 1 && j == 0)) ssq += val * val; }
                    *(LAS f32x4*)(tr + lr * 36 + 8 * g + 4 * hi) = v; }
                LDS_WAIT(); asm volatile("" ::: "memory");
                {
                    f32x4 w[4];
#pragma unroll
                    for (int q = 0; q < 4; ++q) w[q] = *(const LAS f32x4*)(tr + (8 * q + (lane >> 3)) * 36 + 4 * (lane & 7));
                    LDS_WAIT(); asm volatile("" ::: "memory");
#pragma unroll
                    for (int q = 0; q < 4; ++q) *(f32x4*)(hraw + ((size_t)tl0 * FOUT + (n - lr) + 8 * q + (lane >> 3)) * 32 + 4 * (lane & 7)) = w[q];
                }
                ssq += __shfl_xor(ssq, 32);
                if (lane < 32) psum[n] = ssq;
#pragma unroll
                for (int s = 0; s < 4; ++s) bcur[s] = bnxt[s];
            }
        }
        __syncthreads();
        if (F.tid == 0) *tsh = nxt_tile;
        __syncthreads();
    }
}

__device__ __forceinline__ void filter_fft_units(Frame& F) {
    LAS c32* buf = (LAS c32*)(F.lds + RING_OFF);
    LAS float* red = (LAS float*)(F.lds + SCR_OFF);
    const bool deal = F.G == 256, heavy = F.bid < 128;
    if (deal) {
        const int nbig = heavy ? 3 : 5;
        float part[9];
#pragma unroll
        for (int j = 0; j < 9; ++j) { float s = 0.f;
            if (j < 5) { if (j < nbig) { const int oc = (heavy ? F.bid + 128 * j : 384 + (F.bid - 128) + 128 * j); const float* psum = (const float*)(F.ws + WS_PSUM);
                    if (F.tid < 512) s = psum[(size_t)F.tid * FOUT + oc] + psum[(size_t)F.tid * FOUT + 1024 + oc]; } }
            else { const int oc = F.bid + 256 * (j - 5); const float* psum = (const float*)(F.ws + WS_PSUM) + (size_t)512 * FOUT;
                if (F.tid < 128) s = psum[(size_t)F.tid * FOUT + oc] + psum[(size_t)F.tid * FOUT + 1024 + oc]; }
            part[j] = s; }
#pragma unroll
        for (int j = 0; j < 9; ++j) { const float t = wave_sum(part[j]); if (F.lane == 0) red[j * NWAVES + F.wave] = t; }
        __syncthreads();
        auto scale_of = [&](int j) { float tot = 0.f;
#pragma unroll
            for (int w = 0; w < NWAVES; ++w) tot += red[j * NWAVES + w];
            return 1.0f / sqrtf(tot + EPS); };
#pragma unroll 1
        for (int j = 0; j < nbig; ++j) { const int oc = (heavy ? F.bid + 128 * j : 384 + (F.bid - 128) + 128 * j); const float* hr = (const float*)(F.ws + WS_HRAW_P);
            filter_unit<14, 16>(buf, hr + (size_t)oc * 32, hr + (size_t)(1024 + oc) * 32, FOUT * 32, (c32*)(F.ws + WS_KF_P) + (size_t)oc * KFS_P, scale_of(j)); }
#pragma unroll 1
        for (int j = 0; j < 2; ++j) { const int oc0 = F.bid + 512 * j, oc1 = oc0 + 256; const float* hr = (const float*)(F.ws + WS_HRAW_S);
            filter_unit_pair<12, 4>(buf, hr + (size_t)oc0 * 32, hr + (size_t)(1024 + oc0) * 32, hr + (size_t)oc1 * 32, hr + (size_t)(1024 + oc1) * 32, FOUT * 32,
                                    (c32*)(F.ws + WS_KF_S) + (size_t)oc0 * KFS_S, (c32*)(F.ws + WS_KF_S) + (size_t)oc1 * KFS_S, scale_of(5 + 2 * j), scale_of(6 + 2 * j)); }
        return;
    }
    for (int k = 0; k < (2048 + F.G - 1) / F.G; ++k) {
        const int u = F.vcu + k * F.G; if (u >= 2048) break;
        const int set = u >= 1024, oc = u & 1023, ntile = set ? 128 : 512;
        const float* psum = (const float*)(F.ws + WS_PSUM) + (set ? (size_t)512 * FOUT : 0);
        float s = 0.f;
        if (F.tid < ntile) s = psum[(size_t)F.tid * FOUT + oc] + psum[(size_t)F.tid * FOUT + 1024 + oc];
        s = wave_sum(s);
        if (F.lane == 0) red[F.wave] = s;
        __syncthreads();
        float tot = 0.f;
#pragma unroll
        for (int w = 0; w < NWAVES; ++w) tot += red[w];
        const float scale = 1.0f / sqrtf(tot + EPS);
        if (set == 0) { const float* hr = (const float*)(F.ws + WS_HRAW_P); filter_unit<14, 16>(buf, hr + (size_t)oc * 32, hr + (size_t)(1024 + oc) * 32, FOUT * 32, (c32*)(F.ws + WS_KF_P) + (size_t)oc * KFS_P, scale); }
        else          { const float* hr = (const float*)(F.ws + WS_HRAW_S); filter_unit<12, 4>(buf, hr + (size_t)oc * 32, hr + (size_t)(1024 + oc) * 32, FOUT * 32, (c32*)(F.ws + WS_KF_S) + (size_t)oc * KFS_S, scale); }
    }
}
__device__ __forceinline__ void shortconv_transpose(Frame& F, const InTab& A, int l) {
    LAS float* scr = (LAS float*)(F.lds + RING_OFF + F.wave * 16384);
    const int gw = F.vcu * NWAVES + F.wave, NGW = F.G * NWAVES, lane = F.lane;
    const bf16* P = (const bf16*)(F.ws + WS_PROJ); float* HYT = (float*)(F.ws + WS_HYT);
    const float* cw = A.in[I_HCW] + (size_t)l * 3 * NHY; const float* cb = A.in[I_HCB] + (size_t)l * NHY;
    for (int it = gw; it < (T / 64) * (NHY / 32); it += NGW) {
        const int rt = it / (NHY / 32), ct = it % (NHY / 32), r0 = 64 * rt, c0 = 32 * ct;
        int s0, len; seq_bounds(r0, s0, len);
        for (int i = 0; i < 33; ++i) { const int rr = 2 * i + (lane >> 5), r = r0 - 1 + rr;
            float v = 0.f; if (r >= s0 && r < s0 + len) v = bf2f(P[(size_t)r * INW + c0 + (lane & 31)]);
            scr[rr * 33 + (lane & 31)] = v; }
        LDS_WAIT(); asm volatile("" ::: "memory");
        for (int cc = 0; cc < 32; ++cc) { const int c = c0 + cc; const float w0 = cw[c], w1 = cw[NHY + c], w2 = cw[2 * NHY + c], b = cb[c];
            const float v = w0 * scr[lane * 33 + cc] + w1 * scr[(lane + 1) * 33 + cc] + w2 * scr[(lane + 2) * 33 + cc] + b;
            HYT[(size_t)c * T + r0 + lane] = v; }
        LDS_WAIT(); asm volatile("" ::: "memory");
    }
}
__device__ const double ROPE_INV_REV[32] = {0.15915494309189535, 0.11934937021124886, 0.08949940160889101, 0.06711508300522726, 0.050329212104487035, 0.03774158471741977, 0.0283021958306234, 0.02122365276477766,
    0.015915494309189534, 0.011934937021124886, 0.008949940160889102, 0.006711508300522725, 0.005032921210448704, 0.003774158471741977, 0.00283021958306234, 0.0021223652764777662,
    0.0015915494309189536, 0.0011934937021124885, 0.0008949940160889102, 0.0006711508300522726, 0.0005032921210448703, 0.00037741584717419774, 0.00028302195830623395, 0.0002122365276477766,
    0.00015915494309189535, 0.00011934937021124886, 8.949940160889102e-05, 6.711508300522725e-05, 5.0329212104487035e-05, 3.774158471741978e-05, 2.8302195830623396e-05, 2.122365276477766e-05};
__device__ __forceinline__ void qk_norm_rope(Frame& F, const InTab& A, int l) {
    const int gw = F.vcu * NWAVES + F.wave, NGW = F.G * NWAVES, lane = F.lane;
    const bf16* P = (const bf16*)(F.ws + WS_PROJ); bf16* QN = (bf16*)(F.ws + WS_QN); bf16* KN = (bf16*)(F.ws + WS_KN);
    const float gq = A.in[I_QNG][l * HD + lane], gk = A.in[I_KNG][l * HD + lane];
    const double invr = ROPE_INV_REV[lane & 31];
    for (int m = gw; m < T; m += NGW) {
        int s0, len; seq_bounds(m, s0, len);
        double rv = (double)(m - s0) * invr; rv -= floor(rv);
        const float rf = (float)rv, cs = cos_rev(rf), sn = sin_rev(rf);
        for (int h = 0; h < NH + NKV; ++h) {
            const float x = bf2f(P[(size_t)m * INW + COL_Q + h * HD + lane]);
            const float ss = wave_sum(x * x);
            float y = x * (1.0f / sqrtf(ss * (1.f / HD) + EPS)) * (h < NH ? gq : gk);
            const float p = __shfl_xor(y, 32);
            float o = lane < 32 ? y * cs - p * sn : y * cs + p * sn;
            if (h < NH) QN[(size_t)m * ATW + h * HD + lane] = (bf16)f2bf(o * 0.125f); else KN[(size_t)m * KVW + (h - NH) * HD + lane] = (bf16)f2bf(o);
        }
    }
}
__device__ __forceinline__ void hyena_units(Frame& F, const InTab& A, int l) {
    LAS c32* buf = (LAS c32*)(F.lds + RING_OFF);
    LAS float* cws = (LAS float*)(F.lds + SCR_OFF);
    const float* HYT = (const float*)(F.ws + WS_HYT); float* Z2T = (float*)(F.ws + WS_Z2T);
    const float* hb = A.in[I_HYB] + (size_t)l * 2 * HYW;
    const float* cw = A.in[I_HCW] + (size_t)l * 3 * NHY; const float* cb = A.in[I_HCB] + (size_t)l * NHY;
    for (int u = F.vcu; u < 2 * HYW; u += F.G) {
        const int c = u & 511;
        if (F.tid < 12) { const int j = F.tid >> 2, k = F.tid & 3; cws[F.tid] = k < 3 ? cw[k * NHY + j * HYW + c] : cb[j * HYW + c]; }
        __syncthreads();
        float w[12];
#pragma unroll
        for (int i = 0; i < 12; ++i) w[i] = cws[i];
        if (u < HYW) { const size_t o = (size_t)c * TPAD;
            hyena_unit<14, 1, 8>(buf, HYT + o, HYT + (size_t)HYW * TPAD + o, HYT + (size_t)2 * HYW * TPAD + o, w, (const c32*)(F.ws + WS_KF_P) + (size_t)c * KFS_P, (const c32*)(F.ws + WS_KF_P) + (size_t)(512 + c) * KFS_P, hb[c], hb[HYW + c], Z2T + o); }
        else { const size_t o = (size_t)c * TPAD + TP;
            hyena_unit<12, NSB, 8>(buf, HYT + o, HYT + (size_t)HYW * TPAD + o, HYT + (size_t)2 * HYW * TPAD + o, w, (const c32*)(F.ws + WS_KF_S) + (size_t)c * KFS_S, (const c32*)(F.ws + WS_KF_S) + (size_t)(512 + c) * KFS_S, hb[c], hb[HYW + c], Z2T + o); }
    }
}
__device__ __forceinline__ void z2_transpose(Frame& F) {
    LAS float* scr = (LAS float*)(F.lds + RING_OFF + F.wave * 16896);
    const int gw = F.vcu * NWAVES + F.wave, NGW = F.G * NWAVES, lane = F.lane;
    const float* Z2T = (const float*)(F.ws + WS_Z2T); bf16* Z2 = (bf16*)(F.ws + WS_Z2AT);
    for (int it = gw; it < (T / 64) * (HYW / 64); it += NGW) {
        const int rt = it / (HYW / 64), ct = it % (HYW / 64), r0 = 64 * rt, c0 = 64 * ct;
#pragma unroll
        for (int h = 0; h < 2; ++h) { float r_[32];
#pragma unroll
            for (int cc = 0; cc < 32; ++cc) r_[cc] = Z2T[(size_t)(c0 + 32 * h + cc) * TPAD + r0 + lane];
#pragma unroll
            for (int cc = 0; cc < 32; ++cc) scr[(32 * h + cc) * 65 + lane] = r_[cc]; }
        LDS_WAIT(); asm volatile("" ::: "memory");
#pragma unroll
        for (int i = 0; i < 8; ++i) { const int rr = 8 * i + (lane >> 3), cb = 8 * (lane & 7); float v[8];
#pragma unroll
            for (int e = 0; e < 8; ++e) v[e] = scr[(cb + e) * 65 + rr];
            v4u w; w.x = pk2(v[0], v[1]); w.y = pk2(v[2], v[3]); w.z = pk2(v[4], v[5]); w.w = pk2(v[6], v[7]);
            *(v4u*)(Z2 + (size_t)(r0 + rr) * ZAP + c0 + cb) = w; }
        LDS_WAIT(); asm volatile("" ::: "memory");
    }
}
__device__ __forceinline__ void attention_simple(Frame& F, const InTab& A, int l) {
    LAS float* qs = (LAS float*)(F.lds + RING_OFF + F.wave * 4096);
    LAS float* ps = qs + 64;
    const int gw = F.vcu * NWAVES + F.wave, NGW = F.G * NWAVES, lane = F.lane;
    const bf16* P = (const bf16*)(F.ws + WS_PROJ); const bf16* QN = (const bf16*)(F.ws + WS_QN); const bf16* KN = (const bf16*)(F.ws + WS_KN); bf16* AT = (bf16*)(F.ws + WS_Z2AT) + HYW;
    for (int it = gw; it < T * NH; it += NGW) {
        const int m = it >> 3, h = it & 7, kv = h >> 2;
        int s0, len; seq_bounds(m, s0, len);
        const int jlo = max(m - WIN, s0), jhi = min(m + WIN, s0 + len - 1), nk = jhi - jlo + 1;
        qs[lane] = bf2f(QN[(size_t)m * ATW + h * HD + lane]);
        LDS_WAIT(); asm volatile("" ::: "memory");
        const float sink = A.in[I_SINK][l * NH + h];
        float sc[5]; float mx = sink;
#pragma unroll
        for (int r = 0; r < 5; ++r) { const int jj = lane + 64 * r; float s = -1e30f;
            if (jj < nk) { const v4u* kp = (const v4u*)(KN + (size_t)(jlo + jj) * KVW + kv * HD); float a = 0.f;
#pragma unroll
                for (int c = 0; c < 8; ++c) { const v4u w = kp[c]; const LAS float* q = qs + 8 * c;
                    a += q[0] * bflo(w.x) + q[1] * bfhi(w.x) + q[2] * bflo(w.y) + q[3] * bfhi(w.y) + q[4] * bflo(w.z) + q[5] * bfhi(w.z) + q[6] * bflo(w.w) + q[7] * bfhi(w.w); }
                s = a; }
            sc[r] = s; mx = fmaxf(mx, s); }
        mx = wave_max(mx);
        float den = 0.f;
#pragma unroll
        for (int r = 0; r < 5; ++r) { const int jj = lane + 64 * r; const float p = jj < nk ? fast_exp(sc[r] - mx) : 0.f; den += p; ps[jj] = p; }
        den = wave_sum(den) + fast_exp(sink - mx);
        LDS_WAIT(); asm volatile("" ::: "memory");
        float o = 0.f;
        const bf16* vp = P + (size_t)jlo * INW + COL_V + kv * HD + lane;
        for (int j = 0; j < nk; ++j) o += ps[j] * bf2f(vp[(size_t)j * INW]);
        AT[(size_t)m * ZAP + h * HD + lane] = (bf16)f2bf(o / den);
        LDS_WAIT(); asm volatile("" ::: "memory");
    }
}
__device__ __forceinline__ void merge_gates(Frame& F) {
    const bf16* P = (const bf16*)(F.ws + WS_PROJ); const bf16* YH = (const bf16*)(F.ws + WS_YHY); const bf16* YA = (const bf16*)(F.ws + WS_YAT); bf16* MG = (bf16*)(F.ws + WS_MERGED);
    const size_t nthr = (size_t)F.G * NWAVES * 64, t0 = (size_t)F.vcu * NWAVES * 64 + F.tid;
    for (size_t i = t0; i < (size_t)T * D / 8; i += nthr) {
        const size_t m = i >> 7; const int c = (int)(i & 127) * 8;
        const v4u gh = *(const v4u*)(P + m * INW + COL_G + c), ga = *(const v4u*)(P + m * INW + COL_G + D + c), yh = *(const v4u*)(YH + m * D + c), ya = *(const v4u*)(YA + m * D + c);
        v4u o;
#pragma unroll
        for (int k = 0; k < 4; ++k) { const float a = sigmoidf(bflo(gh[k])) * bflo(yh[k]) + sigmoidf(bflo(ga[k])) * bflo(ya[k]), b = sigmoidf(bfhi(gh[k])) * bfhi(yh[k]) + sigmoidf(bfhi(ga[k])) * bfhi(ya[k]); o[k] = pk2(a, b); }
        *(v4u*)(MG + m * D + c) = o;
    }
}
__device__ __forceinline__ void resid_norm_router(Frame& F, const InTab& A, int l) {
    const int gw = F.vcu * NWAVES + F.wave, NGW = F.G * NWAVES, lane = F.lane;
    const float* mod = (const float*)(F.ws + WS_MOD) + (size_t)l * NMOD * 6 * D;
    const float* MIX = (const float*)(F.ws + WS_MIX); bf16* H = (bf16*)(F.ws + WS_H); float* AFFT = (float*)(F.ws + WS_AFFT);
    const float* g2 = A.in[I_N2G] + (size_t)l * D; const float* rw = A.in[I_RW] + (size_t)l * D * NE;
    for (int m = gw; m < T; m += NGW) {
        const f32x4* xr = (const f32x4*)x_row(F, A, l, m) + lane; const f32x4* mx = (const f32x4*)(MIX + (size_t)m * D) + lane;
        const float* mr = mod + (size_t)mod_row(m) * 6 * D;
        f32x4 v[4]; float ss = 0.f;
#pragma unroll
        for (int j = 0; j < 4; ++j) { const int c = 4 * lane + 256 * j; const f32x4 g1 = *(const f32x4*)(mr + 2 * D + c);
            v[j] = xr[64 * j] + g1 * mx[64 * j]; ((f32x4*)(F.out + (size_t)m * D))[lane + 64 * j] = v[j];
            ss += (v[j].x * v[j].x + v[j].y * v[j].y) + (v[j].z * v[j].z + v[j].w * v[j].w); }
        const float rstd = 1.0f / sqrtf(wave_sum(ss) * (1.f / D) + EPS);
        float lg[NE];
#pragma unroll
        for (int e = 0; e < NE; ++e) lg[e] = 0.f;
        unsigned long long* o8 = (unsigned long long*)(H + (size_t)m * D) + lane;
#pragma unroll
        for (int j = 0; j < 4; ++j) { const int c = 4 * lane + 256 * j;
            const f32x4 gg = *(const f32x4*)(g2 + c), sc = *(const f32x4*)(mr + 4 * D + c), sh = *(const f32x4*)(mr + 3 * D + c);
            const f32x4 o = v[j] * rstd * gg * (sc + 1.0f) + sh;
            o8[64 * j] = (unsigned long long)pk2(o.x, o.y) | ((unsigned long long)pk2(o.z, o.w) << 32);
#pragma unroll
            for (int q = 0; q < 4; ++q) { const f32x4* wr = (const f32x4*)(rw + (size_t)(c + q) * NE);
#pragma unroll
                for (int e4 = 0; e4 < 4; ++e4) { const f32x4 w = wr[e4]; lg[4 * e4 + 0] += o[q] * w.x; lg[4 * e4 + 1] += o[q] * w.y; lg[4 * e4 + 2] += o[q] * w.z; lg[4 * e4 + 3] += o[q] * w.w; } } }
        float mxl = -1e30f;
#pragma unroll
        for (int e = 0; e < NE; ++e) { lg[e] = wave_sum(lg[e]); mxl = fmaxf(mxl, lg[e]); }
        float den = 0.f;
#pragma unroll
        for (int e = 0; e < NE; ++e) { lg[e] = expf(lg[e] - mxl); den += lg[e]; }
        const int grp = m >= TG, tg = m - grp * TG;
        float mine = 0.f;
#pragma unroll
        for (int e = 0; e < NE; ++e) mine = lane == e ? lg[e] / den : mine;
        if (lane < NE) AFFT[((size_t)grp * NE + lane) * TG + tg] = mine;
    }
}
__device__ __forceinline__ void topk_rank(Frame& F) {
    const float* AFFT = (const float*)(F.ws + WS_AFFT); int* SLOT = (int*)(F.ws + WS_SLOT); int* IDX = (int*)(F.ws + WS_IDX); float* GV = (float*)(F.ws + WS_GATEV);
    const size_t nthr = (size_t)F.G * NWAVES * 64, t0 = (size_t)F.vcu * NWAVES * 64 + F.tid;
    for (size_t i = t0; i < (size_t)NGRP * NE * TG; i += nthr) {
        const int ge = (int)(i >> 14), t = (int)(i & (TG - 1));
        const float* a = AFFT + (size_t)ge * TG; const float mine = a[t];
        int rank = 0;
        for (int j = 0; j < TG; j += 4) { const f32x4 v = *(const f32x4*)(a + j);
            rank += (v.x > mine || (v.x == mine && j + 0 < t)) ? 1 : 0; rank += (v.y > mine || (v.y == mine && j + 1 < t)) ? 1 : 0;
            rank += (v.z > mine || (v.z == mine && j + 2 < t)) ? 1 : 0; rank += (v.w > mine || (v.w == mine && j + 3 < t)) ? 1 : 0; }
        SLOT[i] = rank < CAP ? rank : -1;
        if (rank < CAP) { IDX[(size_t)ge * CAP + rank] = t; GV[(size_t)ge * CAP + rank] = mine; }
    }
}
__device__ __forceinline__ void gather_rows(Frame& F) {
    const int gw = F.vcu * NWAVES + F.wave, NGW = F.G * NWAVES, lane = F.lane;
    const bf16* __restrict__ H = (const bf16*)(F.ws + WS_H); unsigned char* __restrict__ XE = (unsigned char*)(F.ws + WS_XE); unsigned char* __restrict__ HID = (unsigned char*)(F.ws + WS_HID); const int* __restrict__ IDX = (const int*)(F.ws + WS_IDX);
    for (int sb = gw * 32; sb < NSLOT; sb += NGW * 32) {
        const int grp = sb >> 15, tix = IDX[sb + (lane & 31)];
#pragma unroll
        for (int j = 0; j < 4; ++j) { const int q = j * 64 + lane; *(v4u*)(HID + (size_t)(sb + (q >> 3)) * KB_DN + FF / 2 + 16 * (q & 7)) = (v4u){0u, 0u, 0u, 0u}; }
        for (int i = 0; i < 32; i += 8) {
            v4u a[8], b[8];
#pragma unroll
            for (int k = 0; k < 8; ++k) { const int t = __builtin_amdgcn_readlane(tix, i + k); const v4u* src = (const v4u*)(H + ((size_t)grp * TG + t) * D); a[k] = src[lane]; b[k] = src[64 + lane]; }
#pragma unroll
            for (int k = 0; k < 8; ++k) { unsigned char* dst = XE + (size_t)(sb + i + k) * KB_UP;
                unsigned wa, wb;
                PG8_FP4_PACK8(wa, bflo(a[k].x), bfhi(a[k].x), bflo(a[k].y), bfhi(a[k].y), bflo(a[k].z), bfhi(a[k].z), bflo(a[k].w), bfhi(a[k].w));
                PG8_FP4_PACK8(wb, bflo(b[k].x), bfhi(b[k].x), bflo(b[k].y), bfhi(b[k].y), bflo(b[k].z), bfhi(b[k].z), bflo(b[k].w), bfhi(b[k].w));
                *(unsigned*)(dst + 4 * lane) = wa; *(unsigned*)(dst + 256 + 4 * lane) = wb; }
        }
    }
}
__device__ __forceinline__ void moe_combine(Frame& F, int l) {
    const int gw = F.vcu * NWAVES + F.wave, NGW = F.G * NWAVES, lane = F.lane;
    const float* mod = (const float*)(F.ws + WS_MOD) + (size_t)l * NMOD * 6 * D;
    const int* SLOT = (const int*)(F.ws + WS_SLOT); const float* GV = (const float*)(F.ws + WS_GATEV); const bf16* YE = (const bf16*)(F.ws + WS_YE);
    for (int m = gw; m < T; m += NGW) {
        const int grp = m >= TG, tg = m - grp * TG;
        const float* mr = mod + (size_t)mod_row(m) * 6 * D;
        f32x4 acc[4];
#pragma unroll
        for (int j = 0; j < 4; ++j) acc[j] = (f32x4){0.f, 0.f, 0.f, 0.f};
        for (int e = 0; e < NE; ++e) {
            const int sl = SLOT[((size_t)grp * NE + e) * TG + tg];
            if (sl >= 0) { const size_t row = ((size_t)grp * NE + e) * CAP + sl; const float gt = GV[row]; const v2u* yr = (const v2u*)(YE + row * D) + lane;
#pragma unroll
                for (int j = 0; j < 4; ++j) { const v2u w = yr[64 * j]; acc[j] += (f32x4){bflo(w.x), bfhi(w.x), bflo(w.y), bfhi(w.y)} * gt; } }
        }
        f32x4* xo = (f32x4*)(F.out + (size_t)m * D) + lane;
#pragma unroll
        for (int j = 0; j < 4; ++j) { const f32x4 g2 = *(const f32x4*)(mr + 5 * D + 4 * lane + 256 * j); xo[64 * j] = xo[64 * j] + g2 * acc[j]; }
    }
}

__device__ __forceinline__ void topk_select(Frame& F) {
    LAS unsigned* keys = (LAS unsigned*)(F.lds + RING_OFF);
    LAS unsigned* hist = (LAS unsigned*)(F.lds + RING_OFF + 65536);
    LAS unsigned* misc = (LAS unsigned*)(F.lds + RING_OFF + 65536 + 8192);
    const float* AFFT = (const float*)(F.ws + WS_AFFT); int* SLOT = (int*)(F.ws + WS_SLOT); int* IDX = (int*)(F.ws + WS_IDX); float* GV = (float*)(F.ws + WS_GATEV);
    const int tid = F.tid, lane = F.lane, wave = F.wave;
    for (int u = F.vcu; u < NGRP * NE; u += F.G) {
        const float* a = AFFT + (size_t)u * TG;
        for (int i = tid; i < TG; i += NWAVES * 64) keys[i] = __builtin_bit_cast(unsigned, a[i]);
        unsigned prefix = 0u, mask = 0u, need = CAP;
        for (int pass = 0; pass < 4; ++pass) {
            const int shift = 24 - 8 * pass;
            for (int i = tid; i < NWAVES * 256; i += NWAVES * 64) hist[i] = 0u;
            __syncthreads();
            for (int i = tid; i < TG; i += NWAVES * 64) { const unsigned k = keys[i]; if ((k & mask) == prefix) __hip_atomic_fetch_add(&hist[wave * 256 + ((k >> shift) & 255u)], 1u, __ATOMIC_RELAXED, __HIP_MEMORY_SCOPE_WORKGROUP); }
            __syncthreads();
            if (wave == 0) {
                unsigned h[4];
#pragma unroll
                for (int b = 0; b < 4; ++b) { unsigned s = 0u;
#pragma unroll
                    for (int w = 0; w < NWAVES; ++w) s += hist[w * 256 + 4 * lane + b];
                    h[b] = s; }
                const unsigned mine = h[0] + h[1] + h[2] + h[3];
                unsigned inc = mine;
#pragma unroll
                for (int o = 1; o < 64; o <<= 1) { const unsigned t = __shfl_down(inc, o); if (lane + o < 64) inc += t; }
                unsigned c = inc - mine;
#pragma unroll
                for (int b = 3; b >= 0; --b) { if (c < need && c + h[b] >= need) { misc[0] = (unsigned)(4 * lane + b); misc[1] = need - c; } c += h[b]; }
            }
            __syncthreads();
            prefix |= misc[0] << shift; mask |= 255u << shift; need = misc[1];
            __syncthreads();
        }
        unsigned cg = 0u, ce = 0u;
        for (int r = 0; r < 32; ++r) { const unsigned k = keys[2048 * wave + 64 * r + lane];
            cg += (unsigned)__popcll(__ballot(k > prefix)); ce += (unsigned)__popcll(__ballot(k == prefix)); }
        if (lane == 0) { misc[16 + 2 * wave] = cg; misc[17 + 2 * wave] = ce; }
        __syncthreads();
        unsigned eq_base = 0u, slot_base = 0u;
        for (int w = 0; w < NWAVES; ++w) { const unsigned g = misc[16 + 2 * w], e = misc[17 + 2 * w];
            if (w < wave) { const unsigned take = eq_base >= need ? 0u : ((need - eq_base) < e ? (need - eq_base) : e); slot_base += g + take; eq_base += e; } }
        const unsigned long long below = (1ull << lane) - 1ull;
        for (int r = 0; r < 32; ++r) { const int t = 2048 * wave + 64 * r + lane; const unsigned k = keys[t];
            const unsigned long long beq = __ballot(k == prefix);
            const unsigned eq_rank = eq_base + (unsigned)__popcll(beq & below);
            const bool sel = (k > prefix) || (k == prefix && eq_rank < need);
            const unsigned long long bsel = __ballot(sel);
            const unsigned slot = slot_base + (unsigned)__popcll(bsel & below);
            SLOT[((size_t)(u >> 4) * TG + t) * NE + (u & 15)] = sel ? (int)slot : -1;
            if (sel) { IDX[(size_t)u * CAP + slot] = t; GV[(size_t)u * CAP + slot] = __builtin_bit_cast(float, k); }
            eq_base += (unsigned)__popcll(beq); slot_base += (unsigned)__popcll(bsel); }
        __syncthreads();
    }
}
__device__ __forceinline__ void rope_table(Frame& F) {
    f32x2* RT = (f32x2*)(F.ws + WS_ROPE);
    const int nthr = F.G * NWAVES * 64;
    for (int i = F.vcu * NWAVES * 64 + F.tid; i < TP * 32; i += nthr) { double rv = (double)(i >> 5) * ROPE_INV_REV[i & 31]; rv -= floor(rv); const float rf = (float)rv; RT[i] = (f32x2){cos_rev(rf), sin_rev(rf)}; }
}
constexpr int AT_KP = 72, AT_VP = 388;
__device__ __forceinline__ void attention_mfma(Frame& F, const InTab& A, int l) {
    LAS bf16* Ks = (LAS bf16*)(F.lds + RING_OFF);
    LAS bf16* Vt = (LAS bf16*)(F.lds + RING_OFF + 384 * AT_KP * 2);
    const bf16* P = (const bf16*)(F.ws + WS_PROJ); bf16* AT = (bf16*)(F.ws + WS_Z2AT) + HYW; const f32x2* RT = (const f32x2*)(F.ws + WS_ROPE);
    const float* gqp = A.in[I_QNG] + l * HD; const float* gkp = A.in[I_KNG] + l * HD;
    const int tid = F.tid, lane = F.lane, wave = F.wave, lr = lane & 31, hl = lane >> 5;
    for (int u = F.vcu; u < (T / 128) * NKV; u += F.G) {
        const int kv = u & 1, r0 = (u >> 1) * 128;
        int s0, len; seq_bounds(r0, s0, len);
        const int h = kv * 4 + (wave >> 1);
        v4u kraw[6], vraw[6], qraw[2][4];
#pragma unroll
        for (int it = 0; it < 6; ++it) { const int i = tid + it * (NWAVES * 64), kl = i >> 3, c8 = (i & 7) * 8, row = r0 - 128 + kl;
            const bool ok = row >= s0 && row < s0 + len; const int rc = ok ? row : r0;
            kraw[it] = *(const v4u*)(P + (size_t)rc * INW + COL_K + kv * HD + c8); vraw[it] = *(const v4u*)(P + (size_t)rc * INW + COL_V + kv * HD + c8); }
#pragma unroll
        for (int qt = 0; qt < 2; ++qt) { const bf16* qp = P + (size_t)(r0 + 64 * (wave & 1) + 32 * qt + lr) * INW + COL_Q + h * HD + 8 * hl;
#pragma unroll
            for (int s = 0; s < 4; ++s) qraw[qt][s] = *(const v4u*)(qp + 16 * s); }
#pragma unroll
        for (int it = 0; it < 6; ++it) { const int i = tid + it * (NWAVES * 64), kl = i >> 3, c8 = (i & 7) * 8, row = r0 - 128 + kl;
            const bool ok = row >= s0 && row < s0 + len; const int rc = ok ? row : r0;
            const v4u kr = kraw[it];
            float x[8]; float ss = 0.f;
#pragma unroll
            for (int e = 0; e < 4; ++e) { x[2 * e] = bflo(kr[e]); x[2 * e + 1] = bfhi(kr[e]); ss += x[2 * e] * x[2 * e] + x[2 * e + 1] * x[2 * e + 1]; }
            ss += __shfl_xor(ss, 1); ss += __shfl_xor(ss, 2); ss += __shfl_xor(ss, 4);
            const float rstd = 1.0f / sqrtf(ss * (1.f / HD) + EPS);
            const f32x2* rt = RT + (size_t)(rc - s0) * 32 + (c8 & 31);
            float o[8];
#pragma unroll
            for (int e = 0; e < 8; ++e) { const float y = x[e] * rstd * gkp[c8 + e]; const float p = __shfl_xor(y, 4); const f32x2 cs = rt[e]; o[e] = c8 < 32 ? y * cs.x - p * cs.y : y * cs.x + p * cs.y; }
            v4u kw = {pk2(o[0], o[1]), pk2(o[2], o[3]), pk2(o[4], o[5]), pk2(o[6], o[7])}; v4u vw = vraw[it];
            if (!ok) { kw = (v4u){0u, 0u, 0u, 0u}; vw = (v4u){0u, 0u, 0u, 0u}; }
            *(LAS v4u*)(Ks + kl * AT_KP + c8) = kw;
#pragma unroll
            for (int e = 0; e < 4; ++e) { Vt[(c8 + 2 * e) * AT_VP + kl] = (bf16)(vw[e] & 0xffffu); Vt[(c8 + 2 * e + 1) * AT_VP + kl] = (bf16)(vw[e] >> 16); } }
        __syncthreads();
        const float sink = A.in[I_SINK][l * NH + h];
        for (int qt = 0; qt < 2; ++qt) {
            const int qa = 64 * (wave & 1) + 32 * qt;
            bf16x8 Qf[4];
            {
                const int row = r0 + qa + lr;
                float x[4][8]; float ss = 0.f;
#pragma unroll
                for (int s = 0; s < 4; ++s) { const v4u w = qt == 0 ? qraw[0][s] : qraw[1][s];
#pragma unroll
                    for (int e = 0; e < 4; ++e) { x[s][2 * e] = bflo(w[e]); x[s][2 * e + 1] = bfhi(w[e]); ss += x[s][2 * e] * x[s][2 * e] + x[s][2 * e + 1] * x[s][2 * e + 1]; } }
                ss += __shfl_xor(ss, 32);
                const float rstd = 0.125f / sqrtf(ss * (1.f / HD) + EPS);
                const f32x2* rt = RT + (size_t)(row - s0) * 32 + 8 * hl;
#pragma unroll
                for (int s = 0; s < 2; ++s) { float o1[8], o2[8];
#pragma unroll
                    for (int j = 0; j < 8; ++j) { const int d = 16 * s + 8 * hl + j; const float y1 = x[s][j] * rstd * gqp[d], y2 = x[s + 2][j] * rstd * gqp[d + 32]; const f32x2 cs = rt[16 * s + j];
                        o1[j] = y1 * cs.x - y2 * cs.y; o2[j] = y2 * cs.x + y1 * cs.y; }
                    const v4u a = {pk2(o1[0], o1[1]), pk2(o1[2], o1[3]), pk2(o1[4], o1[5]), pk2(o1[6], o1[7])}, b = {pk2(o2[0], o2[1]), pk2(o2[2], o2[3]), pk2(o2[4], o2[5]), pk2(o2[6], o2[7])};
                    Qf[s] = __builtin_bit_cast(bf16x8, a); Qf[s + 2] = __builtin_bit_cast(bf16x8, b); }
            }
            float m_run = sink, l_run = 0.f;
            f32x16 O0, O1;
#pragma unroll
            for (int r = 0; r < 16; ++r) { O0[r] = 0.f; O1[r] = 0.f; }
            for (int kt = qa >> 5; kt <= (qa >> 5) + 8; ++kt) {
                f32x16 S;
#pragma unroll
                for (int r = 0; r < 16; ++r) S[r] = 0.f;
#pragma unroll
                for (int s = 0; s < 4; ++s) { const bf16x8 Kf = *(const LAS bf16x8*)(Ks + (32 * kt + lr) * AT_KP + 16 * s + 8 * hl); S = __builtin_amdgcn_mfma_f32_32x32x16_bf16(Kf, Qf[s], S, 0, 0, 0); }
                float mt = -1e30f;
                const int jt = kt - (qa >> 5), kr0 = r0 - 128 + 32 * kt;
                if (jt >= 1 && jt <= 7 && kr0 >= s0 && kr0 + 32 <= s0 + len) {
#pragma unroll
                    for (int r = 0; r < 16; ++r) mt = fmaxf(mt, S[r]);
                } else {
#pragma unroll
                    for (int r = 0; r < 16; ++r) { const int kl = 32 * kt + (r & 3) + 8 * (r >> 2) + 4 * hl, dlt = qa + lr + 128 - kl, row = r0 - 128 + kl;
                        const bool ok = dlt <= WIN && dlt >= -WIN && row >= s0 && row < s0 + len;
                        S[r] = ok ? S[r] : -1e30f; mt = fmaxf(mt, S[r]); }
                }
                mt = fmaxf(mt, __shfl_xor(mt, 32));
                const float m_new = fmaxf(m_run, mt), sc = fast_exp(m_run - m_new);
                float ps = 0.f;
#pragma unroll
                for (int r = 0; r < 16; ++r) { S[r] = fast_exp(S[r] - m_new); ps += S[r]; }
                l_run = l_run * sc + ps; m_run = m_new;
                if (__any(sc != 1.0f)) {
#pragma unroll
                    for (int r = 0; r < 16; ++r) { O0[r] *= sc; O1[r] *= sc; } }
#pragma unroll
                for (int sp = 0; sp < 2; ++sp) {
                    v4u pw; pw.x = pk2(S[8 * sp + 0], S[8 * sp + 1]); pw.y = pk2(S[8 * sp + 2], S[8 * sp + 3]); pw.z = pk2(S[8 * sp + 4], S[8 * sp + 5]); pw.w = pk2(S[8 * sp + 6], S[8 * sp + 7]);
                    const bf16x8 Pf = __builtin_bit_cast(bf16x8, pw);
                    const int kb = 32 * kt + 16 * sp + 4 * hl;
                    { const v2u a = *(const LAS v2u*)(Vt + lr * AT_VP + kb), b = *(const LAS v2u*)(Vt + lr * AT_VP + kb + 8); const v4u vv = {a.x, a.y, b.x, b.y};
                      O0 = __builtin_amdgcn_mfma_f32_32x32x16_bf16(__builtin_bit_cast(bf16x8, vv), Pf, O0, 0, 0, 0); }
                    { const v2u a = *(const LAS v2u*)(Vt + (32 + lr) * AT_VP + kb), b = *(const LAS v2u*)(Vt + (32 + lr) * AT_VP + kb + 8); const v4u vv = {a.x, a.y, b.x, b.y};
                      O1 = __builtin_amdgcn_mfma_f32_32x32x16_bf16(__builtin_bit_cast(bf16x8, vv), Pf, O1, 0, 0, 0); }
                }
            }
            const float l_tot = l_run + __shfl_xor(l_run, 32), inv = 1.0f / (l_tot + fast_exp(sink - m_run));
            bf16* orow = AT + (size_t)(r0 + qa + lr) * ZAP + h * HD + 4 * hl;
#pragma unroll
            for (int g = 0; g < 4; ++g) {
                v2u w0; w0.x = pk2(O0[4 * g + 0] * inv, O0[4 * g + 1] * inv); w0.y = pk2(O0[4 * g + 2] * inv, O0[4 * g + 3] * inv); *(v2u*)(orow + 8 * g) = w0;
                v2u w1; w1.x = pk2(O1[4 * g + 0] * inv, O1[4 * g + 1] * inv); w1.y = pk2(O1[4 * g + 2] * inv, O1[4 * g + 3] * inv); *(v2u*)(orow + 32 + 8 * g) = w1; }
        }
        __syncthreads();
    }
}

__device__ __forceinline__ void resid_norm_router2(Frame& F, const InTab& A, int l) {
    LAS float* rwT = (LAS float*)(F.lds + RING_OFF);
    const int gw = F.vcu * NWAVES + F.wave, NGW = F.G * NWAVES, lane = F.lane;
    const float* __restrict__ mod = (const float*)(F.ws + WS_MOD) + (size_t)l * NMOD * 6 * D;
    const float* __restrict__ MIX = (const float*)(F.ws + WS_MIX); bf16* __restrict__ H = (bf16*)(F.ws + WS_H); float* __restrict__ AFFT = (float*)(F.ws + WS_AFFT); float* __restrict__ AFFTOK = (float*)(F.ws + WS_AFFTOK);
    const float* __restrict__ g2 = A.in[I_N2G] + (size_t)l * D; const float* __restrict__ rw = A.in[I_RW] + (size_t)l * D * NE;
    { f32x4 wq[8];
#pragma unroll
      for (int q = 0; q < 8; ++q) wq[q] = ((const f32x4*)rw)[F.tid + q * NWAVES * 64];
#pragma unroll
      for (int q = 0; q < 8; ++q) { const int i = F.tid + q * NWAVES * 64, k = i >> 2, e0 = (i & 3) * 4; const f32x4 w = wq[q];
        rwT[(e0 + 0) * D + k] = w.x; rwT[(e0 + 1) * D + k] = w.y; rwT[(e0 + 2) * D + k] = w.z; rwT[(e0 + 3) * D + k] = w.w; } }
    static_assert(D * NE / 4 == 8 * NWAVES * 64, "router staging");
    __syncthreads();
    for (int blkid = gw; blkid < T / 16; blkid += NGW) {
    const int mb = blkid * 16, me = mb + 16;
    f32x4 xn[2][4], sc[4], sh[4];
    { const float* mr_ = mod + (size_t)mod_row(mb) * 6 * D + 4 * lane;
#pragma unroll
      for (int j = 0; j < 4; ++j) { sc[j] = (*(const f32x4*)(mr_ + 4 * D + 256 * j) + 1.0f) * *(const f32x4*)(g2 + 4 * lane + 256 * j); sh[j] = *(const f32x4*)(mr_ + 3 * D + 256 * j); } }
#define RR_ISSUE(mm) do { _Pragma("unroll") for (int r = 0; r < 2; ++r) { const f32x4* xr_ = (const f32x4*)(F.out + (size_t)((mm) + r) * D) + lane; \
        _Pragma("unroll") for (int j = 0; j < 4; ++j) xn[r][j] = xr_[64 * j]; } } while (0)
    RR_ISSUE(mb);
#pragma unroll 1
    for (int m = mb; m < me; m += 2) {
        constexpr bool two = true;
        f32x4 v[2][4]; float ss[2] = {0.f, 0.f};
#pragma unroll
        for (int r = 0; r < 2; ++r)
#pragma unroll
            for (int j = 0; j < 4; ++j) v[r][j] = xn[r][j];
        if (m + 2 < me) RR_ISSUE(m + 2);
#pragma unroll
        for (int r = 0; r < 2; ++r)
#pragma unroll
            for (int j = 0; j < 4; ++j) ss[r] += (v[r][j].x * v[r][j].x + v[r][j].y * v[r][j].y) + (v[r][j].z * v[r][j].z + v[r][j].w * v[r][j].w);
#pragma unroll
        for (int o = 1; o < 64; o <<= 1) { ss[0] += __shfl_xor(ss[0], o); ss[1] += __shfl_xor(ss[1], o); }
        const float rstd[2] = {1.0f / sqrtf(ss[0] * (1.f / D) + EPS), 1.0f / sqrtf(ss[1] * (1.f / D) + EPS)};
        float lg[2][NE];
#pragma unroll
        for (int r = 0; r < 2; ++r)
#pragma unroll
            for (int e = 0; e < NE; ++e) lg[r][e] = 0.f;
#pragma unroll
        for (int j = 0; j < 4; ++j) { f32x4 o[2];
#pragma unroll
            for (int r = 0; r < 2; ++r) { o[r] = v[r][j] * rstd[r] * sc[j] + sh[j];
                if (r == 0 || two) { unsigned long long* o8 = (unsigned long long*)(H + (size_t)(m + r) * D) + lane; o8[64 * j] = (unsigned long long)pk2(o[r].x, o[r].y) | ((unsigned long long)pk2(o[r].z, o[r].w) << 32); } }
#pragma unroll
            for (int eh = 0; eh < NE; eh += 4) {
#pragma unroll
                for (int e = eh; e < eh + 4; ++e) { const f32x4 w = *(const LAS f32x4*)(rwT + e * D + 4 * lane + 256 * j);
                    lg[0][e] += (o[0].x * w.x + o[0].y * w.y) + (o[0].z * w.z + o[0].w * w.w); lg[1][e] += (o[1].x * w.x + o[1].y * w.y) + (o[1].z * w.z + o[1].w * w.w); }
                asm volatile("" ::: "memory"); } }
        const int e = ((lane >> 5) & 1) * 8 + ((lane >> 4) & 1) * 4 + ((lane >> 3) & 1) * 2 + ((lane >> 2) & 1);
        float k1[2];
#pragma unroll
        for (int r = 0; r < 2; ++r) { float k8[8], k4[4], k2[2];
#pragma unroll
            for (int i = 0; i < 8; ++i) { const bool hi = lane & 32; const float send = hi ? lg[r][i] : lg[r][i + 8], keep = hi ? lg[r][i + 8] : lg[r][i]; k8[i] = keep + __shfl_xor(send, 32); }
#pragma unroll
            for (int i = 0; i < 4; ++i) { const bool hi = lane & 16; const float send = hi ? k8[i] : k8[i + 4], keep = hi ? k8[i + 4] : k8[i]; k4[i] = keep + __shfl_xor(send, 16); }
#pragma unroll
            for (int i = 0; i < 2; ++i) { const bool hi = lane & 8; const float send = hi ? k4[i] : k4[i + 2], keep = hi ? k4[i + 2] : k4[i]; k2[i] = keep + __shfl_xor(send, 8); }
            { const bool hi = lane & 4; const float send = hi ? k2[0] : k2[1], keep = hi ? k2[1] : k2[0]; k1[r] = keep + __shfl_xor(send, 4); }
            k1[r] += __shfl_xor(k1[r], 2); k1[r] += __shfl_xor(k1[r], 1); }
        float mx[2] = {k1[0], k1[1]};
#pragma unroll
        for (int o = 1; o < 64; o <<= 1) { mx[0] = fmaxf(mx[0], __shfl_xor(mx[0], o)); mx[1] = fmaxf(mx[1], __shfl_xor(mx[1], o)); }
        const float ex[2] = {expf(k1[0] - mx[0]), expf(k1[1] - mx[1])}; float dn[2] = {ex[0], ex[1]};
#pragma unroll
        for (int o = 1; o < 64; o <<= 1) { dn[0] += __shfl_xor(dn[0], o); dn[1] += __shfl_xor(dn[1], o); }
#pragma unroll
        for (int r = 0; r < 2; ++r) { const float aff = ex[r] / (dn[r] * 0.25f);
            const int mm = m + r, grp = mm >= TG, tg = mm - grp * TG;
            if ((lane & 3) == 0 && (r == 0 || two)) { AFFT[((size_t)grp * NE + e) * TG + tg] = aff; AFFTOK[(size_t)mm * NE + e] = aff; } }
    }
    }
#undef RR_ISSUE
}
__device__ __forceinline__ void moe_combine2(Frame& F, int l, float zmul, int nl, const float* __restrict__ g1n) {
    const int gw = F.vcu * NWAVES + F.wave, NGW = F.G * NWAVES, lane = F.lane;
    const float* __restrict__ mod = (const float*)(F.ws + WS_MOD) + (size_t)l * NMOD * 6 * D;
    const int* __restrict__ SLOT = (const int*)(F.ws + WS_SLOT); const float* __restrict__ AFFTOK = (const float*)(F.ws + WS_AFFTOK); const bf16* __restrict__ YE = (const bf16*)(F.ws + WS_YE);
    for (int blkid = gw; blkid < T / 16; blkid += NGW) {
    const int mb = blkid * 16;
    f32x4 g2[4], gsc[4], shn[4];
    { const float* __restrict__ mr = mod + (size_t)mod_row(mb) * 6 * D;
#pragma unroll
      for (int j = 0; j < 4; ++j) g2[j] = *(const f32x4*)(mr + 5 * D + 4 * lane + 256 * j) * zmul;
      if (nl >= 0) { const float* __restrict__ mrn = (const float*)(F.ws + WS_MOD) + ((size_t)nl * NMOD + mod_row(mb)) * 6 * D;
#pragma unroll
        for (int j = 0; j < 4; ++j) { const int cc = 4 * lane + 256 * j; gsc[j] = *(const f32x4*)(g1n + cc) * (*(const f32x4*)(mrn + D + cc) + 1.0f); shn[j] = *(const f32x4*)(mrn + cc); } }
      else {
#pragma unroll
        for (int j = 0; j < 4; ++j) { gsc[j] = (f32x4){0.f, 0.f, 0.f, 0.f}; shn[j] = gsc[j]; } } }
#pragma unroll 1
    for (int m = mb; m < mb + 16; ++m) {
        const int grp = m >= TG;
        const int sl = SLOT[(size_t)m * NE + (lane & 15)]; const float gtv = AFFTOK[(size_t)m * NE + (lane & 15)];
        f32x4* xo = (f32x4*)(F.out + (size_t)m * D) + lane;
        f32x4 xv[4], acc[4];
#pragma unroll
        for (int j = 0; j < 4; ++j) { xv[j] = xo[64 * j]; acc[j] = (f32x4){0.f, 0.f, 0.f, 0.f}; }
        unsigned mask = (unsigned)(__ballot(sl >= 0) & 0xffffull);
        while (mask) {
            const int e0 = __builtin_ctz(mask); mask &= mask - 1u;
            const bool two = mask != 0u; const int e1 = two ? __builtin_ctz(mask) : e0; if (two) mask &= mask - 1u;
            const int s0 = __builtin_amdgcn_readlane(sl, e0), s1 = __builtin_amdgcn_readlane(sl, e1);
            const float t0 = rdlane(gtv, e0), t1 = two ? rdlane(gtv, e1) : 0.f;
            const v2u* __restrict__ y0 = (const v2u*)(YE + (((size_t)grp * NE + e0) * CAP + s0) * D) + lane; const v2u* __restrict__ y1 = (const v2u*)(YE + (((size_t)grp * NE + e1) * CAP + s1) * D) + lane;
            v2u a[4], b[4];
#pragma unroll
            for (int j = 0; j < 4; ++j) { a[j] = y0[64 * j]; b[j] = y1[64 * j]; }
#pragma unroll
            for (int j = 0; j < 4; ++j) { acc[j] += (f32x4){bflo(a[j].x), bfhi(a[j].x), bflo(a[j].y), bfhi(a[j].y)} * t0; acc[j] += (f32x4){bflo(b[j].x), bfhi(b[j].x), bflo(b[j].y), bfhi(b[j].y)} * t1; }
        }
#pragma unroll
        for (int j = 0; j < 4; ++j) { xv[j] = xv[j] + g2[j] * acc[j]; xo[64 * j] = xv[j]; }
        if (nl >= 0) {
            float ss = 0.f;
#pragma unroll
            for (int j = 0; j < 4; ++j) ss += (xv[j].x * xv[j].x + xv[j].y * xv[j].y) + (xv[j].z * xv[j].z + xv[j].w * xv[j].w);
            const float rstd = 1.0f / sqrtf(wave_sum(ss) * (1.f / D) + EPS);
            unsigned long long* o8 = (unsigned long long*)((bf16*)(F.ws + WS_H) + (size_t)m * D) + lane;
#pragma unroll
            for (int j = 0; j < 4; ++j) { const f32x4 o = xv[j] * rstd * gsc[j] + shn[j];
                o8[64 * j] = (unsigned long long)pk2(o.x, o.y) | ((unsigned long long)pk2(o.z, o.w) << 32); }
        }
    }
    }
}

#ifdef PROBE_FP8
typedef int v8i_t __attribute__((ext_vector_type(8)));
__device__ __forceinline__ float fp8p_a(int i, int k) { return (float)(((i * 7 + k * 3) % 5) - 2); }
__device__ __forceinline__ float fp8p_b(int k, int j) { return (float)(((k * 5 + j * 11) % 7) - 3); }
__device__ __forceinline__ int fp8p_k(int lane, int b, int hyp) {
    const int g = lane >> 4;
    if (hyp == 1) return 32 * g + b;
    if (hyp == 2) return 16 * g + (b & 15) + 64 * (b >> 4);
    return 8 * g + (b & 7) + 32 * (b >> 3);
}
__device__ __forceinline__ bool fp8_probe(int lane) {
    v8i_t A, B;
#pragma unroll
    for (int v = 0; v < 8; ++v) { int wa = 0, wb = 0;
        { const int k0 = fp8p_k(lane, 4 * v + 0, PROBE_FP8_HA), k1 = fp8p_k(lane, 4 * v + 1, PROBE_FP8_HA), k2 = fp8p_k(lane, 4 * v + 2, PROBE_FP8_HA), k3 = fp8p_k(lane, 4 * v + 3, PROBE_FP8_HA);
          wa = __builtin_amdgcn_cvt_pk_fp8_f32(fp8p_a(lane & 15, k0), fp8p_a(lane & 15, k1), wa, false); wa = __builtin_amdgcn_cvt_pk_fp8_f32(fp8p_a(lane & 15, k2), fp8p_a(lane & 15, k3), wa, true); }
        { const int k0 = fp8p_k(lane, 4 * v + 0, PROBE_FP8_HB), k1 = fp8p_k(lane, 4 * v + 1, PROBE_FP8_HB), k2 = fp8p_k(lane, 4 * v + 2, PROBE_FP8_HB), k3 = fp8p_k(lane, 4 * v + 3, PROBE_FP8_HB);
          wb = __builtin_amdgcn_cvt_pk_fp8_f32(fp8p_b(k0, lane & 15), fp8p_b(k1, lane & 15), wb, false); wb = __builtin_amdgcn_cvt_pk_fp8_f32(fp8p_b(k2, lane & 15), fp8p_b(k3, lane & 15), wb, true); }
        A[v] = wa; B[v] = wb; }
    f32x4 acc = {0.f, 0.f, 0.f, 0.f};
    acc = __builtin_amdgcn_mfma_scale_f32_16x16x128_f8f6f4(A, B, acc, 0, 0, 0, 0x7F7F7F7F, 0, 0x7F7F7F7F);
    bool bad = false;
#pragma unroll
    for (int r = 0; r < 4; ++r) { const int row = 4 * (lane >> 4) + r, col = lane & 15; float s = 0.f;
        for (int k = 0; k < 128; ++k) s += fp8p_a(row, k) * fp8p_b(k, col);
        bad |= (acc[r] != s); }
    return bad;
}
#endif

#ifdef PROBE_FP4
typedef int v8i_p4 __attribute__((ext_vector_type(8)));
__device__ __forceinline__ float fp4p_a(int i, int k) { return (float)(((i * 7 + k * 3) % 5) - 2); }
__device__ __forceinline__ float fp4p_b(int k, int j) { return (float)(((k * 5 + j * 11) % 7) - 3); }
__device__ __forceinline__ bool fp4_probe(int lane) {
    v8i_p4 A, B;
#pragma unroll
    for (int v = 0; v < 8; ++v) { A[v] = 0; B[v] = 0; }
    const int g = lane >> 4;
#pragma unroll
    for (int v = 0; v < 4; ++v) { unsigned wa = 0u, wb = 0u;
#if PROBE_FP4 == 1
#define FP4P_K(by) const int k0 = 32 * g + 8 * v + 2 * (by), k1 = k0 + 1
#else
#define FP4P_K(by) const int k1 = 32 * g + 8 * v + 2 * (by), k0 = k1 + 1
#endif
#define FP4P_BYTE(by) { FP4P_K(by); wa = __builtin_amdgcn_cvt_scalef32_pk_fp4_f32(wa, fp4p_a(lane & 15, k0), fp4p_a(lane & 15, k1), 1.0f, by); wb = __builtin_amdgcn_cvt_scalef32_pk_fp4_f32(wb, fp4p_b(k0, lane & 15), fp4p_b(k1, lane & 15), 1.0f, by); }
        FP4P_BYTE(0) FP4P_BYTE(1) FP4P_BYTE(2) FP4P_BYTE(3)
#undef FP4P_BYTE
#undef FP4P_K
        A[v] = (int)wa; B[v] = (int)wb; }
    f32x4 acc = {0.f, 0.f, 0.f, 0.f};
    acc = __builtin_amdgcn_mfma_scale_f32_16x16x128_f8f6f4(A, B, acc, 4, 4, 0, 0x7F7F7F7F, 0, 0x7F7F7F7F);
    bool bad = false;
#pragma unroll
    for (int r = 0; r < 4; ++r) { const int row = 4 * (lane >> 4) + r, col = lane & 15; float s = 0.f;
        for (int k = 0; k < 128; ++k) s += fp4p_a(row, k) * fp4p_b(k, col);
        bad |= (acc[r] != s); }
    return bad;
}
#endif

constexpr int PH_PER_LAYER = 14, N_PHASES = 1 + DEPTH * PH_PER_LAYER;
__global__ void __launch_bounds__(NWAVES * 64, 2) mk_fwd(Args args) {
    extern __shared__ __attribute__((aligned(16))) unsigned char lds[];
    Frame F;
    F.lds = (LAS unsigned char*)lds;
    F.MISC = (volatile LAS unsigned*)(F.lds + MISC_OFF);
    F.tid = threadIdx.x; F.lane = F.tid & 63; F.wave = __builtin_amdgcn_readfirstlane(F.tid >> 6);
    F.G = gridDim.x; F.bid = blockIdx.x; { const int bx = blockIdx.x; F.vcu = (F.G % 8 == 0) ? (bx % 8) * (F.G / 8) + bx / 8 : bx; }
    F.ws = args.ws; F.out = args.out; F.ctl = (gu32*)(args.ws + WS_CTL);
    for (int u = F.tid; u < (SCR_OFF - LDSCTL_OFF) / 4; u += NWAVES * 64) ((LAS unsigned*)(F.lds + LDSCTL_OFF))[u] = 0u;
    __syncthreads();
    XcdBarrier bar; bar.bar = (unsigned*)(F.ctl + CW_BAR); bar.x = 0; bar.st = nullptr;
    if (!MK_PER_PHASE) bar = xcd_barrier_post((unsigned*)(F.ctl + CW_BAR), F.MISC + 8);
    const int lo = args.ph_lo, hi = args.ph_hi;
#ifndef PH_MASK
#define PH_MASK 0xFFFFu
#endif
#define PHON(j) (((PH_MASK) >> (j)) & 1u)
#define IN(k) (lo <= (k) && (k) < hi)
#define PH_ENTER() Frame P = F; InTab A; { KargTab t_ = (KargTab)__builtin_amdgcn_kernarg_segment_ptr(); asm volatile("" : "+s"(t_)); A.in.t = t_; { size_t z_ = 0; asm volatile("" : "+s"(z_)); P.ws = args.ws + z_; P.out = args.out + z_; } asm volatile("" : "+v"(P.tid)); asm volatile("" : "+s"(P.vcu)); asm volatile("" : "+s"(P.G)); asm volatile("" : "+s"(P.bid)); P.lane = P.tid & 63; P.wave = __builtin_amdgcn_readfirstlane(P.tid >> 6); }
#ifdef PROBE_SEAM2
#define SEAM(k) do { if (IN(k) && IN((k) + 1)) { xcd_barrier(bar); xcd_barrier(bar); } } while (0)
#else
#define SEAM(k) do { if (IN(k) && IN((k) + 1)) xcd_barrier(bar); } while (0)
#endif

    if (PHON(14) && IN(0)) { PH_ENTER(); adaln_mod(P, A); rope_table(P); convert_small_weights(P, A); }
    SEAM(0);

    for (int l = 0; l < DEPTH; ++l) {
        const int k0 = 1 + PH_PER_LAYER * l;
        if (PHON(0) && IN(k0 + 0)) { PH_ENTER(); convert_moe_weights(P, A, l, 2);
            filter_time_tiles(P, A, l); if (l == 0) norm_mod_rows(P, A, l, A.in[I_N1G] + (size_t)l * D, 0, D);
#ifdef PROBE_NORMROWS_TWICE
            norm_mod_rows(P, A, l, A.in[I_N1G] + (size_t)l * D, 0, D);
#endif
#ifdef PROBE_FTILES_TWICE
            filter_time_tiles(P, A, l);
#endif
        }
        SEAM(k0 + 0);
        if (PHON(1) && IN(k0 + 1)) { PH_ENTER();
            { pg8::Gemm g{(const bf16*)(P.ws + WS_H), (const bf16*)(P.ws + WS_WIN) + (size_t)l * INW * D, T, NHY, D, 1 << 30, 1, 0}; pg8::StaticOrder S; S.init(T, NHY, P.G, P.bid);
              pg8::EpiColMajor E{(float*)(P.ws + WS_HYT), TPAD}; pg8::gemm_phase<pg8::EpiColMajor, pg8::StaticOrder, true, true, true>(P.lds + RING_OFF, g, S, E);
#ifdef PROBE_PROJHY_TWICE
              pg8::gemm_phase<pg8::EpiColMajor, pg8::StaticOrder, true, true, true>(P.lds + RING_OFF, g, S, E);
#endif
            }
            { pg8::Gemm g{(const bf16*)(P.ws + WS_H), (const bf16*)(P.ws + WS_WIN) + (size_t)l * INW * D + (size_t)NHY * D, T, INW - NHY, D, 1 << 30, 1, 0}; pg8::StaticOrder S; S.init(T, INW - NHY, P.G, P.bid);
              pg8::EpiBf16<0> E{(bf16*)(P.ws + WS_PROJ) + NHY, INW, nullptr, 0, 0, 1.f}; pg8::gemm_phase<pg8::EpiBf16<0>, pg8::StaticOrder, true, true>(P.lds + RING_OFF, g, S, E);
#ifdef PROBE_PROJREST_TWICE
              pg8::gemm_phase<pg8::EpiBf16<0>, pg8::StaticOrder, true, true>(P.lds + RING_OFF, g, S, E);
#endif
            }
        }
        if (PHON(2) && IN(k0 + 2)) { PH_ENTER(); filter_fft_units(P); }
        SEAM(k0 + 2);
        if (PHON(3) && IN(k0 + 3)) { PH_ENTER(); hyena_units(P, A, l);
#if MK_ATTN_SIMPLE
            attention_simple(P, A, l);
#else
            attention_mfma(P, A, l);
#ifdef PROBE_ATTN_TWICE
            attention_mfma(P, A, l);
#endif
#ifdef PROBE_HYENA_TWICE
            hyena_units(P, A, l);
#endif
#endif
 }
        SEAM(k0 + 3);
        if (PHON(4) && IN(k0 + 4)) { PH_ENTER(); z2_transpose(P); }
        SEAM(k0 + 4);
        if (PHON(5) && IN(k0 + 5)) { PH_ENTER();
            pg8::Gemm g{(const bf16*)(P.ws + WS_Z2AT), (const bf16*)(P.ws + WS_WHY) + (size_t)l * D * ZAP, T, D, ZAP, 1 << 30, 1, 0}; pg8::StaticOrder S; S.init(T, D, P.G, P.bid);
            pg8::EpiGate2 E{(bf16*)(P.ws + WS_MERGED), D, (const bf16*)(P.ws + WS_PROJ) + COL_G, (const bf16*)(P.ws + WS_PROJ) + COL_G + D, INW};
            pg8::gemm_phase<pg8::EpiGate2, pg8::StaticOrder, true, true>(P.lds + RING_OFF, g, S, E); }
        SEAM(k0 + 5);
        if (PHON(7) && IN(k0 + 7)) { PH_ENTER(); pg8::Gemm g{(const bf16*)(P.ws + WS_MERGED), (const bf16*)(P.ws + WS_WO) + (size_t)l * D * D, T, D, D, 1 << 30, 1, 0}; pg8::StaticOrder S; S.init(T, D, P.G, P.bid);
            pg8::EpiResid E{l == 0 ? A.in[I_XP] : (const float*)P.out, l == 0 ? A.in[I_XS] : (const float*)P.out + (size_t)TP * D, P.out, (const float*)(P.ws + WS_MOD) + (size_t)l * NMOD * 6 * D + 2 * D, TP, TS, 6 * D, D};
            pg8::gemm_phase<pg8::EpiResid, pg8::StaticOrder, true, true>(P.lds + RING_OFF, g, S, E); }
        SEAM(k0 + 7);
        if (PHON(8) && IN(k0 + 8)) { PH_ENTER(); resid_norm_router2(P, A, l);
#ifdef PROBE_RESID_TWICE
            if (l == 0) resid_norm_router2(P, A, l);
#endif
        }
        SEAM(k0 + 8);
        if (PHON(9) && IN(k0 + 9)) { PH_ENTER();
#if MK_TOPK_RANK
            topk_rank(P);
#else
            topk_select(P);
#endif
            convert_moe_weights(P, A, l, 1);
        }
        SEAM(k0 + 9);
        if (PHON(10) && IN(k0 + 10)) { PH_ENTER(); gather_rows(P); }
        SEAM(k0 + 10);
        if (PHON(11) && IN(k0 + 11)) { PH_ENTER(); pg8::Gemm g{(const bf16*)(P.ws + WS_XE), (const bf16*)(P.ws + WS_WGU), NSLOT, 2 * FF, KB_UP / 2, CAP / 256, NE, (size_t)2 * FF * KB_UP}; pg8::StaticOrder S; S.init(NSLOT, 2 * FF, P.G, P.bid);
            pg8::EpiSwiGLU4 E{(unsigned char*)(P.ws + WS_HID), KB_DN, 1.0f / 64.0f, 2.0f}; pg8::gemm_phase4<pg8::EpiSwiGLU4, pg8::StaticOrder, true, true>(P.lds + RING_OFF, g, S, E);
#ifdef PROBE_UPVAR
            __syncthreads(); { pg8::EpiSwiGLU4 E2{(unsigned char*)(P.ws + WS_YE), KB_DN, 1.0f / 64.0f, 2.0f}; pg8::gemm_phase4<pg8::EpiSwiGLU4, pg8::StaticOrder, true, true, PROBE_UPVAR>(P.lds + RING_OFF, g, S, E2); }
#endif
        }
        SEAM(k0 + 11);
        if (PHON(12) && IN(k0 + 12)) { PH_ENTER(); pg8::Gemm g{(const bf16*)(P.ws + WS_HID), (const bf16*)(P.ws + WS_WD), NSLOT, D, KB_DN / 2, CAP / 256, NE, (size_t)D * KB_DN}; pg8::StaticOrder S; S.init(NSLOT, D, P.G, P.bid);
            pg8::EpiBf16S E{(bf16*)(P.ws + WS_YE), D, 1.0f / 256.0f}; pg8::gemm_phase4<pg8::EpiBf16S, pg8::StaticOrder, true, true>(P.lds + RING_OFF, g, S, E); }
        SEAM(k0 + 12);
        if (PHON(13) && IN(k0 + 13)) { PH_ENTER(); moe_combine2(P, l, 1.0f, l + 1 < DEPTH ? l + 1 : -1, A.in[I_N1G] + (size_t)(l + 1 < DEPTH ? l + 1 : 0) * D);
#ifdef PROBE_COMBINE_TWICE
            moe_combine2(P, l, (float)__hip_atomic_load(P.ctl + 8, __ATOMIC_RELAXED, __HIP_MEMORY_SCOPE_AGENT), -1, nullptr);
#endif
#ifdef PROBE_CONVERT_TWICE
            if (l + 1 < DEPTH) convert_moe_weights<PROBE_CONVERT_TWICE>(P, A, l + 1);
#endif
        }
    }
#ifdef PROBE_MFMA
    if (hi == N_PHASES) {
        typedef int pv4 __attribute__((ext_vector_type(4))); typedef int pv8 __attribute__((ext_vector_type(8)));
        f32x4 c0 = {0.f, 0.f, 0.f, 0.f}, c1 = c0, c2 = c0, c3 = c0, c4 = c0, c5 = c0, c6 = c0, c7 = c0; f32x16 d0 = {}, d1 = {}, d2 = {}, d3 = {};
        pv4 a = {0, 0, 0, 0}, b = {0, 0, 0, 0}; pv8 a8 = {}, b8 = {}; int sc = 0x7F7F7F7F; asm volatile("" : "+v"(a), "+v"(b), "+v"(sc), "+v"(a8), "+v"(b8));
#pragma unroll 1
        for (int it = 0; it < PROBE_MFMA_N; ++it) {
#if PROBE_MFMA == 1
#define PM(c) asm volatile("v_mfma_scale_f32_16x16x128_f8f6f4 %0, %1, %2, %0, %3, %3 op_sel_hi:[0,0,0] cbsz:4 blgp:4" : "+v"(c) : "v"(a), "v"(b), "v"(sc))
            PM(c0); PM(c1); PM(c2); PM(c3); PM(c4); PM(c5); PM(c6); PM(c7);
#elif PROBE_MFMA == 2
#define PM(c) asm volatile("v_mfma_f32_16x16x128_f8f6f4 %0, %1, %2, %0 cbsz:4 blgp:4" : "+v"(c) : "v"(a), "v"(b))
            PM(c0); PM(c1); PM(c2); PM(c3); PM(c4); PM(c5); PM(c6); PM(c7);
#elif PROBE_MFMA == 3
#define PM(c) asm volatile("v_mfma_scale_f32_32x32x64_f8f6f4 %0, %1, %2, %0, %3, %3 op_sel_hi:[0,0,0] cbsz:4 blgp:4" : "+v"(c) : "v"(a), "v"(b), "v"(sc))
            PM(d0); PM(d1); PM(d2); PM(d3);
#elif PROBE_MFMA == 4
#define PM(c) asm volatile("v_mfma_scale_f32_16x16x128_f8f6f4 %0, %1, %2, %0, %3, %3 op_sel_hi:[0,0,0]" : "+v"(c) : "v"(a8), "v"(b8), "v"(sc))
            PM(c0); PM(c1); PM(c2); PM(c3); PM(c4); PM(c5); PM(c6); PM(c7);
#elif PROBE_MFMA == 5
#define PM(c) asm volatile("v_mfma_f32_16x16x32_bf16 %0, %1, %2, %0" : "+v"(c) : "v"(a), "v"(b))
            PM(c0); PM(c1); PM(c2); PM(c3); PM(c4); PM(c5); PM(c6); PM(c7);
#endif
        }
        asm volatile("s_nop 15\n\ts_nop 15" ::: "memory");
        const float sum = c0[0] + c1[1] + c2[2] + c3[3] + c4[0] + c5[1] + c6[2] + c7[3] + d0[0] + d1[5] + d2[9] + d3[15];
        if (sum != 0.f) F.out[1] = __builtin_nanf("");
    }
#endif
#ifdef PROBE_FP4
    if (blockIdx.x == 0 && threadIdx.x < 64 && hi == N_PHASES) { const bool bad = fp4_probe((int)threadIdx.x); if (__any(bad) && threadIdx.x == 0) F.out[0] = __builtin_nanf(""); }
#endif
#ifdef PROBE_FP8
    if (blockIdx.x == 0 && threadIdx.x < 64 && hi == N_PHASES) { const bool bad = fp8_probe((int)threadIdx.x); if (__any(bad) && threadIdx.x == 0) F.out[0] = __builtin_nanf(""); }
#endif
#undef IN
#undef SEAM
}

#if defined(__HIP_DEVICE_COMPILE__) && MK_NOPK
#pragma clang attribute pop
#endif
extern "C" void kernel_launch(void* const* d_in, const int* in_sizes, int n_in, void* d_out, int out_size, void* d_ws, size_t ws_size, hipStream_t stream) {
    static int grid = 0;
    if (grid == 0) {
        if (n_in != 30 || in_sizes[0] != TP * D || out_size != T * D || ws_size < WS_END) { fprintf(stderr, "kernel_launch: shape/workspace mismatch: n_in %d in0 %d out %d ws %zu (need %zu); nothing launched\n", n_in, n_in > 0 ? in_sizes[0] : -1, out_size, ws_size, (size_t)WS_END); grid = -1; return; }
        int dev = 0, cus = 0, per_cu = 0;
        if (hipGetDevice(&dev) != hipSuccess || hipDeviceGetAttribute(&cus, hipDeviceAttributeMultiprocessorCount, dev) != hipSuccess) { fprintf(stderr, "kernel_launch: device query failed\n"); grid = -1; return; }
        if (hipFuncSetAttribute((const void*)mk_fwd, hipFuncAttributeMaxDynamicSharedMemorySize, LDS_BYTES) != hipSuccess) { fprintf(stderr, "kernel_launch: hipFuncSetAttribute failed\n"); grid = -1; return; }
        if (hipOccupancyMaxActiveBlocksPerMultiprocessor(&per_cu, (const void*)mk_fwd, NWAVES * 64, LDS_BYTES) != hipSuccess || per_cu < 1) fprintf(stderr, "kernel_launch: note: occupancy query reports %d\n", per_cu);
        (void)hipGetLastError();
        grid = cus;
    }
    if (grid < 0) return;
    if (hipMemsetAsync((char*)d_ws + WS_CTL, 0, CTL_ZERO_BYTES, stream) != hipSuccess) { fprintf(stderr, "kernel_launch: memset failed\n"); return; }
    Args a{};
    for (int i = 0; i < 30; ++i) a.in[i] = (const float*)d_in[i];
    a.out = (float*)d_out; a.ws = (unsigned char*)d_ws;
#if MK_PER_PHASE
    for (int k = 0; k < N_PHASES; ++k) { a.ph_lo = k; a.ph_hi = k + 1; hipLaunchKernelGGL(mk_fwd, dim3(grid), dim3(NWAVES * 64), LDS_BYTES, stream, a); }
#else
    a.ph_lo = 0; a.ph_hi = N_PHASES; hipLaunchKernelGGL(mk_fwd, dim3(grid), dim3(NWAVES * 64), LDS_BYTES, stream, a);
#endif
    const hipError_t le = hipPeekAtLastError();
    if (le != hipSuccess) fprintf(stderr, "kernel_launch: launch failed: %s\n", hipGetErrorName(le));
}
```
